# Optimizing an MI355X kernel written in HIP

```python
import jax, jax.numpy as jnp
from jax import lax
import numpy as np

D_MODEL = 1024
BATCH = 4
SEQ = 8192
DEPTH = 2

D_MIX = D_MODEL
LRU_WIDTH = D_MIX // 4
LRU_BLOCKS = 4
LRU_BLOCK_W = LRU_WIDTH // LRU_BLOCKS
CONV_WIDTH = 4
LRU_C = 8.0
MLA_HEADS = 6
MLA_NOPE = 64
MLA_ROPE = 32
MLA_V = 64
MLA_Q_RANK = 192
MLA_KV_RANK = 128
NSA_HEADS = 6
NSA_KV_HEADS = 2
NSA_GROUP = NSA_HEADS // NSA_KV_HEADS
NSA_HEAD_DIM = 64
NSA_KV = NSA_KV_HEADS * NSA_HEAD_DIM
CMP_LEN = 32
CMP_STRIDE = 16
CMP_HIDDEN = 128
SEL_LEN = 64
SEL_TOPK = 16
WINDOW = 512
FORCE_BONUS = 1.0e3
Q_BLOCK = 128
D_FF = 2816
N_EXPERTS = 8
TOP_K = 2
D_FF_EXPERT = 1408
N_DENSE = (DEPTH + 1) // 2
N_MOE = DEPTH // 2
ROPE_THETA = 10000.0
EPS = 1e-6
NEG_INF = -1.0e30
IN_SPLITS = (LRU_WIDTH, LRU_WIDTH,
             MLA_Q_RANK, MLA_KV_RANK, MLA_ROPE,
             NSA_HEADS * NSA_HEAD_DIM, NSA_KV, NSA_KV, NSA_KV, NSA_KV, NSA_KV, NSA_KV, 3 * NSA_HEADS)
IN_COLS = sum(IN_SPLITS)

kernel_name = 'hymba_style_lru_mla_nsa_moe_block'


def rmsnorm(x, g):
    xf = x.astype(jnp.float32)
    y = xf * lax.rsqrt(jnp.mean(xf * xf, axis=-1, keepdims=True) + EPS)
    return (y * g.astype(jnp.float32)).astype(x.dtype)


def masked_softmax(s, mask):
    s = jnp.where(mask, s, NEG_INF)
    m = jnp.max(s, axis=-1, keepdims=True)
    e = jnp.where(mask, jnp.exp(s - m), 0.0)
    return e / jnp.maximum(jnp.sum(e, axis=-1, keepdims=True), 1e-30)


def rope(x, pos):
    d = x.shape[-1]
    half = d // 2
    inv = ROPE_THETA ** (-jnp.arange(half, dtype=jnp.float32) * 2.0 / d)
    ang = pos.astype(jnp.float32)[:, None] * inv[None, :]
    cos = jnp.cos(ang)[None, :, None, :].astype(x.dtype)
    sin = jnp.sin(ang)[None, :, None, :].astype(x.dtype)
    x1, x2 = x[..., :half], x[..., half:]
    return jnp.concatenate([x1 * cos - x2 * sin, x2 * cos + x1 * sin], axis=-1)


def causal_conv(x, w, b):
    S = x.shape[1]
    xp = jnp.pad(x, ((0, 0), (CONV_WIDTH - 1, 0), (0, 0)))
    out = b
    for k in range(CONV_WIDTH):
        out = out + xp[:, k:k + S] * w[k]
    return out


def block_diag(x, w, b):
    B, S, _ = x.shape
    y = jnp.einsum('bsnc,ncd->bsnd', x.reshape(B, S, LRU_BLOCKS, LRU_BLOCK_W), w)
    return y.reshape(B, S, LRU_WIDTH) + b


def rg_lru(x, wa, ba, wx, bx, lam):
    r = jax.nn.sigmoid(block_diag(x, wa, ba)).astype(jnp.float32)
    i = jax.nn.sigmoid(block_diag(x, wx, bx)).astype(jnp.float32)
    log_a = -LRU_C * r * jax.nn.softplus(-lam.astype(jnp.float32))
    a = jnp.exp(log_a)
    b = jnp.sqrt(-jnp.expm1(2.0 * log_a)) * (i * x.astype(jnp.float32))

    def combine(lhs, rhs):
        a1, b1 = lhs
        a2, b2 = rhs
        return a1 * a2, a2 * b1 + b2

    _, h = lax.associative_scan(combine, (a, b), axis=1)
    return h.astype(x.dtype)


def recurrent_group(x_in, y_in, conv_w, conv_b, wa, ba, wx, bx, lam):
    xc = causal_conv(x_in, conv_w, conv_b)
    return rg_lru(xc, wa, ba, wx, bx, lam) * jax.nn.gelu(y_in)


def causal_block_attention(q, k, v, scale):
    B, S, H, Dk = q.shape
    Dv = v.shape[-1]
    nb = S // Q_BLOCK
    qb = q.reshape(B, nb, Q_BLOCK, H, Dk).transpose(1, 0, 2, 3, 4)
    kpos = jnp.arange(S)

    def one(args):
        qi, bidx = args
        qpos = bidx * Q_BLOCK + jnp.arange(Q_BLOCK)
        s = jnp.einsum('bqhd,bkhd->bhqk', qi, k).astype(jnp.float32) * scale
        p = masked_softmax(s, (kpos[None, :] <= qpos[:, None])[None, None])
        return jnp.einsum('bhqk,bkhd->bqhd', p.astype(v.dtype), v)

    o = lax.map(one, (qb, jnp.arange(nb)))
    return o.transpose(1, 0, 2, 3, 4).reshape(B, S, H * Dv)


def mla_group(q_dn, kv_dn, k_pe, pos, q_norm, w_uq, kv_norm, w_ukv):
    B, S, _ = q_dn.shape
    q = (rmsnorm(q_dn, q_norm) @ w_uq).reshape(B, S, MLA_HEADS, MLA_NOPE + MLA_ROPE)
    q = jnp.concatenate([q[..., :MLA_NOPE], rope(q[..., MLA_NOPE:], pos)], axis=-1)
    kv = (rmsnorm(kv_dn, kv_norm) @ w_ukv).reshape(B, S, MLA_HEADS, MLA_NOPE + MLA_V)
    k_rope = jnp.broadcast_to(rope(k_pe[:, :, None, :], pos), (B, S, MLA_HEADS, MLA_ROPE))
    k = jnp.concatenate([kv[..., :MLA_NOPE], k_rope], axis=-1)
    v = kv[..., MLA_NOPE:]
    return causal_block_attention(q, k, v, (MLA_NOPE + MLA_ROPE) ** -0.5)


def compress(kv, pos_emb, w1, w2):
    B, S = kv.shape[0], kv.shape[1]
    nc = (S - CMP_LEN) // CMP_STRIDE + 1
    idx = jnp.arange(nc)[:, None] * CMP_STRIDE + jnp.arange(CMP_LEN)[None, :]
    win = kv[:, idx] + pos_emb[None, None, :, None, :]
    flat = win.transpose(0, 1, 3, 2, 4).reshape(B, nc, NSA_KV_HEADS, CMP_LEN * NSA_HEAD_DIM)
    return jax.nn.gelu(flat @ w1) @ w2


def nsa_group(q_in, kc_in, vc_in, ks_in, vs_in, kw_in, vw_in, g_in, gate_b, pos, cmp_pos, cmp_w1, cmp_w2):
    B, S, _ = q_in.shape
    G, P, D = NSA_KV_HEADS, NSA_GROUP, NSA_HEAD_DIM
    q = rope(q_in.reshape(B, S, NSA_HEADS, D), pos)
    kc = compress(rope(kc_in.reshape(B, S, G, D), pos), cmp_pos[0], cmp_w1[0], cmp_w2[0])
    vc = compress(vc_in.reshape(B, S, G, D), cmp_pos[1], cmp_w1[1], cmp_w2[1])
    nc = kc.shape[1]
    ns = S // SEL_LEN
    n_top = min(SEL_TOPK, ns)
    ks_blk = rope(ks_in.reshape(B, S, G, D), pos).reshape(B, ns, SEL_LEN, G, D).transpose(0, 3, 1, 2, 4)
    vs_blk = vs_in.reshape(B, ns, SEL_LEN, G, D).transpose(0, 3, 1, 2, 4)
    pad = ((0, 0), (WINDOW, 0), (0, 0), (0, 0))
    kw_p = jnp.pad(rope(kw_in.reshape(B, S, G, D), pos), pad)
    vw_p = jnp.pad(vw_in.reshape(B, S, G, D), pad)
    gates = jax.nn.sigmoid(g_in + gate_b)

    cmp_start = jnp.arange(nc) * CMP_STRIDE
    cmp_end = cmp_start + CMP_LEN - 1
    sel_start = jnp.arange(ns) * SEL_LEN
    overlap = ((cmp_start[:, None] < sel_start[None, :] + SEL_LEN)
               & (cmp_end[:, None] >= sel_start[None, :])).astype(jnp.float32)
    scale = D ** -0.5
    nb = S // Q_BLOCK
    qb = q.reshape(B, nb, Q_BLOCK, G, P, D).transpose(1, 0, 2, 3, 4, 5)
    gb = gates.reshape(B, nb, Q_BLOCK, G, P, 3).transpose(1, 0, 2, 3, 4, 5)
    b_ix = jnp.arange(B)[:, None, None, None]
    g_ix = jnp.arange(G)[None, :, None, None]

    def one(args):
        qi, gt, bidx = args
        dt = qi.dtype
        qpos = bidx * Q_BLOCK + jnp.arange(Q_BLOCK)
        s_c = jnp.einsum('bqgpd,bngd->bgpqn', qi, kc).astype(jnp.float32) * scale
        p_c = masked_softmax(s_c, cmp_end[None, :] <= qpos[:, None])
        o_c = jnp.einsum('bgpqn,bngd->bqgpd', p_c.astype(dt), vc)
        imp = jnp.einsum('bgpqn,ns->bgqs', p_c, overlap)
        valid = sel_start[None, :] <= qpos[:, None]
        forced = (sel_start[None, :] == 0) | (sel_start[None, :] == ((qpos // SEL_LEN) * SEL_LEN)[:, None])
        score = jnp.where(valid, imp, -1.0)
        score = jnp.where(forced, score + FORCE_BONUS, score)
        top_val, top_idx = lax.top_k(score, n_top)
        k_sel = ks_blk[b_ix, g_ix, top_idx]
        v_sel = vs_blk[b_ix, g_ix, top_idx]
        kpos = top_idx[..., None] * SEL_LEN + jnp.arange(SEL_LEN)
        m_s = (kpos <= qpos[None, None, :, None, None]) & (top_val >= 0.0)[..., None]
        s_s = jnp.einsum('bqgpd,bgqkld->bgpqkl', qi, k_sel).astype(jnp.float32) * scale
        p_s = masked_softmax(s_s.reshape(B, G, P, Q_BLOCK, n_top * SEL_LEN),
                             m_s.reshape(B, G, 1, Q_BLOCK, n_top * SEL_LEN))
        o_s = jnp.einsum('bgpqkl,bgqkld->bqgpd',
                         p_s.reshape(B, G, P, Q_BLOCK, n_top, SEL_LEN).astype(dt), v_sel)
        k_win = lax.dynamic_slice_in_dim(kw_p, bidx * Q_BLOCK, Q_BLOCK + WINDOW, axis=1)
        v_win = lax.dynamic_slice_in_dim(vw_p, bidx * Q_BLOCK, Q_BLOCK + WINDOW, axis=1)
        wpos = bidx * Q_BLOCK - WINDOW + jnp.arange(Q_BLOCK + WINDOW)
        dist = qpos[:, None] - wpos[None, :]
        m_w = (wpos[None, :] >= 0) & (dist >= 0) & (dist < WINDOW)
        s_w = jnp.einsum('bqgpd,bkgd->bgpqk', qi, k_win).astype(jnp.float32) * scale
        p_w = masked_softmax(s_w, m_w)
        o_w = jnp.einsum('bgpqk,bkgd->bqgpd', p_w.astype(dt), v_win)
        out = gt[..., 0:1] * o_c + gt[..., 1:2] * o_s + gt[..., 2:3] * o_w
        return out.reshape(B, Q_BLOCK, NSA_HEADS * D)

    o = lax.map(one, (qb, gb, jnp.arange(nb)))
    return o.transpose(1, 0, 2, 3).reshape(B, S, NSA_HEADS * D)


def mixer(h, pos, w_in, conv_w, conv_b, wa, ba, wx, bx, lam, q_norm, w_uq, kv_norm, w_ukv,
          cmp_pos, cmp_w1, cmp_w2, gate_b, w_out):
    u = h @ w_in
    (x_lru, y_lru, q_dn, kv_dn, k_pe, q_n, kc, vc, ks, vs, kw, vw, g_n) = jnp.split(
        u, np.cumsum(IN_SPLITS)[:-1].tolist(), axis=-1)
    a_out = recurrent_group(x_lru, y_lru, conv_w, conv_b, wa, ba, wx, bx, lam)
    b_out = mla_group(q_dn, kv_dn, k_pe, pos, q_norm, w_uq, kv_norm, w_ukv)
    c_out = nsa_group(q_n, kc, vc, ks, vs, kw, vw, g_n, gate_b, pos, cmp_pos, cmp_w1, cmp_w2)
    return jnp.concatenate([a_out, b_out, c_out], axis=-1) @ w_out


def swiglu(x, wg, wu, wd):
    return (jax.nn.silu(x @ wg) * (x @ wu)) @ wd


def moe_ffn(x, router_w, wg, wu, wd):
    logits = (x @ router_w).astype(jnp.float32)
    top_val, top_idx = lax.top_k(logits, TOP_K)
    w = jax.nn.softmax(top_val, axis=-1)
    gate = jnp.sum(jax.nn.one_hot(top_idx, N_EXPERTS, dtype=jnp.float32) * w[..., None], axis=-2).astype(x.dtype)
    y = jnp.zeros_like(x)
    for e in range(N_EXPERTS):
        y = y + gate[..., e:e + 1] * swiglu(x, wg[e], wu[e], wd[e])
    return y


def setup_inputs(seed: int = 0) -> dict:
    key = jax.random.key(seed)
    keys = iter(jax.random.split(key, 32))
    f32 = jnp.float32

    def nrm(shape, fan):
        return jax.random.normal(next(keys), shape, f32) * fan ** -0.5

    def small(shape, s=0.01):
        return jax.random.normal(next(keys), shape, f32) * s

    def gain(shape):
        return 1.0 + small(shape)

    x = jax.random.normal(next(keys), (BATCH, SEQ, D_MODEL), f32)
    norm_mix = gain((DEPTH, D_MODEL))
    w_in = nrm((DEPTH, D_MODEL, IN_COLS), D_MODEL)
    lru_conv_w = nrm((DEPTH, CONV_WIDTH, LRU_WIDTH), CONV_WIDTH)
    lru_conv_b = small((DEPTH, LRU_WIDTH))
    lru_wa = nrm((DEPTH, LRU_BLOCKS, LRU_BLOCK_W, LRU_BLOCK_W), LRU_BLOCK_W)
    lru_ba = small((DEPTH, LRU_WIDTH))
    lru_wx = nrm((DEPTH, LRU_BLOCKS, LRU_BLOCK_W, LRU_BLOCK_W), LRU_BLOCK_W)
    lru_bx = small((DEPTH, LRU_WIDTH))
    a_c = jax.random.uniform(next(keys), (DEPTH, LRU_WIDTH), f32, minval=0.9, maxval=0.999)
    a0 = a_c ** (1.0 / LRU_C)
    lru_lambda = jnp.log(a0) - jnp.log1p(-a0)
    mla_q_norm = gain((DEPTH, MLA_Q_RANK))
    mla_w_uq = nrm((DEPTH, MLA_Q_RANK, MLA_HEADS * (MLA_NOPE + MLA_ROPE)), MLA_Q_RANK)
    mla_kv_norm = gain((DEPTH, MLA_KV_RANK))
    mla_w_ukv = nrm((DEPTH, MLA_KV_RANK, MLA_HEADS * (MLA_NOPE + MLA_V)), MLA_KV_RANK)
    nsa_cmp_pos = small((DEPTH, 2, CMP_LEN, NSA_HEAD_DIM), 0.02)
    nsa_cmp_w1 = nrm((DEPTH, 2, CMP_LEN * NSA_HEAD_DIM, CMP_HIDDEN), CMP_LEN * NSA_HEAD_DIM)
    nsa_cmp_w2 = nrm((DEPTH, 2, CMP_HIDDEN, NSA_HEAD_DIM), CMP_HIDDEN)
    nsa_gate_b = small((DEPTH, 3 * NSA_HEADS))
    w_out = nrm((DEPTH, D_MIX, D_MODEL), D_MIX)
    norm_ffn = gain((DEPTH, D_MODEL))
    ffn_w_gate = nrm((N_DENSE, D_MODEL, D_FF), D_MODEL)
    ffn_w_up = nrm((N_DENSE, D_MODEL, D_FF), D_MODEL)
    ffn_w_down = nrm((N_DENSE, D_FF, D_MODEL), D_FF)
    router_w = nrm((N_MOE, D_MODEL, N_EXPERTS), D_MODEL)
    moe_w_gate = nrm((N_MOE, N_EXPERTS, D_MODEL, D_FF_EXPERT), D_MODEL)
    moe_w_up = nrm((N_MOE, N_EXPERTS, D_MODEL, D_FF_EXPERT), D_MODEL)
    moe_w_down = nrm((N_MOE, N_EXPERTS, D_FF_EXPERT, D_MODEL), D_FF_EXPERT)
    norm_final = gain((D_MODEL,))
    return {'x': x, 'norm_mix': norm_mix, 'w_in': w_in, 'lru_conv_w': lru_conv_w, 'lru_conv_b': lru_conv_b,
            'lru_wa': lru_wa, 'lru_ba': lru_ba, 'lru_wx': lru_wx, 'lru_bx': lru_bx, 'lru_lambda': lru_lambda,
            'mla_q_norm': mla_q_norm, 'mla_w_uq': mla_w_uq, 'mla_kv_norm': mla_kv_norm, 'mla_w_ukv': mla_w_ukv,
            'nsa_cmp_pos': nsa_cmp_pos, 'nsa_cmp_w1': nsa_cmp_w1, 'nsa_cmp_w2': nsa_cmp_w2, 'nsa_gate_b': nsa_gate_b,
            'w_out': w_out, 'norm_ffn': norm_ffn, 'ffn_w_gate': ffn_w_gate, 'ffn_w_up': ffn_w_up,
            'ffn_w_down': ffn_w_down, 'router_w': router_w, 'moe_w_gate': moe_w_gate, 'moe_w_up': moe_w_up,
            'moe_w_down': moe_w_down, 'norm_final': norm_final}


def reference(x, norm_mix, w_in, lru_conv_w, lru_conv_b, lru_wa, lru_ba, lru_wx, lru_bx, lru_lambda,
              mla_q_norm, mla_w_uq, mla_kv_norm, mla_w_ukv, nsa_cmp_pos, nsa_cmp_w1, nsa_cmp_w2, nsa_gate_b,
              w_out, norm_ffn, ffn_w_gate, ffn_w_up, ffn_w_down, router_w, moe_w_gate, moe_w_up,
              moe_w_down, norm_final):
    pos = jnp.arange(x.shape[1])
    for l in range(DEPTH):
        h = rmsnorm(x, norm_mix[l])
        x = x + mixer(h, pos, w_in[l], lru_conv_w[l], lru_conv_b[l], lru_wa[l], lru_ba[l], lru_wx[l],
                      lru_bx[l], lru_lambda[l], mla_q_norm[l], mla_w_uq[l], mla_kv_norm[l], mla_w_ukv[l],
                      nsa_cmp_pos[l], nsa_cmp_w1[l], nsa_cmp_w2[l], nsa_gate_b[l], w_out[l])
        h = rmsnorm(x, norm_ffn[l])
        if l % 2 == 0:
            j = l // 2
            x = x + swiglu(h, ffn_w_gate[j], ffn_w_up[j], ffn_w_down[j])
        else:
            j = l // 2
            x = x + moe_ffn(h, router_w[j], moe_w_gate[j], moe_w_up[j], moe_w_down[j])
    return rmsnorm(x, norm_final)
```

```cpp
#include <hip/hip_runtime.h>
#include <cstdint>
#include <cstdio>
#ifndef DUP
#define DUP 0
#endif
#ifndef ALPHA_MOE
#define ALPHA_MOE 1.0f
#endif
#ifndef ALPHA_MIX
#define ALPHA_MIX 1.0f
#endif
#ifndef ALPHA_FFN
#define ALPHA_FFN 1.0f
#endif

#define GAS __attribute__((address_space(1)))
#define LAS __attribute__((address_space(3)))
typedef unsigned short bf16;
typedef unsigned v4u __attribute__((ext_vector_type(4)));
typedef unsigned v2u __attribute__((ext_vector_type(2)));
typedef float f32x4 __attribute__((ext_vector_type(4)));
typedef float f32x2 __attribute__((ext_vector_type(2)));
typedef short bf16x8 __attribute__((ext_vector_type(8)));
typedef GAS unsigned gu32;
typedef float f32x16 __attribute__((ext_vector_type(16)));
typedef short s16x4 __attribute__((ext_vector_type(4)));
__device__ __forceinline__ int crow(int r, int hi) { return (r & 3) + 8 * (r >> 2) + 4 * hi; }
#define RLX_AGENT __ATOMIC_RELAXED, __HIP_MEMORY_SCOPE_AGENT
#define LDS_WAIT() asm volatile("s_waitcnt lgkmcnt(0)" ::: "memory")
#define VM_WAIT() asm volatile("s_waitcnt vmcnt(0)" ::: "memory")

constexpr int NB = 4, SEQ = 8192, DM = 1024, TOK = NB * SEQ, DEPTH = 2;
constexpr int DFF = 2816, NEXP = 8, DFE = 1408;
constexpr float EPS = 1e-6f;
constexpr int NWAVES = 8, NTHR = 512;

constexpr size_t MiB = 1u << 20;
constexpr size_t WS_CTL = 0, CTL_ZERO_BYTES = 1 * MiB;
constexpr size_t WS_TABN = 1 * MiB, WS_TABM = 3 * MiB, WS_MISC = 4 * MiB, WS_LRU = 8 * MiB, WS_SSQ = 12 * MiB, WS_MASK = 14 * MiB, WS_KC = 15 * MiB, WS_G1C = 16 * MiB;
constexpr size_t WS_WIN = 18 * MiB, WS_WQKV = 26 * MiB, WS_WOUT = 29 * MiB, WS_WC1 = 33 * MiB, WS_WGU = 37 * MiB, WS_WD = 48 * MiB, WS_MWGU = 54 * MiB, WS_MWD = 98 * MiB;
constexpr size_t WS_XN = 120 * MiB, WS_CAT = 184 * MiB, WS_PQ = 248 * MiB, WS_U = 280 * MiB, WS_QM = 408 * MiB, WS_KVM = 444 * MiB, WS_END = 492 * MiB;
constexpr size_t WS_OC = WS_XN;
constexpr size_t WS_H = WS_U;
constexpr size_t WS_Y = WS_XN;
constexpr int MAXSLOT = 2 * TOK + NEXP * 256;
static_assert(WS_H + (size_t)MAXSLOT * DFE * 2 <= WS_END && WS_Y + (size_t)MAXSLOT * DM * 2 <= WS_U, "overlays");
constexpr size_t MS_ROUTE = 0;
constexpr size_t MS_TOKSLOT = 512 * 1024;
constexpr size_t MS_ROWLIST = 768 * 1024;
constexpr size_t MS_COUNTS = 1280 * 1024;
constexpr size_t MS_CBIAS = 1300 * 1024;
constexpr size_t MS_EBASE = 1296 * 1024;
constexpr int CW_TMO = 0, CW_BAR = 4096, CW_Q = 16384;

constexpr int NU = 2048, IN_COLS = 2034;
constexpr int C_XL = 0, C_YL = 256, C_QDN = 512, C_KVDN = 704, C_KPE = 832, C_QN = 864, C_KC = 1248, C_VC = 1376, C_KS = 1504, C_VS = 1632, C_KW = 1760, C_VW = 1888, C_GN = 2016;
constexpr float QSCALE_N = 0.125f * 1.4426950408889634f;
constexpr float QSCALE_M = 0.10206207261596575f * 1.4426950408889634f;
__device__ const float INV_N[32] = {1.0f, 0.7498942093324559f, 0.5623413251903491f, 0.4216965034285822f, 0.31622776601683794f, 0.23713737056616552f, 0.1778279410038923f, 0.1333521432163324f, 0.1f, 0.07498942093324558f, 0.05623413251903491f, 0.042169650342858224f, 0.03162277660168379f, 0.023713737056616554f, 0.01778279410038923f, 0.01333521432163324f, 0.01f, 0.007498942093324558f, 0.005623413251903491f, 0.004216965034285823f, 0.0031622776601683794f, 0.0023713737056616554f, 0.0017782794100389228f, 0.001333521432163324f, 0.001f, 0.0007498942093324559f, 0.0005623413251903491f, 0.00042169650342858224f, 0.00031622776601683794f, 0.00023713737056616554f, 0.00017782794100389227f, 0.0001333521432163324f};
__device__ const float INV_M[16] = {1.0f, 0.5623413251903491f, 0.31622776601683794f, 0.1778279410038923f, 0.1f, 0.05623413251903491f, 0.03162277660168379f, 0.01778279410038923f, 0.01f, 0.005623413251903491f, 0.0031622776601683794f, 0.0017782794100389228f, 0.001f, 0.0005623413251903491f, 0.00031622776601683794f, 0.00017782794100389227f};

constexpr int RING_BYTES = 131072, MISC_OFF = RING_BYTES + 320, LDS_BYTES = 147456;

typedef float cvf32x2_t __attribute__((ext_vector_type(2))); typedef __bf16 cvbf16x2_t __attribute__((ext_vector_type(2)));
__device__ __forceinline__ unsigned pk2(float lo, float hi) { const cvf32x2_t v = {lo, hi}; const cvbf16x2_t b = __builtin_convertvector(v, cvbf16x2_t); return __builtin_bit_cast(unsigned, b); }
__device__ __forceinline__ unsigned f2bf(float f) { return pk2(f, 0.0f) & 0xffffu; }
__device__ __forceinline__ float bf2f(unsigned short b) { return __builtin_bit_cast(float, (unsigned)b << 16); }
__device__ __forceinline__ float bflo(unsigned w) { return __builtin_bit_cast(float, w << 16); }
__device__ __forceinline__ float bfhi(unsigned w) { return __builtin_bit_cast(float, w & 0xffff0000u); }
template <int M> __device__ __forceinline__ unsigned xor_u(unsigned u) {
    if constexpr (M == 32) { auto r = __builtin_amdgcn_permlane32_swap(u, u, false, false);
        return (unsigned)r[0] ^ (unsigned)r[1] ^ u; }
    else return (unsigned)__builtin_amdgcn_ds_swizzle((int)u, (M << 10) | 0x1f);
}
template <int M> __device__ __forceinline__ float xor_f(float v) { return __builtin_bit_cast(float, xor_u<M>(__builtin_bit_cast(unsigned, v))); }
__device__ __forceinline__ float wave_sum(float v) {
    v += xor_f<1>(v); v += xor_f<2>(v); v += xor_f<4>(v); v += xor_f<8>(v); v += xor_f<16>(v); v += xor_f<32>(v);
    return v;
}

#define XB_TMO      128
#define XB_XCNT(j)  (256  + 64 * (j))
#define XB_XSUB(j)  (1280 + 64 * (j))
#define XB_XGEN(j)  (2304 + 64 * (j))
#define XB_TOP      3328
#define XB_TOPGEN   3392
#define XCD_BAR_WORDS 3456
#define XB_SPIN_CAP (1u << 18)
__device__ __forceinline__ unsigned xb_ld(unsigned* p)              { return __hip_atomic_load(p, __ATOMIC_RELAXED, __HIP_MEMORY_SCOPE_AGENT); }
__device__ __forceinline__ unsigned xb_add(unsigned* p, unsigned v) { return __hip_atomic_fetch_add(p, v, __ATOMIC_RELAXED, __HIP_MEMORY_SCOPE_AGENT); }
__device__ __forceinline__ unsigned xb_xcc_id() { return (unsigned)__builtin_amdgcn_s_getreg((3 << 11) | 20) & 0xFu; }
#define XB_SPIN(cond, bar) do { unsigned _sp = 0; while (cond) { __builtin_amdgcn_s_sleep(1); \
    if ((++_sp & 255u) == 0u) { if (xb_ld(&(bar)[XB_TMO])) break; if (_sp > XB_SPIN_CAP) { atomicAdd(&(bar)[XB_TMO], 1u); break; } } } } while (0)
struct XcdBarrier { unsigned* bar; unsigned x; volatile LAS unsigned* st; };
__device__ __forceinline__ XcdBarrier xcd_barrier_post(unsigned* bar, volatile LAS unsigned* st, const bool first_wave) {
    XcdBarrier b; b.bar = bar; b.x = xb_xcc_id(); b.st = st;
    if (st != nullptr && __builtin_amdgcn_mbcnt_hi(~0u, __builtin_amdgcn_mbcnt_lo(~0u, 0u)) == 0u && first_wave) (void)xb_add(&bar[XB_XCNT(b.x)], 1u);
    return b;
}
__device__ __forceinline__ void xcd_barrier_complete(unsigned* bar, unsigned x, unsigned& nloc, unsigned& nx) {
    const unsigned G = gridDim.x * gridDim.y * gridDim.z;
    unsigned sum, cnt, sp = 0u;
    for (;;) {
        sum = 0u; cnt = 0u;
#pragma unroll
        for (unsigned j = 0; j < 16; ++j) { const unsigned c = xb_ld(&bar[XB_XCNT(j)]); sum += c; cnt += (c > 0u) ? 1u : 0u; }
        if (sum == G) break;
        __builtin_amdgcn_s_sleep(1);
        if ((++sp & 255u) == 0u) { if (xb_ld(&bar[XB_TMO])) break; if (sp > XB_SPIN_CAP) { atomicAdd(&bar[XB_TMO], 1u); break; } }
    }
    const unsigned mine = xb_ld(&bar[XB_XCNT(x)]);
    nloc = mine > 0u ? mine : 1u; nx = cnt > 0u ? cnt : 1u;
}
__device__ __forceinline__ void xcd_barrier(const XcdBarrier& b, const int tid) {
    asm volatile("s_waitcnt vmcnt(0)" ::: "memory");
    __syncthreads();
    if (tid == 0) {
        unsigned* bar = b.bar; unsigned bx = b.x; asm volatile("" : "+s"(bx));
        __builtin_amdgcn_s_waitcnt(0);
        unsigned nloc = b.st[0], nx = b.st[1];
        if (nloc == 0u) { xcd_barrier_complete(bar, bx, nloc, nx); b.st[0] = nloc; b.st[1] = nx; }
        const unsigned old = xb_add(&bar[XB_XSUB(bx)], 1u);
        const unsigned gen = old / nloc;
        if (old + 1u == (gen + 1u) * nloc) {
            __builtin_amdgcn_fence(__ATOMIC_RELEASE, "agent");
            asm volatile("s_waitcnt vmcnt(0)" ::: "memory");
            const unsigned og = xb_add(&bar[XB_TOP], 1u);
            const unsigned tg = og / nx;
            if (og + 1u == (tg + 1u) * nx) xb_add(&bar[XB_TOPGEN], 1u);
            else XB_SPIN(xb_ld(&bar[XB_TOPGEN]) == tg, bar);
            __builtin_amdgcn_fence(__ATOMIC_ACQUIRE, "agent");
            xb_add(&bar[XB_XGEN(bx)], 1u);
            asm volatile("s_waitcnt vmcnt(0)" ::: "memory");
        } else {
            XB_SPIN(xb_ld(&bar[XB_XGEN(bx)]) == gen, bar);
            __builtin_amdgcn_fence(__ATOMIC_ACQUIRE, "agent");
            asm volatile("s_waitcnt vmcnt(0)" ::: "memory");
        }
    }
    __syncthreads();
}

namespace pg8 {
constexpr int BM = 256, BK = 64, HALF = 128, HTB = HALF * BK * 2, STAGE_BYTES = 8 * HTB, NXCD = 8, WGM = 8;
__host__ __device__ __forceinline__ int lds_byte(int r, int c) { const int st = (r >> 4) * 2 + (c >> 5), rr = r & 15, cc = c & 31, ob = rr * 64 + cc * 2; return st * 1024 + (ob ^ (((ob >> 9) & 1) << 5)); }
__host__ __device__ __forceinline__ void stage_rc(int b, int& R, int& C) { const int st = b / 1024, sb = b % 1024, swz = sb ^ (((sb >> 9) & 1) << 5); R = (st >> 1) * 16 + swz / 64; C = (st & 1) * 32 + (swz % 64) / 2; }
__host__ __device__ __forceinline__ int perm32(int rho) { const int n = rho >> 4, i = rho & 15; return 8 * (i >> 2) + 4 * n + (i & 3); }
struct Unit { int pm, pn; };
struct TileOrder {
    int nM, nN, nwg, G, c;
    __device__ __forceinline__ void init(int nM_, int nN_, int G_, int c_) { nM = nM_; nN = nN_; nwg = nM * nN; G = G_; c = c_; asm volatile("" : "+s"(c)); }
    __device__ __forceinline__ bool next(int i, Unit& u) const {
        const long L = (long)i * G + c; if (L >= nwg) return false;
        int wgid = (int)L; { const int q = nwg / NXCD, r = nwg % NXCD, xcd = wgid % NXCD, off = wgid / NXCD; wgid = (xcd < r ? xcd * (q + 1) : r * (q + 1) + (xcd - r) * q) + off; }
        const int nig = WGM * nN, gid = wgid / nig, fm = gid * WGM, gsz = (nM - fm) < WGM ? (nM - fm) : WGM;
        u.pm = fm + ((wgid % nig) % gsz); u.pn = (wgid % nig) / gsz; return true;
    }
};
__device__ __forceinline__ unsigned cvt_pk_bf16(float lo, float hi) { unsigned r; asm volatile("v_cvt_pk_bf16_f32 %0, %1, %2" : "=v"(r) : "v"(lo), "v"(hi)); return r; }

template <class Epi, class Sched>
__device__ __forceinline__ void gemm_phase(const int tid_in, LAS unsigned char* lds, const char* Abase, const int K, const unsigned kstepA, const unsigned ldb, const Sched& S, const Epi& E) {
    int tid = tid_in; asm volatile("" : "+v"(tid));
    const int wid = __builtin_amdgcn_readfirstlane(tid >> 6), lane = tid & 63, wr = wid >> 2, wc = wid & 3, fr = lane & 15, fq = lane >> 4;
    const int nt = K / BK;
    unsigned voffB[2];
#pragma unroll
    for (int i = 0; i < 2; ++i) { int R, C; stage_rc(tid * 16 + i * 8192, R, C); const int Rb = Epi::PERM ? ((R & ~31) + perm32(R & 31)) : R; voffB[i] = (unsigned)(Rb * ldb + C) * 2u; }
    const size_t hstepB = (size_t)HALF * ldb * 2;
    const unsigned kstepB = BK * 2;
    const unsigned ldsw = (unsigned)wid * 1024u;
    const int aoff = lds_byte(wr * 64 + fr, fq * 8), boff = lds_byte(wc * 32 + fr, fq * 8);
#define PG8_SA(b, h) (((b) * 2 + (h)) * HTB)
#define PG8_SB(b, h) ((4 + (b) * 2 + (h)) * HTB)
#define PG8_STAGE_B(bufoff, gbase) do { _Pragma("unroll") for (int _i = 0; _i < 2; ++_i) { unsigned _o = voffB[_i]; asm volatile("" : "+v"(_o)); \
        __builtin_amdgcn_global_load_lds((const unsigned*)((const char*)(gbase) + _o), (LAS unsigned*)(lds + (bufoff) + ldsw + _i * 8192), 16, 0, 0); } } while (0)
#define PG8_STAGE_A(bufoff, offs, ubase) do { _Pragma("unroll") for (int _i = 0; _i < 2; ++_i) { unsigned _o = (offs)[_i]; asm volatile("" : "+v"(_o)); \
        __builtin_amdgcn_global_load_lds((const unsigned*)((ubase) + _o), (LAS unsigned*)(lds + (bufoff) + ldsw + _i * 8192), 16, 0, 0); } } while (0)
#define PG8_LDA(dst, b, h) do { _Pragma("unroll") for (int m = 0; m < 4; ++m) _Pragma("unroll") for (int k = 0; k < 2; ++k) dst[m][k] = *(const LAS bf16x8*)(lds + PG8_SA(b, h) + aoff + m * 2048 + k * 1024); } while (0)
#define PG8_LDB(dst, b, h) do { _Pragma("unroll") for (int n = 0; n < 2; ++n) _Pragma("unroll") for (int k = 0; k < 2; ++k) dst[n][k] = *(const LAS bf16x8*)(lds + PG8_SB(b, h) + boff + n * 2048 + k * 1024); } while (0)
#define PG8_MMA(ai, bj, At, Bt) do { __builtin_amdgcn_s_setprio(1); _Pragma("unroll") for (int m = 0; m < 4; ++m) _Pragma("unroll") for (int n = 0; n < 2; ++n) _Pragma("unroll") for (int k = 0; k < 2; ++k) \
        acc[ai][bj][m][n] = __builtin_amdgcn_mfma_f32_16x16x32_bf16(Bt[n][k], At[m][k], acc[ai][bj][m][n], 0, 0, 0); __builtin_amdgcn_s_setprio(0); } while (0)
#define PG8_WAIT_V(n) asm volatile("s_waitcnt vmcnt(" #n ")" ::: "memory")
#define PG8_WAIT_L(n) asm volatile("s_waitcnt lgkmcnt(" #n ")" ::: "memory")
#define PG8_BAR __builtin_amdgcn_s_barrier()
#define PG8_SCHED __builtin_amdgcn_sched_barrier(0)
    Unit cur, nxt; int ui = 0;
    if (!S.next(0, cur)) return;
    f32x4 acc[2][2][4][2];
#pragma unroll
    for (int a = 0; a < 2; ++a)
#pragma unroll
        for (int b = 0; b < 2; ++b)
#pragma unroll
            for (int m = 0; m < 4; ++m)
#pragma unroll
                for (int n = 0; n < 2; ++n) acc[a][b][m][n] = (f32x4){0.f, 0.f, 0.f, 0.f};
    bf16x8 At[4][2], B0[2][2], B1[2][2];
    unsigned oA[2][2];
#define PG8_AOFF(dst, unit) do { _Pragma("unroll") for (int _h = 0; _h < 2; ++_h) _Pragma("unroll") for (int _i = 0; _i < 2; ++_i) { int _R, _C; stage_rc(tid * 16 + _i * 8192, _R, _C); \
        dst[_h][_i] = S.arow(unit, _h * HALF + _R) + (unsigned)_C * 2u; } } while (0)
    PG8_AOFF(oA, cur);
    const char* cB = S.bbase(cur);
    const char* cA0 = Abase + S.abase(cur, 0); const char* cA1 = Abase + S.abase(cur, 1);
    PG8_STAGE_B(PG8_SB(0, 0), cB); PG8_STAGE_B(PG8_SB(0, 1), cB + hstepB); PG8_STAGE_A(PG8_SA(0, 0), oA[0], cA0); PG8_STAGE_A(PG8_SA(0, 1), oA[1], cA1);
    if (wr == 1) PG8_BAR;
    PG8_WAIT_V(2); PG8_BAR;
    PG8_STAGE_B(PG8_SB(1, 0), cB + kstepB); PG8_STAGE_A(PG8_SA(1, 0), oA[0], cA0 + kstepA); PG8_STAGE_B(PG8_SB(1, 1), cB + hstepB + kstepB);
    PG8_WAIT_V(6); PG8_BAR;
    for (;;) {
        const bool has_next = S.next(ui + 1, nxt);
        const char* nB = has_next ? S.bbase(nxt) : cB;
        const char* nA0 = has_next ? Abase + S.abase(nxt, 0) : cA0; const char* nA1 = has_next ? Abase + S.abase(nxt, 1) : cA1;
        for (int t = 0; t < nt; t += 2) {
            const bool last = (t == nt - 2);
            const char* a1h1 = cA1 + (size_t)(t + 1) * kstepA;
            const char* a2h0 = last ? nA0 : cA0 + (size_t)(t + 2) * kstepA; const char* a2h1 = last ? nA1 : cA1 + (size_t)(t + 2) * kstepA;
            const char* b2 = last ? nB : cB + (size_t)(t + 2) * kstepB; const char* b3 = b2 + kstepB;
            unsigned nO[2][2];
#pragma unroll
            for (int h = 0; h < 2; ++h)
#pragma unroll
                for (int i = 0; i < 2; ++i) nO[h][i] = oA[h][i];
            if (last && has_next) PG8_AOFF(nO, nxt);
            PG8_LDB(B0, 0, 0); PG8_LDB(B1, 0, 1); PG8_SCHED; PG8_LDA(At, 0, 0); PG8_STAGE_A(PG8_SA(1, 1), oA[1], a1h1);
#pragma unroll
            for (int h = 0; h < 2; ++h)
#pragma unroll
                for (int i = 0; i < 2; ++i) oA[h][i] = nO[h][i];
            PG8_WAIT_V(8); PG8_WAIT_L(0); PG8_BAR; PG8_MMA(0, 0, At, B0); PG8_MMA(0, 1, At, B1); PG8_BAR; PG8_SCHED;
            PG8_LDA(At, 0, 1); PG8_STAGE_B(PG8_SB(0, 0), b2); PG8_STAGE_B(PG8_SB(0, 1), b2 + hstepB); PG8_STAGE_A(PG8_SA(0, 0), oA[0], a2h0);
            PG8_WAIT_V(8); PG8_WAIT_L(0); PG8_BAR; PG8_MMA(1, 0, At, B0); PG8_MMA(1, 1, At, B1); PG8_BAR; PG8_SCHED;
            PG8_LDB(B0, 1, 0); PG8_LDB(B1, 1, 1); PG8_SCHED; PG8_LDA(At, 1, 0); PG8_STAGE_A(PG8_SA(0, 1), oA[1], a2h1);
            PG8_WAIT_V(8); PG8_WAIT_L(0); PG8_BAR; PG8_MMA(0, 0, At, B0); PG8_MMA(0, 1, At, B1); PG8_BAR; PG8_SCHED;
            PG8_LDA(At, 1, 1); PG8_STAGE_B(PG8_SB(1, 0), b3); PG8_STAGE_B(PG8_SB(1, 1), b3 + hstepB); PG8_STAGE_A(PG8_SA(1, 0), oA[0], a2h0 + kstepA);
            PG8_WAIT_V(8); PG8_WAIT_L(0); PG8_BAR; PG8_MMA(1, 0, At, B0); PG8_MMA(1, 1, At, B1); PG8_BAR; PG8_SCHED;
        }
        if (wr == 0) PG8_BAR;
        E(acc, cur, wr, wc, fr, fq);
        if (!has_next) break;
#pragma unroll
        for (int a = 0; a < 2; ++a)
#pragma unroll
            for (int b = 0; b < 2; ++b)
#pragma unroll
                for (int m = 0; m < 4; ++m)
#pragma unroll
                    for (int n = 0; n < 2; ++n) acc[a][b][m][n] = (f32x4){0.f, 0.f, 0.f, 0.f};
        cur = nxt; cB = nB; cA0 = nA0; cA1 = nA1; ++ui;
        if (wr == 1) PG8_BAR;
    }
    PG8_WAIT_V(0);
    PG8_BAR;
#undef PG8_AOFF
#undef PG8_SA
#undef PG8_SB
#undef PG8_STAGE_A
#undef PG8_STAGE_B
#undef PG8_LDA
#undef PG8_LDB
#undef PG8_MMA
#undef PG8_WAIT_V
#undef PG8_WAIT_L
#undef PG8_BAR
#undef PG8_SCHED
}
}
using pg8::Unit;

typedef const float* cfptr_t;
__device__ __forceinline__ const float* ldarg(int i) {
    const unsigned long long v = (unsigned long long)(*(const volatile __attribute__((address_space(4))) cfptr_t*)((const __attribute__((address_space(4))) char*)__builtin_amdgcn_kernarg_segment_ptr() + 8 * i));
    const unsigned lo = __builtin_amdgcn_readfirstlane((unsigned)v), hi = __builtin_amdgcn_readfirstlane((unsigned)(v >> 32));
    return (const float*)(const GAS float*)(((unsigned long long)hi << 32) | lo);
}
#define ARGP(i) ldarg(i)

struct Frame {
    int trbase;
    LAS unsigned char* lds;
    volatile LAS unsigned* MISC;
    gu32* ctl;
    unsigned char* ws;
    int tid, lane, wave, G, vcu;
    int wv;
    float* out;
};

__device__ __forceinline__ void phase_begin(Frame& F) {
    unsigned z_ = 0u; asm volatile("" : "+v"(z_));
    int t = F.wv * 64 + (int)__builtin_amdgcn_mbcnt_hi(~0u, __builtin_amdgcn_mbcnt_lo(~0u, z_)); F.tid = t; F.lane = t & 63; F.wave = __builtin_amdgcn_readfirstlane(t >> 6);
    int g = gridDim.x, bx = blockIdx.x; asm volatile("" : "+s"(g), "+s"(bx)); F.G = g; F.vcu = (g % 8 == 0) ? (bx % 8) * (g / 8) + bx / 8 : bx;
    F.ws = (unsigned char*)ldarg(29); F.ctl = (gu32*)(F.ws + WS_CTL); F.out = (float*)ldarg(28);
}
struct SchedPlain : pg8::TileOrder {
    unsigned lda2; const char* B; size_t btile;
    __device__ __forceinline__ unsigned arow(const Unit&, int r) const { return (unsigned)(r & 127) * lda2; }
    __device__ __forceinline__ size_t abase(const Unit& u, int h) const { return (size_t)(u.pm * 256 + h * 128) * lda2; }
    __device__ __forceinline__ const char* bbase(const Unit& u) const { return B + (size_t)u.pn * btile; }
};
struct SchedMoeUp : pg8::TileOrder {
    unsigned lda2; const char* B; size_t btile, bexp; const int* rowlist; const int* ebase;
    __device__ __forceinline__ int expert(int pm) const { int e = 0;
#pragma unroll
        for (int j = 1; j < NEXP; ++j) e += (pm >= __builtin_amdgcn_readfirstlane(ebase[j])) ? 1 : 0; return e; }
    __device__ __forceinline__ unsigned arow(const Unit& u, int r) const { return (unsigned)rowlist[u.pm * 256 + r] * lda2; }
    __device__ __forceinline__ size_t abase(const Unit&, int) const { return 0; }
    __device__ __forceinline__ const char* bbase(const Unit& u) const { return B + (size_t)expert(u.pm) * bexp + (size_t)u.pn * btile; }
};
struct SchedMoeDown : pg8::TileOrder {
    unsigned lda2; const char* B; size_t btile, bexp; const int* ebase;
    __device__ __forceinline__ int expert(int pm) const { int e = 0;
#pragma unroll
        for (int j = 1; j < NEXP; ++j) e += (pm >= __builtin_amdgcn_readfirstlane(ebase[j])) ? 1 : 0; return e; }
    __device__ __forceinline__ unsigned arow(const Unit&, int r) const { return (unsigned)(r & 127) * lda2; }
    __device__ __forceinline__ size_t abase(const Unit& u, int h) const { return (size_t)(u.pm * 256 + h * 128) * lda2; }
    __device__ __forceinline__ const char* bbase(const Unit& u) const { return B + (size_t)expert(u.pm) * bexp + (size_t)u.pn * btile; }
};

__device__ __forceinline__ float silu_mul(float g, float u) { return g * u * __builtin_amdgcn_rcpf(1.0f + __builtin_amdgcn_exp2f(-1.4426950408889634f * g)); }
struct EpiSwiGLU {
    static constexpr bool PERM = true;
    bf16* O; int ldo;
    __device__ __forceinline__ void operator()(const f32x4 (&acc)[2][2][4][2], const Unit& u, int wr, int wc, int fr, int fq) const {
        const int row0 = u.pm * 256 + wr * 64 + fr, col0 = u.pn * 128 + wc * 32 + 8 * fq;
#pragma unroll
        for (int ai = 0; ai < 2; ++ai)
#pragma unroll
            for (int m = 0; m < 4; ++m) {
                const f32x4 g0 = acc[ai][0][m][0], g1 = acc[ai][0][m][1], u0 = acc[ai][1][m][0], u1 = acc[ai][1][m][1];
                v4u w;
                w.x = pg8::cvt_pk_bf16(silu_mul(g0[0], u0[0]), silu_mul(g0[1], u0[1])); w.y = pg8::cvt_pk_bf16(silu_mul(g0[2], u0[2]), silu_mul(g0[3], u0[3]));
                w.z = pg8::cvt_pk_bf16(silu_mul(g1[0], u1[0]), silu_mul(g1[1], u1[1])); w.w = pg8::cvt_pk_bf16(silu_mul(g1[2], u1[2]), silu_mul(g1[3], u1[3]));
                *(v4u*)(O + (size_t)(row0 + ai * 128 + m * 16) * ldo + col0) = w;
            }
    }
};
struct EpiNull {
    static constexpr bool PERM = true;
    __device__ __forceinline__ void operator()(const f32x4 (&acc)[2][2][4][2], const Unit&, int, int, int, int) const {
#pragma unroll
        for (int ai = 0; ai < 2; ++ai)
#pragma unroll
            for (int bj = 0; bj < 2; ++bj)
#pragma unroll
                for (int m = 0; m < 4; ++m) asm volatile("" :: "v"(acc[ai][bj][m][0]), "v"(acc[ai][bj][m][1]));
    }
};
struct EpiResF32 {
    static constexpr bool PERM = false;
    const float* base; float* out; int ldc; float alpha = 1.0f;
    __device__ __forceinline__ void operator()(const f32x4 (&acc)[2][2][4][2], const Unit& u, int wr, int wc, int fr, int fq) const {
        const int row0 = u.pm * 256 + wr * 64 + fr, col0 = u.pn * 256 + wc * 32 + 4 * fq;
#pragma unroll
        for (int ai = 0; ai < 2; ++ai)
#pragma unroll
            for (int m = 0; m < 4; ++m) { const size_t off = (size_t)(row0 + ai * 128 + m * 16) * ldc + col0;
#pragma unroll
                for (int bj = 0; bj < 2; ++bj)
#pragma unroll
                    for (int n = 0; n < 2; ++n) { const f32x4 b = *(const f32x4*)(base + off + bj * 128 + n * 16); *(f32x4*)(out + off + bj * 128 + n * 16) = b + acc[ai][bj][m][n] * alpha; } }
    }
};
struct EpiBf16Plain {
    static constexpr bool PERM = true;
    bf16* O; int ldo;
    __device__ __forceinline__ void operator()(const f32x4 (&acc)[2][2][4][2], const Unit& u, int wr, int wc, int fr, int fq) const {
        const int row0 = u.pm * 256 + wr * 64 + fr, col0 = u.pn * 256 + wc * 32 + 8 * fq;
#pragma unroll
        for (int ai = 0; ai < 2; ++ai)
#pragma unroll
            for (int m = 0; m < 4; ++m)
#pragma unroll
                for (int bj = 0; bj < 2; ++bj) { const f32x4 v0 = acc[ai][bj][m][0], v1 = acc[ai][bj][m][1]; v4u w;
                    w.x = pg8::cvt_pk_bf16(v0[0], v0[1]); w.y = pg8::cvt_pk_bf16(v0[2], v0[3]); w.z = pg8::cvt_pk_bf16(v1[0], v1[1]); w.w = pg8::cvt_pk_bf16(v1[2], v1[3]);
                    *(v4u*)(O + (size_t)(row0 + ai * 128 + m * 16) * ldo + col0 + bj * 128) = w; }
    }
};

template <class CM>
__device__ __forceinline__ void tr_item(const float* src, int srcN, int kofs, int kvalid, const float* kscale, bf16* dst, int dstK, int k0, int n0, const CM& cm, LAS float* scr, int lane) {
    const int col = cm(n0 + (lane & 31)); const int colc = col < 0 ? 0 : col;
    float v[32];
#pragma unroll
    for (int i = 0; i < 32; ++i) { const int ks = k0 + 2 * i + (lane >> 5) - kofs; const int ksc = ks < 0 ? 0 : (ks >= kvalid ? kvalid - 1 : ks); v[i] = src[(size_t)ksc * srcN + colc]; }
    if (kscale) {
#pragma unroll
        for (int i = 0; i < 32; ++i) { const int ks = k0 + 2 * i + (lane >> 5) - kofs; const int ksc = ks < 0 ? 0 : (ks >= kvalid ? kvalid - 1 : ks); v[i] *= kscale[ksc]; } }
#pragma unroll
    for (int i = 0; i < 32; ++i) { const int kk = 2 * i + (lane >> 5); const int ks = k0 + kk - kofs; scr[kk * 33 + (lane & 31)] = (col >= 0 && ks >= 0 && ks < kvalid) ? v[i] : 0.f; }
    LDS_WAIT(); asm volatile("" ::: "memory");
    const int c = lane & 7;
#pragma unroll
    for (int j = 0; j < 4; ++j) { const int n = (lane >> 3) + 8 * j; const LAS float* s = scr + (8 * c) * 33 + n;
        v4u o; o.x = pk2(s[0 * 33], s[1 * 33]); o.y = pk2(s[2 * 33], s[3 * 33]); o.z = pk2(s[4 * 33], s[5 * 33]); o.w = pk2(s[6 * 33], s[7 * 33]);
        *(GAS v4u*)(dst + (size_t)(n0 + n) * dstK + k0 + 8 * c) = o; }
    LDS_WAIT(); asm volatile("" ::: "memory");
}
struct CmQ { __device__ __forceinline__ int operator()(int j) const { if (j >= 576) return -1; const int hd = j / 96, w = j - hd * 96; if (w < 64) return j; const int w2 = w - 64, i = w2 >> 3, e = w2 & 7; return hd * 96 + 64 + (e < 4 ? 4 * i + e : 16 + 4 * i + (e - 4)); } };
struct CmIdent { int nvalid; __device__ __forceinline__ int operator()(int n) const { return n < nvalid ? n : -1; } };
struct CmGU { __device__ __forceinline__ int operator()(int n) const { return (n >> 8) * 128 + (n & 127); } };

template <class CM>
__device__ __forceinline__ void tr_job(Frame& F, const float* src, int srcN, int kofs, int kvalid, const float* kscale, bf16* dst, int dstK, int rows, const CM& cm) {
    LAS float* scr = (LAS float*)(F.lds + F.wave * 8704);
    const int gw = F.vcu * NWAVES + F.wave, NGW = F.G * NWAVES;
    const int nblk = rows / 32, nit = (dstK / 64) * nblk;
    int it0 = gw - F.trbase; it0 += it0 < 0 ? NGW : 0; F.trbase = (F.trbase + nit) % NGW;
    for (int it = it0; it < nit; it += NGW) { const int kb = it / nblk, nb = it % nblk; tr_item(src, srcN, kofs, kvalid, kscale, dst, dstK, 64 * kb, 32 * nb, cm, scr, F.lane); }
}
__device__ __forceinline__ void tr_job_gu(Frame& F, const float* srcG, const float* srcU, int srcN, bf16* dst, int dstK, int rows) {
    LAS float* scr = (LAS float*)(F.lds + F.wave * 8704);
    const int gw = F.vcu * NWAVES + F.wave, NGW = F.G * NWAVES;
    const int nblk = rows / 32, nit = (dstK / 64) * nblk; const CmGU cm;
    int it0 = gw - F.trbase; it0 += it0 < 0 ? NGW : 0; F.trbase = (F.trbase + nit) % NGW;
    for (int it = it0; it < nit; it += NGW) { const int kb = it / nblk, nb = it % nblk; const int n0 = 32 * nb;
        tr_item((n0 & 128) ? srcU : srcG, srcN, 0, dstK, nullptr, dst, dstK, 64 * kb, n0, cm, scr, F.lane); }
}

__device__ __forceinline__ void p_prologue_ffn(Frame& F, const float* fg, const float* fu, const float* fd, const float* mg, const float* mu, const float* md) {
    phase_begin(F);
    tr_job_gu(F, fg, fu, DFF, (bf16*)(F.ws + WS_WGU), DM, 2 * DFF);
    tr_job(F, fd, DM, 0, DFF, nullptr, (bf16*)(F.ws + WS_WD), DFF, DM, CmIdent{DM});
    for (int e = 0; e < NEXP; ++e) {
        tr_job_gu(F, mg + (size_t)e * DM * DFE, mu + (size_t)e * DM * DFE, DFE, (bf16*)(F.ws + WS_MWGU) + (size_t)e * 2 * DFE * DM, DM, 2 * DFE);
        tr_job(F, md + (size_t)e * DFE * DM, DM, 0, DFE, nullptr, (bf16*)(F.ws + WS_MWD) + (size_t)e * DM * DFE, DFE, DM, CmIdent{DM});
    }
}


__device__ __forceinline__ bool is_rope64(int c) { return (c >= C_QN && c < C_VC) || (c >= C_KS && c < C_VS) || (c >= C_KW && c < C_VW); }
struct CmInProj { __device__ __forceinline__ int operator()(int j) const {
    if (j >= IN_COLS) return -1;
    if (is_rope64(j)) { const int seg = j >= C_KW ? C_KW : j >= C_KS ? C_KS : j >= C_KC ? C_KC : C_QN; const int l = j - seg, hd = l >> 6, w = l & 63, i = w >> 3, e = w & 7; return seg + hd * 64 + (e < 4 ? 4 * i + e : 32 + 4 * i + (e - 4)); }
    if (j >= C_KPE && j < C_QN) { const int w = j - C_KPE, i = w >> 3, e = w & 7; return C_KPE + (e < 4 ? 4 * i + e : 16 + 4 * i + (e - 4)); }
    return j; } };

__device__ __forceinline__ void sincos_acc(double x, float& sn, float& cs) {
    const double kd = __builtin_rint(x * 0.63661977236758134308); const int k = (int)kd;
    const double r = ((x - kd * 1.57079632673412561417e+00) - kd * 6.07710050650619224932e-11) - kd * 2.02226624879595063154e-21, r2 = r * r;
    const double s = r * (1.0 + r2 * (-1.0 / 6 + r2 * (1.0 / 120 + r2 * (-1.0 / 5040 + r2 * (1.0 / 362880 + r2 * (-1.0 / 39916800 + r2 * (1.0 / 6227020800.0)))))));
    const double c = 1.0 + r2 * (-0.5 + r2 * (1.0 / 24 + r2 * (-1.0 / 720 + r2 * (1.0 / 40320 + r2 * (-1.0 / 3628800 + r2 * (1.0 / 479001600.0 + r2 * (-1.0 / 87178291200.0)))))));
    const int q = k & 3; sn = (float)(q == 0 ? s : q == 1 ? c : q == 2 ? -s : -c); cs = (float)(q == 0 ? c : q == 1 ? -s : q == 2 ? -c : s);
}
__device__ __forceinline__ void p_tables(Frame& F) {
    phase_begin(F);
    const int gt = F.vcu * NTHR + F.tid, NGT = F.G * NTHR;
    GAS f32x2* tn = (GAS f32x2*)(F.ws + WS_TABN); GAS f32x2* tm = (GAS f32x2*)(F.ws + WS_TABM);
    for (int e = gt; e < SEQ * 32; e += NGT) { const int pos = e >> 5, i = e & 31; float sn, cs; sincos_acc((double)((float)pos * INV_N[i]), sn, cs); tn[e] = (f32x2){cs, sn}; }
    for (int e = gt; e < SEQ * 16; e += NGT) { const int pos = e >> 4, i = e & 15; float sn, cs; sincos_acc((double)((float)pos * INV_M[i]), sn, cs); tm[e] = (f32x2){cs, sn}; }
}

struct EpiInProj {
    static constexpr bool PERM = true;
    bf16* U; const f32x2* tabn; const f32x2* tabm; float* ssq;
    __device__ __forceinline__ void operator()(const f32x4 (&acc)[2][2][4][2], const Unit& u, int wr, int wc, int fr, int fq) const {
        const int row0 = u.pm * 256 + wr * 64 + fr;
#pragma unroll
        for (int bj = 0; bj < 2; ++bj) {
            const int c32 = u.pn * 256 + bj * 128 + wc * 32;
            const int c8 = c32 + 8 * fq;
            if (is_rope64(c32)) {
                const int seg = c32 >= C_KW ? C_KW : c32 >= C_KS ? C_KS : c32 >= C_KC ? C_KC : C_QN;
                const int l = c8 - seg, hb = seg + (l & ~63), i = (l & 63) >> 3; const float sc = (seg == C_QN) ? QSCALE_N : 1.0f;
#pragma unroll
                for (int am = 0; am < 8; am += 2) {
                    f32x4 ta[2], tb[2];
#pragma unroll
                    for (int q = 0; q < 2; ++q) { const int pos = (row0 + ((am + q) >> 2) * 128 + ((am + q) & 3) * 16) & (SEQ - 1); const GAS f32x4* t = (const GAS f32x4*)(tabn + pos * 32 + 4 * i); ta[q] = t[0]; tb[q] = t[1]; }
#pragma unroll
                    for (int q = 0; q < 2; ++q) { const int ai = (am + q) >> 2, m = (am + q) & 3, row = row0 + ai * 128 + m * 16;
                        const f32x4 x1 = acc[ai][bj][m][0], x2 = acc[ai][bj][m][1]; const f32x4 t0 = ta[q], t1 = tb[q];
                        const float y10 = (x1[0] * t0[0] - x2[0] * t0[1]) * sc, y11 = (x1[1] * t0[2] - x2[1] * t0[3]) * sc, y12 = (x1[2] * t1[0] - x2[2] * t1[1]) * sc, y13 = (x1[3] * t1[2] - x2[3] * t1[3]) * sc;
                        const float y20 = (x2[0] * t0[0] + x1[0] * t0[1]) * sc, y21 = (x2[1] * t0[2] + x1[1] * t0[3]) * sc, y22 = (x2[2] * t1[0] + x1[2] * t1[1]) * sc, y23 = (x2[3] * t1[2] + x1[3] * t1[3]) * sc;
                        const auto s0 = __builtin_amdgcn_permlane16_swap(pg8::cvt_pk_bf16(y10, y11), pg8::cvt_pk_bf16(y20, y21), false, false);
                        const auto s1 = __builtin_amdgcn_permlane16_swap(pg8::cvt_pk_bf16(y12, y13), pg8::cvt_pk_bf16(y22, y23), false, false);
                        bf16* o = U + (size_t)row * NU + hb + 4 * i + ((fq & 1) ? 28 : 0);
                        *(v4u*)o = (v4u){s0[0], s1[0], s0[1], s1[1]}; }
                    asm volatile("" ::: "memory"); }
            } else if (c32 == C_KPE) {
                const int i = fq;
#pragma unroll
                for (int ai = 0; ai < 2; ++ai)
#pragma unroll
                    for (int m = 0; m < 4; ++m) { const int row = row0 + ai * 128 + m * 16, pos = row & (SEQ - 1);
                        const f32x4 x1 = acc[ai][bj][m][0], x2 = acc[ai][bj][m][1]; const GAS f32x4* t = (const GAS f32x4*)(tabm + pos * 16 + 4 * i);
                        const f32x4 t0 = t[0], t1 = t[1];
                        const float y10 = x1[0] * t0[0] - x2[0] * t0[1], y11 = x1[1] * t0[2] - x2[1] * t0[3], y12 = x1[2] * t1[0] - x2[2] * t1[1], y13 = x1[3] * t1[2] - x2[3] * t1[3];
                        const float y20 = x2[0] * t0[0] + x1[0] * t0[1], y21 = x2[1] * t0[2] + x1[1] * t0[3], y22 = x2[2] * t1[0] + x1[2] * t1[1], y23 = x2[3] * t1[2] + x1[3] * t1[3];
                        const auto s0 = __builtin_amdgcn_permlane16_swap(pg8::cvt_pk_bf16(y10, y11), pg8::cvt_pk_bf16(y20, y21), false, false);
                        const auto s1 = __builtin_amdgcn_permlane16_swap(pg8::cvt_pk_bf16(y12, y13), pg8::cvt_pk_bf16(y22, y23), false, false);
                        bf16* o = U + (size_t)row * NU + C_KPE + 4 * i + ((fq & 1) ? 12 : 0);
                        *(v4u*)o = (v4u){s0[0], s1[0], s0[1], s1[1]}; asm volatile("" ::: "memory"); }
            } else {
                const bool sq = (c32 >= C_QDN && c32 < C_KPE); const int grp = (c32 - C_QDN) >> 5;
#pragma unroll
                for (int ai = 0; ai < 2; ++ai)
#pragma unroll
                    for (int m = 0; m < 4; ++m) { const int row = row0 + ai * 128 + m * 16; const f32x4 v0 = acc[ai][bj][m][0], v1 = acc[ai][bj][m][1]; v4u w;
                        w.x = pg8::cvt_pk_bf16(v0[0], v0[1]); w.y = pg8::cvt_pk_bf16(v0[2], v0[3]); w.z = pg8::cvt_pk_bf16(v1[0], v1[1]); w.w = pg8::cvt_pk_bf16(v1[2], v1[3]);
                        *(v4u*)(U + (size_t)row * NU + c8) = w;
                        if (sq) { float q = (v0[0] * v0[0] + v0[1] * v0[1]) + (v0[2] * v0[2] + v0[3] * v0[3]) + (v1[0] * v1[0] + v1[1] * v1[1]) + (v1[2] * v1[2] + v1[3] * v1[3]);
                            q += xor_f<16>(q); q += xor_f<32>(q); if (fq == 0) ssq[(size_t)row * 16 + grp] = q; } }
            }
        }
    }
};

__device__ __forceinline__ float sigmoidf_(float x) { return __builtin_amdgcn_rcpf(1.0f + __expf(-x)); }
__device__ __forceinline__ float gelu_tanh(float y) { const float z = 0.7978845608028654f * (y + 0.044715f * y * y * y); const float t = 1.0f - 2.0f * __builtin_amdgcn_rcpf(1.0f + __expf(2.0f * z)); return 0.5f * y * (1.0f + t); }
__device__ __forceinline__ float one_minus_exp(float x) {
    const float p = -x * (1.0f + x * (0.5f + x * (0.16666667f + x * (0.041666668f + x * 0.0083333338f))));
    return (x > -0.125f) ? p : 1.0f - __expf(x); }
constexpr int LRU_XP = 264;
__device__ __forceinline__ int q_fetch(Frame& F, int qid);
__device__ __forceinline__ void p_lru_local(Frame& F, int qid, const float* cw, const float* cb, const float* wa, const float* ba, const float* wx, const float* bx, const float* lam) {
    phase_begin(F);
    const int d = F.tid & 255, half = F.tid >> 8;
    LAS bf16* xsb = (LAS bf16*)F.lds;
    LAS bf16* gts = (LAS bf16*)(F.lds + 64 * LRU_XP * 2);
    const bf16* U = (const bf16*)(F.ws + WS_U);
    bf16* P = (bf16*)(F.ws + WS_PQ); bf16* Q = P + (size_t)TOK * 256;
    float* SA = (float*)(F.ws + WS_LRU); float* SB = SA + 1024 * 256;
    const int r32 = F.lane & 31, hi = F.lane >> 5, gsel = F.wave >> 2, blk = F.wave & 3;
    bf16x8 bw[2][4];
    { const float* W = (gsel ? wx : wa) + (size_t)blk * 4096;
#pragma unroll
      for (int nt = 0; nt < 2; ++nt)
#pragma unroll
          for (int ks = 0; ks < 4; ++ks) { v4u w;
              const float* wp = W + (size_t)(16 * ks + 8 * hi) * 64 + 32 * nt + r32;
              w.x = pk2(wp[0], wp[64]); w.y = pk2(wp[128], wp[192]); w.z = pk2(wp[256], wp[320]); w.w = pk2(wp[384], wp[448]);
              bw[nt][ks] = __builtin_bit_cast(bf16x8, w); } }
    const float w0 = cw[d], w1 = cw[256 + d], w2 = cw[512 + d], w3 = cw[768 + d], cbd = cb[d], bad = ba[d], bxd = bx[d];
    const float sp = log1pf(__expf(-lam[d]));
    for (;;) {
        const int ch = q_fetch(F, qid); if (ch >= TOK / 64) break;
        const int t0 = ch * 64 + half * 32, pos0 = t0 & (SEQ - 1);
        float xm3 = 0.f, xm2 = 0.f, xm1 = 0.f;
        if (pos0 >= 3) { xm3 = bf2f(U[(size_t)(t0 - 3) * NU + C_XL + d]); xm2 = bf2f(U[(size_t)(t0 - 2) * NU + C_XL + d]); xm1 = bf2f(U[(size_t)(t0 - 1) * NU + C_XL + d]); }
        { float xv[32];
#pragma unroll
          for (int i = 0; i < 32; ++i) xv[i] = bf2f(U[(size_t)(t0 + i) * NU + C_XL + d]);
#pragma unroll
          for (int i = 0; i < 32; ++i) { const float x0 = xv[i]; const float v = cbd + w0 * xm3 + w1 * xm2 + w2 * xm1 + w3 * x0; xm3 = xm2; xm2 = xm1; xm1 = x0;
              xsb[(half * 32 + i) * LRU_XP + d] = (bf16)f2bf(v); } }
        __syncthreads();
#pragma unroll
        for (int mt = 0; mt < 2; ++mt) {
            f32x16 acc0 = f32x16{}, acc1 = f32x16{};
#pragma unroll
            for (int ks = 0; ks < 4; ++ks) { const bf16x8 a = *(const LAS bf16x8*)(xsb + (32 * mt + r32) * LRU_XP + 64 * blk + 16 * ks + 8 * hi);
                acc0 = __builtin_amdgcn_mfma_f32_32x32x16_bf16(a, bw[0][ks], acc0, 0, 0, 0); acc1 = __builtin_amdgcn_mfma_f32_32x32x16_bf16(a, bw[1][ks], acc1, 0, 0, 0); }
#pragma unroll
            for (int r = 0; r < 16; ++r) { const int tok = 32 * mt + crow(r, hi);
                gts[((size_t)gsel * 64 + tok) * 256 + 64 * blk + r32] = (bf16)f2bf(acc0[r]); gts[((size_t)gsel * 64 + tok) * 256 + 64 * blk + 32 + r32] = (bf16)f2bf(acc1[r]); }
        }
        __syncthreads();
        float h = 0.f, cum = 1.f;
        float y0 = bf2f(U[(size_t)t0 * NU + C_YL + d]), y1 = bf2f(U[(size_t)(t0 + 1) * NU + C_YL + d]);
#pragma unroll 2
        for (int i = 0; i < 32; ++i) {
            const float ycur = y0; y0 = y1; if (i + 2 < 32) y1 = bf2f(U[(size_t)(t0 + i + 2) * NU + C_YL + d]);
            const float ra = bad + bf2f(gts[(size_t)(half * 32 + i) * 256 + d]), ia = bxd + bf2f(gts[(size_t)(64 + half * 32 + i) * 256 + d]);
            const float xcv = bf2f(xsb[(half * 32 + i) * LRU_XP + d]);
            const float r = sigmoidf_(ra), ig = sigmoidf_(ia), la = -8.0f * r * sp, a = __expf(la), b = __builtin_amdgcn_sqrtf(one_minus_exp(2.0f * la)) * (ig * xcv);
            h = a * h + b; cum *= a;
            const float gl = gelu_tanh(ycur);
            P[(size_t)(t0 + i) * 256 + d] = (bf16)f2bf(h * gl); Q[(size_t)(t0 + i) * 256 + d] = (bf16)f2bf(cum * gl);
        }
        SA[(size_t)(ch * 2 + half) * 256 + d] = cum; SB[(size_t)(ch * 2 + half) * 256 + d] = h;
    }
}
__device__ __forceinline__ void p_lru_carry(Frame& F) {
    phase_begin(F);
    if (F.vcu >= NB || F.tid >= 256) return;
    const float* SA = (const float*)(F.ws + WS_LRU); const float* SB = SA + 1024 * 256; float* CY = (float*)(F.ws + WS_LRU) + 2 * 1024 * 256;
    const int d = F.tid; float c = 0.f;
    for (int k0 = 0; k0 < 256; k0 += 16) { float a[16], b[16];
#pragma unroll
        for (int i = 0; i < 16; ++i) { const size_t o = (size_t)(F.vcu * 256 + k0 + i) * 256 + d; a[i] = SA[o]; b[i] = SB[o]; }
#pragma unroll
        for (int i = 0; i < 16; ++i) { const size_t o = (size_t)(F.vcu * 256 + k0 + i) * 256 + d; CY[o] = c; c = a[i] * c + b[i]; } }
}
__device__ __forceinline__ void p_lru_fix(Frame& F, int zfrom) {
    phase_begin(F);
    const int gw = F.vcu * NWAVES + F.wave, NGW = F.G * NWAVES;
    const bf16* P = (const bf16*)(F.ws + WS_PQ); const bf16* Q = P + (size_t)TOK * 256; const float* CY = (const float*)(F.ws + WS_LRU) + 2 * 1024 * 256; bf16* CAT = (bf16*)(F.ws + WS_CAT);
    for (int m0 = gw; m0 < TOK; m0 += 4 * NGW) {
        v2u p[4], q[4]; f32x4 c[4];
#pragma unroll
        for (int i = 0; i < 4; ++i) { const int m = m0 + i * NGW; if (m < TOK) { p[i] = *((const GAS v2u*)(P + (size_t)m * 256) + F.lane); q[i] = *((const GAS v2u*)(Q + (size_t)m * 256) + F.lane);
            c[i] = *((const GAS f32x4*)(CY + (size_t)(m >> 5) * 256) + F.lane); } }
#pragma unroll
        for (int i = 0; i < 4; ++i) { const int m = m0 + i * NGW; if (m < TOK) {
            v2u o; o.x = pk2(bflo(p[i].x) + bflo(q[i].x) * c[i].x, bfhi(p[i].x) + bfhi(q[i].x) * c[i].y); o.y = pk2(bflo(p[i].y) + bflo(q[i].y) * c[i].z, bfhi(p[i].y) + bfhi(q[i].y) * c[i].w);
            *((GAS v2u*)(CAT + (size_t)m * DM) + F.lane) = o;
            { GAS v4u* z = (GAS v4u*)(CAT + (size_t)m * DM + zfrom); const int nz = (DM - zfrom) / 8;
#pragma unroll
              for (int j = 0; j < 2; ++j) { const int idx = F.lane + 64 * j; if (idx < nz) z[idx] = (v4u){0u, 0u, 0u, 0u}; } } } }
    }
}

__device__ __forceinline__ void p_prologue_mix(Frame& F, const float* w_in, const float* w_out) {
    phase_begin(F);
    for (int l = 0; l < DEPTH; ++l) {
        tr_job(F, w_in + (size_t)l * DM * IN_COLS, IN_COLS, 0, DM, nullptr, (bf16*)(F.ws + WS_WIN) + (size_t)l * NU * DM, DM, NU, CmInProj{});
        tr_job(F, w_out + (size_t)l * DM * DM, DM, 0, DM, nullptr, (bf16*)(F.ws + WS_WOUT) + (size_t)l * DM * DM, DM, DM, CmIdent{DM});
    }
}
__device__ __forceinline__ void p_prologue_cmp(Frame& F, const float* w1) {
    phase_begin(F);
    for (int ls = 0; ls < DEPTH * 2; ++ls) tr_job(F, w1 + (size_t)ls * 2048 * 128, 128, 0, 2048, nullptr, (bf16*)(F.ws + WS_WC1) + (size_t)ls * 256 * 2048, 2048, 256, CmIdent{128});
}
__device__ __forceinline__ void p_prologue_qkv(Frame& F, const float* qn, const float* wuq, const float* kvn, const float* wukv) {
    phase_begin(F);
    for (int l = 0; l < DEPTH; ++l) {
        bf16* W = (bf16*)(F.ws + WS_WQKV) + (size_t)l * 1536 * 384;
        tr_job(F, wuq + (size_t)l * 192 * 576, 576, 0, 192, qn + l * 192, W, 384, 768, CmQ{});
        tr_job(F, wukv + (size_t)l * 128 * 768, 768, 192, 128, kvn + l * 128, W + (size_t)768 * 384, 384, 768, CmIdent{768});
    }
}

enum { AM_CAUSAL = 0, AM_WINDOW = 1, AM_SELECT = 2, AM_CMP = 3 };
constexpr int NSA_WIN = 512;
template <int DK, int NSUB = 1> struct AttnLds { static constexpr int KP = DK + 8, KT = 64 * KP * 2, KBYTES = NSUB * KT, VBYTES = NSUB * 8192, BUF = KBYTES + VBYTES; };
struct SrcMla { const bf16* kvm; const bf16* u; int h; size_t base;
    __device__ __forceinline__ const bf16* kp(int key, int c) const { return c < 8 ? kvm + (base + key) * 768 + h * 128 + 8 * c : u + (base + key) * NU + C_KPE + 8 * (c - 8); }
    __device__ __forceinline__ const bf16* vp(int key, int c) const { return kvm + (base + key) * 768 + h * 128 + 64 + 8 * c; }
    __device__ __forceinline__ unsigned koff(int key, int c) const { return c < 8 ? (unsigned)WS_KVM + ((unsigned)base + key) * 1536u + h * 256 + 16 * c : (unsigned)WS_U + ((unsigned)base + key) * (NU * 2u) + (C_KPE + 8 * (c - 8)) * 2; }
    __device__ __forceinline__ unsigned kstride(int c) const { return c < 8 ? 1536u : NU * 2u; }
    __device__ __forceinline__ unsigned voff(int key, int c) const { return (unsigned)WS_KVM + ((unsigned)base + key) * 1536u + h * 256 + 128 + 16 * c; }
    __device__ __forceinline__ unsigned vstride() const { return 1536u; } };
struct SrcU { const bf16* u; int kcol, vcol; size_t base;
    __device__ __forceinline__ const bf16* kp(int key, int c) const { return u + (base + key) * NU + kcol + 8 * c; }
    __device__ __forceinline__ const bf16* vp(int key, int c) const { return u + (base + key) * NU + vcol + 8 * c; }
    __device__ __forceinline__ unsigned koff(int key, int c) const { return (unsigned)WS_U + ((unsigned)base + key) * (NU * 2u) + (kcol + 8 * c) * 2; }
    __device__ __forceinline__ unsigned kstride(int) const { return NU * 2u; }
    __device__ __forceinline__ unsigned voff(int key, int c) const { return (unsigned)WS_U + ((unsigned)base + key) * (NU * 2u) + (vcol + 8 * c) * 2; }
    __device__ __forceinline__ unsigned vstride() const { return NU * 2u; } };
struct SrcCmp { const bf16* kc; const bf16* vc; unsigned kc0, vc0;
    __device__ __forceinline__ const bf16* kp(int key, int c) const { return kc + key * 64 + 8 * c; }
    __device__ __forceinline__ const bf16* vp(int key, int c) const { return vc + key * 64 + 8 * c; }
    __device__ __forceinline__ unsigned koff(int key, int c) const { return kc0 + key * 128 + 16 * c; }
    __device__ __forceinline__ unsigned kstride(int) const { return 128u; }
    __device__ __forceinline__ unsigned voff(int key, int c) const { return vc0 + key * 128 + 16 * c; }
    __device__ __forceinline__ unsigned vstride() const { return 128u; } };

template <int DK, int MODE, int NSUB, int VAR = 0, class Src>
__device__ __forceinline__ void attn_branch(Frame& F, LAS unsigned char* lds, const Src& src, const bf16x8 (&qf)[DK / 16], int qpos0w, int jlo, int jhi, const v4u selmask, f32x16 (&o)[2], float& m_out, float& l_out) {
    typedef AttnLds<DK, NSUB> L;
    const int tid = F.tid, lane = F.lane, r32 = lane & 31, hi = lane >> 5;
    const int qpos = qpos0w + r32;
    o[0] = f32x16{}; o[1] = f32x16{};
    float m = -1.0e30f, l = 0.f;
    f32x16 lacc_unused = f32x16{};
    const bf16x8 ones = (bf16x8){(short)0x3f80, (short)0x3f80, (short)0x3f80, (short)0x3f80, (short)0x3f80, (short)0x3f80, (short)0x3f80, (short)0x3f80};
    constexpr int KC = DK / 8, NKP = NSUB * 64 * KC, NPT = (NKP + 511) / 512; constexpr bool KEXACT = (NKP % 512) == 0;
    const int vkey = tid >> 3, vc = tid & 7;
    const GAS unsigned char* wsb = (const GAS unsigned char*)F.ws;
    unsigned kl[NPT], kst[NPT], vl[NSUB];
#pragma unroll
    for (int i = 0; i < NPT; ++i) { const int p_ = tid + 512 * i; kl[i] = src.koff(p_ / KC, p_ % KC); kst[i] = src.kstride(p_ % KC); }
#pragma unroll
    for (int i = 0; i < NSUB; ++i) vl[i] = src.voff(64 * i + vkey, vc);
    v4u kr[NPT], vr[NSUB];
#define AT_LOAD(jm_) do { const unsigned kb_ = (unsigned)((jm_) * (NSUB * 64)); \
        _Pragma("unroll") for (int i_ = 0; i_ < NPT; ++i_) { const int p_ = tid + 512 * i_; if (KEXACT || i_ + 1 < NPT || p_ < NKP) kr[i_] = *(const GAS v4u*)(wsb + (size_t)(kl[i_] + kb_ * kst[i_])); } \
        _Pragma("unroll") for (int i_ = 0; i_ < NSUB; ++i_) vr[i_] = *(const GAS v4u*)(wsb + (size_t)(vl[i_] + kb_ * src.vstride())); } while (0)
#define AT_WRITE(buf) do { LAS unsigned char* b_ = lds + (buf) * L::BUF; \
        _Pragma("unroll") for (int i_ = 0; i_ < NPT; ++i_) { const int p_ = tid + 512 * i_; if (KEXACT || i_ + 1 < NPT || p_ < NKP) *(LAS v4u*)(b_ + (p_ / KC) * (L::KP * 2) + (p_ % KC) * 16) = kr[i_]; } \
        _Pragma("unroll") for (int i_ = 0; i_ < NSUB; ++i_) *(LAS v4u*)(b_ + L::KBYTES + i_ * 8192 + (vc >> 2) * 4096 + vkey * 64 + (vc & 3) * 16) = vr[i_]; } while (0)
    const int mlo = jlo / NSUB, mhi = jhi / NSUB;
    if (jlo <= jhi) { AT_LOAD(mlo); AT_WRITE(0); }
    __syncthreads();
    if (F.wave & 1) __builtin_amdgcn_s_setprio(3);
    int cur = 0;
    for (int jm = mlo; jm <= mhi; ++jm) {
        if (jm < mhi) AT_LOAD(jm + 1);
#pragma unroll
      for (int sub = 0; sub < NSUB; ++sub) {
        const int j = jm * NSUB + sub;
        const int kb = j * 64;
        bool need, part, lanesel = true;
        if (MODE == AM_CAUSAL)      { need = kb <= qpos0w + 31; part = kb + 63 > qpos0w; }
        else if (MODE == AM_WINDOW) { need = (kb <= qpos0w + 31) && (kb + 63 > qpos0w - NSA_WIN); part = (kb + 63 > qpos0w) || (kb <= qpos0w + 31 - NSA_WIN); }
        else if (MODE == AM_SELECT) { const unsigned w = (j < 32) ? selmask.x : (j < 64) ? selmask.y : (j < 96) ? selmask.z : selmask.w; lanesel = (w >> (j & 31)) & 1u;
                                      need = __any(lanesel) && kb <= qpos0w + 31; part = kb + 63 > qpos0w; }
        else                        { need = (16 * kb + 31) <= qpos0w + 31; part = (16 * (kb + 63) + 31 > qpos0w) || (kb + 63 > 510); }
        if (NSUB > 1) need = need && j >= jlo && j <= jhi;
        if (need) {
            const LAS unsigned char* kb_l = lds + cur * L::BUF + sub * L::KT; const LAS unsigned char* vb_l = lds + cur * L::BUF + L::KBYTES + sub * 8192;
            f32x16 p0 = f32x16{}, p1 = f32x16{};
#pragma unroll
            for (int ks = 0; ks < DK / 16; ++ks) {
                const bf16x8 k0 = *(const LAS bf16x8*)(kb_l + r32 * (L::KP * 2) + ks * 32 + hi * 16);
                const bf16x8 k1 = (VAR == 6) ? k0 : *(const LAS bf16x8*)(kb_l + (32 + r32) * (L::KP * 2) + ks * 32 + hi * 16);
                p0 = __builtin_amdgcn_mfma_f32_32x32x16_bf16(k0, qf[ks], p0, 0, 0, 0);
                p1 = __builtin_amdgcn_mfma_f32_32x32x16_bf16(k1, qf[ks], p1, 0, 0, 0);
            }
            s16x4 vlo[2][4], vhh[2][4];
            { const int li = lane & 15, dhalf = (lane >> 4) & 1;
              const LAS unsigned char* vbase = vb_l + (4 * hi + (li >> 2)) * 64 + (16 * dhalf + 4 * (li & 3)) * 2;
#pragma unroll
              for (int db = 0; db < 2; ++db)
#pragma unroll
                  for (int s4 = 0; s4 < 4; ++s4) {
                      vlo[db][s4] = __builtin_bit_cast(s16x4, __builtin_amdgcn_ds_read_tr16_b64_v4i16((LAS s16x4*)(vbase + db * 4096 + s4 * 1024)));
                      vhh[db][s4] = __builtin_bit_cast(s16x4, __builtin_amdgcn_ds_read_tr16_b64_v4i16((LAS s16x4*)(vbase + db * 4096 + s4 * 1024 + 512))); } }
            __builtin_amdgcn_sched_barrier(0);
            if (part) {
                const float NEG = -INFINITY;
                if (MODE == AM_WINDOW) {
                    if (kb + 63 > qpos0w) { const int lim = qpos - kb - 4 * hi;
#pragma unroll
                        for (int r = 0; r < 16; ++r) { const int c = (r & 3) + 8 * (r >> 2); if (!(lim >= c)) p0[r] = NEG; if (!(lim >= c + 32)) p1[r] = NEG; } }
                    if (kb <= qpos0w + 31 - NSA_WIN) { const int lim = qpos - NSA_WIN - kb - 4 * hi;
#pragma unroll
                        for (int r = 0; r < 16; ++r) { const int c = (r & 3) + 8 * (r >> 2); if (!(lim < c)) p0[r] = NEG; if (!(lim < c + 32)) p1[r] = NEG; } }
                } else {
                    int lim;
                    if (MODE == AM_CMP) { const int nl = (qpos - 31) >> 4; lim = (nl < 510 ? nl : 510) - kb - 4 * hi; }
                    else lim = qpos - kb - 4 * hi;
#pragma unroll
                    for (int r = 0; r < 16; ++r) { const int c = (r & 3) + 8 * (r >> 2); if (!(lim >= c)) p0[r] = NEG; if (!(lim >= c + 32)) p1[r] = NEG; }
                }
            }
            float mxa = __builtin_fmaxf(__builtin_fmaxf(p0[0], p0[1]), p1[0]), mxc = __builtin_fmaxf(__builtin_fmaxf(p0[2], p0[3]), p1[1]); mxa = __builtin_fmaxf(__builtin_fmaxf(mxa, p1[2]), p1[3]);
#pragma unroll
            for (int r = 4; r < 16; r += 4) { mxa = __builtin_fmaxf(__builtin_fmaxf(mxa, p0[r]), p0[r + 1]); mxc = __builtin_fmaxf(__builtin_fmaxf(mxc, p0[r + 2]), p0[r + 3]); mxa = __builtin_fmaxf(__builtin_fmaxf(mxa, p1[r]), p1[r + 1]); mxc = __builtin_fmaxf(__builtin_fmaxf(mxc, p1[r + 2]), p1[r + 3]); }
            float mx = __builtin_fmaxf(mxa, mxc); mx = __builtin_fmaxf(mx, xor_f<32>(mx));
            if (MODE == AM_SELECT) mx = lanesel ? mx : -INFINITY;
            if (__any(mx > m + 6.0f)) { const float mn = fmaxf(m, mx), alpha = __builtin_amdgcn_exp2f(m - mn); m = mn; l *= alpha;
#pragma unroll
                for (int r = 0; r < 16; ++r) { o[0][r] *= alpha; o[1][r] *= alpha; } }
            typedef float f32x2v __attribute__((ext_vector_type(2)));
            const float msub = (MODE == AM_SELECT) ? (lanesel ? m : INFINITY) : m;
            const f32x2v m2 = (f32x2v){msub, msub}; f32x2v ps2 = (f32x2v){0.f, 0.f};
#pragma unroll
            for (int r = 0; r < 16; r += 2) { const f32x2v a_ = (f32x2v){p0[r], p0[r + 1]} - m2, b_ = (f32x2v){p1[r], p1[r + 1]} - m2;
                p0[r] = __builtin_amdgcn_exp2f(a_[0]); p0[r + 1] = __builtin_amdgcn_exp2f(a_[1]); p1[r] = __builtin_amdgcn_exp2f(b_[0]); p1[r + 1] = __builtin_amdgcn_exp2f(b_[1]);
                ps2 += (f32x2v){p0[r], p0[r + 1]}; ps2 += (f32x2v){p1[r], p1[r + 1]}; }
            l += ps2[0] + ps2[1];
            bf16x8 pf[4];
#pragma unroll
            for (int s4 = 0; s4 < 4; ++s4) { const int rb = 8 * (s4 & 1); v4u w;
                if (s4 < 2) { w.x = pg8::cvt_pk_bf16(p0[rb], p0[rb + 1]); w.y = pg8::cvt_pk_bf16(p0[rb + 2], p0[rb + 3]); w.z = pg8::cvt_pk_bf16(p0[rb + 4], p0[rb + 5]); w.w = pg8::cvt_pk_bf16(p0[rb + 6], p0[rb + 7]); }
                else        { w.x = pg8::cvt_pk_bf16(p1[rb], p1[rb + 1]); w.y = pg8::cvt_pk_bf16(p1[rb + 2], p1[rb + 3]); w.z = pg8::cvt_pk_bf16(p1[rb + 4], p1[rb + 5]); w.w = pg8::cvt_pk_bf16(p1[rb + 6], p1[rb + 7]); }
                pf[s4] = __builtin_bit_cast(bf16x8, w); }
#pragma unroll
            for (int s4 = 0; s4 < 4; ++s4) {
#pragma unroll
                for (int db = 0; db < 2; ++db) {
                    const s16x4 lo = vlo[db][s4], hh = vhh[db][s4];
                    const bf16x8 vf = (bf16x8){lo[0], lo[1], lo[2], lo[3], hh[0], hh[1], hh[2], hh[3]};
                    o[db] = __builtin_amdgcn_mfma_f32_32x32x16_bf16(vf, pf[s4], o[db], 0, 0, 0);
                }
            }
        }
      }
        if (jm < mhi) AT_WRITE(cur ^ 1);
        if (VAR != 7) __syncthreads();
        cur ^= 1;
    }
#undef AT_LOAD
#undef AT_WRITE
    __builtin_amdgcn_s_setprio(0);
    l += xor_f<32>(l);
    m_out = m; l_out = l;
    const float inv = (l > 0.f) ? 1.0f / l : 0.f;
#pragma unroll
    for (int r = 0; r < 16; ++r) { o[0][r] *= inv; o[1][r] *= inv; }
}
__device__ __forceinline__ unsigned q_issue(Frame& F, int qid) { unsigned t = 0u; if (F.tid == 0) t = __hip_atomic_fetch_add((unsigned*)(F.ctl + CW_Q + 64 * qid), 1u, __ATOMIC_RELAXED, __HIP_MEMORY_SCOPE_AGENT); return t; }
__device__ __forceinline__ int q_take(Frame& F, unsigned t) { if (F.tid == 0) F.MISC[0] = t; __syncthreads(); const int v = (int)F.MISC[0]; __syncthreads(); return __builtin_amdgcn_readfirstlane(v); }
__device__ __forceinline__ int q_fetch(Frame& F, int qid) {
    if (F.tid == 0) F.MISC[0] = __hip_atomic_fetch_add((unsigned*)(F.ctl + CW_Q + 64 * qid), 1u, __ATOMIC_RELAXED, __HIP_MEMORY_SCOPE_AGENT);
    __syncthreads(); const int v = (int)F.MISC[0]; __syncthreads(); return __builtin_amdgcn_readfirstlane(v);
}

constexpr int CW_FLAG = 19000;
__device__ __forceinline__ void unit_publish(Frame& F, int word) {
    asm volatile("s_waitcnt vmcnt(0)" ::: "memory");
    __syncthreads();
    if (F.tid == 0) { __builtin_amdgcn_fence(__ATOMIC_RELEASE, "agent"); asm volatile("s_waitcnt vmcnt(0)" ::: "memory"); (void)xb_add((unsigned*)(F.ctl + word), 1u); }
}
__device__ __forceinline__ void count_await(Frame& F, int word, unsigned target) {
    if (F.tid == 0) { unsigned* bar = (unsigned*)(F.ctl + CW_BAR); XB_SPIN(xb_ld((unsigned*)(F.ctl + word)) < target, bar); __builtin_amdgcn_fence(__ATOMIC_ACQUIRE, "agent"); asm volatile("s_waitcnt vmcnt(0)" ::: "memory"); }
    __syncthreads();
}
__device__ __forceinline__ void unit_await(Frame& F, int word) {
    if (F.tid == 0) { unsigned* bar = (unsigned*)(F.ctl + CW_BAR); XB_SPIN(xb_ld((unsigned*)(F.ctl + word)) == 0u, bar); __builtin_amdgcn_fence(__ATOMIC_ACQUIRE, "agent"); asm volatile("s_waitcnt vmcnt(0)" ::: "memory"); }
    __syncthreads();
}

constexpr size_t KC_HEAD = (size_t)512 * 64;
struct SchedCmp : pg8::TileOrder {
    const char* B;
    __device__ __forceinline__ unsigned arow(const Unit& u, int r) const { const int R = u.pm * 256 + r, n = R & 511, g = (R >> 9) & 1, b = (R >> 10) & 3, sr = R >> 12;
        return (unsigned)(((size_t)(b * SEQ + 16 * n) * NU + (sr ? C_VC : C_KC) + g * 64) * 2); }
    __device__ __forceinline__ size_t abase(const Unit&, int) const { return 0; }
    __device__ __forceinline__ const char* bbase(const Unit& u) const { return B + (size_t)(u.pm >> 4) * (256 * 2048 * 2); }
};
struct EpiCmp {
    static constexpr bool PERM = true;
    bf16* G; const float* bias;
    __device__ __forceinline__ void operator()(const f32x4 (&acc)[2][2][4][2], const Unit& u, int wr, int wc, int fr, int fq) const {
        const int row0 = u.pm * 256 + wr * 64 + fr, c8 = wc * 32 + 8 * fq; const float* bp = bias + (u.pm >> 4) * 128 + c8;
        const f32x4 b0 = *(const GAS f32x4*)bp, b1 = *(const GAS f32x4*)(bp + 4);
#pragma unroll
        for (int ai = 0; ai < 2; ++ai)
#pragma unroll
            for (int m = 0; m < 4; ++m) { const f32x4 v0 = acc[ai][0][m][0] + b0, v1 = acc[ai][0][m][1] + b1;
                *(v4u*)(G + (size_t)(row0 + ai * 128 + m * 16) * 128 + c8) = (v4u){pg8::cvt_pk_bf16(gelu_tanh(v0[0]), gelu_tanh(v0[1])), pg8::cvt_pk_bf16(gelu_tanh(v0[2]), gelu_tanh(v0[3])),
                                                                                      pg8::cvt_pk_bf16(gelu_tanh(v1[0]), gelu_tanh(v1[1])), pg8::cvt_pk_bf16(gelu_tanh(v1[2]), gelu_tanh(v1[3]))}; }
    }
};
__device__ __forceinline__ void p_cmp2(Frame& F, const float* w2) {
    phase_begin(F);
    const bf16* G = (const bf16*)(F.ws + WS_G1C); bf16* KC = (bf16*)(F.ws + WS_KC);
    for (int e = F.vcu * NTHR + F.tid; e < 8192 * 64; e += F.G * NTHR) { const int R = e >> 6, d = e & 63, sr = R >> 12; float a = 0.f;
        const GAS v4u* gr = (const GAS v4u*)(G + (size_t)R * 128); const float* w = w2 + (size_t)sr * 128 * 64 + d;
        for (int j8 = 0; j8 < 16; ++j8) { const v4u g = gr[j8];
            a += bflo(g.x) * w[(8 * j8 + 0) * 64] + bfhi(g.x) * w[(8 * j8 + 1) * 64] + bflo(g.y) * w[(8 * j8 + 2) * 64] + bfhi(g.y) * w[(8 * j8 + 3) * 64]
               + bflo(g.z) * w[(8 * j8 + 4) * 64] + bfhi(g.z) * w[(8 * j8 + 5) * 64] + bflo(g.w) * w[(8 * j8 + 6) * 64] + bfhi(g.w) * w[(8 * j8 + 7) * 64]; }
        KC[e] = (bf16)(((R & 511) == 511) ? 0u : f2bf(a)); }
}
__device__ __forceinline__ void p_cmp_bias(Frame& F, const float* cpos, const float* w1) {
    phase_begin(F);
    float* bias = (float*)(F.ws + WS_MISC + MS_CBIAS);
    LAS float* red = (LAS float*)F.lds;
    __syncthreads();
    for (int e = F.vcu; e < DEPTH * 2 * 128; e += F.G) { const int ls = e >> 7, j = e & 127; float a = 0.f;
#pragma unroll
        for (int i = 0; i < 2048 / NTHR; ++i) { const int k = F.tid + i * NTHR; a += cpos[(size_t)ls * 2048 + k] * w1[((size_t)ls * 2048 + k) * 128 + j]; }
        a = wave_sum(a);
        if (F.lane == 0) red[F.wave] = a;
        __syncthreads();
        if (F.tid == 0) bias[e] = ((red[0] + red[1]) + (red[2] + red[3])) + ((red[4] + red[5]) + (red[6] + red[7]));
        __syncthreads(); }
}
__device__ __forceinline__ float gate_of(const bf16* U, const float* gb, size_t row, int h, int br) { return sigmoidf_(bf2f(U[row * NU + C_GN + h * 3 + br]) + gb[h * 3 + br]); }

constexpr int KALL_OFF = 36864;
__device__ __forceinline__ void nsa_a_unit(Frame& F, int u, const float* gb) {
    typedef AttnLds<64> L;
    const bf16* U = (const bf16*)(F.ws + WS_U); bf16* OC = (bf16*)(F.ws + WS_OC); unsigned* MASK = (unsigned*)(F.ws + WS_MASK);
    const int r32 = F.lane & 31, hi = F.lane >> 5;
    const int qb = 31 - (u >> 3), bg = u & 7, b = bg >> 1, g = bg & 1;
    const int qpos0w = qb * 256 + F.wave * 32, qpos = qpos0w + r32; const size_t row = (size_t)b * SEQ + qpos;
    const int nmax = (qb * 256 + 255 - 31) >> 4;
    const int jhi = nmax >> 6;
    SrcCmp src{(const bf16*)(F.ws + WS_KC) + (size_t)(b * 2 + g) * KC_HEAD, (const bf16*)(F.ws + WS_KC) + (size_t)(8 + b * 2 + g) * KC_HEAD, (unsigned)(WS_KC + (size_t)(b * 2 + g) * KC_HEAD * 2), (unsigned)(WS_KC + (size_t)(8 + b * 2 + g) * KC_HEAD * 2)};
    { const int kkey = F.tid >> 3, kc = F.tid & 7;
#pragma unroll
      for (int j = 0; j < 8; ++j) if (j <= jhi) *(LAS v4u*)(F.lds + KALL_OFF + j * L::KBYTES + kkey * (L::KP * 2) + kc * 16) = *(const GAS v4u*)src.kp(j * 64 + kkey, kc); }
    float m0 = 0.f, m1 = 0.f, m2 = 0.f, l0 = 0.f, l1 = 0.f, l2 = 0.f;
#pragma unroll 1
    for (int p = 0; p < 3; ++p) { const int h = g * 3 + p;
        bf16x8 qf[4];
#pragma unroll
        for (int ks = 0; ks < 4; ++ks) qf[ks] = *(const GAS bf16x8*)(U + row * NU + C_QN + h * 64 + ks * 16 + hi * 8);
        f32x16 o[2]; float mh, lh;
        attn_branch<64, AM_CMP, 1>(F, F.lds, src, qf, qpos0w, 0, jhi, (v4u){0u, 0u, 0u, 0u}, o, mh, lh);
        if (p == 0) { m0 = mh; l0 = lh; } else if (p == 1) { m1 = mh; l1 = lh; } else { m2 = mh; l2 = lh; }
        const float gt = gate_of(U, gb, row, h, 0);
        bf16* orow = OC + row * 384 + h * 64;
#pragma unroll
        for (int db = 0; db < 2; ++db)
#pragma unroll
            for (int a = 0; a < 4; ++a) *(GAS v2u*)(orow + 32 * db + 8 * a + 4 * hi) = (v2u){pg8::cvt_pk_bf16(o[db][4 * a] * gt, o[db][4 * a + 1] * gt), pg8::cvt_pk_bf16(o[db][4 * a + 2] * gt, o[db][4 * a + 3] * gt)};
    }
    float imp[64];
#pragma unroll
    for (int k = 0; k < 64; ++k) imp[k] = 0.f;
#pragma unroll 1
    for (int p = 0; p < 3; ++p) { const int h = g * 3 + p;
        bf16x8 qf[4];
#pragma unroll
        for (int ks = 0; ks < 4; ++ks) qf[ks] = *(const GAS bf16x8*)(U + row * NU + C_QN + h * 64 + ks * 16 + hi * 8);
        const float mh = (p == 0) ? m0 : (p == 1) ? m1 : m2, lh = (p == 0) ? l0 : (p == 1) ? l1 : l2;
        const float il = (lh > 0.f) ? 1.0f / lh : 0.f; float carryE = 0.f;
        int qp2 = qpos; asm volatile("" : "+v"(qp2));
#pragma unroll 1
        for (int j = 0; j <= jhi; ++j) {
            const int kb = j * 64; const LAS unsigned char* kb_l = F.lds + KALL_OFF + j * L::KBYTES;
            f32x16 p0 = f32x16{}, p1 = f32x16{};
#pragma unroll
            for (int ks = 0; ks < 4; ++ks) {
                const bf16x8 k0 = *(const LAS bf16x8*)(kb_l + r32 * (L::KP * 2) + ks * 32 + hi * 16);
                const bf16x8 k1 = *(const LAS bf16x8*)(kb_l + (32 + r32) * (L::KP * 2) + ks * 32 + hi * 16);
                p0 = __builtin_amdgcn_mfma_f32_32x32x16_bf16(k0, qf[ks], p0, 0, 0, 0); p1 = __builtin_amdgcn_mfma_f32_32x32x16_bf16(k1, qf[ks], p1, 0, 0, 0); }
#pragma unroll
            for (int r = 0; r < 16; ++r) { p0[r] = __builtin_amdgcn_exp2f(p0[r] - mh); p1[r] = __builtin_amdgcn_exp2f(p1[r] - mh); }
            if ((16 * (kb + 63) + 31 > qpos0w) || (kb + 63 > 510)) {
                const int nl = (qp2 - 31) >> 4; const int lim = (nl < 510 ? nl : 510) - kb - 4 * hi;
#pragma unroll
                for (int r = 0; r < 16; ++r) { const int c = (r & 3) + 8 * (r >> 2); if (!(lim >= c)) p0[r] = 0.f; if (!(lim >= c + 32)) p1[r] = 0.f; } }
            float E0[4], E1[4], add[8];
#pragma unroll
            for (int a = 0; a < 4; ++a) { E0[a] = xor_f<32>(p0[4 * a + 3]); E1[a] = xor_f<32>(p1[4 * a + 3]); }
#pragma unroll
            for (int a = 0; a < 4; ++a) {
                const float e0 = hi ? E0[a] : (a > 0 ? E0[a > 0 ? a - 1 : 0] : carryE), e1 = hi ? E1[a] : (a > 0 ? E1[a > 0 ? a - 1 : 0] : E0[3]);
                add[a] = ((p0[4 * a] + p0[4 * a + 1]) + (p0[4 * a + 2] + p0[4 * a + 3])) + e0;
                add[4 + a] = ((p1[4 * a] + p1[4 * a + 1]) + (p1[4 * a + 2] + p1[4 * a + 3])) + e1; }
            carryE = E1[3];
#define IMP_ADD(J) if (j == (J)) { _Pragma("unroll") for (int i = 0; i < 8; ++i) imp[8 * (J) + i] += add[i] * il; }
            IMP_ADD(0) else IMP_ADD(1) else IMP_ADD(2) else IMP_ADD(3) else IMP_ADD(4) else IMP_ADD(5) else IMP_ADD(6) else IMP_ADD(7)
#undef IMP_ADD
        }
    }
    __syncthreads();
    {
        const int curb = qpos >> 6; unsigned mk0 = 0u, mk1 = 0u, mk2 = 0u, mk3 = 0u;
        LAS float* iv = (LAS float*)(F.lds + F.wave * 16384) + F.lane;
#pragma unroll
        for (int k = 0; k < 64; ++k) { const int sblk = 16 * (k >> 3) + 8 * ((k >> 2) & 1) + 2 * (k & 3) + hi; iv[k * 64] = (sblk == 0 || sblk >= curb) ? -2.0f : imp[k]; }
#define MK_SET(sv) do { const int s_ = (sv); const unsigned bit_ = 1u << (s_ & 31); const int w_ = s_ >> 5; mk0 |= (w_ == 0) ? bit_ : 0u; mk1 |= (w_ == 1) ? bit_ : 0u; mk2 |= (w_ == 2) ? bit_ : 0u; mk3 |= (w_ == 3) ? bit_ : 0u; } while (0)
        if (!__all(curb < 16)) {
#pragma unroll 1
            for (int rnd = 0; rnd < 14; ++rnd) {
                float best = -1.0f; int bk = 0;
#pragma unroll 8
                for (int k = 0; k < 64; ++k) { const float v = iv[k * 64]; if (v > best) { best = v; bk = k; } }
                const int bs = 16 * (bk >> 3) + 8 * ((bk >> 2) & 1) + 2 * (bk & 3) + hi;
                const float ob = xor_f<32>(best); const int os = (int)xor_u<32>((unsigned)bs);
                const bool win = (best > ob) || (best == ob && bs < os);
                if (win && best >= 0.f) { iv[bk * 64] = -2.0f; MK_SET(bs); }
            }
            MK_SET(0); MK_SET(curb);
        }
        if (curb < 16) { mk0 = (2u << curb) - 1u; mk1 = 0u; mk2 = 0u; mk3 = 0u; }
        mk0 |= xor_u<32>(mk0); mk1 |= xor_u<32>(mk1); mk2 |= xor_u<32>(mk2); mk3 |= xor_u<32>(mk3);
#undef MK_SET
        if (hi == 0) *(GAS v4u*)(MASK + ((size_t)(b * 2 + g) * SEQ + qpos) * 4) = (v4u){mk0, mk1, mk2, mk3};
    }
    __syncthreads();
}
template <int VAR>
__device__ __forceinline__ void nsa_b_unit(Frame& F, int u, const float* gb) {
    const bf16* U = (const bf16*)(F.ws + WS_U); bf16* CAT = (bf16*)(F.ws + WS_CAT); const unsigned* MASK = (const unsigned*)(F.ws + WS_MASK);
    const int r32 = F.lane & 31, hi = F.lane >> 5;
    const int qb = 31 - u / 24, bh = u % 24, b = bh / 6, h = bh % 6, g = h / 3;
    const int qpos0w = qb * 256 + F.wave * 32, qpos = qpos0w + r32; const size_t row = (size_t)b * SEQ + qpos;
    bf16x8 qf[4];
#pragma unroll
    for (int ks = 0; ks < 4; ++ks) qf[ks] = *(const GAS bf16x8*)(U + row * NU + C_QN + h * 64 + ks * 16 + hi * 8);
    const v4u sm = *(const GAS v4u*)(MASK + ((size_t)(b * 2 + g) * SEQ + qpos) * 4);
    f32x16 o[2], acc[2]; float m_, l_;
    { SrcU src{U, C_KS + g * 64, C_VS + g * 64, (size_t)b * SEQ};
      attn_branch<64, AM_SELECT, 2, VAR>(F, F.lds, src, qf, qpos0w, 0, qb * 4 + 3, sm, o, m_, l_); }
    { const float gt = gate_of(U, gb, row, h, 1);
#pragma unroll
      for (int r = 0; r < 16; ++r) { acc[0][r] = o[0][r] * gt; acc[1][r] = o[1][r] * gt; } }
    { SrcU src{U, C_KW + g * 64, C_VW + g * 64, (size_t)b * SEQ};
      const int jl = qb * 4 - 8 < 0 ? 0 : qb * 4 - 8;
      attn_branch<64, AM_WINDOW, 2, VAR>(F, F.lds, src, qf, qpos0w, jl, qb * 4 + 3, (v4u){0u, 0u, 0u, 0u}, o, m_, l_); }
    { const float gt = gate_of(U, gb, row, h, 2);
#pragma unroll
      for (int r = 0; r < 16; ++r) { acc[0][r] += o[0][r] * gt; acc[1][r] += o[1][r] * gt; } }
    bf16* orow = CAT + row * DM + 640 + h * 64; const bf16* crow_ = (const bf16*)(F.ws + WS_OC) + row * 384 + h * 64;
#pragma unroll
    for (int db = 0; db < 2; ++db)
#pragma unroll
        for (int a = 0; a < 4; ++a) { GAS v2u* p = (GAS v2u*)(orow + 32 * db + 8 * a + 4 * hi); const v2u c = *(const GAS v2u*)(crow_ + 32 * db + 8 * a + 4 * hi);
            *p = (v2u){pg8::cvt_pk_bf16(acc[db][4 * a] + bflo(c.x), acc[db][4 * a + 1] + bfhi(c.x)), pg8::cvt_pk_bf16(acc[db][4 * a + 2] + bflo(c.y), acc[db][4 * a + 3] + bfhi(c.y))}; }
}
namespace nb {
typedef __attribute__((address_space(3))) const char* lds_cptr;
typedef short v4i16_t __attribute__((ext_vector_type(4)));
constexpr int SLOTB = 8192, NSLOT = 3, LDS_K = 0, LDS_V = NSLOT * SLOTB, LDS_WS = 2 * NSLOT * SLOTB, LDS_OST = LDS_WS + 8 * 64 * 4, LDS_OST2 = LDS_OST + 8 * 4096, LDS_END = LDS_OST2 + 8 * 4096;
static_assert(LDS_END + 8192 <= RING_BYTES, "attention scratch must fit below the frame's control words");
constexpr int LDS_X = LDS_OST2;
constexpr float THRL = 8.0f;
#define NB_SBAR() __builtin_amdgcn_sched_barrier(0)
#define NB_WAIT_BAR(N) asm volatile("s_waitcnt vmcnt(" #N ") lgkmcnt(0)\n\ts_barrier" ::: "memory")
#define NB_PIN(x) asm volatile("" : "+v"(x))
#define NB_MX3(a, b, c) __builtin_fmaxf(__builtin_fmaxf((a), (b)), (c))
__device__ __forceinline__ void glds16(const void* gbase, unsigned voff, unsigned lds_dst) { unsigned keep;
    asm volatile("s_mov_b32 %0, m0\n\ts_mov_b32 m0, %2\n\ts_nop 0\n\tglobal_load_lds_dwordx4 %1, %3\n\ts_mov_b32 m0, %0" : "=&s"(keep) : "v"(voff), "s"(lds_dst), "s"(gbase) : "memory"); }
__device__ __forceinline__ int fresh_lane() { int z_ = 0; asm volatile("" : "+v"(z_)); return (int)__builtin_amdgcn_mbcnt_hi(~0u, __builtin_amdgcn_mbcnt_lo(~0u, z_)); }
typedef float f32x2_t __attribute__((ext_vector_type(2))); typedef __bf16 bf16x2_t __attribute__((ext_vector_type(2)));
__device__ __forceinline__ unsigned cvtpk_s(float lo, float hi) { f32x2_t v = {lo, hi}; bf16x2_t b = __builtin_convertvector(v, bf16x2_t); return __builtin_bit_cast(unsigned, b); }
__device__ __forceinline__ void kload2(bf16x8* kf, lds_cptr kp, int j) { kf[2 * j] = *(const __attribute__((address_space(3))) bf16x8*)(kp + j * 2048); kf[2 * j + 1] = *(const __attribute__((address_space(3))) bf16x8*)(kp + j * 2048 + 512); }
__device__ __forceinline__ s16x4 vtr(lds_cptr p) { return __builtin_bit_cast(s16x4, __builtin_amdgcn_ds_read_tr16_b64_v4i16((__attribute__((address_space(3))) v4i16_t*)p)); }
__device__ __forceinline__ float rowmax(const f32x16& p0, const f32x16& p1) {
    float a = NB_MX3(p0[0], p0[1], p1[0]), b = NB_MX3(p0[2], p0[3], p1[1]); a = NB_MX3(a, p1[2], p1[3]);
#pragma unroll
    for (int r = 4; r < 16; r += 4) { a = NB_MX3(a, p0[r], p0[r + 1]); b = NB_MX3(b, p0[r + 2], p0[r + 3]); a = NB_MX3(a, p1[r], p1[r + 1]); b = NB_MX3(b, p1[r + 2], p1[r + 3]); }
    float m = __builtin_fmaxf(a, b); auto rr = __builtin_amdgcn_permlane32_swap(__float_as_uint(m), __float_as_uint(m), false, false);
    return __builtin_fmaxf(__uint_as_float(rr[0]), __uint_as_float(rr[1])); }
__device__ __forceinline__ void cmask(f32x16& p0, f32x16& p1, int jb, int qrel, int hi) {
    const int kb = 64 * jb + 4 * hi;
#pragma unroll
    for (int r = 0; r < 16; ++r) { const int kv = kb + (r & 3) + 8 * (r >> 2); if (kv > qrel) p0[r] = -INFINITY; if (kv + 32 > qrel) p1[r] = -INFINITY; } }
__device__ __forceinline__ void lmask(f32x16& p0, f32x16& p1, int t, int qrel, int hi) {
    const int kb = 64 * t + 4 * hi;
#pragma unroll
    for (int r = 0; r < 16; ++r) { const int kv = kb + (r & 3) + 8 * (r >> 2); if (kv <= qrel) p0[r] = -INFINITY; if (kv + 32 <= qrel) p1[r] = -INFINITY; } }

template <int MODE, int QP, int KP, int VP, int KX, int XP>
__device__ __forceinline__ void branch(int wid, const bf16* Qw, const bf16* K0, const bf16* V0, const bf16* X0, int NT, bool lowm, const v4u sm, char* shm, int ost) {
    const int lane = fresh_lane();
    const int r32 = lane & 31, hi = lane >> 5;
    const unsigned lds0 = (unsigned)(uintptr_t)shm;
    float* wsf = (float*)(shm + LDS_WS) + wid * 64;
    const unsigned koff = (unsigned)(lane * KP + wid * 8) * 2u;
    const unsigned voff = (unsigned)((16 * (wid & 3) + (lane >> 2)) * VP + (wid >> 2) * 32 + (lane & 3) * 8) * 2u;
    const unsigned xoff = (unsigned)(lane * XP + (wid & 3) * 8) * 2u;
    const unsigned kdst = lds0 + LDS_K + wid * 1024, vdst = lds0 + LDS_V + wid * 1024, xdst = lds0 + LDS_X + (wid & 3) * 1024;
#define DMA_K(t, slot) glds16(K0 + (long)(t) * 64 * KP, koff, (unsigned)__builtin_amdgcn_readfirstlane(kdst + (slot)))
#define DMA_V(t, slot) glds16(V0 + (long)(t) * 64 * VP, voff, (unsigned)__builtin_amdgcn_readfirstlane(vdst + (slot)))
#define DMA_X(t) do { if (KX) glds16(X0 + (long)(t) * 64 * XP, xoff, (unsigned)__builtin_amdgcn_readfirstlane(xdst + (((t) & 3) * 4096))); } while (0)
    LAS unsigned* smw = (LAS unsigned*)((LAS unsigned char*)(lds_cptr)shm + LDS_END) + (wid * 64 + lane) * 4;
    unsigned cw = sm.x;
    if (MODE == AM_SELECT) *(LAS v4u*)smw = sm;
#define SELB(t) ((MODE != AM_SELECT) || ((cw >> ((t) & 31)) & 1u))
#define SELNEXT(t) do { if (MODE == AM_SELECT) { if ((((t) + 1) & 31) == 0) cw = smw[(((t) + 1) >> 5) & 3]; } } while (0)
    const lds_cptr shm3 = (lds_cptr)shm; const lds_cptr kp0 = shm3 + LDS_K + hi * 1024 + r32 * 16; const lds_cptr xp0 = shm3 + LDS_X + hi * 1024 + r32 * 16;
    const lds_cptr vp0 = shm3 + LDS_V + ((lane >> 4) & 1) * 32 + (lane & 3) * 8 + (4 * hi + ((lane & 15) >> 2)) * 64;
    bf16x8 kf[8];
    DMA_K(0, 0); DMA_X(0); DMA_V(0, 0); DMA_K(1, SLOTB); DMA_X(1);
    bf16x8 qr[4], qx[KX ? KX : 1];
#pragma unroll
    for (int d0 = 0; d0 < 4; ++d0) qr[d0] = *reinterpret_cast<const bf16x8*>(&Qw[(long)r32 * QP + d0 * 16 + hi * 8]);
#pragma unroll
    for (int d0 = 0; d0 < KX; ++d0) qx[d0] = *reinterpret_cast<const bf16x8*>(&Qw[(long)r32 * QP + 64 + d0 * 16 + hi * 8]);
    float mhat = 0.f, l_reg = 0.f; f32x16 o[2]; o[0] = f32x16{}; o[1] = f32x16{};
    f32x16 cin = f32x16{}; NB_PIN(cin);
#define CMASK(P0, P1, t, BAND) do { if (BAND) { const int jb_ = (t) - (NT - 4); if (jb_ >= 0) { const int ln_ = fresh_lane(); cmask(P0, P1, jb_, wid * 32 + (ln_ & 31), ln_ >> 5); } } \
        if (MODE == AM_WINDOW) { if (lowm && (t) <= 3) { const int ln_ = fresh_lane(); lmask(P0, P1, (t), wid * 32 + (ln_ & 31), ln_ >> 5); } } } while (0)
    bool resc = false;
#define RESC() do { if (resc) { asm volatile("s_waitcnt lgkmcnt(0)" ::: "memory"); const int hi_ = fresh_lane() >> 5; \
        _Pragma("unroll") for (int d_ = 0; d_ < 2; ++d_) _Pragma("unroll") for (int r = 0; r < 16; ++r) o[d_][r] *= wsf[crow(r, hi_)]; } } while (0)
    f32x16 pA0, pA1, pB0, pB1;
    int sl_prev = 0, sl_cur = 0, sl_next = SLOTB;
#define ROT() do { sl_prev = sl_cur; sl_cur = sl_next; sl_next = (sl_next == (NSLOT - 1) * SLOTB) ? 0 : sl_next + SLOTB; } while (0)
    DMA_K(2, 2 * SLOTB); DMA_X(2);
    if (KX) { NB_WAIT_BAR(5); } else { NB_WAIT_BAR(3); }
    { _Pragma("unroll") for (int d0 = 0; d0 < 4; ++d0) kload2(kf, kp0, d0);
      pA0 = __builtin_amdgcn_mfma_f32_32x32x16_bf16(kf[0], qr[0], cin, 0, 0, 0); pA1 = __builtin_amdgcn_mfma_f32_32x32x16_bf16(kf[1], qr[0], cin, 0, 0, 0);
      _Pragma("unroll") for (int d0 = 1; d0 < 4; ++d0) { pA0 = __builtin_amdgcn_mfma_f32_32x32x16_bf16(kf[2 * d0], qr[d0], pA0, 0, 0, 0); pA1 = __builtin_amdgcn_mfma_f32_32x32x16_bf16(kf[2 * d0 + 1], qr[d0], pA1, 0, 0, 0); }
      _Pragma("unroll") for (int d0 = 0; d0 < KX; ++d0) { const bf16x8 x0 = *(const __attribute__((address_space(3))) bf16x8*)(xp0 + d0 * 2048), x1 = *(const __attribute__((address_space(3))) bf16x8*)(xp0 + d0 * 2048 + 512);
          pA0 = __builtin_amdgcn_mfma_f32_32x32x16_bf16(x0, qx[d0], pA0, 0, 0, 0); pA1 = __builtin_amdgcn_mfma_f32_32x32x16_bf16(x1, qx[d0], pA1, 0, 0, 0); } }
    CMASK(pA0, pA1, 0, true);
    if (!SELB(0)) { _Pragma("unroll") for (int r = 0; r < 16; ++r) { pA0[r] = -INFINITY; pA1[r] = -INFINITY; } }
    { const float rm = rowmax(pA0, pA1); const float dl = (rm > -1.0e30f) ? rm : 0.f; mhat = dl;
#pragma unroll
      for (int r = 0; r < 16; ++r) { pA0[r] = __builtin_amdgcn_exp2f(pA0[r] - dl); pA1[r] = __builtin_amdgcn_exp2f(pA1[r] - dl); } }
    { const float cv0 = SELB(1) ? -mhat : -INFINITY;
#pragma unroll
      for (int r = 0; r < 16; ++r) cin[r] = cv0;
      NB_PIN(cin); }
    NB_WAIT_BAR(0);
    DMA_K(3, 0); DMA_X(3); DMA_V(1, SLOTB);
    ROT();
    { _Pragma("unroll") for (int d0 = 0; d0 < 4; ++d0) kload2(kf, kp0 + sl_cur, d0); }
    if (KX) { NB_WAIT_BAR(3); } else { NB_WAIT_BAR(2); }
    s16x4 vlo[8], vhi[8]; v4u pw0, pw1, pw2, pw3;
#define PKW(P, B) cvtpk_s(P[B], P[B + 1])
#define PAF(k) __builtin_bit_cast(bf16x8, pw##k)
#define VFR(i) (bf16x8){vlo[i][0], vlo[i][1], vlo[i][2], vlo[i][3], vhi[i][0], vhi[i][1], vhi[i][2], vhi[i][3]}
#define GAPA(MF, A0, A1, A2, A3, W0, W1, PW) do { MF; sacc += A0; sacc += A1; sacc += A2; sacc += A3; NB_PIN(sacc); W0; W1; NB_PIN(PW); NB_SBAR(); } while (0)
#define EX(v) __builtin_amdgcn_exp2f(v)
#define GAPB(MF, X, B, CI) do { MF; X[B] = EX(X[B]); X[B + 1] = EX(X[B + 1]); X[B + 2] = EX(X[B + 2]); X[B + 3] = EX(X[B + 3]); if (MODE == AM_SELECT) { cin[CI] = cv_; cin[CI + 1] = cv_; NB_PIN(cin); } NB_PIN(X); NB_SBAR(); } while (0)
#define VRD(i) do { vlo[i] = vtr(vp_ + (((i) >> 2) * 4096 + ((i) & 3) * 1024)); vhi[i] = vtr(vp_ + (((i) >> 2) * 4096 + ((i) & 3) * 1024 + 512)); } while (0)
#define KRD(G, j) do { if (G) { kload2(kf, kp0 + sl_next, j); NB_SBAR(); } } while (0)
#define STEP(C0, C1, P0, P1, t, GK, GV, GL, BAND) do { NB_SBAR(); \
    const lds_cptr vp_ = vp0 + sl_prev; \
    VRD(0); NB_SBAR(); float sacc = (P0[0] + P0[1]); \
    GAPA(C0 = __builtin_amdgcn_mfma_f32_32x32x16_bf16(kf[0], qr[0], cin, 0, 0, 0), P0[2], P0[3], P0[4], P0[5],     pw0[0] = PKW(P0, 0), pw0[1] = PKW(P0, 2), pw0); \
    VRD(4); NB_SBAR(); GAPA(C1 = __builtin_amdgcn_mfma_f32_32x32x16_bf16(kf[1], qr[0], cin, 0, 0, 0), P0[6], P0[7], P0[8], P0[9],     pw0[2] = PKW(P0, 4), pw0[3] = PKW(P0, 6), pw0); \
    VRD(1); NB_SBAR(); GAPA(C0 = __builtin_amdgcn_mfma_f32_32x32x16_bf16(kf[2], qr[1], C0, 0, 0, 0),  P0[10], P0[11], P0[12], P0[13], pw1[0] = PKW(P0, 8), pw1[1] = PKW(P0, 10), pw1); \
    VRD(5); NB_SBAR(); GAPA(C1 = __builtin_amdgcn_mfma_f32_32x32x16_bf16(kf[3], qr[1], C1, 0, 0, 0),  P0[14], P0[15], P1[0], P1[1],   pw1[2] = PKW(P0, 12), pw1[3] = PKW(P0, 14), pw1); \
    bf16x8 kx0_, kx1_, kx2_, kx3_; \
    if (KX) { const lds_cptr xp_ = xp0 + (((t) & 3) * 4096); kx0_ = *(const __attribute__((address_space(3))) bf16x8*)(xp_); kx1_ = *(const __attribute__((address_space(3))) bf16x8*)(xp_ + 512); NB_SBAR(); } \
    VRD(2); NB_SBAR(); GAPA(C0 = __builtin_amdgcn_mfma_f32_32x32x16_bf16(kf[4], qr[2], C0, 0, 0, 0),  P1[2], P1[3], P1[4], P1[5],     pw2[0] = PKW(P1, 0), pw2[1] = PKW(P1, 2), pw2); \
    VRD(6); NB_SBAR(); GAPA(C1 = __builtin_amdgcn_mfma_f32_32x32x16_bf16(kf[5], qr[2], C1, 0, 0, 0),  P1[6], P1[7], P1[8], P1[9],     pw2[2] = PKW(P1, 4), pw2[3] = PKW(P1, 6), pw2); \
    if (KX > 1) { const lds_cptr xp_ = xp0 + (((t) & 3) * 4096); kx2_ = *(const __attribute__((address_space(3))) bf16x8*)(xp_ + 2048); kx3_ = *(const __attribute__((address_space(3))) bf16x8*)(xp_ + 2560); NB_SBAR(); } \
    VRD(3); NB_SBAR(); GAPA(C0 = __builtin_amdgcn_mfma_f32_32x32x16_bf16(kf[6], qr[3], C0, 0, 0, 0),  P1[10], P1[11], P1[12], P1[13], pw3[0] = PKW(P1, 8), pw3[1] = PKW(P1, 10), pw3); \
    VRD(7); NB_SBAR(); GAPA(C1 = __builtin_amdgcn_mfma_f32_32x32x16_bf16(kf[7], qr[3], C1, 0, 0, 0),  P1[14], P1[15], 0.f, 0.f,       pw3[2] = PKW(P1, 12), pw3[3] = PKW(P1, 14), pw3); \
    if (KX) { C0 = __builtin_amdgcn_mfma_f32_32x32x16_bf16(kx0_, qx[0], C0, 0, 0, 0); NB_SBAR(); C1 = __builtin_amdgcn_mfma_f32_32x32x16_bf16(kx1_, qx[0], C1, 0, 0, 0); NB_SBAR(); } \
    if (KX > 1) { C0 = __builtin_amdgcn_mfma_f32_32x32x16_bf16(kx2_, qx[KX > 1 ? 1 : 0], C0, 0, 0, 0); NB_SBAR(); C1 = __builtin_amdgcn_mfma_f32_32x32x16_bf16(kx3_, qx[KX > 1 ? 1 : 0], C1, 0, 0, 0); NB_SBAR(); } \
    l_reg += sacc; \
    if (GK) { DMA_K((t) + 3, sl_cur); DMA_X((t) + 3); } if (GV) { DMA_V((t) + 1, sl_next); } \
    CMASK(C0, C1, t, BAND); \
    { float a = NB_MX3(C0[0], C0[1], C1[0]), b = NB_MX3(C0[2], C0[3], C1[1]); a = NB_MX3(a, C1[2], C1[3]); \
      _Pragma("unroll") for (int r = 4; r < 16; r += 4) { a = NB_MX3(a, C0[r], C0[r + 1]); b = NB_MX3(b, C0[r + 2], C0[r + 3]); a = NB_MX3(a, C1[r], C1[r + 1]); b = NB_MX3(b, C1[r + 2], C1[r + 3]); } \
      float rm = __builtin_fmaxf(a, b); { auto rr = __builtin_amdgcn_permlane32_swap(__float_as_uint(rm), __float_as_uint(rm), false, false); rm = __builtin_fmaxf(__uint_as_float(rr[0]), __uint_as_float(rr[1])); } \
      resc = false; \
      if (__builtin_expect(__any(rm > THRL), 0)) { const float dl = __builtin_fmaxf(rm, 0.f); mhat += dl; \
        _Pragma("unroll") for (int r = 0; r < 16; ++r) { C0[r] -= dl; C1[r] -= dl; } \
        if (MODE != AM_SELECT) { _Pragma("unroll") for (int r = 0; r < 16; ++r) cin[r] = -mhat; NB_PIN(cin); }        \
        const float f = __builtin_amdgcn_exp2f(-dl); l_reg *= f; { const int ln_ = fresh_lane(); if (ln_ < 32) wsf[ln_] = f; } resc = true; } } \
    SELNEXT(t); const float cv_ = SELB((t) + 1) ? -mhat : -INFINITY; \
    NB_SBAR(); \
    GAPB(o[0] = __builtin_amdgcn_mfma_f32_32x32x16_bf16(PAF(0), VFR(0), o[0], 0, 0, 0), C0, 0, 0); \
    GAPB(o[1] = __builtin_amdgcn_mfma_f32_32x32x16_bf16(PAF(0), VFR(4), o[1], 0, 0, 0), C0, 4, 2); \
    KRD(GL, 0); GAPB(o[0] = __builtin_amdgcn_mfma_f32_32x32x16_bf16(PAF(1), VFR(1), o[0], 0, 0, 0), C0, 8, 4); \
    KRD(GL, 1); GAPB(o[1] = __builtin_amdgcn_mfma_f32_32x32x16_bf16(PAF(1), VFR(5), o[1], 0, 0, 0), C0, 12, 6); \
    KRD(GL, 2); GAPB(o[0] = __builtin_amdgcn_mfma_f32_32x32x16_bf16(PAF(2), VFR(2), o[0], 0, 0, 0), C1, 0, 8); \
    KRD(GL, 3); GAPB(o[1] = __builtin_amdgcn_mfma_f32_32x32x16_bf16(PAF(2), VFR(6), o[1], 0, 0, 0), C1, 4, 10); \
    GAPB(o[0] = __builtin_amdgcn_mfma_f32_32x32x16_bf16(PAF(3), VFR(3), o[0], 0, 0, 0), C1, 8, 12); \
    GAPB(o[1] = __builtin_amdgcn_mfma_f32_32x32x16_bf16(PAF(3), VFR(7), o[1], 0, 0, 0), C1, 12, 14); \
    } while (0)
#define WAIT_FULL() do { if (KX) { NB_WAIT_BAR(3); } else { NB_WAIT_BAR(2); } } while (0)
    int t = 1;
    for (; t + 5 < NT; t += 2) {
        STEP(pB0, pB1, pA0, pA1, t, true, true, true, false);       WAIT_FULL(); RESC(); ROT();
        STEP(pA0, pA1, pB0, pB1, t + 1, true, true, true, false);   WAIT_FULL(); RESC(); ROT();
    }
#define ENDW(tt) do { if ((tt) + 3 < NT) { WAIT_FULL(); } else if ((tt) + 2 < NT) { NB_WAIT_BAR(1); } else { NB_WAIT_BAR(0); } } while (0)
    for (; t + 1 < NT; t += 2) {
        STEP(pB0, pB1, pA0, pA1, t, (t + 3 < NT), (t + 1 < NT), (t + 1 < NT), true);         ENDW(t);     RESC(); ROT();
        STEP(pA0, pA1, pB0, pB1, t + 1, (t + 4 < NT), (t + 2 < NT), (t + 2 < NT), true);     ENDW(t + 1); RESC(); ROT();
    }
    STEP(pB0, pB1, pA0, pA1, NT - 1, false, false, false, true); RESC();
    { float sacc = pB0[0] + pB0[1];
      _Pragma("unroll") for (int r = 2; r < 16; ++r) sacc += pB0[r];
      _Pragma("unroll") for (int r = 0; r < 16; ++r) sacc += pB1[r];
      l_reg += sacc;
      pw0 = (v4u){PKW(pB0, 0), PKW(pB0, 2), PKW(pB0, 4), PKW(pB0, 6)}; pw1 = (v4u){PKW(pB0, 8), PKW(pB0, 10), PKW(pB0, 12), PKW(pB0, 14)};
      pw2 = (v4u){PKW(pB1, 0), PKW(pB1, 2), PKW(pB1, 4), PKW(pB1, 6)}; pw3 = (v4u){PKW(pB1, 8), PKW(pB1, 10), PKW(pB1, 12), PKW(pB1, 14)};
      NB_SBAR();
      const lds_cptr vp_ = vp0 + sl_cur;
      _Pragma("unroll") for (int i = 0; i < 8; ++i) VRD(i);
      o[0] = __builtin_amdgcn_mfma_f32_32x32x16_bf16(PAF(0), VFR(0), o[0], 0, 0, 0); o[1] = __builtin_amdgcn_mfma_f32_32x32x16_bf16(PAF(0), VFR(4), o[1], 0, 0, 0);
      o[0] = __builtin_amdgcn_mfma_f32_32x32x16_bf16(PAF(1), VFR(1), o[0], 0, 0, 0); o[1] = __builtin_amdgcn_mfma_f32_32x32x16_bf16(PAF(1), VFR(5), o[1], 0, 0, 0);
      o[0] = __builtin_amdgcn_mfma_f32_32x32x16_bf16(PAF(2), VFR(2), o[0], 0, 0, 0); o[1] = __builtin_amdgcn_mfma_f32_32x32x16_bf16(PAF(2), VFR(6), o[1], 0, 0, 0);
      o[0] = __builtin_amdgcn_mfma_f32_32x32x16_bf16(PAF(3), VFR(3), o[0], 0, 0, 0); o[1] = __builtin_amdgcn_mfma_f32_32x32x16_bf16(PAF(3), VFR(7), o[1], 0, 0, 0); }
#undef PKW
#undef PAF
#undef VFR
#undef GAPA
#undef GAPB
#undef EX
#undef VRD
#undef KRD
#undef STEP
#undef ENDW
#undef WAIT_FULL
    { auto rr = __builtin_amdgcn_permlane32_swap(__float_as_uint(l_reg), __float_as_uint(l_reg), false, false); l_reg = __uint_as_float(rr[0]) + __uint_as_float(rr[1]); }
    const int lne = fresh_lane(), r32e = lne & 31, hie = lne >> 5;
    if (hie == 0) wsf[32 + r32e] = l_reg; asm volatile("s_waitcnt lgkmcnt(0)" ::: "memory");
    { bf16* stg = (bf16*)(shm + ost) + wid * 2048 + r32e;
#pragma unroll
      for (int r = 0; r < 16; ++r) { const int orow = crow(r, hie); const float lv = wsf[32 + orow]; const float rl = lv > 0.f ? __builtin_amdgcn_rcpf(lv) : 0.f;
#pragma unroll
          for (int d0 = 0; d0 < 2; ++d0) stg[orow * 64 + d0 * 32] = (bf16)f2bf(o[d0][r] * rl); } }
    asm volatile("s_waitcnt lgkmcnt(0)\n\ts_barrier" ::: "memory");
#undef DMA_K
#undef DMA_V
#undef DMA_X
#undef SELB
#undef SELNEXT
#undef CMASK
#undef RESC
#undef ROT
}
}

__device__ __forceinline__ void nsa_b_unit2(Frame& F, int u, const float* gb) {
    const bf16* U = (const bf16*)(F.ws + WS_U); bf16* CAT = (bf16*)(F.ws + WS_CAT); const unsigned* MASK = (const unsigned*)(F.ws + WS_MASK); const bf16* OC = (const bf16*)(F.ws + WS_OC);
    const int wid = F.wave; const int r32 = nb::fresh_lane() & 31;
    const int qb = 31 - u / 24, bh = u % 24, b = bh / 6, h = bh % 6, g = h / 3;
    const size_t rowbase = (size_t)b * SEQ; const int q0 = qb * 256, qpos0w = q0 + wid * 32;
    char* shm = (char*)F.lds;
    const bf16* Qw = U + (rowbase + qpos0w) * NU + C_QN + h * 64;
    const v4u sm = *(const GAS v4u*)(MASK + ((size_t)(b * 2 + g) * SEQ + qpos0w + r32) * 4);
    nb::branch<AM_SELECT, NU, NU, NU, 0, NU>(wid, Qw, U + rowbase * NU + C_KS + g * 64, U + rowbase * NU + C_VS + g * 64, U, 4 * qb + 4, false, sm, shm, nb::LDS_OST);
    { const int jl = qb >= 2 ? 4 * qb - 8 : 0; const int NT = 4 * qb + 4 - jl;
      nb::branch<AM_WINDOW, NU, NU, NU, 0, NU>(wid, Qw, U + (rowbase + (size_t)jl * 64) * NU + C_KW + g * 64, U + (rowbase + (size_t)jl * 64) * NU + C_VW + g * 64, U, NT, qb >= 2, (v4u){0u, 0u, 0u, 0u}, shm, nb::LDS_OST2); }
    const int lane2 = nb::fresh_lane();
    const LAS unsigned char* s1 = F.lds + nb::LDS_OST + wid * 4096; const LAS unsigned char* s2 = F.lds + nb::LDS_OST2 + wid * 4096;
#pragma unroll 1
    for (int i = 0; i < 4; ++i) { const int row = i * 8 + (lane2 >> 3), ch = lane2 & 7; const size_t grow = rowbase + qpos0w + row;
        const float gs = gate_of(U, gb, grow, h, 1), gw = gate_of(U, gb, grow, h, 2);
        const v4u a = *(const LAS v4u*)(s1 + row * 128 + ch * 16), w = *(const LAS v4u*)(s2 + row * 128 + ch * 16), c = *(const GAS v4u*)(OC + grow * 384 + h * 64 + ch * 8);
        v4u r_;
        r_.x = pg8::cvt_pk_bf16(gs * bflo(a.x) + gw * bflo(w.x) + bflo(c.x), gs * bfhi(a.x) + gw * bfhi(w.x) + bfhi(c.x));
        r_.y = pg8::cvt_pk_bf16(gs * bflo(a.y) + gw * bflo(w.y) + bflo(c.y), gs * bfhi(a.y) + gw * bfhi(w.y) + bfhi(c.y));
        r_.z = pg8::cvt_pk_bf16(gs * bflo(a.z) + gw * bflo(w.z) + bflo(c.z), gs * bfhi(a.z) + gw * bfhi(w.z) + bfhi(c.z));
        r_.w = pg8::cvt_pk_bf16(gs * bflo(a.w) + gw * bflo(w.w) + bflo(c.w), gs * bfhi(a.w) + gw * bfhi(w.w) + bfhi(c.w));
        *(GAS v4u*)(CAT + grow * DM + 640 + h * 64 + ch * 8) = r_; }
}
__device__ __forceinline__ void mla_unit2(Frame& F, int u) {
    const bf16* QM = (const bf16*)(F.ws + WS_QM); const bf16* KVM = (const bf16*)(F.ws + WS_KVM); const bf16* U = (const bf16*)(F.ws + WS_U); bf16* CAT = (bf16*)(F.ws + WS_CAT);
    const int wid = F.wave;
    const int qb = 31 - u / 24, bh = u % 24, b = bh / 6, h = bh % 6;
    const size_t rowbase = (size_t)b * SEQ; const int qpos0w = qb * 256 + wid * 32;
    nb::branch<AM_CAUSAL, 576, 768, 768, 2, NU>(wid, QM + (rowbase + qpos0w) * 576 + h * 96, KVM + rowbase * 768 + h * 128, KVM + rowbase * 768 + h * 128 + 64, U + rowbase * NU + C_KPE, 4 * qb + 4, false,
                                                (v4u){0u, 0u, 0u, 0u}, (char*)F.lds, nb::LDS_OST);
    const int lane2 = nb::fresh_lane();
    const LAS unsigned char* s1 = F.lds + nb::LDS_OST + wid * 4096;
#pragma unroll
    for (int i = 0; i < 4; ++i) { const int row = i * 8 + (lane2 >> 3), ch = lane2 & 7;
        *(GAS v4u*)(CAT + (rowbase + qpos0w + row) * DM + 256 + h * 64 + ch * 8) = *(const LAS v4u*)(s1 + row * 128 + ch * 16); }
}
__device__ __forceinline__ void mla_unit(Frame& F, int u) {
    const bf16* QM = (const bf16*)(F.ws + WS_QM); bf16* CAT = (bf16*)(F.ws + WS_CAT);
    const int r32 = F.lane & 31, hi = F.lane >> 5;
    const int qb = 31 - u / 24, bh = u % 24, b = bh / 6, h = bh % 6;
    const int qpos0w = qb * 256 + F.wave * 32; const size_t row = (size_t)b * SEQ + qpos0w + r32;
    bf16x8 qf[6];
#pragma unroll
    for (int ks = 0; ks < 6; ++ks) qf[ks] = *(const GAS bf16x8*)(QM + row * 576 + h * 96 + ks * 16 + hi * 8);
    SrcMla src{(const bf16*)(F.ws + WS_KVM), (const bf16*)(F.ws + WS_U), h, (size_t)b * SEQ};
    f32x16 o[2]; float m_, l_;
    attn_branch<96, AM_CAUSAL, 2>(F, F.lds, src, qf, qpos0w, 0, qb * 4 + 3, (v4u){0u, 0u, 0u, 0u}, o, m_, l_);
    bf16* orow = CAT + row * DM + 256 + h * 64;
#pragma unroll
    for (int db = 0; db < 2; ++db)
#pragma unroll
        for (int a = 0; a < 4; ++a) *(GAS v2u*)(orow + 32 * db + 8 * a + 4 * hi) = (v2u){pg8::cvt_pk_bf16(o[db][4 * a], o[db][4 * a + 1]), pg8::cvt_pk_bf16(o[db][4 * a + 2], o[db][4 * a + 3])};
}
__device__ __forceinline__ void p_attn1(Frame& F, int qid, const float* gb) {
    phase_begin(F);
    int dready = 0;
    unsigned tk = q_issue(F, qid);
    for (;;) {
        const int t = q_take(F, tk); if (t >= 1024) break; tk = q_issue(F, qid);
        if (t >= 576 && t < 832) {
            if (!dready) { count_await(F, CW_FLAG + 512 + (qid >> 1), (unsigned)F.G); dready = 1; phase_begin(F); }
            const int u = __builtin_amdgcn_readfirstlane(t - 576);
            nsa_a_unit(F, u, gb); unit_publish(F, CW_FLAG + (qid >> 1) * 256 + u);
        } else {
            mla_unit2(F, __builtin_amdgcn_readfirstlane(t < 576 ? t : t - 256));
        }
        phase_begin(F);
    }
    if (!dready) { phase_begin(F); count_await(F, CW_FLAG + 512 + (qid >> 1), (unsigned)F.G); }
}
template <int VAR>
__device__ __forceinline__ void p_attn2(Frame& F, int qid, const float* gb) {
    phase_begin(F);
    for (;;) { const int u = q_fetch(F, qid); if (u >= 768) break;
        { const int bh = u % 24, b = bh / 6, g = (bh % 6) / 3; unit_await(F, CW_FLAG + (qid >> 1) * 256 + (((u / 24) << 3) | (b * 2 + g))); }
        nsa_b_unit2(F, __builtin_amdgcn_readfirstlane(u), gb); phase_begin(F); }
}

struct EpiQKV {
    static constexpr bool PERM = true;
    bf16* QM; bf16* KVM; const float* ssq; const f32x2* tabm;
    __device__ __forceinline__ void operator()(const f32x4 (&acc)[2][2][4][2], const Unit& u, int wr, int wc, int fr, int fq) const {
        const int row0 = u.pm * 256 + wr * 64 + fr; const bool isq = u.pn < 3;
        float rs[8];
        { f32x4 s0[8], s1[8], s2[8];
#pragma unroll
          for (int i = 0; i < 8; ++i) { const GAS f32x4* sp = (const GAS f32x4*)((const GAS char*)ssq + (unsigned)(row0 + (i >> 2) * 128 + (i & 3) * 16) * 64u); s0[i] = sp[0]; s1[i] = sp[1]; s2[i] = sp[2]; }
#pragma unroll
          for (int i = 0; i < 8; ++i) rs[i] = isq ? QSCALE_M / sqrtf(((s0[i][0] + s0[i][1]) + (s0[i][2] + s0[i][3]) + (s1[i][0] + s1[i][1])) * (1.0f / 192.0f) + EPS)
                                                  : 1.0f / sqrtf(((s1[i][2] + s1[i][3]) + (s2[i][0] + s2[i][1])) * (1.0f / 128.0f) + EPS); }
        const bool isrope = isq && (((u.pn % 3) * 256 + wc * 32) % 96 == 64 || ((u.pn % 3) * 256 + 128 + wc * 32) % 96 == 64);
        f32x4 t0[8], t1[8];
        if (isrope) {
#pragma unroll
            for (int i = 0; i < 8; ++i) { const int pos = (row0 + (i >> 2) * 128 + (i & 3) * 16) & (SEQ - 1); const GAS f32x4* t = (const GAS f32x4*)((const GAS char*)tabm + (unsigned)(pos * 128 + 32 * fq)); t0[i] = t[0]; t1[i] = t[1]; } }
#pragma unroll
        for (int ai = 0; ai < 2; ++ai)
#pragma unroll
            for (int m = 0; m < 4; ++m) { const int row = row0 + ai * 128 + m * 16; const float r_ = rs[ai * 4 + m];
#pragma unroll
                for (int bj = 0; bj < 2; ++bj) {
                    const int c32 = (u.pn % 3) * 256 + bj * 128 + wc * 32, c8 = c32 + 8 * fq; const f32x4 v0 = acc[ai][bj][m][0], v1 = acc[ai][bj][m][1];
                    if (!isq) { const f32x4 a = v0 * r_, b = v1 * r_; *(v4u*)(KVM + (size_t)row * 768 + c8) = (v4u){pg8::cvt_pk_bf16(a[0], a[1]), pg8::cvt_pk_bf16(a[2], a[3]), pg8::cvt_pk_bf16(b[0], b[1]), pg8::cvt_pk_bf16(b[2], b[3])}; }
                    else if (c32 < 576) {
                        const int hd = c32 / 96, w32 = c32 - hd * 96;
                        if (w32 < 64) { const f32x4 a = v0 * r_, b = v1 * r_; *(v4u*)(QM + (size_t)row * 576 + c8) = (v4u){pg8::cvt_pk_bf16(a[0], a[1]), pg8::cvt_pk_bf16(a[2], a[3]), pg8::cvt_pk_bf16(b[0], b[1]), pg8::cvt_pk_bf16(b[2], b[3])}; }
                        else { const int i = fq; const f32x4 ta = t0[ai * 4 + m], tb = t1[ai * 4 + m]; const f32x4 x1 = v0 * r_, x2 = v1 * r_;
                            const auto s0 = __builtin_amdgcn_permlane16_swap(pg8::cvt_pk_bf16(x1[0] * ta[0] - x2[0] * ta[1], x1[1] * ta[2] - x2[1] * ta[3]), pg8::cvt_pk_bf16(x2[0] * ta[0] + x1[0] * ta[1], x2[1] * ta[2] + x1[1] * ta[3]), false, false);
                            const auto s1 = __builtin_amdgcn_permlane16_swap(pg8::cvt_pk_bf16(x1[2] * tb[0] - x2[2] * tb[1], x1[3] * tb[2] - x2[3] * tb[3]), pg8::cvt_pk_bf16(x2[2] * tb[0] + x1[2] * tb[1], x2[3] * tb[2] + x1[3] * tb[3]), false, false);
                            bf16* o = QM + (size_t)row * 576 + hd * 96 + 64 + 4 * i + ((fq & 1) ? 12 : 0);
                            *(v4u*)o = (v4u){s0[0], s1[0], s0[1], s1[1]}; }
                    }
                } }
    }
};
struct SchedQKV : pg8::TileOrder {
    const char* B;
    __device__ __forceinline__ unsigned arow(const Unit&, int r) const { return (unsigned)(r & 127) * (NU * 2); }
    __device__ __forceinline__ size_t abase(const Unit& u, int h) const { return (size_t)(u.pm * 256 + h * 128) * (NU * 2); }
    __device__ __forceinline__ const char* bbase(const Unit& u) const { return B + (size_t)u.pn * (256 * 384 * 2); }
};

__device__ __forceinline__ void p_copy_rows(Frame& F, const float* src, float* dst) {
    phase_begin(F);
    const int gw = F.vcu * NWAVES + F.wave, NGW = F.G * NWAVES;
    for (int m = gw; m < TOK; m += NGW) { const GAS f32x4* s = (const GAS f32x4*)(src + (size_t)m * DM) + F.lane; GAS f32x4* d = (GAS f32x4*)(dst + (size_t)m * DM) + F.lane;
#pragma unroll
        for (int j = 0; j < 4; ++j) d[64 * j] = s[64 * j]; }
}
template <bool ROUTE>
__device__ __forceinline__ void p_norm(Frame& F, const float* x, const float* gain, const float* rw) {
    phase_begin(F);
    bf16* XN = (bf16*)(F.ws + WS_XN);
    f32x4 gv[4];
#pragma unroll
    for (int j = 0; j < 4; ++j) gv[j] = *((const GAS f32x4*)gain + F.lane + 64 * j);
    f32x4 rwv[16][2];
    if (ROUTE) {
#pragma unroll
        for (int j = 0; j < 4; ++j)
#pragma unroll
            for (int k = 0; k < 4; ++k) { const int c = 4 * F.lane + 256 * j + k; rwv[4 * j + k][0] = *(const GAS f32x4*)(rw + (size_t)c * 8); rwv[4 * j + k][1] = *(const GAS f32x4*)(rw + (size_t)c * 8 + 4); }
    }
    LAS unsigned* es = (LAS unsigned*)F.lds;
    for (int ch = F.vcu; ch < TOK / 128; ch += F.G) {
        for (int rr = 0; rr < 16; ++rr) {
            const int m = ch * 128 + F.wave * 16 + rr;
            const GAS f32x4* xr = (const GAS f32x4*)(x + (size_t)m * DM) + F.lane;
            f32x4 v[4]; float s2 = 0.f;
#pragma unroll
            for (int j = 0; j < 4; ++j) { v[j] = xr[64 * j]; s2 += (v[j].x * v[j].x + v[j].y * v[j].y) + (v[j].z * v[j].z + v[j].w * v[j].w); }
            const float rstd = 1.0f / sqrtf(wave_sum(s2) * (1.f / DM) + EPS);
#pragma unroll
            for (int j = 0; j < 4; ++j) v[j] = v[j] * rstd * gv[j];
            GAS unsigned long long* o8 = (GAS unsigned long long*)(XN + (size_t)m * DM) + F.lane;
#pragma unroll
            for (int j = 0; j < 4; ++j) o8[64 * j] = (unsigned long long)pk2(v[j].x, v[j].y) | ((unsigned long long)pk2(v[j].z, v[j].w) << 32);
            if (ROUTE) {
                float lg[8];
#pragma unroll
                for (int e = 0; e < 8; ++e) lg[e] = 0.f;
#pragma unroll
                for (int j = 0; j < 4; ++j)
#pragma unroll
                    for (int k = 0; k < 4; ++k) { const float xv = v[j][k]; const f32x4 a = rwv[4 * j + k][0], b = rwv[4 * j + k][1];
                        lg[0] += xv * a.x; lg[1] += xv * a.y; lg[2] += xv * a.z; lg[3] += xv * a.w; lg[4] += xv * b.x; lg[5] += xv * b.y; lg[6] += xv * b.z; lg[7] += xv * b.w; }
#pragma unroll
                for (int e = 0; e < 8; ++e) lg[e] = wave_sum(lg[e]);
                int e1 = 0; float v1 = lg[0];
#pragma unroll
                for (int e = 1; e < 8; ++e) if (lg[e] > v1) { v1 = lg[e]; e1 = e; }
                int e2 = (e1 == 0) ? 1 : 0; float v2 = (e1 == 0) ? lg[1] : lg[0];
#pragma unroll
                for (int e = 0; e < 8; ++e) if (e != e1 && lg[e] > v2) { v2 = lg[e]; e2 = e; }
                const float ex = __expf(v2 - v1); const float g1 = 1.0f / (1.0f + ex), g2 = ex / (1.0f + ex);
                if (F.lane == 0) { f32x4 r; r.x = __builtin_bit_cast(float, e1); r.y = __builtin_bit_cast(float, e2); r.z = g1; r.w = g2;
                    *(GAS f32x4*)(F.ws + WS_MISC + MS_ROUTE + (size_t)m * 16) = r; es[F.wave * 16 + rr] = (unsigned)e1 | ((unsigned)e2 << 8); }
            }
        }
        if (ROUTE) {
            __syncthreads();
            { const unsigned w = (F.tid < 128) ? es[F.tid] : 0xffffu;
#pragma unroll
              for (int e = 0; e < 8; ++e) { const unsigned long long mk = __ballot((int)(w & 255u) == e || (int)(w >> 8) == e); if (F.lane == 0 && F.wave < 2) es[128 + F.wave * 8 + e] = (unsigned)__popcll(mk); } }
            __syncthreads();
            if (F.tid < 8) ((GAS int*)(F.ws + WS_MISC + MS_COUNTS))[ch * 8 + F.tid] = (int)(es[128 + F.tid] + es[136 + F.tid]);
            __syncthreads();
        }
    }
}
__device__ __forceinline__ void p_scatter(Frame& F) {
    phase_begin(F);
    LAS int* cnt = (LAS int*)F.lds;
    LAS int* tot = cnt + 2048;
    const GAS int* counts = (const GAS int*)(F.ws + WS_MISC + MS_COUNTS);
    GAS int* rowlist = (GAS int*)(F.ws + WS_MISC + MS_ROWLIST);
    GAS int* tokslot = (GAS int*)(F.ws + WS_MISC + MS_TOKSLOT);
    for (int i = F.tid; i < 2048; i += NTHR) cnt[i] = counts[i];
    __syncthreads();
    LAS int* gp = tot + 64;
    if (F.tid < 256) { const int e = F.tid & 7, g = F.tid >> 3; int t = 0;
#pragma unroll
        for (int c = 0; c < 8; ++c) t += cnt[(8 * g + c) * 8 + e];
        gp[e * 33 + g] = t; }
    __syncthreads();
    if (F.tid < 8) { int run = 0; for (int g = 0; g < 32; ++g) { const int v = gp[F.tid * 33 + g]; gp[F.tid * 33 + g] = run; run += v; } tot[F.tid] = run; }
    __syncthreads();
    if (F.tid == 0) { int b = 0; for (int e = 0; e < 8; ++e) { tot[8 + e] = b; b += (tot[e] + 255) & ~255; } tot[16] = b; }
    __syncthreads();
    LAS int* pre = tot + 32;
    for (int ch = F.vcu; ch < TOK / 128; ch += F.G) {
        if (F.tid < 8) { const int e = F.tid; int pos = tot[8 + e] + gp[e * 33 + (ch >> 3)]; for (int c = ch & ~7; c < ch; ++c) pos += cnt[c * 8 + e]; pre[e] = pos; }
        int e1 = -1, e2 = -1; const int m = ch * 128 + F.tid;
        if (F.tid < 128) { const GAS int* r = (const GAS int*)(F.ws + WS_MISC + MS_ROUTE + (size_t)m * 16); e1 = r[0]; e2 = r[1]; }
        int rk1 = 0, rk2 = 0;
        const unsigned long long lt = (1ull << F.lane) - 1ull;
#pragma unroll
        for (int e = 0; e < 8; ++e) { const unsigned long long mk = __ballot(e1 == e || e2 == e); const int rk = __popcll(mk & lt);
            if (e1 == e) rk1 = rk; if (e2 == e) rk2 = rk; if (F.tid == 0) pre[8 + e] = __popcll(mk); }
        __syncthreads();
        if (F.tid < 128) { const int add = (F.tid >= 64) ? 1 : 0;
            const int p1 = pre[e1] + (add ? pre[8 + e1] : 0) + rk1, p2 = pre[e2] + (add ? pre[8 + e2] : 0) + rk2;
            rowlist[p1] = m; tokslot[2 * m] = p1; rowlist[p2] = m; tokslot[2 * m + 1] = p2; }
        __syncthreads();
    }
    if (F.vcu == 0) {
        if (F.tid < 8) { const int e = F.tid; const int b = tot[8 + e] + tot[e], en = tot[8 + e] + ((tot[e] + 255) & ~255); for (int p = b; p < en; ++p) rowlist[p] = 0; }
        if (F.tid < 9) ((GAS int*)(F.ws + WS_MISC + MS_EBASE))[F.tid] = (F.tid < 8 ? tot[8 + F.tid] : tot[16]) / 256;
    }
}
__device__ __forceinline__ void p_combine_final(Frame& F, const float* gain) {
    phase_begin(F);
    const int gw = F.vcu * NWAVES + F.wave, NGW = F.G * NWAVES;
    const bf16* Y = (const bf16*)(F.ws + WS_Y);
    f32x4 gv[4];
#pragma unroll
    for (int j = 0; j < 4; ++j) gv[j] = *((const GAS f32x4*)gain + F.lane + 64 * j);
    f32x4 rn = (f32x4){0.f, 0.f, 0.f, 0.f}; v2u sn = (v2u){0u, 0u};
    if (gw < TOK) { rn = *(const GAS f32x4*)(F.ws + WS_MISC + MS_ROUTE + (size_t)gw * 16); sn = *(const GAS v2u*)(F.ws + WS_MISC + MS_TOKSLOT + (size_t)gw * 8); }
    for (int m = gw; m < TOK; m += NGW) {
        f32x4 r = rn; r.z *= ALPHA_MOE; r.w *= ALPHA_MOE;
        const int s1 = (int)sn.x, s2 = (int)sn.y;
        { const int mn = m + NGW; if (mn < TOK) { rn = *(const GAS f32x4*)(F.ws + WS_MISC + MS_ROUTE + (size_t)mn * 16); sn = *(const GAS v2u*)(F.ws + WS_MISC + MS_TOKSLOT + (size_t)mn * 8); } }
        GAS f32x4* xr = (GAS f32x4*)(F.out + (size_t)m * DM) + F.lane;
        const GAS v2u* y1 = (const GAS v2u*)(Y + (size_t)s1 * DM) + F.lane; const GAS v2u* y2 = (const GAS v2u*)(Y + (size_t)s2 * DM) + F.lane;
        f32x4 v[4]; float ss = 0.f;
#pragma unroll
        for (int j = 0; j < 4; ++j) { v[j] = xr[64 * j]; const v2u a = y1[64 * j], b = y2[64 * j];
            v[j].x += r.z * bflo(a.x) + r.w * bflo(b.x); v[j].y += r.z * bfhi(a.x) + r.w * bfhi(b.x); v[j].z += r.z * bflo(a.y) + r.w * bflo(b.y); v[j].w += r.z * bfhi(a.y) + r.w * bfhi(b.y);
            ss += (v[j].x * v[j].x + v[j].y * v[j].y) + (v[j].z * v[j].z + v[j].w * v[j].w); }
        const float rstd = 1.0f / sqrtf(wave_sum(ss) * (1.f / DM) + EPS);
#pragma unroll
        for (int j = 0; j < 4; ++j) xr[64 * j] = v[j] * rstd * gv[j];
    }
}
__device__ __forceinline__ void p_nan_rows(Frame& F) {
    phase_begin(F);
    const int gw = F.vcu * NWAVES + F.wave, NGW = F.G * NWAVES; const float q = __builtin_nanf("");
    for (int m = gw; m < TOK; m += NGW) { GAS f32x4* o = (GAS f32x4*)(F.out + (size_t)m * DM) + F.lane;
#pragma unroll
        for (int j = 0; j < 4; ++j) o[64 * j] = (f32x4){q, q, q, q}; }
}


#ifdef DBG
constexpr int CW_DBG = 20000;
#ifndef DBG_STAT
#define DBG_STAT 40
#endif
__device__ __forceinline__ unsigned hsh(unsigned a) { a ^= a >> 16; a *= 0x7feb352du; a ^= a >> 15; a *= 0x846ca68bu; a ^= a >> 16; return a; }
__device__ __forceinline__ void dbg_put(Frame& F, int id, float err) { if (!(err >= 0.f)) err = 1e30f; atomicMax((unsigned*)(F.ctl + CW_DBG + id), __builtin_bit_cast(unsigned, err)); }
__device__ __forceinline__ float relerr(float got, float ref) { return fabsf(got - ref) / (fabsf(ref) + 1.0f); }
__device__ __forceinline__ float silu_ref(float g) { return g / (1.0f + expf(-g)); }
__device__ __forceinline__ int dbg_sample(Frame& F, int salt) { return (int)hsh((unsigned)(blockIdx.x * NTHR + F.tid) * 7919u + (unsigned)salt); }
__device__ __forceinline__ void chk_xn(Frame& F, int id, const float* x, const float* gain) {
    phase_begin(F); if (blockIdx.x >= 16) return;
    const unsigned h = (unsigned)dbg_sample(F, 11); const int row = h % TOK, col = (h >> 16) % DM;
    float ss = 0.f; for (int k = 0; k < DM; ++k) { const float v = x[(size_t)row * DM + k]; ss += v * v; }
    const float ref = x[(size_t)row * DM + col] / sqrtf(ss / DM + EPS) * gain[col];
    dbg_put(F, id, relerr(bf2f(((const bf16*)(F.ws + WS_XN))[(size_t)row * DM + col]), ref));
}
__device__ __forceinline__ void chk_ffn_up(Frame& F, int id, const float* wg, const float* wu) {
    phase_begin(F); if (blockIdx.x >= 16) return;
    const unsigned h = (unsigned)dbg_sample(F, 23); const int row = h % TOK, hid = (h >> 15) % DFF;
    const bf16* xn = (const bf16*)(F.ws + WS_XN) + (size_t)row * DM; float g = 0.f, u = 0.f;
    for (int k = 0; k < DM; ++k) { const float a = bf2f(xn[k]); g += a * wg[(size_t)k * DFF + hid]; u += a * wu[(size_t)k * DFF + hid]; }
    dbg_put(F, id, relerr(bf2f(((const bf16*)(F.ws + WS_H))[(size_t)row * DFF + hid]), silu_ref(g) * u));
}
__device__ __forceinline__ void chk_ffn_down(Frame& F, int id, const float* base, const float* wd) {
    phase_begin(F); if (blockIdx.x >= 16) return;
    const unsigned h = (unsigned)dbg_sample(F, 37); const int row = h % TOK, col = (h >> 16) % DM;
    const bf16* hr = (const bf16*)(F.ws + WS_H) + (size_t)row * DFF; float a = base[(size_t)row * DM + col];
    for (int k = 0; k < DFF; ++k) a += bf2f(hr[k]) * wd[(size_t)k * DM + col];
    dbg_put(F, id, relerr(F.out[(size_t)row * DM + col], a));
}
__device__ __forceinline__ void chk_route(Frame& F, int id, const float* x, const float* gain, const float* rw) {
    phase_begin(F); if (blockIdx.x >= 4) return;
    const unsigned h = (unsigned)dbg_sample(F, 41); const int row = h % TOK;
    float ss = 0.f; for (int k = 0; k < DM; ++k) { const float v = x[(size_t)row * DM + k]; ss += v * v; }
    const float rstd = 1.0f / sqrtf(ss / DM + EPS); float lg[8]; for (int e = 0; e < 8; ++e) lg[e] = 0.f;
    for (int k = 0; k < DM; ++k) { const float v = x[(size_t)row * DM + k] * rstd * gain[k]; for (int e = 0; e < 8; ++e) lg[e] += v * rw[(size_t)k * 8 + e]; }
    int e1 = 0; for (int e = 1; e < 8; ++e) if (lg[e] > lg[e1]) e1 = e;
    int e2 = (e1 == 0) ? 1 : 0; for (int e = 0; e < 8; ++e) if (e != e1 && lg[e] > lg[e2]) e2 = e;
    const float g1 = 1.0f / (1.0f + expf(lg[e2] - lg[e1]));
    const GAS int* r = (const GAS int*)(F.ws + WS_MISC + MS_ROUTE + (size_t)row * 16);
    float gap = 1e9f; for (int e = 0; e < 8; ++e) if (e != e1 && e != e2) gap = fminf(gap, lg[e2] - lg[e]);
    float err = 0.f;
    if (gap > 1e-3f && lg[e1] - lg[e2] > 1e-3f) { if (r[0] != e1 || r[1] != e2) err = 10.f; err = fmaxf(err, fabsf(__builtin_bit_cast(float, r[2]) - g1)); }
    dbg_put(F, id, err);
    const GAS int* ts = (const GAS int*)(F.ws + WS_MISC + MS_TOKSLOT); const GAS int* rl = (const GAS int*)(F.ws + WS_MISC + MS_ROWLIST); const GAS int* eb = (const GAS int*)(F.ws + WS_MISC + MS_EBASE);
    float e2r = 0.f;
    for (int k = 0; k < 2; ++k) { const int sl = ts[2 * row + k]; if (sl < 0 || sl >= MAXSLOT || rl[sl] != row) { e2r = 10.f; break; }
        int ex = 0; for (int j = 1; j < 8; ++j) ex += (sl / 256 >= eb[j]) ? 1 : 0; if (ex != r[k]) e2r = 20.f; }
    dbg_put(F, id + 1, e2r);
}
__device__ __forceinline__ void chk_moe_up(Frame& F, int id, const float* wg, const float* wu) {
    phase_begin(F); if (blockIdx.x >= 16) return;
    const GAS int* eb = (const GAS int*)(F.ws + WS_MISC + MS_EBASE); const GAS int* rl = (const GAS int*)(F.ws + WS_MISC + MS_ROWLIST);
    const unsigned h = (unsigned)dbg_sample(F, 53); const int slot = h % (eb[8] * 256), hid = (h >> 15) % DFE; const int row = rl[slot];
    int ex = 0; for (int j = 1; j < 8; ++j) ex += (slot / 256 >= eb[j]) ? 1 : 0;
    const bf16* xn = (const bf16*)(F.ws + WS_XN) + (size_t)row * DM; float g = 0.f, u = 0.f;
    for (int k = 0; k < DM; ++k) { const float a = bf2f(xn[k]); g += a * wg[((size_t)ex * DM + k) * DFE + hid]; u += a * wu[((size_t)ex * DM + k) * DFE + hid]; }
    dbg_put(F, id, relerr(bf2f(((const bf16*)(F.ws + WS_H))[(size_t)slot * DFE + hid]), silu_ref(g) * u));
}
__device__ __forceinline__ void chk_moe_down(Frame& F, int id, const float* wd) {
    phase_begin(F); if (blockIdx.x >= 16) return;
    const GAS int* eb = (const GAS int*)(F.ws + WS_MISC + MS_EBASE);
    const unsigned h = (unsigned)dbg_sample(F, 67); const int slot = h % (eb[8] * 256), col = (h >> 16) % DM;
    int ex = 0; for (int j = 1; j < 8; ++j) ex += (slot / 256 >= eb[j]) ? 1 : 0;
    const bf16* hr = (const bf16*)(F.ws + WS_H) + (size_t)slot * DFE; float a = 0.f;
    for (int k = 0; k < DFE; ++k) a += bf2f(hr[k]) * wd[((size_t)ex * DFE + k) * DM + col];
    dbg_put(F, id, relerr(bf2f(((const bf16*)(F.ws + WS_Y))[(size_t)slot * DM + col]), a));
}

__device__ __forceinline__ void chk_u(Frame& F, int id, const float* w_in) {
    phase_begin(F); if (blockIdx.x >= 16) return;
    const unsigned h = (unsigned)dbg_sample(F, 71 + id); const int row = h % TOK, c = (h >> 15) % IN_COLS, pos = row & (SEQ - 1);
    const bf16* xn = (const bf16*)(F.ws + WS_XN) + (size_t)row * DM;
    int c1 = c, c2 = -1; float cs = 1.f, sn = 0.f, sc = 1.f; bool second = false;
    if (is_rope64(c)) { const int seg = c >= C_KW ? C_KW : c >= C_KS ? C_KS : c >= C_KC ? C_KC : C_QN; const int l = c - seg, hb = seg + (l & ~63), dd = l & 63, i = dd & 31;
        c1 = hb + i; c2 = hb + 32 + i; second = dd >= 32; const float ang = (float)pos * INV_N[i]; cs = cosf(ang); sn = sinf(ang); if (seg == C_QN) sc = QSCALE_N; }
    else if (c >= C_KPE && c < C_QN) { const int dd = c - C_KPE, i = dd & 15; c1 = C_KPE + i; c2 = C_KPE + 16 + i; second = dd >= 16; const float ang = (float)pos * INV_M[i]; cs = cosf(ang); sn = sinf(ang); }
    float a1 = 0.f, a2 = 0.f;
    for (int k = 0; k < DM; ++k) { const float a = bf2f(xn[k]); a1 += a * w_in[(size_t)k * IN_COLS + c1]; if (c2 >= 0) a2 += a * w_in[(size_t)k * IN_COLS + c2]; }
    const float ref = (c2 < 0) ? a1 : (second ? (a2 * cs + a1 * sn) * sc : (a1 * cs - a2 * sn) * sc);
    dbg_put(F, id, relerr(bf2f(((const bf16*)(F.ws + WS_U))[(size_t)row * NU + c]), ref));
}
__device__ __forceinline__ void chk_lru(Frame& F, int id, const float* cw, const float* cb, const float* wa, const float* ba, const float* wx, const float* bx, const float* lam) {
    phase_begin(F); if (blockIdx.x >= 2) return;
    const unsigned hs = (unsigned)dbg_sample(F, 91 + id); const int b = hs & 3, pos = (hs >> 2) % 150, d = (hs >> 16) & 255, blk = d >> 6, dd = d & 63;
    const bf16* U = (const bf16*)(F.ws + WS_U); const float sp = logf(1.0f + expf(-lam[d])); float h = 0.f;
    for (int p = 0; p <= pos; ++p) { const size_t t = (size_t)b * SEQ + p; float ra = ba[d], ia = bx[d], xcd = 0.f;
        for (int c = 0; c < 64; ++c) { const int ch = blk * 64 + c; float xc = cb[ch];
            for (int k = 0; k < 4; ++k) { const int pp = p - 3 + k; if (pp >= 0) xc += cw[k * 256 + ch] * bf2f(U[((size_t)b * SEQ + pp) * NU + C_XL + ch]); }
            ra += xc * wa[(size_t)(blk * 64 + c) * 64 + dd]; ia += xc * wx[(size_t)(blk * 64 + c) * 64 + dd]; if (c == dd) xcd = xc; }
        const float r = 1.0f / (1.0f + expf(-ra)), ig = 1.0f / (1.0f + expf(-ia)), la = -8.0f * r * sp, a = expf(la);
        h = a * h + sqrtf(1.0f - expf(2.0f * la)) * (ig * xcd); }
    const size_t t = (size_t)b * SEQ + pos; const float y = bf2f(U[t * NU + C_YL + d]); const float gl = 0.5f * y * (1.0f + tanhf(0.7978845608f * (y + 0.044715f * y * y * y)));
    dbg_put(F, id, relerr(bf2f(((const bf16*)(F.ws + WS_CAT))[t * DM + d]), h * gl));
}

__device__ __forceinline__ void chk_lru_rec(Frame& F, int id, const float* cw, const float* cb, const float* wa, const float* ba, const float* wx, const float* bx, const float* lam) {
    phase_begin(F); if (blockIdx.x >= 8) return;
    const unsigned hs = (unsigned)dbg_sample(F, 191 + id); const int b = hs & 3, pos = 4 + (hs >> 2) % (SEQ - 4), d = (hs >> 16) & 255, blk = d >> 6, dd = d & 63;
    const bf16* U = (const bf16*)(F.ws + WS_U); const bf16* CAT = (const bf16*)(F.ws + WS_CAT); const float sp = logf(1.0f + expf(-lam[d]));
    const size_t t = (size_t)b * SEQ + pos;
    float ra = ba[d], ia = bx[d], xcd = 0.f;
    for (int c = 0; c < 64; ++c) { const int ch = blk * 64 + c; float xc = cb[ch];
        for (int k = 0; k < 4; ++k) xc += cw[k * 256 + ch] * bf2f(U[(t - 3 + k) * NU + C_XL + ch]);
        ra += xc * wa[(size_t)(blk * 64 + c) * 64 + dd]; ia += xc * wx[(size_t)(blk * 64 + c) * 64 + dd]; if (c == dd) xcd = xc; }
    const float r = 1.0f / (1.0f + expf(-ra)), ig = 1.0f / (1.0f + expf(-ia)), la = -8.0f * r * sp, a = expf(la);
    const float y0 = bf2f(U[(t - 1) * NU + C_YL + d]), y1 = bf2f(U[t * NU + C_YL + d]);
    const float g0 = 0.5f * y0 * (1.0f + tanhf(0.7978845608f * (y0 + 0.044715f * y0 * y0 * y0))), g1 = 0.5f * y1 * (1.0f + tanhf(0.7978845608f * (y1 + 0.044715f * y1 * y1 * y1)));
    float err = 0.f;
    if (fabsf(g0) > 0.25f) { const float hp = bf2f(CAT[(t - 1) * DM + d]) / g0; const float ref = (a * hp + sqrtf(1.0f - expf(2.0f * la)) * (ig * xcd)) * g1; err = relerr(bf2f(CAT[t * DM + d]), ref); }
    dbg_put(F, id, err);
}
__device__ __forceinline__ void chk_outproj(Frame& F, int id, const float* base, const float* w_out) {
    phase_begin(F); if (blockIdx.x >= 16) return;
    const unsigned h = (unsigned)dbg_sample(F, 37 + id); const int row = h % TOK, col = (h >> 16) % DM;
    const bf16* cr = (const bf16*)(F.ws + WS_CAT) + (size_t)row * DM; float a = base[(size_t)row * DM + col];
    for (int k = 0; k < DM; ++k) a += bf2f(cr[k]) * w_out[(size_t)k * DM + col];
    dbg_put(F, id, relerr(F.out[(size_t)row * DM + col], a));
}


__device__ __forceinline__ void chk_qkv(Frame& F, int id, const float* qn, const float* wuq, const float* kvn, const float* wukv) {
    phase_begin(F); if (blockIdx.x >= 16) return;
    const unsigned hs = (unsigned)dbg_sample(F, 301 + id); const int row = hs % TOK, pos = row & (SEQ - 1); const bf16* ur = (const bf16*)(F.ws + WS_U) + (size_t)row * NU;
    float err;
    if (hs & 0x80000000u) {
        const int c = (hs >> 15) % 768; float ss = 0.f, a = 0.f;
        for (int k = 0; k < 128; ++k) { const float v = bf2f(ur[C_KVDN + k]); ss += v * v; a += v * kvn[k] * wukv[(size_t)k * 768 + c]; }
        err = relerr(bf2f(((const bf16*)(F.ws + WS_KVM))[(size_t)row * 768 + c]), a / sqrtf(ss / 128.f + EPS));
    } else {
        const int c = (hs >> 15) % 576, hd = c / 96, w = c % 96; int c1 = c, c2 = -1; bool second = false; float cs = 1.f, sn = 0.f;
        if (w >= 64) { const int i = (w - 64) & 15; c1 = hd * 96 + 64 + i; c2 = c1 + 16; second = (w - 64) >= 16; const float ang = (float)pos * INV_M[i]; cs = cosf(ang); sn = sinf(ang); }
        float ss = 0.f, a1 = 0.f, a2 = 0.f;
        for (int k = 0; k < 192; ++k) { const float v = bf2f(ur[C_QDN + k]); ss += v * v; a1 += v * qn[k] * wuq[(size_t)k * 576 + c1]; if (c2 >= 0) a2 += v * qn[k] * wuq[(size_t)k * 576 + c2]; }
        const float rs = QSCALE_M / sqrtf(ss / 192.f + EPS); const float ref = (c2 < 0) ? a1 * rs : (second ? (a2 * cs + a1 * sn) * rs : (a1 * cs - a2 * sn) * rs);
        err = relerr(bf2f(((const bf16*)(F.ws + WS_QM))[(size_t)row * 576 + c]), ref);
    }
    dbg_put(F, id, err);
}
__device__ __forceinline__ void chk_mla(Frame& F, int id) {
    phase_begin(F); if (blockIdx.x >= 4) return;
    const unsigned hs = (unsigned)dbg_sample(F, 401 + id); const int b = hs & 3, h = (hs >> 2) % 6, d = (hs >> 8) & 63, pos = (F.tid < 64) ? (int)((hs >> 14) % SEQ) : (int)((hs >> 14) % 1200);
    const bf16* QM = (const bf16*)(F.ws + WS_QM); const bf16* KVM = (const bf16*)(F.ws + WS_KVM); const bf16* U = (const bf16*)(F.ws + WS_U);
    const size_t t = (size_t)b * SEQ + pos; float m = -1e30f, l = 0.f, o = 0.f;
    for (int k = 0; k <= pos; ++k) { const size_t tk = (size_t)b * SEQ + k; float sc = 0.f;
        for (int j = 0; j < 64; ++j) sc += bf2f(QM[t * 576 + h * 96 + j]) * bf2f(KVM[tk * 768 + h * 128 + j]);
        for (int j = 0; j < 32; ++j) sc += bf2f(QM[t * 576 + h * 96 + 64 + j]) * bf2f(U[tk * NU + C_KPE + j]);
        const float mn = fmaxf(m, sc), al = exp2f(m - mn), p = exp2f(sc - mn); l = l * al + p; o = o * al + p * bf2f(KVM[tk * 768 + h * 128 + 64 + d]); m = mn; }
    dbg_put(F, id, fabsf(bf2f(((const bf16*)(F.ws + WS_CAT))[t * DM + 256 + h * 64 + d]) - o / l) / (fabsf(o / l) + 0.05f));
}

__device__ __forceinline__ void chk_kc(Frame& F, int id, const float* cpos, const float* w1, const float* w2) {
    phase_begin(F); if (blockIdx.x >= 8) return;
    const int grp = F.tid >> 7, j = F.tid & 127; LAS float* red = (LAS float*)F.lds;
    for (int it = 0; it < 4; ++it) {
        const unsigned hs = hsh((unsigned)((blockIdx.x * 4 + grp) * 4 + it) * 7919u + 501u + (unsigned)id); const int sr = hs & 1, b = (hs >> 1) & 3, g = (hs >> 3) & 1, n = (hs >> 4) % 511, d = (hs >> 16) & 63;
        const bf16* U = (const bf16*)(F.ws + WS_U); float y = 0.f;
        for (int l = 0; l < 32; ++l) for (int dd = 0; dd < 64; ++dd) { const float x = bf2f(U[((size_t)b * SEQ + 16 * n + l) * NU + (sr ? C_VC : C_KC) + g * 64 + dd]) + cpos[sr * 2048 + l * 64 + dd];
            y += x * w1[((size_t)sr * 2048 + l * 64 + dd) * 128 + j]; }
        __syncthreads();
        red[F.tid] = 0.5f * y * (1.0f + tanhf(0.7978845608f * (y + 0.044715f * y * y * y))) * w2[((size_t)sr * 128 + j) * 64 + d];
        __syncthreads();
        if (j == 0) { float a = 0.f; for (int k = 0; k < 128; ++k) a += red[grp * 128 + k];
            dbg_put(F, id, fabsf(bf2f(((const bf16*)(F.ws + WS_KC))[((size_t)(sr * 8 + b * 2 + g) * 512 + n) * 64 + d]) - a) / (fabsf(a) + 0.25f)); }
    }
    __syncthreads();
}
__device__ __forceinline__ void chk_nsa(Frame& F, int id, const float* gb) {
    phase_begin(F); if (blockIdx.x >= 1) return;
    const unsigned hs = (unsigned)dbg_sample(F, 601 + id); const int b = hs & 3, h = (hs >> 2) % 6, g = h / 3, d = (hs >> 8) & 63;
    const int pos = (F.tid < 32) ? (int)((hs >> 14) % SEQ) : (F.tid < 256) ? (int)(1024 + (hs >> 14) % 700) : (int)((hs >> 14) % 1100);
    const bf16* U = (const bf16*)(F.ws + WS_U); const bf16* KC = (const bf16*)(F.ws + WS_KC) + (size_t)(b * 2 + g) * KC_HEAD; const bf16* VC = KC + 8 * KC_HEAD;
    float* P3 = (float*)(F.ws + WS_XN + 32 * MiB) + (size_t)F.tid * 1024; float* imp = P3 + 512;
    const size_t t = (size_t)b * SEQ + pos; const int nv = (pos >= 31) ? (pos - 31) / 16 + 1 : 0;
    for (int n = 0; n < 512; ++n) P3[n] = 0.f;
    float oc = 0.f;
    float* SC = P3 + 1024 * 512;
    for (int p = 0; p < 3; ++p) { const int hh = g * 3 + p; float m = -1e30f;
        for (int n = 0; n < nv; ++n) { float sc = 0.f; for (int j = 0; j < 64; ++j) sc += bf2f(U[t * NU + C_QN + hh * 64 + j]) * bf2f(KC[n * 64 + j]); SC[n] = sc; m = fmaxf(m, sc); }
        float l = 0.f; for (int n = 0; n < nv; ++n) l += exp2f(SC[n] - m);
        for (int n = 0; n < nv; ++n) { const float pr = exp2f(SC[n] - m) / l; P3[n] += pr; if (hh == h) oc += pr * bf2f(VC[n * 64 + d]); } }
    const int cur = pos >> 6;
    for (int s2 = 0; s2 < 128; ++s2) { float a = 0.f; for (int n = 4 * s2 - 1; n <= 4 * s2 + 3; ++n) if (n >= 0 && n < nv) a += P3[n]; imp[s2] = (s2 <= cur) ? a : -1.f; }
    unsigned mk[4] = {0u, 0u, 0u, 0u}; float gapmin = 1e9f;
    { int cnt = 0; imp[0] += 1000.f; if (cur != 0) imp[cur] += 1000.f;
      for (int r = 0; r < 16; ++r) { int bi = -1; float bv = -0.5f; for (int s2 = 0; s2 < 128; ++s2) if (imp[s2] > bv) { bv = imp[s2]; bi = s2; } if (bi < 0) break;
          if (r == 15) { float nx = -0.5f; for (int s2 = 0; s2 < 128; ++s2) if (s2 != bi && imp[s2] > nx) nx = imp[s2]; gapmin = bv - nx; }
          imp[bi] = -3.f; const unsigned bit = 1u << (bi & 31); if ((bi >> 5) == 0) mk[0] |= bit; else if ((bi >> 5) == 1) mk[1] |= bit; else if ((bi >> 5) == 2) mk[2] |= bit; else mk[3] |= bit; ++cnt; } }
    const GAS unsigned* km = (const GAS unsigned*)(F.ws + WS_MASK) + ((size_t)(b * 2 + g) * SEQ + pos) * 4;
    const bool same = km[0] == mk[0] && km[1] == mk[1] && km[2] == mk[2] && km[3] == mk[3];
    dbg_put(F, id + 1, (same || gapmin < 2e-3f) ? 0.f : 10.f);
    float m = -1e30f, l = 0.f, os = 0.f;
    for (int k = 0; k <= pos; ++k) { const unsigned w = km[k >> 11]; if (!((w >> ((k >> 6) & 31)) & 1u)) continue; const size_t tk = (size_t)b * SEQ + k; float sc = 0.f;
        for (int j = 0; j < 64; ++j) sc += bf2f(U[t * NU + C_QN + h * 64 + j]) * bf2f(U[tk * NU + C_KS + g * 64 + j]);
        const float mn = fmaxf(m, sc), al = exp2f(m - mn), pr = exp2f(sc - mn); l = l * al + pr; os = os * al + pr * bf2f(U[tk * NU + C_VS + g * 64 + d]); m = mn; }
    os = (l > 0.f) ? os / l : 0.f;
    m = -1e30f; l = 0.f; float ow = 0.f;
    for (int k = (pos - 511 < 0 ? 0 : pos - 511); k <= pos; ++k) { const size_t tk = (size_t)b * SEQ + k; float sc = 0.f;
        for (int j = 0; j < 64; ++j) sc += bf2f(U[t * NU + C_QN + h * 64 + j]) * bf2f(U[tk * NU + C_KW + g * 64 + j]);
        const float mn = fmaxf(m, sc), al = exp2f(m - mn), pr = exp2f(sc - mn); l = l * al + pr; ow = ow * al + pr * bf2f(U[tk * NU + C_VW + g * 64 + d]); m = mn; }
    ow /= l;
    float gt[3]; for (int br = 0; br < 3; ++br) gt[br] = 1.0f / (1.0f + expf(-(bf2f(U[t * NU + C_GN + h * 3 + br]) + gb[h * 3 + br])));
    const float ref = gt[0] * oc + gt[1] * os + gt[2] * ow;
    dbg_put(F, id, fabsf(bf2f(((const bf16*)(F.ws + WS_CAT))[t * DM + 640 + h * 64 + d]) - ref) / (fabsf(ref) + 0.02f));
}
__device__ __forceinline__ void stat_mix(Frame& F, const float* x) {
    phase_begin(F); if (blockIdx.x >= 16) return;
    const unsigned h = (unsigned)dbg_sample(F, 777); const int row = h % TOK, col = (h >> 16) % DM;
    const float d = F.out[(size_t)row * DM + col] - x[(size_t)row * DM + col];
    atomicAdd((float*)(F.ctl + CW_DBG + 40), d * d);
    const float c = bf2f(((const bf16*)(F.ws + WS_CAT))[(size_t)row * DM + (col & 255)]);
    atomicAdd((float*)(F.ctl + CW_DBG + 41), c * c);
}
__device__ __forceinline__ void dbg_finish(Frame& F, int nchk) {
    if (blockIdx.x == 0 && F.tid == 0) { for (int i = 0; i < nchk; ++i) { const float e = __builtin_bit_cast(float, xb_ld((unsigned*)(F.ctl + CW_DBG + i))); if (!(e <= 0.05f)) { F.out[0] = 1000.f * (i + 1); return; } }
#ifdef DBG_STATOUT
        const float st = __builtin_bit_cast(float, xb_ld((unsigned*)(F.ctl + CW_DBG + DBG_STAT))) / 8192.f; F.out[0] = 1.0e5f * st;
#endif
    }
}
#ifdef DBG_ALL
#define DBGRUN(stmt) do { stmt; GRID_BAR(); } while (0)
#else
#define DBGRUN(stmt) do {} while (0)
#endif
#define DBGNEW(stmt) do { stmt; GRID_BAR(); } while (0)
#else
#define DBGNEW(stmt) do {} while (0)
#define DBGRUN(stmt) do {} while (0)
#endif

struct Args { const float* in[28]; float* out; unsigned char* ws; };
#ifndef PHM
#define PHM 0xffff
#endif
__device__ __forceinline__ void grid_bar(Frame& F) {
    XcdBarrier b_; b_.bar = (unsigned*)((gu32*)((unsigned char*)ARGP(29) + WS_CTL) + CW_BAR); b_.x = xb_xcc_id(); b_.st = (volatile LAS unsigned*)(F.lds + MISC_OFF) + 8; phase_begin(F); xcd_barrier(b_, F.tid);
}
#define GRID_BAR() grid_bar(F)

template <int L>
__device__ __forceinline__ void mixer_layer(Frame& F) {
    p_norm<false>(F, L == 0 ? ARGP(0) : (const float*)ARGP(28), ARGP(1) + (size_t)L * DM, nullptr);
    GRID_BAR();
    if (PHM & 1024) { phase_begin(F); SchedPlain S; S.init(TOK / 256, NU / 256, F.G, (int)blockIdx.x); S.lda2 = DM * 2; S.B = (const char*)(F.ws + WS_WIN) + (size_t)L * NU * DM * 2; S.btile = (size_t)256 * DM * 2;
      EpiInProj E{(bf16*)(F.ws + WS_U), (const f32x2*)(F.ws + WS_TABN), (const f32x2*)(F.ws + WS_TABM), (float*)(F.ws + WS_SSQ)};
      pg8::gemm_phase(F.tid, F.lds, (const char*)(F.ws + WS_XN), DM, 128u, (unsigned)DM, S, E);
#if DUP & 4
      GRID_BAR(); pg8::gemm_phase(F.tid, F.lds, (const char*)(F.ws + WS_XN), DM, 128u, (unsigned)DM, S, E);
#endif
    }
    GRID_BAR();
    DBGRUN(chk_u(F, 8 + 3 * L, ARGP(2) + (size_t)L * DM * IN_COLS));
    { phase_begin(F); SchedQKV S; S.init(TOK / 256, 6, F.G, (int)blockIdx.x); S.B = (const char*)(F.ws + WS_WQKV) + (size_t)L * 1536 * 384 * 2;
      EpiQKV E{(bf16*)(F.ws + WS_QM), (bf16*)(F.ws + WS_KVM), (const float*)(F.ws + WS_SSQ), (const f32x2*)(F.ws + WS_TABM)};
      pg8::gemm_phase(F.tid, F.lds, (const char*)(F.ws + WS_U) + C_QDN * 2, 384, 128u, 384u, S, E); }
    { phase_begin(F); SchedCmp S; S.init(32, 1, F.G, (int)blockIdx.x); S.B = (const char*)(F.ws + WS_WC1) + (size_t)L * 2 * 256 * 2048 * 2;
      EpiCmp E{(bf16*)(F.ws + WS_G1C), (const float*)(F.ws + WS_MISC + MS_CBIAS) + L * 256};
      pg8::gemm_phase(F.tid, F.lds, (const char*)(F.ws + WS_U), 2048, (unsigned)(NU * 2), 2048u, S, E); }
    if (PHM & 512) p_lru_local(F, 20 + L, ARGP(3) + (size_t)L * 1024, ARGP(4) + (size_t)L * 256, ARGP(5) + (size_t)L * 16384, ARGP(6) + (size_t)L * 256, ARGP(7) + (size_t)L * 16384, ARGP(8) + (size_t)L * 256, ARGP(9) + (size_t)L * 256);
    GRID_BAR();
#if DUP & 8
#if DUP & 256
    { phase_begin(F); SchedQKV S; S.init(TOK / 256, 6, F.G, (int)blockIdx.x); S.B = (const char*)(F.ws + WS_WQKV) + (size_t)L * 1536 * 384 * 2;
      EpiQKV E{(bf16*)(F.ws + WS_QM), (bf16*)(F.ws + WS_KVM), (const float*)(F.ws + WS_SSQ), (const f32x2*)(F.ws + WS_TABM)};
      pg8::gemm_phase(F.tid, F.lds, (const char*)(F.ws + WS_U) + C_QDN * 2, 384, 128u, 384u, S, E); }
#endif
#if DUP & 512
    { phase_begin(F); SchedCmp S; S.init(32, 1, F.G, (int)blockIdx.x); S.B = (const char*)(F.ws + WS_WC1) + (size_t)L * 2 * 256 * 2048 * 2;
      EpiCmp E{(bf16*)(F.ws + WS_G1C), (const float*)(F.ws + WS_MISC + MS_CBIAS) + L * 256};
      pg8::gemm_phase(F.tid, F.lds, (const char*)(F.ws + WS_U), 2048, (unsigned)(NU * 2), 2048u, S, E); }
#endif
#if DUP & 1024
    if (PHM & 512) p_lru_local(F, 20 + L, ARGP(3) + (size_t)L * 1024, ARGP(4) + (size_t)L * 256, ARGP(5) + (size_t)L * 16384, ARGP(6) + (size_t)L * 256, ARGP(7) + (size_t)L * 16384, ARGP(8) + (size_t)L * 256, ARGP(9) + (size_t)L * 256);
#endif
    GRID_BAR();
#endif
    if (PHM & 8192) p_lru_carry(F);
    p_cmp2(F, ARGP(16) + (size_t)L * 2 * 128 * 64);
    phase_begin(F); unit_publish(F, CW_FLAG + 512 + L);
#if DUP & 64
    if (PHM & 8192) p_lru_carry(F);
    p_cmp2(F, ARGP(16) + (size_t)L * 2 * 128 * 64);
    GRID_BAR();
#endif
    DBGRUN(chk_qkv(F, 16 + L, ARGP(10) + L * 192, ARGP(11) + (size_t)L * 192 * 576, ARGP(12) + L * 128, ARGP(13) + (size_t)L * 128 * 768));
    DBGNEW(chk_kc(F, 20 + L, ARGP(14) + (size_t)L * 4096, ARGP(15) + (size_t)L * 2 * 2048 * 128, ARGP(16) + (size_t)L * 2 * 128 * 64));
    p_attn1(F, 2 * L, ARGP(17) + L * 18);
#if DUP & 3
    GRID_BAR();
#endif
#if DUP & 1
    p_attn1(F, 4 + 2 * L, ARGP(17) + L * 18); GRID_BAR();
#endif
#ifdef ATTVAR
    p_attn2<ATTVAR>(F, 4 + 2 * L + 1, ARGP(17) + L * 18); GRID_BAR();
#endif
    p_attn2<0>(F, 2 * L + 1, ARGP(17) + L * 18);
#if DUP & 2
    GRID_BAR(); p_attn2<0>(F, 4 + 2 * L + 1, ARGP(17) + L * 18);
#endif
    if (PHM & 16384) p_lru_fix(F, 1024);
    GRID_BAR();
    DBGRUN(chk_mla(F, 18 + L));
    DBGNEW(chk_nsa(F, 22 + 2 * L, ARGP(17) + L * 18));
    DBGRUN(chk_lru(F, 9 + 3 * L, ARGP(3) + (size_t)L * 1024, ARGP(4) + (size_t)L * 256, ARGP(5) + (size_t)L * 16384, ARGP(6) + (size_t)L * 256, ARGP(7) + (size_t)L * 16384, ARGP(8) + (size_t)L * 256, ARGP(9) + (size_t)L * 256));
    DBGRUN(chk_lru_rec(F, 14 + L, ARGP(3) + (size_t)L * 1024, ARGP(4) + (size_t)L * 256, ARGP(5) + (size_t)L * 16384, ARGP(6) + (size_t)L * 256, ARGP(7) + (size_t)L * 16384, ARGP(8) + (size_t)L * 256, ARGP(9) + (size_t)L * 256));
    if (PHM & 32768) { phase_begin(F); SchedPlain S; S.init(TOK / 256, DM / 256, F.G, (int)blockIdx.x); S.lda2 = DM * 2; S.B = (const char*)(F.ws + WS_WOUT) + (size_t)L * DM * DM * 2; S.btile = (size_t)256 * DM * 2;
      EpiResF32 E{L == 0 ? ARGP(0) : (const float*)F.out, F.out, DM, ALPHA_MIX};
      pg8::gemm_phase(F.tid, F.lds, (const char*)(F.ws + WS_CAT), DM, 128u, (unsigned)DM, S, E); }
    GRID_BAR();
    if (L == 0) DBGRUN(chk_outproj(F, 10, ARGP(0), ARGP(18)));
    if (L == 0) DBGRUN(stat_mix(F, ARGP(0)));
}
__device__ __forceinline__ void ffn_dense(Frame& F) {
    p_norm<false>(F, (const float*)ARGP(28), ARGP(19), nullptr);
    GRID_BAR();
    DBGRUN(chk_xn(F, 0, F.out, ARGP(19)));
#ifdef GEMMPROBE
    { phase_begin(F); SchedPlain S; S.init(TOK / 256, 2 * DFF / 256, F.G, (int)blockIdx.x); S.lda2 = DM * 2; S.B = (const char*)(F.ws + WS_WGU); S.btile = (size_t)256 * DM * 2;
#if GEMMPROBE == 1
      EpiNull E{};
#else
      EpiSwiGLU E{(bf16*)(F.ws + WS_H), DFF};
#endif
      pg8::gemm_phase(F.tid, F.lds, (const char*)(F.ws + WS_XN), DM, 128u, (unsigned)DM, S, E); GRID_BAR(); }
#endif
    if (PHM & 8) { phase_begin(F); SchedPlain S; S.init(TOK / 256, 2 * DFF / 256, F.G, (int)blockIdx.x); S.lda2 = DM * 2; S.B = (const char*)(F.ws + WS_WGU); S.btile = (size_t)256 * DM * 2;
      EpiSwiGLU E{(bf16*)(F.ws + WS_H), DFF};
      pg8::gemm_phase(F.tid, F.lds, (const char*)(F.ws + WS_XN), DM, 128u, (unsigned)DM, S, E);
#if DUP & 16
      GRID_BAR(); pg8::gemm_phase(F.tid, F.lds, (const char*)(F.ws + WS_XN), DM, 128u, (unsigned)DM, S, E);
#endif
    }
    GRID_BAR();
    DBGRUN(chk_ffn_up(F, 1, ARGP(20), ARGP(21)));
    if (PHM & 16) { phase_begin(F); SchedPlain S; S.init(TOK / 256, DM / 256, F.G, (int)blockIdx.x); S.lda2 = DFF * 2; S.B = (const char*)(F.ws + WS_WD); S.btile = (size_t)256 * DFF * 2;
      EpiResF32 E{F.out, F.out, DM, ALPHA_FFN};
      pg8::gemm_phase(F.tid, F.lds, (const char*)(F.ws + WS_H), DFF, 128u, (unsigned)DFF, S, E); }
    GRID_BAR();
}
__device__ __forceinline__ void ffn_moe(Frame& F) {
    p_norm<true>(F, (const float*)ARGP(28), ARGP(19) + DM, ARGP(23));
    GRID_BAR();
    DBGRUN(chk_xn(F, 3, F.out, ARGP(19) + DM));
    if (PHM & 32) p_scatter(F);
    GRID_BAR();
    DBGRUN(chk_route(F, 4, F.out, ARGP(19) + DM, ARGP(23)));
    if (PHM & 64) { phase_begin(F); const int* ebase = (const int*)(F.ws + WS_MISC + MS_EBASE); const int ntiles = __builtin_amdgcn_readfirstlane(ebase[8]);
      SchedMoeUp S; S.init(ntiles, 2 * DFE / 256, F.G, (int)blockIdx.x); S.lda2 = DM * 2; S.B = (const char*)(F.ws + WS_MWGU); S.btile = (size_t)256 * DM * 2; S.bexp = (size_t)2 * DFE * DM * 2;
      S.rowlist = (const int*)(F.ws + WS_MISC + MS_ROWLIST); S.ebase = ebase;
      EpiSwiGLU E{(bf16*)(F.ws + WS_H), DFE};
      pg8::gemm_phase(F.tid, F.lds, (const char*)(F.ws + WS_XN), DM, 128u, (unsigned)DM, S, E);
#if DUP & 16
      GRID_BAR(); pg8::gemm_phase(F.tid, F.lds, (const char*)(F.ws + WS_XN), DM, 128u, (unsigned)DM, S, E);
#endif
    }
    GRID_BAR();
    DBGRUN(chk_moe_up(F, 6, ARGP(24), ARGP(25)));
    if (PHM & 128) { phase_begin(F); const int* ebase = (const int*)(F.ws + WS_MISC + MS_EBASE); const int ntiles = __builtin_amdgcn_readfirstlane(ebase[8]);
      SchedMoeDown S; S.init(ntiles, DM / 256, F.G, (int)blockIdx.x); S.lda2 = DFE * 2; S.B = (const char*)(F.ws + WS_MWD); S.btile = (size_t)256 * DFE * 2; S.bexp = (size_t)DM * DFE * 2; S.ebase = ebase;
      EpiBf16Plain E{(bf16*)(F.ws + WS_Y), DM};
      pg8::gemm_phase(F.tid, F.lds, (const char*)(F.ws + WS_H), DFE, 128u, (unsigned)DFE, S, E); }
    GRID_BAR();
    DBGRUN(chk_moe_down(F, 7, ARGP(26)));
}

__global__ void __launch_bounds__(NTHR, 2) mk_fwd(Args args) {
    extern __shared__ __attribute__((aligned(16))) unsigned char lds[];
    Frame F;
    F.lds = (LAS unsigned char*)lds;
    F.MISC = (volatile LAS unsigned*)(F.lds + MISC_OFF);
    F.wv = __builtin_amdgcn_readfirstlane((int)threadIdx.x >> 6);
    phase_begin(F);
    for (int u = F.tid; u < (LDS_BYTES - RING_BYTES) / 4; u += NTHR) ((LAS unsigned*)(F.lds + RING_BYTES))[u] = 0u;
    __syncthreads();
    (void)xcd_barrier_post((unsigned*)(F.ctl + CW_BAR), F.MISC + 8, F.wv == 0);

    F.trbase = 0;
    if (PHM & 1) p_prologue_ffn(F, ARGP(20), ARGP(21), ARGP(22), ARGP(24), ARGP(25), ARGP(26));
    if (PHM & 2048) p_prologue_mix(F, ARGP(2), ARGP(18));
    p_prologue_qkv(F, ARGP(10), ARGP(11), ARGP(12), ARGP(13));
    p_prologue_cmp(F, ARGP(15));
    p_cmp_bias(F, ARGP(14), ARGP(15));
#if DUP & 32
    GRID_BAR();
    p_prologue_ffn(F, ARGP(20), ARGP(21), ARGP(22), ARGP(24), ARGP(25), ARGP(26)); p_prologue_mix(F, ARGP(2), ARGP(18)); p_prologue_qkv(F, ARGP(10), ARGP(11), ARGP(12), ARGP(13)); p_prologue_cmp(F, ARGP(15));
#endif
    if (PHM & 4096) p_tables(F);
    GRID_BAR();

    mixer_layer<0>(F);
    ffn_dense(F);
    mixer_layer<1>(F);
    ffn_moe(F);

    phase_begin(F);
    if (xb_ld((unsigned*)(F.ctl + CW_BAR) + XB_TMO) != 0u) p_nan_rows(F);
    else if (PHM & 256) p_combine_final(F, ARGP(27));
#ifdef DBG
    GRID_BAR(); dbg_finish(F, 26);
#endif
}

extern "C" void kernel_launch(void* const* d_in, const int* in_sizes, int n_in, void* d_out, int out_size, void* d_ws, size_t ws_size, hipStream_t stream) {
    static int grid = 0;
    if (grid == 0) {
        if (n_in != 28 || in_sizes[0] != TOK * DM || out_size != TOK * DM || ws_size < WS_END) { fprintf(stderr, "kernel_launch: unexpected shapes (n_in %d, in0 %d, out %d, ws %zu)\n", n_in, n_in > 0 ? in_sizes[0] : -1, out_size, ws_size); grid = -1; return; }
        int dev = 0, cus = 0, per_cu = 0;
        if (hipGetDevice(&dev) != hipSuccess || hipDeviceGetAttribute(&cus, hipDeviceAttributeMultiprocessorCount, dev) != hipSuccess) { grid = -1; return; }
        if (hipFuncSetAttribute((const void*)mk_fwd, hipFuncAttributeMaxDynamicSharedMemorySize, LDS_BYTES) != hipSuccess) { fprintf(stderr, "kernel_launch: hipFuncSetAttribute failed\n"); grid = -1; return; }
        if (hipOccupancyMaxActiveBlocksPerMultiprocessor(&per_cu, (const void*)mk_fwd, NTHR, LDS_BYTES) != hipSuccess || per_cu < 1) fprintf(stderr, "kernel_launch: occupancy query reports %d\n", per_cu);
        (void)hipGetLastError();
        grid = cus;
    }
    if (grid < 0) return;
    if (hipMemsetAsync((char*)d_ws + WS_CTL, 0, CTL_ZERO_BYTES, stream) != hipSuccess) return;
    Args a{};
    for (int i = 0; i < 28; ++i) a.in[i] = (const float*)d_in[i];
    a.out = (float*)d_out; a.ws = (unsigned char*)d_ws;
    hipLaunchKernelGGL(mk_fwd, dim3(grid), dim3(NTHR), LDS_BYTES, stream, a);
}
```

```cpp
#include <hip/hip_runtime.h>
#include <cstdint>
#include <cstdio>
#ifndef DUP
#define DUP 0
#endif
#ifndef ALPHA_MOE
#define ALPHA_MOE 1.0f
#endif
#ifndef ALPHA_MIX
#define ALPHA_MIX 1.0f
#endif
#ifndef ALPHA_FFN
#define ALPHA_FFN 1.0f
#endif

#define GAS __attribute__((address_space(1)))
#define LAS __attribute__((address_space(3)))
typedef unsigned short bf16;
typedef unsigned v4u __attribute__((ext_vector_type(4)));
typedef unsigned v2u __attribute__((ext_vector_type(2)));
typedef float f32x4 __attribute__((ext_vector_type(4)));
typedef float f32x2 __attribute__((ext_vector_type(2)));
typedef short bf16x8 __attribute__((ext_vector_type(8)));
typedef GAS unsigned gu32;
typedef float f32x16 __attribute__((ext_vector_type(16)));
typedef short s16x4 __attribute__((ext_vector_type(4)));
__device__ __forceinline__ int crow(int r, int hi) { return (r & 3) + 8 * (r >> 2) + 4 * hi; }
#define RLX_AGENT __ATOMIC_RELAXED, __HIP_MEMORY_SCOPE_AGENT
#define LDS_WAIT() asm volatile("s_waitcnt lgkmcnt(0)" ::: "memory")
#define VM_WAIT() asm volatile("s_waitcnt vmcnt(0)" ::: "memory")

constexpr int NB = 4, SEQ = 8192, DM = 1024, TOK = NB * SEQ, DEPTH = 2;
constexpr int DFF = 2816, NEXP = 8, DFE = 1408;
constexpr float EPS = 1e-6f;
constexpr int NWAVES = 8, NTHR = 512;

constexpr size_t MiB = 1u << 20;
constexpr size_t WS_CTL = 0, CTL_ZERO_BYTES = 1 * MiB;
constexpr size_t WS_TABN = 1 * MiB, WS_TABM = 3 * MiB, WS_MISC = 4 * MiB, WS_LRU = 8 * MiB, WS_SSQ = 12 * MiB, WS_MASK = 14 * MiB, WS_KC = 15 * MiB, WS_G1C = 16 * MiB;
constexpr size_t WS_WIN = 18 * MiB, WS_WQKV = 26 * MiB, WS_WOUT = 29 * MiB, WS_WC1 = 33 * MiB, WS_WGU = 37 * MiB, WS_WD = 48 * MiB, WS_MWGU = 54 * MiB, WS_MWD = 98 * MiB;
constexpr size_t WS_XN = 120 * MiB, WS_CAT = 184 * MiB, WS_PQ = 248 * MiB, WS_U = 280 * MiB, WS_QM = 408 * MiB, WS_KVM = 444 * MiB, WS_END = 492 * MiB;
constexpr size_t WS_OC = WS_XN;
constexpr size_t WS_H = WS_U;
constexpr size_t WS_Y = WS_XN;
constexpr int MAXSLOT = 2 * TOK + NEXP * 256;
static_assert(WS_H + (size_t)MAXSLOT * DFE * 2 <= WS_END && WS_Y + (size_t)MAXSLOT * DM * 2 <= WS_U, "overlays");
constexpr size_t MS_ROUTE = 0;
constexpr size_t MS_TOKSLOT = 512 * 1024;
constexpr size_t MS_ROWLIST = 768 * 1024;
constexpr size_t MS_COUNTS = 1280 * 1024;
constexpr size_t MS_CBIAS = 1300 * 1024;
constexpr size_t MS_EBASE = 1296 * 1024;
constexpr int CW_TMO = 0, CW_BAR = 4096, CW_Q = 16384;

constexpr int NU = 2048, IN_COLS = 2034;
constexpr int C_XL = 0, C_YL = 256, C_QDN = 512, C_KVDN = 704, C_KPE = 832, C_QN = 864, C_KC = 1248, C_VC = 1376, C_KS = 1504, C_VS = 1632, C_KW = 1760, C_VW = 1888, C_GN = 2016;
constexpr float QSCALE_N = 0.125f * 1.4426950408889634f;
constexpr float QSCALE_M = 0.10206207261596575f * 1.4426950408889634f;
__device__ const float INV_N[32] = {1.0f, 0.7498942093324559f, 0.5623413251903491f, 0.4216965034285822f, 0.31622776601683794f, 0.23713737056616552f, 0.1778279410038923f, 0.1333521432163324f, 0.1f, 0.07498942093324558f, 0.05623413251903491f, 0.042169650342858224f, 0.03162277660168379f, 0.023713737056616554f, 0.01778279410038923f, 0.01333521432163324f, 0.01f, 0.007498942093324558f, 0.005623413251903491f, 0.004216965034285823f, 0.0031622776601683794f, 0.0023713737056616554f, 0.0017782794100389228f, 0.001333521432163324f, 0.001f, 0.0007498942093324559f, 0.0005623413251903491f, 0.00042169650342858224f, 0.00031622776601683794f, 0.00023713737056616554f, 0.00017782794100389227f, 0.0001333521432163324f};
__device__ const float INV_M[16] = {1.0f, 0.5623413251903491f, 0.31622776601683794f, 0.1778279410038923f, 0.1f, 0.05623413251903491f, 0.03162277660168379f, 0.01778279410038923f, 0.01f, 0.005623413251903491f, 0.0031622776601683794f, 0.0017782794100389228f, 0.001f, 0.0005623413251903491f, 0.00031622776601683794f, 0.00017782794100389227f};

constexpr int RING_BYTES = 131072, MISC_OFF = RING_BYTES + 320, LDS_BYTES = 147456;

typedef float cvf32x2_t __attribute__((ext_vector_type(2))); typedef __bf16 cvbf16x2_t __attribute__((ext_vector_type(2)));
__device__ __forceinline__ unsigned pk2(float lo, float hi) { const cvf32x2_t v = {lo, hi}; const cvbf16x2_t b = __builtin_convertvector(v, cvbf16x2_t); return __builtin_bit_cast(unsigned, b); }
__device__ __forceinline__ unsigned f2bf(float f) { return pk2(f, 0.0f) & 0xffffu; }
__device__ __forceinline__ float bf2f(unsigned short b) { return __builtin_bit_cast(float, (unsigned)b << 16); }
__device__ __forceinline__ float bflo(unsigned w) { return __builtin_bit_cast(float, w << 16); }
__device__ __forceinline__ float bfhi(unsigned w) { return __builtin_bit_cast(float, w & 0xffff0000u); }
template <int M> __device__ __forceinline__ unsigned xor_u(unsigned u) {
    if constexpr (M == 32) { auto r = __builtin_amdgcn_permlane32_swap(u, u, false, false);
        return (unsigned)r[0] ^ (unsigned)r[1] ^ u; }
    else return (unsigned)__builtin_amdgcn_ds_swizzle((int)u, (M << 10) | 0x1f);
}
template <int M> __device__ __forceinline__ float xor_f(float v) { return __builtin_bit_cast(float, xor_u<M>(__builtin_bit_cast(unsigned, v))); }
__device__ __forceinline__ float wave_sum(float v) {
    v += xor_f<1>(v); v += xor_f<2>(v); v += xor_f<4>(v); v += xor_f<8>(v); v += xor_f<16>(v); v += xor_f<32>(v);
    return v;
}

#define XB_TMO      128
#define XB_XCNT(j)  (256  + 64 * (j))
#define XB_XSUB(j)  (1280 + 64 * (j))
#define XB_XGEN(j)  (2304 + 64 * (j))
#define XB_TOP      3328
#define XB_TOPGEN   3392
#define XCD_BAR_WORDS 3456
#define XB_SPIN_CAP (1u << 18)
__device__ __forceinline__ unsigned xb_ld(unsigned* p)              { return __hip_atomic_load(p, __ATOMIC_RELAXED, __HIP_MEMORY_SCOPE_AGENT); }
__device__ __forceinline__ unsigned xb_add(unsigned* p, unsigned v) { return __hip_atomic_fetch_add(p, v, __ATOMIC_RELAXED, __HIP_MEMORY_SCOPE_AGENT); }
__device__ __forceinline__ unsigned xb_xcc_id() { return (unsigned)__builtin_amdgcn_s_getreg((3 << 11) | 20) & 0xFu; }
#define XB_SPIN(cond, bar) do { unsigned _sp = 0; while (cond) { __builtin_amdgcn_s_sleep(1); \
    if ((++_sp & 255u) == 0u) { if (xb_ld(&(bar)[XB_TMO])) break; if (_sp > XB_SPIN_CAP) { atomicAdd(&(bar)[XB_TMO], 1u); break; } } } } while (0)
struct XcdBarrier { unsigned* bar; unsigned x; volatile LAS unsigned* st; };
__device__ __forceinline__ XcdBarrier xcd_barrier_post(unsigned* bar, volatile LAS unsigned* st, const bool first_wave) {
    XcdBarrier b; b.bar = bar; b.x = xb_xcc_id(); b.st = st;
    if (st != nullptr && __builtin_amdgcn_mbcnt_hi(~0u, __builtin_amdgcn_mbcnt_lo(~0u, 0u)) == 0u && first_wave) (void)xb_add(&bar[XB_XCNT(b.x)], 1u);
    return b;
}
__device__ __forceinline__ void xcd_barrier_complete(unsigned* bar, unsigned x, unsigned& nloc, unsigned& nx) {
    const unsigned G = gridDim.x * gridDim.y * gridDim.z;
    unsigned sum, cnt, sp = 0u;
    for (;;) {
        sum = 0u; cnt = 0u;
#pragma unroll
        for (unsigned j = 0; j < 16; ++j) { const unsigned c = xb_ld(&bar[XB_XCNT(j)]); sum += c; cnt += (c > 0u) ? 1u : 0u; }
        if (sum == G) break;
        __builtin_amdgcn_s_sleep(1);
        if ((++sp & 255u) == 0u) { if (xb_ld(&bar[XB_TMO])) break; if (sp > XB_SPIN_CAP) { atomicAdd(&bar[XB_TMO], 1u); break; } }
    }
    const unsigned mine = xb_ld(&bar[XB_XCNT(x)]);
    nloc = mine > 0u ? mine : 1u; nx = cnt > 0u ? cnt : 1u;
}
__device__ __forceinline__ void xcd_barrier(const XcdBarrier& b, const int tid) {
    asm volatile("s_waitcnt vmcnt(0)" ::: "memory");
    __syncthreads();
    if (tid == 0) {
        unsigned* bar = b.bar; unsigned bx = b.x; asm volatile("" : "+s"(bx));
        __builtin_amdgcn_s_waitcnt(0);
        unsigned nloc = b.st[0], nx = b.st[1];
        if (nloc == 0u) { xcd_barrier_complete(bar, bx, nloc, nx); b.st[0] = nloc; b.st[1] = nx; }
        const unsigned old = xb_add(&bar[XB_XSUB(bx)], 1u);
        const unsigned gen = old / nloc;
        if (old + 1u == (gen + 1u) * nloc) {
            __builtin_amdgcn_fence(__ATOMIC_RELEASE, "agent");
            asm volatile("s_waitcnt vmcnt(0)" ::: "memory");
            const unsigned og = xb_add(&bar[XB_TOP], 1u);
            const unsigned tg = og / nx;
            if (og + 1u == (tg + 1u) * nx) xb_add(&bar[XB_TOPGEN], 1u);
            else XB_SPIN(xb_ld(&bar[XB_TOPGEN]) == tg, bar);
            __builtin_amdgcn_fence(__ATOMIC_ACQUIRE, "agent");
            xb_add(&bar[XB_XGEN(bx)], 1u);
            asm volatile("s_waitcnt vmcnt(0)" ::: "memory");
        } else {
            XB_SPIN(xb_ld(&bar[XB_XGEN(bx)]) == gen, bar);
            __builtin_amdgcn_fence(__ATOMIC_ACQUIRE, "agent");
            asm volatile("s_waitcnt vmcnt(0)" ::: "memory");
        }
    }
    __syncthreads();
}

namespace pg8 {
constexpr int BM = 256, BK = 64, HALF = 128, HTB = HALF * BK * 2, STAGE_BYTES = 8 * HTB, NXCD = 8, WGM = 8;
__host__ __device__ __forceinline__ int lds_byte(int r, int c) { const int st = (r >> 4) * 2 + (c >> 5), rr = r & 15, cc = c & 31, ob = rr * 64 + cc * 2; return st * 1024 + (ob ^ (((ob >> 9) & 1) << 5)); }
__host__ __device__ __forceinline__ void stage_rc(int b, int& R, int& C) { const int st = b / 1024, sb = b % 1024, swz = sb ^ (((sb >> 9) & 1) << 5); R = (st >> 1) * 16 + swz / 64; C = (st & 1) * 32 + (swz % 64) / 2; }
__host__ __device__ __forceinline__ int perm32(int rho) { const int n = rho >> 4, i = rho & 15; return 8 * (i >> 2) + 4 * n + (i & 3); }
struct Unit { int pm, pn; };
struct TileOrder {
    int nM, nN, nwg, G, c;
    __device__ __forceinline__ void init(int nM_, int nN_, int G_, int c_) { nM = nM_; nN = nN_; nwg = nM * nN; G = G_; c = c_; asm volatile("" : "+s"(c)); }
    __device__ __forceinline__ bool next(int i, Unit& u) const { return tile_of((long)i * G + c, u); }
    __device__ __forceinline__ bool tile_of(const long L, Unit& u) const {
        if (L >= nwg) return false;
        int wgid = (int)L; { const int q = nwg / NXCD, r = nwg % NXCD, xcd = wgid % NXCD, off = wgid / NXCD; wgid = (xcd < r ? xcd * (q + 1) : r * (q + 1) + (xcd - r) * q) + off; }
        const int nig = WGM * nN, gid = wgid / nig, fm = gid * WGM, gsz = (nM - fm) < WGM ? (nM - fm) : WGM;
        u.pm = fm + ((wgid % nig) % gsz); u.pn = (wgid % nig) / gsz; return true;
    }
};
__device__ __forceinline__ unsigned cvt_pk_bf16(float lo, float hi) { unsigned r; asm volatile("v_cvt_pk_bf16_f32 %0, %1, %2" : "=v"(r) : "v"(lo), "v"(hi)); return r; }

template <class Epi, class Sched>
__device__ __forceinline__ void gemm_phase(const int tid_in, LAS unsigned char* lds, const char* Abase, const int K, const unsigned kstepA, const unsigned ldb, const Sched& S, const Epi& E) {
    int tid = tid_in; asm volatile("" : "+v"(tid));
    const int wid = __builtin_amdgcn_readfirstlane(tid >> 6), lane = tid & 63, wr = wid >> 2, wc = wid & 3, fr = lane & 15, fq = lane >> 4;
    const int nt = K / BK;
    unsigned voffB[2];
#pragma unroll
    for (int i = 0; i < 2; ++i) { int R, C; stage_rc(tid * 16 + i * 8192, R, C); const int Rb = Epi::PERM ? ((R & ~31) + perm32(R & 31)) : R; voffB[i] = (unsigned)(Rb * ldb + C) * 2u; }
    const size_t hstepB = (size_t)HALF * ldb * 2;
    const unsigned kstepB = BK * 2;
    const unsigned ldsw = (unsigned)wid * 1024u;
    const int aoff = lds_byte(wr * 64 + fr, fq * 8), boff = lds_byte(wc * 32 + fr, fq * 8);
#define PG8_SA(b, h) (((b) * 2 + (h)) * HTB)
#define PG8_SB(b, h) ((4 + (b) * 2 + (h)) * HTB)
#define PG8_STAGE_B(bufoff, gbase) do { _Pragma("unroll") for (int _i = 0; _i < 2; ++_i) { unsigned _o = voffB[_i]; asm volatile("" : "+v"(_o)); \
        __builtin_amdgcn_global_load_lds((const unsigned*)((const char*)(gbase) + _o), (LAS unsigned*)(lds + (bufoff) + ldsw + _i * 8192), 16, 0, 0); } } while (0)
#define PG8_STAGE_A(bufoff, offs, ubase) do { _Pragma("unroll") for (int _i = 0; _i < 2; ++_i) { unsigned _o = (offs)[_i]; asm volatile("" : "+v"(_o)); \
        __builtin_amdgcn_global_load_lds((const unsigned*)((ubase) + _o), (LAS unsigned*)(lds + (bufoff) + ldsw + _i * 8192), 16, 0, 0); } } while (0)
#define PG8_LDA(dst, b, h) do { _Pragma("unroll") for (int m = 0; m < 4; ++m) _Pragma("unroll") for (int k = 0; k < 2; ++k) dst[m][k] = *(const LAS bf16x8*)(lds + PG8_SA(b, h) + aoff + m * 2048 + k * 1024); } while (0)
#define PG8_LDB(dst, b, h) do { _Pragma("unroll") for (int n = 0; n < 2; ++n) _Pragma("unroll") for (int k = 0; k < 2; ++k) dst[n][k] = *(const LAS bf16x8*)(lds + PG8_SB(b, h) + boff + n * 2048 + k * 1024); } while (0)
#define PG8_MMA(ai, bj, At, Bt) do { __builtin_amdgcn_s_setprio(1); _Pragma("unroll") for (int m = 0; m < 4; ++m) _Pragma("unroll") for (int n = 0; n < 2; ++n) _Pragma("unroll") for (int k = 0; k < 2; ++k) \
        acc[ai][bj][m][n] = __builtin_amdgcn_mfma_f32_16x16x32_bf16(Bt[n][k], At[m][k], acc[ai][bj][m][n], 0, 0, 0); __builtin_amdgcn_s_setprio(0); } while (0)
#define PG8_WAIT_V(n) asm volatile("s_waitcnt vmcnt(" #n ")" ::: "memory")
#define PG8_WAIT_L(n) asm volatile("s_waitcnt lgkmcnt(" #n ")" ::: "memory")
#define PG8_BAR __builtin_amdgcn_s_barrier()
#define PG8_SCHED __builtin_amdgcn_sched_barrier(0)
    Unit cur, nxt; int ui = 0;
    if (!S.next(0, cur)) return;
    f32x4 acc[2][2][4][2];
#pragma unroll
    for (int a = 0; a < 2; ++a)
#pragma unroll
        for (int b = 0; b < 2; ++b)
#pragma unroll
            for (int m = 0; m < 4; ++m)
#pragma unroll
                for (int n = 0; n < 2; ++n) acc[a][b][m][n] = (f32x4){0.f, 0.f, 0.f, 0.f};
    bf16x8 At[4][2], B0[2][2], B1[2][2];
    unsigned oA[2][2];
#define PG8_AOFF(dst, unit) do { _Pragma("unroll") for (int _h = 0; _h < 2; ++_h) _Pragma("unroll") for (int _i = 0; _i < 2; ++_i) { int _R, _C; stage_rc(tid * 16 + _i * 8192, _R, _C); \
        dst[_h][_i] = S.arow(unit, _h * HALF + _R) + (unsigned)_C * 2u; } } while (0)
    PG8_AOFF(oA, cur);
    const char* cB = S.bbase(cur);
    const char* cA0 = Abase + S.abase(cur, 0); const char* cA1 = Abase + S.abase(cur, 1);
    PG8_STAGE_B(PG8_SB(0, 0), cB); PG8_STAGE_B(PG8_SB(0, 1), cB + hstepB); PG8_STAGE_A(PG8_SA(0, 0), oA[0], cA0); PG8_STAGE_A(PG8_SA(0, 1), oA[1], cA1);
    if (wr == 1) PG8_BAR;
    PG8_WAIT_V(2); PG8_BAR;
    PG8_STAGE_B(PG8_SB(1, 0), cB + kstepB); PG8_STAGE_A(PG8_SA(1, 0), oA[0], cA0 + kstepA); PG8_STAGE_B(PG8_SB(1, 1), cB + hstepB + kstepB);
    PG8_WAIT_V(6); PG8_BAR;
    for (;;) {
        const bool has_next = S.next(ui + 1, nxt);
        const char* nB = has_next ? S.bbase(nxt) : cB;
        const char* nA0 = has_next ? Abase + S.abase(nxt, 0) : cA0; const char* nA1 = has_next ? Abase + S.abase(nxt, 1) : cA1;
        for (int t = 0; t < nt; t += 2) {
            const bool last = (t == nt - 2);
            const char* a1h1 = cA1 + (size_t)(t + 1) * kstepA;
            const char* a2h0 = last ? nA0 : cA0 + (size_t)(t + 2) * kstepA; const char* a2h1 = last ? nA1 : cA1 + (size_t)(t + 2) * kstepA;
            const char* b2 = last ? nB : cB + (size_t)(t + 2) * kstepB; const char* b3 = b2 + kstepB;
            unsigned nO[2][2];
#pragma unroll
            for (int h = 0; h < 2; ++h)
#pragma unroll
                for (int i = 0; i < 2; ++i) nO[h][i] = oA[h][i];
            if (last && has_next) PG8_AOFF(nO, nxt);
            PG8_LDB(B0, 0, 0); PG8_LDB(B1, 0, 1); PG8_SCHED; PG8_LDA(At, 0, 0); PG8_STAGE_A(PG8_SA(1, 1), oA[1], a1h1);
#pragma unroll
            for (int h = 0; h < 2; ++h)
#pragma unroll
                for (int i = 0; i < 2; ++i) oA[h][i] = nO[h][i];
            PG8_WAIT_V(8); PG8_WAIT_L(0); PG8_BAR; PG8_MMA(0, 0, At, B0); PG8_MMA(0, 1, At, B1); PG8_BAR; PG8_SCHED;
            PG8_LDA(At, 0, 1); PG8_STAGE_B(PG8_SB(0, 0), b2); PG8_STAGE_B(PG8_SB(0, 1), b2 + hstepB); PG8_STAGE_A(PG8_SA(0, 0), oA[0], a2h0);
            PG8_WAIT_V(8); PG8_WAIT_L(0); PG8_BAR; PG8_MMA(1, 0, At, B0); PG8_MMA(1, 1, At, B1); PG8_BAR; PG8_SCHED;
            PG8_LDB(B0, 1, 0); PG8_LDB(B1, 1, 1); PG8_SCHED; PG8_LDA(At, 1, 0); PG8_STAGE_A(PG8_SA(0, 1), oA[1], a2h1);
            PG8_WAIT_V(8); PG8_WAIT_L(0); PG8_BAR; PG8_MMA(0, 0, At, B0); PG8_MMA(0, 1, At, B1); PG8_BAR; PG8_SCHED;
            PG8_LDA(At, 1, 1); PG8_STAGE_B(PG8_SB(1, 0), b3); PG8_STAGE_B(PG8_SB(1, 1), b3 + hstepB); PG8_STAGE_A(PG8_SA(1, 0), oA[0], a2h0 + kstepA);
            PG8_WAIT_V(8); PG8_WAIT_L(0); PG8_BAR; PG8_MMA(1, 0, At, B0); PG8_MMA(1, 1, At, B1); PG8_BAR; PG8_SCHED;
        }
        if (wr == 0) PG8_BAR;
        E(acc, cur, wr, wc, fr, fq);
        if (!has_next) break;
#pragma unroll
        for (int a = 0; a < 2; ++a)
#pragma unroll
            for (int b = 0; b < 2; ++b)
#pragma unroll
                for (int m = 0; m < 4; ++m)
#pragma unroll
                    for (int n = 0; n < 2; ++n) acc[a][b][m][n] = (f32x4){0.f, 0.f, 0.f, 0.f};
        cur = nxt; cB = nB; cA0 = nA0; cA1 = nA1; ++ui;
        if (wr == 1) PG8_BAR;
    }
    PG8_WAIT_V(0);
    PG8_BAR;
#undef PG8_AOFF
#undef PG8_SA
#undef PG8_SB
#undef PG8_STAGE_A
#undef PG8_STAGE_B
#undef PG8_LDA
#undef PG8_LDB
#undef PG8_MMA
#undef PG8_WAIT_V
#undef PG8_WAIT_L
#undef PG8_BAR
#undef PG8_SCHED
}
}
using pg8::Unit;

typedef const float* cfptr_t;
__device__ __forceinline__ const float* ldarg(int i) {
    const unsigned long long v = (unsigned long long)(*(const volatile __attribute__((address_space(4))) cfptr_t*)((const __attribute__((address_space(4))) char*)__builtin_amdgcn_kernarg_segment_ptr() + 8 * i));
    const unsigned lo = __builtin_amdgcn_readfirstlane((unsigned)v), hi = __builtin_amdgcn_readfirstlane((unsigned)(v >> 32));
    return (const float*)(const GAS float*)(((unsigned long long)hi << 32) | lo);
}
#define ARGP(i) ldarg(i)

struct Frame {
    int trbase;
    LAS unsigned char* lds;
    volatile LAS unsigned* MISC;
    gu32* ctl;
    unsigned char* ws;
    int tid, lane, wave, G, vcu;
    int wv;
    float* out;
};

__device__ __forceinline__ void phase_begin(Frame& F) {
    unsigned z_ = 0u; asm volatile("" : "+v"(z_));
    int t = F.wv * 64 + (int)__builtin_amdgcn_mbcnt_hi(~0u, __builtin_amdgcn_mbcnt_lo(~0u, z_)); F.tid = t; F.lane = t & 63; F.wave = __builtin_amdgcn_readfirstlane(t >> 6);
    int g = gridDim.x, bx = blockIdx.x; asm volatile("" : "+s"(g), "+s"(bx)); F.G = g; F.vcu = (g % 8 == 0) ? (bx % 8) * (g / 8) + bx / 8 : bx;
    F.ws = (unsigned char*)ldarg(29); F.ctl = (gu32*)(F.ws + WS_CTL); F.out = (float*)ldarg(28);
}
struct SchedPlain : pg8::TileOrder {
    unsigned lda2; const char* B; size_t btile;
    __device__ __forceinline__ unsigned arow(const Unit&, int r) const { return (unsigned)(r & 127) * lda2; }
    __device__ __forceinline__ size_t abase(const Unit& u, int h) const { return (size_t)(u.pm * 256 + h * 128) * lda2; }
    __device__ __forceinline__ const char* bbase(const Unit& u) const { return B + (size_t)u.pn * btile; }
};
struct SchedMoeUp : pg8::TileOrder {
    unsigned lda2; const char* B; size_t btile, bexp; const int* rowlist; const int* ebase;
    __device__ __forceinline__ int expert(int pm) const { int e = 0;
#pragma unroll
        for (int j = 1; j < NEXP; ++j) e += (pm >= __builtin_amdgcn_readfirstlane(ebase[j])) ? 1 : 0; return e; }
    __device__ __forceinline__ unsigned arow(const Unit& u, int r) const { return (unsigned)rowlist[u.pm * 256 + r] * lda2; }
    __device__ __forceinline__ size_t abase(const Unit&, int) const { return 0; }
    __device__ __forceinline__ const char* bbase(const Unit& u) const { return B + (size_t)expert(u.pm) * bexp + (size_t)u.pn * btile; }
};
struct SchedMoeDown : pg8::TileOrder {
    unsigned lda2; const char* B; size_t btile, bexp; const int* ebase;
    __device__ __forceinline__ int expert(int pm) const { int e = 0;
#pragma unroll
        for (int j = 1; j < NEXP; ++j) e += (pm >= __builtin_amdgcn_readfirstlane(ebase[j])) ? 1 : 0; return e; }
    __device__ __forceinline__ unsigned arow(const Unit&, int r) const { return (unsigned)(r & 127) * lda2; }
    __device__ __forceinline__ size_t abase(const Unit& u, int h) const { return (size_t)(u.pm * 256 + h * 128) * lda2; }
    __device__ __forceinline__ const char* bbase(const Unit& u) const { return B + (size_t)expert(u.pm) * bexp + (size_t)u.pn * btile; }
};

__device__ __forceinline__ float silu_mul(float g, float u) { return g * u * __builtin_amdgcn_rcpf(1.0f + __builtin_amdgcn_exp2f(-1.4426950408889634f * g)); }
struct EpiSwiGLU {
    static constexpr bool PERM = true;
    bf16* O; int ldo;
    __device__ __forceinline__ void operator()(const f32x4 (&acc)[2][2][4][2], const Unit& u, int wr, int wc, int fr, int fq) const {
        const int row0 = u.pm * 256 + wr * 64 + fr, col0 = u.pn * 128 + wc * 32 + 8 * fq;
#pragma unroll
        for (int ai = 0; ai < 2; ++ai)
#pragma unroll
            for (int m = 0; m < 4; ++m) {
                const f32x4 g0 = acc[ai][0][m][0], g1 = acc[ai][0][m][1], u0 = acc[ai][1][m][0], u1 = acc[ai][1][m][1];
                v4u w;
                w.x = pg8::cvt_pk_bf16(silu_mul(g0[0], u0[0]), silu_mul(g0[1], u0[1])); w.y = pg8::cvt_pk_bf16(silu_mul(g0[2], u0[2]), silu_mul(g0[3], u0[3]));
                w.z = pg8::cvt_pk_bf16(silu_mul(g1[0], u1[0]), silu_mul(g1[1], u1[1])); w.w = pg8::cvt_pk_bf16(silu_mul(g1[2], u1[2]), silu_mul(g1[3], u1[3]));
                *(v4u*)(O + (size_t)(row0 + ai * 128 + m * 16) * ldo + col0) = w;
            }
    }
};
struct EpiNull {
    static constexpr bool PERM = true;
    __device__ __forceinline__ void operator()(const f32x4 (&acc)[2][2][4][2], const Unit&, int, int, int, int) const {
#pragma unroll
        for (int ai = 0; ai < 2; ++ai)
#pragma unroll
            for (int bj = 0; bj < 2; ++bj)
#pragma unroll
                for (int m = 0; m < 4; ++m) asm volatile("" :: "v"(acc[ai][bj][m][0]), "v"(acc[ai][bj][m][1]));
    }
};
struct EpiResF32 {
    static constexpr bool PERM = false;
    const float* base; float* out; int ldc; float alpha = 1.0f;
    __device__ __forceinline__ void operator()(const f32x4 (&acc)[2][2][4][2], const Unit& u, int wr, int wc, int fr, int fq) const {
        const int row0 = u.pm * 256 + wr * 64 + fr, col0 = u.pn * 256 + wc * 32 + 4 * fq;
#pragma unroll
        for (int ai = 0; ai < 2; ++ai)
#pragma unroll
            for (int m = 0; m < 4; ++m) { const size_t off = (size_t)(row0 + ai * 128 + m * 16) * ldc + col0;
#pragma unroll
                for (int bj = 0; bj < 2; ++bj)
#pragma unroll
                    for (int n = 0; n < 2; ++n) { const f32x4 b = *(const f32x4*)(base + off + bj * 128 + n * 16); *(f32x4*)(out + off + bj * 128 + n * 16) = b + acc[ai][bj][m][n] * alpha; } }
    }
};
struct EpiBf16Plain {
    static constexpr bool PERM = true;
    bf16* O; int ldo;
    __device__ __forceinline__ void operator()(const f32x4 (&acc)[2][2][4][2], const Unit& u, int wr, int wc, int fr, int fq) const {
        const int row0 = u.pm * 256 + wr * 64 + fr, col0 = u.pn * 256 + wc * 32 + 8 * fq;
#pragma unroll
        for (int ai = 0; ai < 2; ++ai)
#pragma unroll
            for (int m = 0; m < 4; ++m)
#pragma unroll
                for (int bj = 0; bj < 2; ++bj) { const f32x4 v0 = acc[ai][bj][m][0], v1 = acc[ai][bj][m][1]; v4u w;
                    w.x = pg8::cvt_pk_bf16(v0[0], v0[1]); w.y = pg8::cvt_pk_bf16(v0[2], v0[3]); w.z = pg8::cvt_pk_bf16(v1[0], v1[1]); w.w = pg8::cvt_pk_bf16(v1[2], v1[3]);
                    *(v4u*)(O + (size_t)(row0 + ai * 128 + m * 16) * ldo + col0 + bj * 128) = w; }
    }
};

template <class CM>
__device__ __forceinline__ void tr_item(const float* src, int srcN, int kofs, int kvalid, const float* kscale, bf16* dst, int dstK, int k0, int n0, const CM& cm, LAS float* scr, int lane) {
    const int col = cm(n0 + (lane & 31)); const int colc = col < 0 ? 0 : col;
    float v[32];
#pragma unroll
    for (int i = 0; i < 32; ++i) { const int ks = k0 + 2 * i + (lane >> 5) - kofs; const int ksc = ks < 0 ? 0 : (ks >= kvalid ? kvalid - 1 : ks); v[i] = src[(size_t)ksc * srcN + colc]; }
    if (kscale) {
#pragma unroll
        for (int i = 0; i < 32; ++i) { const int ks = k0 + 2 * i + (lane >> 5) - kofs; const int ksc = ks < 0 ? 0 : (ks >= kvalid ? kvalid - 1 : ks); v[i] *= kscale[ksc]; } }
#pragma unroll
    for (int i = 0; i < 32; ++i) { const int kk = 2 * i + (lane >> 5); const int ks = k0 + kk - kofs; scr[kk * 33 + (lane & 31)] = (col >= 0 && ks >= 0 && ks < kvalid) ? v[i] : 0.f; }
    LDS_WAIT(); asm volatile("" ::: "memory");
    const int c = lane & 7;
#pragma unroll
    for (int j = 0; j < 4; ++j) { const int n = (lane >> 3) + 8 * j; const LAS float* s = scr + (8 * c) * 33 + n;
        v4u o; o.x = pk2(s[0 * 33], s[1 * 33]); o.y = pk2(s[2 * 33], s[3 * 33]); o.z = pk2(s[4 * 33], s[5 * 33]); o.w = pk2(s[6 * 33], s[7 * 33]);
        *(GAS v4u*)(dst + (size_t)(n0 + n) * dstK + k0 + 8 * c) = o; }
    LDS_WAIT(); asm volatile("" ::: "memory");
}
struct CmQ { __device__ __forceinline__ int operator()(int j) const { if (j >= 576) return -1; const int hd = j / 96, w = j - hd * 96; if (w < 64) return j; const int w2 = w - 64, i = w2 >> 3, e = w2 & 7; return hd * 96 + 64 + (e < 4 ? 4 * i + e : 16 + 4 * i + (e - 4)); } };
struct CmIdent { int nvalid; __device__ __forceinline__ int operator()(int n) const { return n < nvalid ? n : -1; } };
struct CmGU { __device__ __forceinline__ int operator()(int n) const { return (n >> 8) * 128 + (n & 127); } };

template <class CM>
__device__ __forceinline__ void tr_job(Frame& F, const float* src, int srcN, int kofs, int kvalid, const float* kscale, bf16* dst, int dstK, int rows, const CM& cm) {
    LAS float* scr = (LAS float*)(F.lds + F.wave * 8704);
    const int gw = F.vcu * NWAVES + F.wave, NGW = F.G * NWAVES;
    const int nblk = rows / 32, nit = (dstK / 64) * nblk;
    int it0 = gw - F.trbase; it0 += it0 < 0 ? NGW : 0; F.trbase = (F.trbase + nit) % NGW;
    for (int it = it0; it < nit; it += NGW) { const int kb = it / nblk, nb = it % nblk; tr_item(src, srcN, kofs, kvalid, kscale, dst, dstK, 64 * kb, 32 * nb, cm, scr, F.lane); }
}
__device__ __forceinline__ void tr_job_gu(Frame& F, const float* srcG, const float* srcU, int srcN, bf16* dst, int dstK, int rows) {
    LAS float* scr = (LAS float*)(F.lds + F.wave * 8704);
    const int gw = F.vcu * NWAVES + F.wave, NGW = F.G * NWAVES;
    const int nblk = rows / 32, nit = (dstK / 64) * nblk; const CmGU cm;
    int it0 = gw - F.trbase; it0 += it0 < 0 ? NGW : 0; F.trbase = (F.trbase + nit) % NGW;
    for (int it = it0; it < nit; it += NGW) { const int kb = it / nblk, nb = it % nblk; const int n0 = 32 * nb;
        tr_item((n0 & 128) ? srcU : srcG, srcN, 0, dstK, nullptr, dst, dstK, 64 * kb, n0, cm, scr, F.lane); }
}

__device__ __forceinline__ void p_prologue_ffn(Frame& F, const float* fg, const float* fu, const float* fd, const float* mg, const float* mu, const float* md) {
    phase_begin(F);
    tr_job_gu(F, fg, fu, DFF, (bf16*)(F.ws + WS_WGU), DM, 2 * DFF);
    tr_job(F, fd, DM, 0, DFF, nullptr, (bf16*)(F.ws + WS_WD), DFF, DM, CmIdent{DM});
    for (int e = 0; e < NEXP; ++e) {
        tr_job_gu(F, mg + (size_t)e * DM * DFE, mu + (size_t)e * DM * DFE, DFE, (bf16*)(F.ws + WS_MWGU) + (size_t)e * 2 * DFE * DM, DM, 2 * DFE);
        tr_job(F, md + (size_t)e * DFE * DM, DM, 0, DFE, nullptr, (bf16*)(F.ws + WS_MWD) + (size_t)e * DM * DFE, DFE, DM, CmIdent{DM});
    }
}


__device__ __forceinline__ bool is_rope64(int c) { return (c >= C_QN && c < C_VC) || (c >= C_KS && c < C_VS) || (c >= C_KW && c < C_VW); }
struct CmInProj { __device__ __forceinline__ int operator()(int j) const {
    if (j >= IN_COLS) return -1;
    if (is_rope64(j)) { const int seg = j >= C_KW ? C_KW : j >= C_KS ? C_KS : j >= C_KC ? C_KC : C_QN; const int l = j - seg, hd = l >> 6, w = l & 63, i = w >> 3, e = w & 7; return seg + hd * 64 + (e < 4 ? 4 * i + e : 32 + 4 * i + (e - 4)); }
    if (j >= C_KPE && j < C_QN) { const int w = j - C_KPE, i = w >> 3, e = w & 7; return C_KPE + (e < 4 ? 4 * i + e : 16 + 4 * i + (e - 4)); }
    return j; } };

__device__ __forceinline__ void sincos_acc(double x, float& sn, float& cs) {
    const double kd = __builtin_rint(x * 0.63661977236758134308); const int k = (int)kd;
    const double r = ((x - kd * 1.57079632673412561417e+00) - kd * 6.07710050650619224932e-11) - kd * 2.02226624879595063154e-21, r2 = r * r;
    const double s = r * (1.0 + r2 * (-1.0 / 6 + r2 * (1.0 / 120 + r2 * (-1.0 / 5040 + r2 * (1.0 / 362880 + r2 * (-1.0 / 39916800 + r2 * (1.0 / 6227020800.0)))))));
    const double c = 1.0 + r2 * (-0.5 + r2 * (1.0 / 24 + r2 * (-1.0 / 720 + r2 * (1.0 / 40320 + r2 * (-1.0 / 3628800 + r2 * (1.0 / 479001600.0 + r2 * (-1.0 / 87178291200.0)))))));
    const int q = k & 3; sn = (float)(q == 0 ? s : q == 1 ? c : q == 2 ? -s : -c); cs = (float)(q == 0 ? c : q == 1 ? -s : q == 2 ? -c : s);
}
__device__ __forceinline__ void p_tables(Frame& F) {
    phase_begin(F);
    const int gt = F.vcu * NTHR + F.tid, NGT = F.G * NTHR;
    GAS f32x2* tn = (GAS f32x2*)(F.ws + WS_TABN); GAS f32x2* tm = (GAS f32x2*)(F.ws + WS_TABM);
    for (int e = gt; e < SEQ * 32; e += NGT) { const int pos = e >> 5, i = e & 31; float sn, cs; sincos_acc((double)((float)pos * INV_N[i]), sn, cs); tn[e] = (f32x2){cs, sn}; }
    for (int e = gt; e < SEQ * 16; e += NGT) { const int pos = e >> 4, i = e & 15; float sn, cs; sincos_acc((double)((float)pos * INV_M[i]), sn, cs); tm[e] = (f32x2){cs, sn}; }
}

struct EpiInProj {
    static constexpr bool PERM = true;
    bf16* U; const f32x2* tabn; const f32x2* tabm; float* ssq;
    __device__ __forceinline__ void operator()(const f32x4 (&acc)[2][2][4][2], const Unit& u, int wr, int wc, int fr, int fq) const {
        const int row0 = u.pm * 256 + wr * 64 + fr;
#pragma unroll
        for (int bj = 0; bj < 2; ++bj) {
            const int c32 = u.pn * 256 + bj * 128 + wc * 32;
            const int c8 = c32 + 8 * fq;
            if (is_rope64(c32)) {
                const int seg = c32 >= C_KW ? C_KW : c32 >= C_KS ? C_KS : c32 >= C_KC ? C_KC : C_QN;
                const int l = c8 - seg, hb = seg + (l & ~63), i = (l & 63) >> 3; const float sc = (seg == C_QN) ? QSCALE_N : 1.0f;
#pragma unroll
                for (int am = 0; am < 8; am += 2) {
                    f32x4 ta[2], tb[2];
#pragma unroll
                    for (int q = 0; q < 2; ++q) { const int pos = (row0 + ((am + q) >> 2) * 128 + ((am + q) & 3) * 16) & (SEQ - 1); const GAS f32x4* t = (const GAS f32x4*)(tabn + pos * 32 + 4 * i); ta[q] = t[0]; tb[q] = t[1]; }
#pragma unroll
                    for (int q = 0; q < 2; ++q) { const int ai = (am + q) >> 2, m = (am + q) & 3, row = row0 + ai * 128 + m * 16;
                        const f32x4 x1 = acc[ai][bj][m][0], x2 = acc[ai][bj][m][1]; const f32x4 t0 = ta[q], t1 = tb[q];
                        const float y10 = (x1[0] * t0[0] - x2[0] * t0[1]) * sc, y11 = (x1[1] * t0[2] - x2[1] * t0[3]) * sc, y12 = (x1[2] * t1[0] - x2[2] * t1[1]) * sc, y13 = (x1[3] * t1[2] - x2[3] * t1[3]) * sc;
                        const float y20 = (x2[0] * t0[0] + x1[0] * t0[1]) * sc, y21 = (x2[1] * t0[2] + x1[1] * t0[3]) * sc, y22 = (x2[2] * t1[0] + x1[2] * t1[1]) * sc, y23 = (x2[3] * t1[2] + x1[3] * t1[3]) * sc;
                        const auto s0 = __builtin_amdgcn_permlane16_swap(pg8::cvt_pk_bf16(y10, y11), pg8::cvt_pk_bf16(y20, y21), false, false);
                        const auto s1 = __builtin_amdgcn_permlane16_swap(pg8::cvt_pk_bf16(y12, y13), pg8::cvt_pk_bf16(y22, y23), false, false);
                        bf16* o = U + (size_t)row * NU + hb + 4 * i + ((fq & 1) ? 28 : 0);
                        *(v4u*)o = (v4u){s0[0], s1[0], s0[1], s1[1]}; }
                    asm volatile("" ::: "memory"); }
            } else if (c32 == C_KPE) {
                const int i = fq;
#pragma unroll
                for (int ai = 0; ai < 2; ++ai)
#pragma unroll
                    for (int m = 0; m < 4; ++m) { const int row = row0 + ai * 128 + m * 16, pos = row & (SEQ - 1);
                        const f32x4 x1 = acc[ai][bj][m][0], x2 = acc[ai][bj][m][1]; const GAS f32x4* t = (const GAS f32x4*)(tabm + pos * 16 + 4 * i);
                        const f32x4 t0 = t[0], t1 = t[1];
                        const float y10 = x1[0] * t0[0] - x2[0] * t0[1], y11 = x1[1] * t0[2] - x2[1] * t0[3], y12 = x1[2] * t1[0] - x2[2] * t1[1], y13 = x1[3] * t1[2] - x2[3] * t1[3];
                        const float y20 = x2[0] * t0[0] + x1[0] * t0[1], y21 = x2[1] * t0[2] + x1[1] * t0[3], y22 = x2[2] * t1[0] + x1[2] * t1[1], y23 = x2[3] * t1[2] + x1[3] * t1[3];
                        const auto s0 = __builtin_amdgcn_permlane16_swap(pg8::cvt_pk_bf16(y10, y11), pg8::cvt_pk_bf16(y20, y21), false, false);
                        const auto s1 = __builtin_amdgcn_permlane16_swap(pg8::cvt_pk_bf16(y12, y13), pg8::cvt_pk_bf16(y22, y23), false, false);
                        bf16* o = U + (size_t)row * NU + C_KPE + 4 * i + ((fq & 1) ? 12 : 0);
                        *(v4u*)o = (v4u){s0[0], s1[0], s0[1], s1[1]}; asm volatile("" ::: "memory"); }
            } else {
                const bool sq = (c32 >= C_QDN && c32 < C_KPE); const int grp = (c32 - C_QDN) >> 5;
#pragma unroll
                for (int ai = 0; ai < 2; ++ai)
#pragma unroll
                    for (int m = 0; m < 4; ++m) { const int row = row0 + ai * 128 + m * 16; const f32x4 v0 = acc[ai][bj][m][0], v1 = acc[ai][bj][m][1]; v4u w;
                        w.x = pg8::cvt_pk_bf16(v0[0], v0[1]); w.y = pg8::cvt_pk_bf16(v0[2], v0[3]); w.z = pg8::cvt_pk_bf16(v1[0], v1[1]); w.w = pg8::cvt_pk_bf16(v1[2], v1[3]);
                        *(v4u*)(U + (size_t)row * NU + c8) = w;
                        if (sq) { float q = (v0[0] * v0[0] + v0[1] * v0[1]) + (v0[2] * v0[2] + v0[3] * v0[3]) + (v1[0] * v1[0] + v1[1] * v1[1]) + (v1[2] * v1[2] + v1[3] * v1[3]);
                            q += xor_f<16>(q); q += xor_f<32>(q); if (fq == 0) ssq[(size_t)row * 16 + grp] = q; } }
            }
        }
    }
};

__device__ __forceinline__ float sigmoidf_(float x) { return __builtin_amdgcn_rcpf(1.0f + __expf(-x)); }
__device__ __forceinline__ float gelu_tanh(float y) { const float z = 0.7978845608028654f * (y + 0.044715f * y * y * y); const float t = 1.0f - 2.0f * __builtin_amdgcn_rcpf(1.0f + __expf(2.0f * z)); return 0.5f * y * (1.0f + t); }
__device__ __forceinline__ float one_minus_exp(float x) {
    const float p = -x * (1.0f + x * (0.5f + x * (0.16666667f + x * (0.041666668f + x * 0.0083333338f))));
    return (x > -0.125f) ? p : 1.0f - __expf(x); }
constexpr int LRU_XP = 264;
__device__ __forceinline__ int q_fetch(Frame& F, int qid);
__device__ __forceinline__ void p_lru_local(Frame& F, int qid, const float* cw, const float* cb, const float* wa, const float* ba, const float* wx, const float* bx, const float* lam) {
    phase_begin(F);
    const int d = F.tid & 255, half = F.tid >> 8;
    LAS bf16* xsb = (LAS bf16*)F.lds;
    LAS bf16* gts = (LAS bf16*)(F.lds + 64 * LRU_XP * 2);
    const bf16* U = (const bf16*)(F.ws + WS_U);
    bf16* P = (bf16*)(F.ws + WS_PQ); bf16* Q = P + (size_t)TOK * 256;
    float* SA = (float*)(F.ws + WS_LRU); float* SB = SA + 1024 * 256;
    const int r32 = F.lane & 31, hi = F.lane >> 5, gsel = F.wave >> 2, blk = F.wave & 3;
    bf16x8 bw[2][4];
    { const float* W = (gsel ? wx : wa) + (size_t)blk * 4096;
#pragma unroll
      for (int nt = 0; nt < 2; ++nt)
#pragma unroll
          for (int ks = 0; ks < 4; ++ks) { v4u w;
              const float* wp = W + (size_t)(16 * ks + 8 * hi) * 64 + 32 * nt + r32;
              w.x = pk2(wp[0], wp[64]); w.y = pk2(wp[128], wp[192]); w.z = pk2(wp[256], wp[320]); w.w = pk2(wp[384], wp[448]);
              bw[nt][ks] = __builtin_bit_cast(bf16x8, w); } }
    const float w0 = cw[d], w1 = cw[256 + d], w2 = cw[512 + d], w3 = cw[768 + d], cbd = cb[d], bad = ba[d], bxd = bx[d];
    const float sp = log1pf(__expf(-lam[d]));
    for (;;) {
        const int ch = q_fetch(F, qid); if (ch >= TOK / 64) break;
        const int t0 = ch * 64 + half * 32, pos0 = t0 & (SEQ - 1);
        float xm3 = 0.f, xm2 = 0.f, xm1 = 0.f;
        if (pos0 >= 3) { xm3 = bf2f(U[(size_t)(t0 - 3) * NU + C_XL + d]); xm2 = bf2f(U[(size_t)(t0 - 2) * NU + C_XL + d]); xm1 = bf2f(U[(size_t)(t0 - 1) * NU + C_XL + d]); }
        { float xv[32];
#pragma unroll
          for (int i = 0; i < 32; ++i) xv[i] = bf2f(U[(size_t)(t0 + i) * NU + C_XL + d]);
#pragma unroll
          for (int i = 0; i < 32; ++i) { const float x0 = xv[i]; const float v = cbd + w0 * xm3 + w1 * xm2 + w2 * xm1 + w3 * x0; xm3 = xm2; xm2 = xm1; xm1 = x0;
              xsb[(half * 32 + i) * LRU_XP + d] = (bf16)f2bf(v); } }
        __syncthreads();
#pragma unroll
        for (int mt = 0; mt < 2; ++mt) {
            f32x16 acc0 = f32x16{}, acc1 = f32x16{};
#pragma unroll
            for (int ks = 0; ks < 4; ++ks) { const bf16x8 a = *(const LAS bf16x8*)(xsb + (32 * mt + r32) * LRU_XP + 64 * blk + 16 * ks + 8 * hi);
                acc0 = __builtin_amdgcn_mfma_f32_32x32x16_bf16(a, bw[0][ks], acc0, 0, 0, 0); acc1 = __builtin_amdgcn_mfma_f32_32x32x16_bf16(a, bw[1][ks], acc1, 0, 0, 0); }
#pragma unroll
            for (int r = 0; r < 16; ++r) { const int tok = 32 * mt + crow(r, hi);
                gts[((size_t)gsel * 64 + tok) * 256 + 64 * blk + r32] = (bf16)f2bf(acc0[r]); gts[((size_t)gsel * 64 + tok) * 256 + 64 * blk + 32 + r32] = (bf16)f2bf(acc1[r]); }
        }
        __syncthreads();
        float h = 0.f, cum = 1.f;
        float y0 = bf2f(U[(size_t)t0 * NU + C_YL + d]), y1 = bf2f(U[(size_t)(t0 + 1) * NU + C_YL + d]);
#pragma unroll 2
        for (int i = 0; i < 32; ++i) {
            const float ycur = y0; y0 = y1; if (i + 2 < 32) y1 = bf2f(U[(size_t)(t0 + i + 2) * NU + C_YL + d]);
            const float ra = bad + bf2f(gts[(size_t)(half * 32 + i) * 256 + d]), ia = bxd + bf2f(gts[(size_t)(64 + half * 32 + i) * 256 + d]);
            const float xcv = bf2f(xsb[(half * 32 + i) * LRU_XP + d]);
            const float r = sigmoidf_(ra), ig = sigmoidf_(ia), la = -8.0f * r * sp, a = __expf(la), b = __builtin_amdgcn_sqrtf(one_minus_exp(2.0f * la)) * (ig * xcv);
            h = a * h + b; cum *= a;
            const float gl = gelu_tanh(ycur);
            P[(size_t)(t0 + i) * 256 + d] = (bf16)f2bf(h * gl); Q[(size_t)(t0 + i) * 256 + d] = (bf16)f2bf(cum * gl);
        }
        SA[(size_t)(ch * 2 + half) * 256 + d] = cum; SB[(size_t)(ch * 2 + half) * 256 + d] = h;
    }
}
__device__ __forceinline__ void p_lru_carry(Frame& F) {
    phase_begin(F);
    if (F.vcu >= NB || F.tid >= 256) return;
    const float* SA = (const float*)(F.ws + WS_LRU); const float* SB = SA + 1024 * 256; float* CY = (float*)(F.ws + WS_LRU) + 2 * 1024 * 256;
    const int d = F.tid; float c = 0.f;
    for (int k0 = 0; k0 < 256; k0 += 16) { float a[16], b[16];
#pragma unroll
        for (int i = 0; i < 16; ++i) { const size_t o = (size_t)(F.vcu * 256 + k0 + i) * 256 + d; a[i] = SA[o]; b[i] = SB[o]; }
#pragma unroll
        for (int i = 0; i < 16; ++i) { const size_t o = (size_t)(F.vcu * 256 + k0 + i) * 256 + d; CY[o] = c; c = a[i] * c + b[i]; } }
}
__device__ __forceinline__ void p_lru_fix(Frame& F, int zfrom) {
    phase_begin(F);
    const int gw = F.vcu * NWAVES + F.wave, NGW = F.G * NWAVES;
    const bf16* P = (const bf16*)(F.ws + WS_PQ); const bf16* Q = P + (size_t)TOK * 256; const float* CY = (const float*)(F.ws + WS_LRU) + 2 * 1024 * 256; bf16* CAT = (bf16*)(F.ws + WS_CAT);
    for (int m0 = gw; m0 < TOK; m0 += 4 * NGW) {
        v2u p[4], q[4]; f32x4 c[4];
#pragma unroll
        for (int i = 0; i < 4; ++i) { const int m = m0 + i * NGW; if (m < TOK) { p[i] = *((const GAS v2u*)(P + (size_t)m * 256) + F.lane); q[i] = *((const GAS v2u*)(Q + (size_t)m * 256) + F.lane);
            c[i] = *((const GAS f32x4*)(CY + (size_t)(m >> 5) * 256) + F.lane); } }
#pragma unroll
        for (int i = 0; i < 4; ++i) { const int m = m0 + i * NGW; if (m < TOK) {
            v2u o; o.x = pk2(bflo(p[i].x) + bflo(q[i].x) * c[i].x, bfhi(p[i].x) + bfhi(q[i].x) * c[i].y); o.y = pk2(bflo(p[i].y) + bflo(q[i].y) * c[i].z, bfhi(p[i].y) + bfhi(q[i].y) * c[i].w);
            *((GAS v2u*)(CAT + (size_t)m * DM) + F.lane) = o;
            { GAS v4u* z = (GAS v4u*)(CAT + (size_t)m * DM + zfrom); const int nz = (DM - zfrom) / 8;
#pragma unroll
              for (int j = 0; j < 2; ++j) { const int idx = F.lane + 64 * j; if (idx < nz) z[idx] = (v4u){0u, 0u, 0u, 0u}; } } } }
    }
}

__device__ __forceinline__ void p_prologue_mix(Frame& F, const float* w_in, const float* w_out) {
    phase_begin(F);
    for (int l = 0; l < DEPTH; ++l) {
        tr_job(F, w_in + (size_t)l * DM * IN_COLS, IN_COLS, 0, DM, nullptr, (bf16*)(F.ws + WS_WIN) + (size_t)l * NU * DM, DM, NU, CmInProj{});
        tr_job(F, w_out + (size_t)l * DM * DM, DM, 0, DM, nullptr, (bf16*)(F.ws + WS_WOUT) + (size_t)l * DM * DM, DM, DM, CmIdent{DM});
    }
}
__device__ __forceinline__ void p_prologue_cmp(Frame& F, const float* w1) {
    phase_begin(F);
    for (int ls = 0; ls < DEPTH * 2; ++ls) tr_job(F, w1 + (size_t)ls * 2048 * 128, 128, 0, 2048, nullptr, (bf16*)(F.ws + WS_WC1) + (size_t)ls * 256 * 2048, 2048, 256, CmIdent{128});
}
__device__ __forceinline__ void p_prologue_qkv(Frame& F, const float* qn, const float* wuq, const float* kvn, const float* wukv) {
    phase_begin(F);
    for (int l = 0; l < DEPTH; ++l) {
        bf16* W = (bf16*)(F.ws + WS_WQKV) + (size_t)l * 1536 * 384;
        tr_job(F, wuq + (size_t)l * 192 * 576, 576, 0, 192, qn + l * 192, W, 384, 768, CmQ{});
        tr_job(F, wukv + (size_t)l * 128 * 768, 768, 192, 128, kvn + l * 128, W + (size_t)768 * 384, 384, 768, CmIdent{768});
    }
}

enum { AM_CAUSAL = 0, AM_WINDOW = 1, AM_SELECT = 2, AM_CMP = 3 };
constexpr int NSA_WIN = 512;
template <int DK, int NSUB = 1> struct AttnLds { static constexpr int KP = DK + 8, KT = 64 * KP * 2, KBYTES = NSUB * KT, VBYTES = NSUB * 8192, BUF = KBYTES + VBYTES; };
struct SrcMla { const bf16* kvm; const bf16* u; int h; size_t base;
    __device__ __forceinline__ const bf16* kp(int key, int c) const { return c < 8 ? kvm + (base + key) * 768 + h * 128 + 8 * c : u + (base + key) * NU + C_KPE + 8 * (c - 8); }
    __device__ __forceinline__ const bf16* vp(int key, int c) const { return kvm + (base + key) * 768 + h * 128 + 64 + 8 * c; }
    __device__ __forceinline__ unsigned koff(int key, int c) const { return c < 8 ? (unsigned)WS_KVM + ((unsigned)base + key) * 1536u + h * 256 + 16 * c : (unsigned)WS_U + ((unsigned)base + key) * (NU * 2u) + (C_KPE + 8 * (c - 8)) * 2; }
    __device__ __forceinline__ unsigned kstride(int c) const { return c < 8 ? 1536u : NU * 2u; }
    __device__ __forceinline__ unsigned voff(int key, int c) const { return (unsigned)WS_KVM + ((unsigned)base + key) * 1536u + h * 256 + 128 + 16 * c; }
    __device__ __forceinline__ unsigned vstride() const { return 1536u; } };
struct SrcU { const bf16* u; int kcol, vcol; size_t base;
    __device__ __forceinline__ const bf16* kp(int key, int c) const { return u + (base + key) * NU + kcol + 8 * c; }
    __device__ __forceinline__ const bf16* vp(int key, int c) const { return u + (base + key) * NU + vcol + 8 * c; }
    __device__ __forceinline__ unsigned koff(int key, int c) const { return (unsigned)WS_U + ((unsigned)base + key) * (NU * 2u) + (kcol + 8 * c) * 2; }
    __device__ __forceinline__ unsigned kstride(int) const { return NU * 2u; }
    __device__ __forceinline__ unsigned voff(int key, int c) const { return (unsigned)WS_U + ((unsigned)base + key) * (NU * 2u) + (vcol + 8 * c) * 2; }
    __device__ __forceinline__ unsigned vstride() const { return NU * 2u; } };
struct SrcCmp { const bf16* kc; const bf16* vc; unsigned kc0, vc0;
    __device__ __forceinline__ const bf16* kp(int key, int c) const { return kc + key * 64 + 8 * c; }
    __device__ __forceinline__ const bf16* vp(int key, int c) const { return vc + key * 64 + 8 * c; }
    __device__ __forceinline__ unsigned koff(int key, int c) const { return kc0 + key * 128 + 16 * c; }
    __device__ __forceinline__ unsigned kstride(int) const { return 128u; }
    __device__ __forceinline__ unsigned voff(int key, int c) const { return vc0 + key * 128 + 16 * c; }
    __device__ __forceinline__ unsigned vstride() const { return 128u; } };

template <int DK, int MODE, int NSUB, int VAR = 0, class Src>
__device__ __forceinline__ void attn_branch(Frame& F, LAS unsigned char* lds, const Src& src, const bf16x8 (&qf)[DK / 16], int qpos0w, int jlo, int jhi, const v4u selmask, f32x16 (&o)[2], float& m_out, float& l_out) {
    typedef AttnLds<DK, NSUB> L;
    const int tid = F.tid, lane = F.lane, r32 = lane & 31, hi = lane >> 5;
    const int qpos = qpos0w + r32;
    o[0] = f32x16{}; o[1] = f32x16{};
    float m = -1.0e30f, l = 0.f;
    f32x16 lacc_unused = f32x16{};
    const bf16x8 ones = (bf16x8){(short)0x3f80, (short)0x3f80, (short)0x3f80, (short)0x3f80, (short)0x3f80, (short)0x3f80, (short)0x3f80, (short)0x3f80};
    constexpr int KC = DK / 8, NKP = NSUB * 64 * KC, NPT = (NKP + 511) / 512; constexpr bool KEXACT = (NKP % 512) == 0;
    const int vkey = tid >> 3, vc = tid & 7;
    const GAS unsigned char* wsb = (const GAS unsigned char*)F.ws;
    unsigned kl[NPT], kst[NPT], vl[NSUB];
#pragma unroll
    for (int i = 0; i < NPT; ++i) { const int p_ = tid + 512 * i; kl[i] = src.koff(p_ / KC, p_ % KC); kst[i] = src.kstride(p_ % KC); }
#pragma unroll
    for (int i = 0; i < NSUB; ++i) vl[i] = src.voff(64 * i + vkey, vc);
    v4u kr[NPT], vr[NSUB];
#define AT_LOAD(jm_) do { const unsigned kb_ = (unsigned)((jm_) * (NSUB * 64)); \
        _Pragma("unroll") for (int i_ = 0; i_ < NPT; ++i_) { const int p_ = tid + 512 * i_; if (KEXACT || i_ + 1 < NPT || p_ < NKP) kr[i_] = *(const GAS v4u*)(wsb + (size_t)(kl[i_] + kb_ * kst[i_])); } \
        _Pragma("unroll") for (int i_ = 0; i_ < NSUB; ++i_) vr[i_] = *(const GAS v4u*)(wsb + (size_t)(vl[i_] + kb_ * src.vstride())); } while (0)
#define AT_WRITE(buf) do { LAS unsigned char* b_ = lds + (buf) * L::BUF; \
        _Pragma("unroll") for (int i_ = 0; i_ < NPT; ++i_) { const int p_ = tid + 512 * i_; if (KEXACT || i_ + 1 < NPT || p_ < NKP) *(LAS v4u*)(b_ + (p_ / KC) * (L::KP * 2) + (p_ % KC) * 16) = kr[i_]; } \
        _Pragma("unroll") for (int i_ = 0; i_ < NSUB; ++i_) *(LAS v4u*)(b_ + L::KBYTES + i_ * 8192 + (vc >> 2) * 4096 + vkey * 64 + (vc & 3) * 16) = vr[i_]; } while (0)
    const int mlo = jlo / NSUB, mhi = jhi / NSUB;
    if (jlo <= jhi) { AT_LOAD(mlo); AT_WRITE(0); }
    __syncthreads();
    if (F.wave & 1) __builtin_amdgcn_s_setprio(3);
    int cur = 0;
    for (int jm = mlo; jm <= mhi; ++jm) {
        if (jm < mhi) AT_LOAD(jm + 1);
#pragma unroll
      for (int sub = 0; sub < NSUB; ++sub) {
        const int j = jm * NSUB + sub;
        const int kb = j * 64;
        bool need, part, lanesel = true;
        if (MODE == AM_CAUSAL)      { need = kb <= qpos0w + 31; part = kb + 63 > qpos0w; }
        else if (MODE == AM_WINDOW) { need = (kb <= qpos0w + 31) && (kb + 63 > qpos0w - NSA_WIN); part = (kb + 63 > qpos0w) || (kb <= qpos0w + 31 - NSA_WIN); }
        else if (MODE == AM_SELECT) { const unsigned w = (j < 32) ? selmask.x : (j < 64) ? selmask.y : (j < 96) ? selmask.z : selmask.w; lanesel = (w >> (j & 31)) & 1u;
                                      need = __any(lanesel) && kb <= qpos0w + 31; part = kb + 63 > qpos0w; }
        else                        { need = (16 * kb + 31) <= qpos0w + 31; part = (16 * (kb + 63) + 31 > qpos0w) || (kb + 63 > 510); }
        if (NSUB > 1) need = need && j >= jlo && j <= jhi;
        if (need) {
            const LAS unsigned char* kb_l = lds + cur * L::BUF + sub * L::KT; const LAS unsigned char* vb_l = lds + cur * L::BUF + L::KBYTES + sub * 8192;
            f32x16 p0 = f32x16{}, p1 = f32x16{};
#pragma unroll
            for (int ks = 0; ks < DK / 16; ++ks) {
                const bf16x8 k0 = *(const LAS bf16x8*)(kb_l + r32 * (L::KP * 2) + ks * 32 + hi * 16);
                const bf16x8 k1 = (VAR == 6) ? k0 : *(const LAS bf16x8*)(kb_l + (32 + r32) * (L::KP * 2) + ks * 32 + hi * 16);
                p0 = __builtin_amdgcn_mfma_f32_32x32x16_bf16(k0, qf[ks], p0, 0, 0, 0);
                p1 = __builtin_amdgcn_mfma_f32_32x32x16_bf16(k1, qf[ks], p1, 0, 0, 0);
            }
            s16x4 vlo[2][4], vhh[2][4];
            { const int li = lane & 15, dhalf = (lane >> 4) & 1;
              const LAS unsigned char* vbase = vb_l + (4 * hi + (li >> 2)) * 64 + (16 * dhalf + 4 * (li & 3)) * 2;
#pragma unroll
              for (int db = 0; db < 2; ++db)
#pragma unroll
                  for (int s4 = 0; s4 < 4; ++s4) {
                      vlo[db][s4] = __builtin_bit_cast(s16x4, __builtin_amdgcn_ds_read_tr16_b64_v4i16((LAS s16x4*)(vbase + db * 4096 + s4 * 1024)));
                      vhh[db][s4] = __builtin_bit_cast(s16x4, __builtin_amdgcn_ds_read_tr16_b64_v4i16((LAS s16x4*)(vbase + db * 4096 + s4 * 1024 + 512))); } }
            __builtin_amdgcn_sched_barrier(0);
            if (part) {
                const float NEG = -INFINITY;
                if (MODE == AM_WINDOW) {
                    if (kb + 63 > qpos0w) { const int lim = qpos - kb - 4 * hi;
#pragma unroll
                        for (int r = 0; r < 16; ++r) { const int c = (r & 3) + 8 * (r >> 2); if (!(lim >= c)) p0[r] = NEG; if (!(lim >= c + 32)) p1[r] = NEG; } }
                    if (kb <= qpos0w + 31 - NSA_WIN) { const int lim = qpos - NSA_WIN - kb - 4 * hi;
#pragma unroll
                        for (int r = 0; r < 16; ++r) { const int c = (r & 3) + 8 * (r >> 2); if (!(lim < c)) p0[r] = NEG; if (!(lim < c + 32)) p1[r] = NEG; } }
                } else {
                    int lim;
                    if (MODE == AM_CMP) { const int nl = (qpos - 31) >> 4; lim = (nl < 510 ? nl : 510) - kb - 4 * hi; }
                    else lim = qpos - kb - 4 * hi;
#pragma unroll
                    for (int r = 0; r < 16; ++r) { const int c = (r & 3) + 8 * (r >> 2); if (!(lim >= c)) p0[r] = NEG; if (!(lim >= c + 32)) p1[r] = NEG; }
                }
            }
            float mxa = __builtin_fmaxf(__builtin_fmaxf(p0[0], p0[1]), p1[0]), mxc = __builtin_fmaxf(__builtin_fmaxf(p0[2], p0[3]), p1[1]); mxa = __builtin_fmaxf(__builtin_fmaxf(mxa, p1[2]), p1[3]);
#pragma unroll
            for (int r = 4; r < 16; r += 4) { mxa = __builtin_fmaxf(__builtin_fmaxf(mxa, p0[r]), p0[r + 1]); mxc = __builtin_fmaxf(__builtin_fmaxf(mxc, p0[r + 2]), p0[r + 3]); mxa = __builtin_fmaxf(__builtin_fmaxf(mxa, p1[r]), p1[r + 1]); mxc = __builtin_fmaxf(__builtin_fmaxf(mxc, p1[r + 2]), p1[r + 3]); }
            float mx = __builtin_fmaxf(mxa, mxc); mx = __builtin_fmaxf(mx, xor_f<32>(mx));
            if (MODE == AM_SELECT) mx = lanesel ? mx : -INFINITY;
            if (__any(mx > m + 6.0f)) { const float mn = fmaxf(m, mx), alpha = __builtin_amdgcn_exp2f(m - mn); m = mn; l *= alpha;
#pragma unroll
                for (int r = 0; r < 16; ++r) { o[0][r] *= alpha; o[1][r] *= alpha; } }
            typedef float f32x2v __attribute__((ext_vector_type(2)));
            const float msub = (MODE == AM_SELECT) ? (lanesel ? m : INFINITY) : m;
            const f32x2v m2 = (f32x2v){msub, msub}; f32x2v ps2 = (f32x2v){0.f, 0.f};
#pragma unroll
            for (int r = 0; r < 16; r += 2) { const f32x2v a_ = (f32x2v){p0[r], p0[r + 1]} - m2, b_ = (f32x2v){p1[r], p1[r + 1]} - m2;
                p0[r] = __builtin_amdgcn_exp2f(a_[0]); p0[r + 1] = __builtin_amdgcn_exp2f(a_[1]); p1[r] = __builtin_amdgcn_exp2f(b_[0]); p1[r + 1] = __builtin_amdgcn_exp2f(b_[1]);
                ps2 += (f32x2v){p0[r], p0[r + 1]}; ps2 += (f32x2v){p1[r], p1[r + 1]}; }
            l += ps2[0] + ps2[1];
            bf16x8 pf[4];
#pragma unroll
            for (int s4 = 0; s4 < 4; ++s4) { const int rb = 8 * (s4 & 1); v4u w;
                if (s4 < 2) { w.x = pg8::cvt_pk_bf16(p0[rb], p0[rb + 1]); w.y = pg8::cvt_pk_bf16(p0[rb + 2], p0[rb + 3]); w.z = pg8::cvt_pk_bf16(p0[rb + 4], p0[rb + 5]); w.w = pg8::cvt_pk_bf16(p0[rb + 6], p0[rb + 7]); }
                else        { w.x = pg8::cvt_pk_bf16(p1[rb], p1[rb + 1]); w.y = pg8::cvt_pk_bf16(p1[rb + 2], p1[rb + 3]); w.z = pg8::cvt_pk_bf16(p1[rb + 4], p1[rb + 5]); w.w = pg8::cvt_pk_bf16(p1[rb + 6], p1[rb + 7]); }
                pf[s4] = __builtin_bit_cast(bf16x8, w); }
#pragma unroll
            for (int s4 = 0; s4 < 4; ++s4) {
#pragma unroll
                for (int db = 0; db < 2; ++db) {
                    const s16x4 lo = vlo[db][s4], hh = vhh[db][s4];
                    const bf16x8 vf = (bf16x8){lo[0], lo[1], lo[2], lo[3], hh[0], hh[1], hh[2], hh[3]};
                    o[db] = __builtin_amdgcn_mfma_f32_32x32x16_bf16(vf, pf[s4], o[db], 0, 0, 0);
                }
            }
        }
      }
        if (jm < mhi) AT_WRITE(cur ^ 1);
        if (VAR != 7) __syncthreads();
        cur ^= 1;
    }
#undef AT_LOAD
#undef AT_WRITE
    __builtin_amdgcn_s_setprio(0);
    l += xor_f<32>(l);
    m_out = m; l_out = l;
    const float inv = (l > 0.f) ? 1.0f / l : 0.f;
#pragma unroll
    for (int r = 0; r < 16; ++r) { o[0][r] *= inv; o[1][r] *= inv; }
}
__device__ __forceinline__ unsigned q_issue(Frame& F, int qid) { unsigned t = 0u; if (F.tid == 0) t = __hip_atomic_fetch_add((unsigned*)(F.ctl + CW_Q + 64 * qid), 1u, __ATOMIC_RELAXED, __HIP_MEMORY_SCOPE_AGENT); return t; }
__device__ __forceinline__ int q_take(Frame& F, unsigned t) { if (F.tid == 0) F.MISC[0] = t; __syncthreads(); const int v = (int)F.MISC[0]; __syncthreads(); return __builtin_amdgcn_readfirstlane(v); }
__device__ __forceinline__ int q_fetch(Frame& F, int qid) {
    if (F.tid == 0) F.MISC[0] = __hip_atomic_fetch_add((unsigned*)(F.ctl + CW_Q + 64 * qid), 1u, __ATOMIC_RELAXED, __HIP_MEMORY_SCOPE_AGENT);
    __syncthreads(); const int v = (int)F.MISC[0]; __syncthreads(); return __builtin_amdgcn_readfirstlane(v);
}

constexpr int CW_FLAG = 19000;
__device__ __forceinline__ void unit_publish(Frame& F, int word) {
    asm volatile("s_waitcnt vmcnt(0)" ::: "memory");
    __syncthreads();
    if (F.tid == 0) { __builtin_amdgcn_fence(__ATOMIC_RELEASE, "agent"); asm volatile("s_waitcnt vmcnt(0)" ::: "memory"); (void)xb_add((unsigned*)(F.ctl + word), 1u); }
}
__device__ __forceinline__ void count_await(Frame& F, int word, unsigned target) {
    if (F.tid == 0) { unsigned* bar = (unsigned*)(F.ctl + CW_BAR); XB_SPIN(xb_ld((unsigned*)(F.ctl + word)) < target, bar); __builtin_amdgcn_fence(__ATOMIC_ACQUIRE, "agent"); asm volatile("s_waitcnt vmcnt(0)" ::: "memory"); }
    __syncthreads();
}
__device__ __forceinline__ void unit_await(Frame& F, int word) {
    if (F.tid == 0) { unsigned* bar = (unsigned*)(F.ctl + CW_BAR); XB_SPIN(xb_ld((unsigned*)(F.ctl + word)) == 0u, bar); __builtin_amdgcn_fence(__ATOMIC_ACQUIRE, "agent"); asm volatile("s_waitcnt vmcnt(0)" ::: "memory"); }
    __syncthreads();
}

constexpr size_t KC_HEAD = (size_t)512 * 64;
struct SchedCmp : pg8::TileOrder {
    const char* B;
    __device__ __forceinline__ unsigned arow(const Unit& u, int r) const { const int R = u.pm * 256 + r, n = R & 511, g = (R >> 9) & 1, b = (R >> 10) & 3, sr = R >> 12;
        return (unsigned)(((size_t)(b * SEQ + 16 * n) * NU + (sr ? C_VC : C_KC) + g * 64) * 2); }
    __device__ __forceinline__ size_t abase(const Unit&, int) const { return 0; }
    __device__ __forceinline__ const char* bbase(const Unit& u) const { return B + (size_t)(u.pm >> 4) * (256 * 2048 * 2); }
};
struct EpiCmp {
    static constexpr bool PERM = true;
    bf16* G; const float* bias;
    __device__ __forceinline__ void operator()(const f32x4 (&acc)[2][2][4][2], const Unit& u, int wr, int wc, int fr, int fq) const {
        const int row0 = u.pm * 256 + wr * 64 + fr, c8 = wc * 32 + 8 * fq; const float* bp = bias + (u.pm >> 4) * 128 + c8;
        const f32x4 b0 = *(const GAS f32x4*)bp, b1 = *(const GAS f32x4*)(bp + 4);
#pragma unroll
        for (int ai = 0; ai < 2; ++ai)
#pragma unroll
            for (int m = 0; m < 4; ++m) { const f32x4 v0 = acc[ai][0][m][0] + b0, v1 = acc[ai][0][m][1] + b1;
                *(v4u*)(G + (size_t)(row0 + ai * 128 + m * 16) * 128 + c8) = (v4u){pg8::cvt_pk_bf16(gelu_tanh(v0[0]), gelu_tanh(v0[1])), pg8::cvt_pk_bf16(gelu_tanh(v0[2]), gelu_tanh(v0[3])),
                                                                                      pg8::cvt_pk_bf16(gelu_tanh(v1[0]), gelu_tanh(v1[1])), pg8::cvt_pk_bf16(gelu_tanh(v1[2]), gelu_tanh(v1[3]))}; }
    }
};
__device__ __forceinline__ void p_cmp2(Frame& F, const float* w2) {
    phase_begin(F);
    const bf16* G = (const bf16*)(F.ws + WS_G1C); bf16* KC = (bf16*)(F.ws + WS_KC);
    for (int e = F.vcu * NTHR + F.tid; e < 8192 * 64; e += F.G * NTHR) { const int R = e >> 6, d = e & 63, sr = R >> 12; float a = 0.f;
        const GAS v4u* gr = (const GAS v4u*)(G + (size_t)R * 128); const float* w = w2 + (size_t)sr * 128 * 64 + d;
        for (int j8 = 0; j8 < 16; ++j8) { const v4u g = gr[j8];
            a += bflo(g.x) * w[(8 * j8 + 0) * 64] + bfhi(g.x) * w[(8 * j8 + 1) * 64] + bflo(g.y) * w[(8 * j8 + 2) * 64] + bfhi(g.y) * w[(8 * j8 + 3) * 64]
               + bflo(g.z) * w[(8 * j8 + 4) * 64] + bfhi(g.z) * w[(8 * j8 + 5) * 64] + bflo(g.w) * w[(8 * j8 + 6) * 64] + bfhi(g.w) * w[(8 * j8 + 7) * 64]; }
        KC[e] = (bf16)(((R & 511) == 511) ? 0u : f2bf(a)); }
}
__device__ __forceinline__ void p_cmp_bias(Frame& F, const float* cpos, const float* w1) {
    phase_begin(F);
    float* bias = (float*)(F.ws + WS_MISC + MS_CBIAS);
    LAS float* red = (LAS float*)F.lds;
    __syncthreads();
    for (int e = F.vcu; e < DEPTH * 2 * 128; e += F.G) { const int ls = e >> 7, j = e & 127; float a = 0.f;
#pragma unroll
        for (int i = 0; i < 2048 / NTHR; ++i) { const int k = F.tid + i * NTHR; a += cpos[(size_t)ls * 2048 + k] * w1[((size_t)ls * 2048 + k) * 128 + j]; }
        a = wave_sum(a);
        if (F.lane == 0) red[F.wave] = a;
        __syncthreads();
        if (F.tid == 0) bias[e] = ((red[0] + red[1]) + (red[2] + red[3])) + ((red[4] + red[5]) + (red[6] + red[7]));
        __syncthreads(); }
}
__device__ __forceinline__ float gate_of(const bf16* U, const float* gb, size_t row, int h, int br) { return sigmoidf_(bf2f(U[row * NU + C_GN + h * 3 + br]) + gb[h * 3 + br]); }

constexpr int KALL_OFF = 36864;
__device__ __forceinline__ void nsa_a_unit(Frame& F, int u, const float* gb) {
    typedef AttnLds<64> L;
    const bf16* U = (const bf16*)(F.ws + WS_U); bf16* OC = (bf16*)(F.ws + WS_OC); unsigned* MASK = (unsigned*)(F.ws + WS_MASK);
    const int r32 = F.lane & 31, hi = F.lane >> 5;
    const int qb = 31 - (u >> 3), bg = u & 7, b = bg >> 1, g = bg & 1;
    const int qpos0w = qb * 256 + F.wave * 32, qpos = qpos0w + r32; const size_t row = (size_t)b * SEQ + qpos;
    const int nmax = (qb * 256 + 255 - 31) >> 4;
    const int jhi = nmax >> 6;
    SrcCmp src{(const bf16*)(F.ws + WS_KC) + (size_t)(b * 2 + g) * KC_HEAD, (const bf16*)(F.ws + WS_KC) + (size_t)(8 + b * 2 + g) * KC_HEAD, (unsigned)(WS_KC + (size_t)(b * 2 + g) * KC_HEAD * 2), (unsigned)(WS_KC + (size_t)(8 + b * 2 + g) * KC_HEAD * 2)};
    { const int kkey = F.tid >> 3, kc = F.tid & 7;
#pragma unroll
      for (int j = 0; j < 8; ++j) if (j <= jhi) *(LAS v4u*)(F.lds + KALL_OFF + j * L::KBYTES + kkey * (L::KP * 2) + kc * 16) = *(const GAS v4u*)src.kp(j * 64 + kkey, kc); }
    float m0 = 0.f, m1 = 0.f, m2 = 0.f, l0 = 0.f, l1 = 0.f, l2 = 0.f;
#pragma unroll 1
    for (int p = 0; p < 3; ++p) { const int h = g * 3 + p;
        bf16x8 qf[4];
#pragma unroll
        for (int ks = 0; ks < 4; ++ks) qf[ks] = *(const GAS bf16x8*)(U + row * NU + C_QN + h * 64 + ks * 16 + hi * 8);
        f32x16 o[2]; float mh, lh;
        attn_branch<64, AM_CMP, 1>(F, F.lds, src, qf, qpos0w, 0, jhi, (v4u){0u, 0u, 0u, 0u}, o, mh, lh);
        if (p == 0) { m0 = mh; l0 = lh; } else if (p == 1) { m1 = mh; l1 = lh; } else { m2 = mh; l2 = lh; }
        const float gt = gate_of(U, gb, row, h, 0);
        bf16* orow = OC + row * 384 + h * 64;
#pragma unroll
        for (int db = 0; db < 2; ++db)
#pragma unroll
            for (int a = 0; a < 4; ++a) *(GAS v2u*)(orow + 32 * db + 8 * a + 4 * hi) = (v2u){pg8::cvt_pk_bf16(o[db][4 * a] * gt, o[db][4 * a + 1] * gt), pg8::cvt_pk_bf16(o[db][4 * a + 2] * gt, o[db][4 * a + 3] * gt)};
    }
    float imp[64];
#pragma unroll
    for (int k = 0; k < 64; ++k) imp[k] = 0.f;
#pragma unroll 1
    for (int p = 0; p < 3; ++p) { const int h = g * 3 + p;
        bf16x8 qf[4];
#pragma unroll
        for (int ks = 0; ks < 4; ++ks) qf[ks] = *(const GAS bf16x8*)(U + row * NU + C_QN + h * 64 + ks * 16 + hi * 8);
        const float mh = (p == 0) ? m0 : (p == 1) ? m1 : m2, lh = (p == 0) ? l0 : (p == 1) ? l1 : l2;
        const float il = (lh > 0.f) ? 1.0f / lh : 0.f; float carryE = 0.f;
        int qp2 = qpos; asm volatile("" : "+v"(qp2));
#pragma unroll 1
        for (int j = 0; j <= jhi; ++j) {
            const int kb = j * 64; const LAS unsigned char* kb_l = F.lds + KALL_OFF + j * L::KBYTES;
            f32x16 p0 = f32x16{}, p1 = f32x16{};
#pragma unroll
            for (int ks = 0; ks < 4; ++ks) {
                const bf16x8 k0 = *(const LAS bf16x8*)(kb_l + r32 * (L::KP * 2) + ks * 32 + hi * 16);
                const bf16x8 k1 = *(const LAS bf16x8*)(kb_l + (32 + r32) * (L::KP * 2) + ks * 32 + hi * 16);
                p0 = __builtin_amdgcn_mfma_f32_32x32x16_bf16(k0, qf[ks], p0, 0, 0, 0); p1 = __builtin_amdgcn_mfma_f32_32x32x16_bf16(k1, qf[ks], p1, 0, 0, 0); }
#pragma unroll
            for (int r = 0; r < 16; ++r) { const int ka = kb + crow(r, hi), kbb = ka + 32;
                const bool v0 = (16 * ka + 31 <= qp2) && ka <= 510, v1 = (16 * kbb + 31 <= qp2) && kbb <= 510;
                p0[r] = v0 ? __builtin_amdgcn_exp2f(p0[r] - mh) * il : 0.f; p1[r] = v1 ? __builtin_amdgcn_exp2f(p1[r] - mh) * il : 0.f; }
            float E0[4], E1[4], add[8];
#pragma unroll
            for (int a = 0; a < 4; ++a) { E0[a] = xor_f<32>(p0[4 * a + 3]); E1[a] = xor_f<32>(p1[4 * a + 3]); }
#pragma unroll
            for (int a = 0; a < 4; ++a) {
                const float e0 = hi ? E0[a] : (a > 0 ? E0[a > 0 ? a - 1 : 0] : carryE), e1 = hi ? E1[a] : (a > 0 ? E1[a > 0 ? a - 1 : 0] : E0[3]);
                add[a] = ((p0[4 * a] + p0[4 * a + 1]) + (p0[4 * a + 2] + p0[4 * a + 3])) + e0;
                add[4 + a] = ((p1[4 * a] + p1[4 * a + 1]) + (p1[4 * a + 2] + p1[4 * a + 3])) + e1; }
            carryE = E1[3];
#define IMP_ADD(J) if (j == (J)) { _Pragma("unroll") for (int i = 0; i < 8; ++i) imp[8 * (J) + i] += add[i]; }
            IMP_ADD(0) else IMP_ADD(1) else IMP_ADD(2) else IMP_ADD(3) else IMP_ADD(4) else IMP_ADD(5) else IMP_ADD(6) else IMP_ADD(7)
#undef IMP_ADD
        }
    }
    __syncthreads();
    {
        const int curb = qpos >> 6; unsigned mk0 = 0u, mk1 = 0u, mk2 = 0u, mk3 = 0u;
        LAS float* iv = (LAS float*)(F.lds + F.wave * 16384) + F.lane;
#pragma unroll
        for (int k = 0; k < 64; ++k) { const int sblk = 16 * (k >> 3) + 8 * ((k >> 2) & 1) + 2 * (k & 3) + hi; iv[k * 64] = (sblk == 0 || sblk >= curb) ? -2.0f : imp[k]; }
#define MK_SET(sv) do { const int s_ = (sv); const unsigned bit_ = 1u << (s_ & 31); const int w_ = s_ >> 5; mk0 |= (w_ == 0) ? bit_ : 0u; mk1 |= (w_ == 1) ? bit_ : 0u; mk2 |= (w_ == 2) ? bit_ : 0u; mk3 |= (w_ == 3) ? bit_ : 0u; } while (0)
        if (!__all(curb < 16)) {
#pragma unroll 1
            for (int rnd = 0; rnd < 14; ++rnd) {
                float best = -1.0f; int bk = 0;
#pragma unroll 8
                for (int k = 0; k < 64; ++k) { const float v = iv[k * 64]; if (v > best) { best = v; bk = k; } }
                const int bs = 16 * (bk >> 3) + 8 * ((bk >> 2) & 1) + 2 * (bk & 3) + hi;
                const float ob = xor_f<32>(best); const int os = (int)xor_u<32>((unsigned)bs);
                const bool win = (best > ob) || (best == ob && bs < os);
                if (win && best >= 0.f) { iv[bk * 64] = -2.0f; MK_SET(bs); }
            }
            MK_SET(0); MK_SET(curb);
        }
        if (curb < 16) { mk0 = (2u << curb) - 1u; mk1 = 0u; mk2 = 0u; mk3 = 0u; }
        mk0 |= xor_u<32>(mk0); mk1 |= xor_u<32>(mk1); mk2 |= xor_u<32>(mk2); mk3 |= xor_u<32>(mk3);
#undef MK_SET
        if (hi == 0) *(GAS v4u*)(MASK + ((size_t)(b * 2 + g) * SEQ + qpos) * 4) = (v4u){mk0, mk1, mk2, mk3};
    }
    __syncthreads();
}
template <int VAR>
__device__ __forceinline__ void nsa_b_unit(Frame& F, int u, const float* gb) {
    const bf16* U = (const bf16*)(F.ws + WS_U); bf16* CAT = (bf16*)(F.ws + WS_CAT); const unsigned* MASK = (const unsigned*)(F.ws + WS_MASK);
    const int r32 = F.lane & 31, hi = F.lane >> 5;
    const int qb = 31 - u / 24, bh = u % 24, b = bh / 6, h = bh % 6, g = h / 3;
    const int qpos0w = qb * 256 + F.wave * 32, qpos = qpos0w + r32; const size_t row = (size_t)b * SEQ + qpos;
    bf16x8 qf[4];
#pragma unroll
    for (int ks = 0; ks < 4; ++ks) qf[ks] = *(const GAS bf16x8*)(U + row * NU + C_QN + h * 64 + ks * 16 + hi * 8);
    const v4u sm = *(const GAS v4u*)(MASK + ((size_t)(b * 2 + g) * SEQ + qpos) * 4);
    f32x16 o[2], acc[2]; float m_, l_;
    { SrcU src{U, C_KS + g * 64, C_VS + g * 64, (size_t)b * SEQ};
      attn_branch<64, AM_SELECT, 2, VAR>(F, F.lds, src, qf, qpos0w, 0, qb * 4 + 3, sm, o, m_, l_); }
    { const float gt = gate_of(U, gb, row, h, 1);
#pragma unroll
      for (int r = 0; r < 16; ++r) { acc[0][r] = o[0][r] * gt; acc[1][r] = o[1][r] * gt; } }
    { SrcU src{U, C_KW + g * 64, C_VW + g * 64, (size_t)b * SEQ};
      const int jl = qb * 4 - 8 < 0 ? 0 : qb * 4 - 8;
      attn_branch<64, AM_WINDOW, 2, VAR>(F, F.lds, src, qf, qpos0w, jl, qb * 4 + 3, (v4u){0u, 0u, 0u, 0u}, o, m_, l_); }
    { const float gt = gate_of(U, gb, row, h, 2);
#pragma unroll
      for (int r = 0; r < 16; ++r) { acc[0][r] += o[0][r] * gt; acc[1][r] += o[1][r] * gt; } }
    bf16* orow = CAT + row * DM + 640 + h * 64; const bf16* crow_ = (const bf16*)(F.ws + WS_OC) + row * 384 + h * 64;
#pragma unroll
    for (int db = 0; db < 2; ++db)
#pragma unroll
        for (int a = 0; a < 4; ++a) { GAS v2u* p = (GAS v2u*)(orow + 32 * db + 8 * a + 4 * hi); const v2u c = *(const GAS v2u*)(crow_ + 32 * db + 8 * a + 4 * hi);
            *p = (v2u){pg8::cvt_pk_bf16(acc[db][4 * a] + bflo(c.x), acc[db][4 * a + 1] + bfhi(c.x)), pg8::cvt_pk_bf16(acc[db][4 * a + 2] + bflo(c.y), acc[db][4 * a + 3] + bfhi(c.y))}; }
}
namespace nb {
typedef __attribute__((address_space(3))) const char* lds_cptr;
typedef short v4i16_t __attribute__((ext_vector_type(4)));
constexpr int SLOTB = 8192, NSLOT = 3, LDS_K = 0, LDS_V = NSLOT * SLOTB, LDS_WS = 2 * NSLOT * SLOTB, LDS_OST = LDS_WS + 8 * 64 * 4, LDS_OST2 = LDS_OST + 8 * 4096, LDS_END = LDS_OST2 + 8 * 4096;
static_assert(LDS_END + 8192 <= RING_BYTES, "attention scratch must fit below the frame's control words");
constexpr int LDS_X = LDS_OST2;
constexpr float THRL = 8.0f;
#define NB_SBAR() __builtin_amdgcn_sched_barrier(0)
#define NB_WAIT_BAR(N) asm volatile("s_waitcnt vmcnt(" #N ") lgkmcnt(0)\n\ts_barrier" ::: "memory")
#define NB_PIN(x) asm volatile("" : "+v"(x))
#define NB_MX3(a, b, c) __builtin_fmaxf(__builtin_fmaxf((a), (b)), (c))
__device__ __forceinline__ void glds16(const void* gbase, unsigned voff, unsigned lds_dst) { unsigned keep;
    asm volatile("s_mov_b32 %0, m0\n\ts_mov_b32 m0, %2\n\ts_nop 0\n\tglobal_load_lds_dwordx4 %1, %3\n\ts_mov_b32 m0, %0" : "=&s"(keep) : "v"(voff), "s"(lds_dst), "s"(gbase) : "memory"); }
__device__ __forceinline__ int fresh_lane() { int z_ = 0; asm volatile("" : "+v"(z_)); return (int)__builtin_amdgcn_mbcnt_hi(~0u, __builtin_amdgcn_mbcnt_lo(~0u, z_)); }
typedef float f32x2_t __attribute__((ext_vector_type(2))); typedef __bf16 bf16x2_t __attribute__((ext_vector_type(2)));
__device__ __forceinline__ unsigned cvtpk_s(float lo, float hi) { f32x2_t v = {lo, hi}; bf16x2_t b = __builtin_convertvector(v, bf16x2_t); return __builtin_bit_cast(unsigned, b); }
__device__ __forceinline__ void kload2(bf16x8* kf, lds_cptr kp, int j) { kf[2 * j] = *(const __attribute__((address_space(3))) bf16x8*)(kp + j * 2048); kf[2 * j + 1] = *(const __attribute__((address_space(3))) bf16x8*)(kp + j * 2048 + 512); }
__device__ __forceinline__ s16x4 vtr(lds_cptr p) { return __builtin_bit_cast(s16x4, __builtin_amdgcn_ds_read_tr16_b64_v4i16((__attribute__((address_space(3))) v4i16_t*)p)); }
__device__ __forceinline__ float rowmax(const f32x16& p0, const f32x16& p1) {
    float a = NB_MX3(p0[0], p0[1], p1[0]), b = NB_MX3(p0[2], p0[3], p1[1]); a = NB_MX3(a, p1[2], p1[3]);
#pragma unroll
    for (int r = 4; r < 16; r += 4) { a = NB_MX3(a, p0[r], p0[r + 1]); b = NB_MX3(b, p0[r + 2], p0[r + 3]); a = NB_MX3(a, p1[r], p1[r + 1]); b = NB_MX3(b, p1[r + 2], p1[r + 3]); }
    float m = __builtin_fmaxf(a, b); auto rr = __builtin_amdgcn_permlane32_swap(__float_as_uint(m), __float_as_uint(m), false, false);
    return __builtin_fmaxf(__uint_as_float(rr[0]), __uint_as_float(rr[1])); }
__device__ __forceinline__ void cmask(f32x16& p0, f32x16& p1, int jb, int qrel, int hi) {
    const int kb = 64 * jb + 4 * hi;
#pragma unroll
    for (int r = 0; r < 16; ++r) { const int kv = kb + (r & 3) + 8 * (r >> 2); if (kv > qrel) p0[r] = -INFINITY; if (kv + 32 > qrel) p1[r] = -INFINITY; } }
__device__ __forceinline__ void lmask(f32x16& p0, f32x16& p1, int t, int qrel, int hi) {
    const int kb = 64 * t + 4 * hi;
#pragma unroll
    for (int r = 0; r < 16; ++r) { const int kv = kb + (r & 3) + 8 * (r >> 2); if (kv <= qrel) p0[r] = -INFINITY; if (kv + 32 <= qrel) p1[r] = -INFINITY; } }

template <int MODE, int QP, int KP, int VP, int KX, int XP>
__device__ __forceinline__ void branch(int wid, const bf16* Qw, const bf16* K0, const bf16* V0, const bf16* X0, int NT, bool lowm, const v4u sm, char* shm, int ost) {
    const int lane = fresh_lane();
    const int r32 = lane & 31, hi = lane >> 5;
    const unsigned lds0 = (unsigned)(uintptr_t)shm;
    float* wsf = (float*)(shm + LDS_WS) + wid * 64;
    const unsigned koff = (unsigned)(lane * KP + wid * 8) * 2u;
    const unsigned voff = (unsigned)((16 * (wid & 3) + (lane >> 2)) * VP + (wid >> 2) * 32 + (lane & 3) * 8) * 2u;
    const unsigned xoff = (unsigned)(lane * XP + (wid & 3) * 8) * 2u;
    const unsigned kdst = lds0 + LDS_K + wid * 1024, vdst = lds0 + LDS_V + wid * 1024, xdst = lds0 + LDS_X + (wid & 3) * 1024;
#define DMA_K(t, slot) glds16(K0 + (long)(t) * 64 * KP, koff, (unsigned)__builtin_amdgcn_readfirstlane(kdst + (slot)))
#define DMA_V(t, slot) glds16(V0 + (long)(t) * 64 * VP, voff, (unsigned)__builtin_amdgcn_readfirstlane(vdst + (slot)))
#define DMA_X(t) do { if (KX) glds16(X0 + (long)(t) * 64 * XP, xoff, (unsigned)__builtin_amdgcn_readfirstlane(xdst + (((t) & 3) * 4096))); } while (0)
    LAS unsigned* smw = (LAS unsigned*)((LAS unsigned char*)(lds_cptr)shm + LDS_END) + (wid * 64 + lane) * 4;
    unsigned cw = sm.x;
    if (MODE == AM_SELECT) *(LAS v4u*)smw = sm;
#define SELB(t) ((MODE != AM_SELECT) || ((cw >> ((t) & 31)) & 1u))
#define SELNEXT(t) do { if (MODE == AM_SELECT) { if ((((t) + 1) & 31) == 0) cw = smw[(((t) + 1) >> 5) & 3]; } } while (0)
    const lds_cptr shm3 = (lds_cptr)shm; const lds_cptr kp0 = shm3 + LDS_K + hi * 1024 + r32 * 16; const lds_cptr xp0 = shm3 + LDS_X + hi * 1024 + r32 * 16;
    const lds_cptr vp0 = shm3 + LDS_V + ((lane >> 4) & 1) * 32 + (lane & 3) * 8 + (4 * hi + ((lane & 15) >> 2)) * 64;
    bf16x8 kf[8];
    DMA_K(0, 0); DMA_X(0); DMA_V(0, 0); DMA_K(1, SLOTB); DMA_X(1);
    bf16x8 qr[4], qx[KX ? KX : 1];
#pragma unroll
    for (int d0 = 0; d0 < 4; ++d0) qr[d0] = *reinterpret_cast<const bf16x8*>(&Qw[(long)r32 * QP + d0 * 16 + hi * 8]);
#pragma unroll
    for (int d0 = 0; d0 < KX; ++d0) qx[d0] = *reinterpret_cast<const bf16x8*>(&Qw[(long)r32 * QP + 64 + d0 * 16 + hi * 8]);
    float mhat = 0.f, l_reg = 0.f; f32x16 o[2]; o[0] = f32x16{}; o[1] = f32x16{};
    f32x16 cin = f32x16{}; NB_PIN(cin);
#define CMASK(P0, P1, t, BAND) do { if (BAND) { const int jb_ = (t) - (NT - 4); if (jb_ >= 0) { const int ln_ = fresh_lane(); cmask(P0, P1, jb_, wid * 32 + (ln_ & 31), ln_ >> 5); } } \
        if (MODE == AM_WINDOW) { if (lowm && (t) <= 3) { const int ln_ = fresh_lane(); lmask(P0, P1, (t), wid * 32 + (ln_ & 31), ln_ >> 5); } } } while (0)
    bool resc = false;
#define RESC() do { if (resc) { asm volatile("s_waitcnt lgkmcnt(0)" ::: "memory"); const int hi_ = fresh_lane() >> 5; \
        _Pragma("unroll") for (int d_ = 0; d_ < 2; ++d_) _Pragma("unroll") for (int r = 0; r < 16; ++r) o[d_][r] *= wsf[crow(r, hi_)]; } } while (0)
    f32x16 pA0, pA1, pB0, pB1;
    int sl_prev = 0, sl_cur = 0, sl_next = SLOTB;
#define ROT() do { sl_prev = sl_cur; sl_cur = sl_next; sl_next = (sl_next == (NSLOT - 1) * SLOTB) ? 0 : sl_next + SLOTB; } while (0)
    DMA_K(2, 2 * SLOTB); DMA_X(2);
    if (KX) { NB_WAIT_BAR(5); } else { NB_WAIT_BAR(3); }
    { _Pragma("unroll") for (int d0 = 0; d0 < 4; ++d0) kload2(kf, kp0, d0);
      pA0 = __builtin_amdgcn_mfma_f32_32x32x16_bf16(kf[0], qr[0], cin, 0, 0, 0); pA1 = __builtin_amdgcn_mfma_f32_32x32x16_bf16(kf[1], qr[0], cin, 0, 0, 0);
      _Pragma("unroll") for (int d0 = 1; d0 < 4; ++d0) { pA0 = __builtin_amdgcn_mfma_f32_32x32x16_bf16(kf[2 * d0], qr[d0], pA0, 0, 0, 0); pA1 = __builtin_amdgcn_mfma_f32_32x32x16_bf16(kf[2 * d0 + 1], qr[d0], pA1, 0, 0, 0); }
      _Pragma("unroll") for (int d0 = 0; d0 < KX; ++d0) { const bf16x8 x0 = *(const __attribute__((address_space(3))) bf16x8*)(xp0 + d0 * 2048), x1 = *(const __attribute__((address_space(3))) bf16x8*)(xp0 + d0 * 2048 + 512);
          pA0 = __builtin_amdgcn_mfma_f32_32x32x16_bf16(x0, qx[d0], pA0, 0, 0, 0); pA1 = __builtin_amdgcn_mfma_f32_32x32x16_bf16(x1, qx[d0], pA1, 0, 0, 0); } }
    CMASK(pA0, pA1, 0, true);
    if (!SELB(0)) { _Pragma("unroll") for (int r = 0; r < 16; ++r) { pA0[r] = -INFINITY; pA1[r] = -INFINITY; } }
    { const float rm = rowmax(pA0, pA1); const float dl = (rm > -1.0e30f) ? rm : 0.f; mhat = dl;
#pragma unroll
      for (int r = 0; r < 16; ++r) { pA0[r] = __builtin_amdgcn_exp2f(pA0[r] - dl); pA1[r] = __builtin_amdgcn_exp2f(pA1[r] - dl); } }
    { const float cv0 = SELB(1) ? -mhat : -INFINITY;
#pragma unroll
      for (int r = 0; r < 16; ++r) cin[r] = cv0;
      NB_PIN(cin); }
    NB_WAIT_BAR(0);
    DMA_K(3, 0); DMA_X(3); DMA_V(1, SLOTB);
    ROT();
    { _Pragma("unroll") for (int d0 = 0; d0 < 4; ++d0) kload2(kf, kp0 + sl_cur, d0); }
    if (KX) { NB_WAIT_BAR(3); } else { NB_WAIT_BAR(2); }
    s16x4 vlo[8], vhi[8]; v4u pw0, pw1, pw2, pw3;
#define PKW(P, B) cvtpk_s(P[B], P[B + 1])
#define PAF(k) __builtin_bit_cast(bf16x8, pw##k)
#define VFR(i) (bf16x8){vlo[i][0], vlo[i][1], vlo[i][2], vlo[i][3], vhi[i][0], vhi[i][1], vhi[i][2], vhi[i][3]}
#define GAPA(MF, A0, A1, A2, A3, W0, W1, PW) do { MF; sacc += A0; sacc += A1; sacc += A2; sacc += A3; NB_PIN(sacc); W0; W1; NB_PIN(PW); NB_SBAR(); } while (0)
#define EX(v) __builtin_amdgcn_exp2f(v)
#define GAPB(MF, X, B, CI) do { MF; X[B] = EX(X[B]); X[B + 1] = EX(X[B + 1]); X[B + 2] = EX(X[B + 2]); X[B + 3] = EX(X[B + 3]); if (MODE == AM_SELECT) { cin[CI] = cv_; cin[CI + 1] = cv_; NB_PIN(cin); } NB_PIN(X); NB_SBAR(); } while (0)
#define VRD(i) do { vlo[i] = vtr(vp_ + (((i) >> 2) * 4096 + ((i) & 3) * 1024)); vhi[i] = vtr(vp_ + (((i) >> 2) * 4096 + ((i) & 3) * 1024 + 512)); } while (0)
#define KRD(G, j) do { if (G) { kload2(kf, kp0 + sl_next, j); NB_SBAR(); } } while (0)
#define STEP(C0, C1, P0, P1, t, GK, GV, GL, BAND) do { NB_SBAR(); \
    const lds_cptr vp_ = vp0 + sl_prev; \
    VRD(0); NB_SBAR(); float sacc = (P0[0] + P0[1]); \
    GAPA(C0 = __builtin_amdgcn_mfma_f32_32x32x16_bf16(kf[0], qr[0], cin, 0, 0, 0), P0[2], P0[3], P0[4], P0[5],     pw0[0] = PKW(P0, 0), pw0[1] = PKW(P0, 2), pw0); \
    VRD(4); NB_SBAR(); GAPA(C1 = __builtin_amdgcn_mfma_f32_32x32x16_bf16(kf[1], qr[0], cin, 0, 0, 0), P0[6], P0[7], P0[8], P0[9],     pw0[2] = PKW(P0, 4), pw0[3] = PKW(P0, 6), pw0); \
    VRD(1); NB_SBAR(); GAPA(C0 = __builtin_amdgcn_mfma_f32_32x32x16_bf16(kf[2], qr[1], C0, 0, 0, 0),  P0[10], P0[11], P0[12], P0[13], pw1[0] = PKW(P0, 8), pw1[1] = PKW(P0, 10), pw1); \
    VRD(5); NB_SBAR(); GAPA(C1 = __builtin_amdgcn_mfma_f32_32x32x16_bf16(kf[3], qr[1], C1, 0, 0, 0),  P0[14], P0[15], P1[0], P1[1],   pw1[2] = PKW(P0, 12), pw1[3] = PKW(P0, 14), pw1); \
    bf16x8 kx0_, kx1_, kx2_, kx3_; \
    if (KX) { const lds_cptr xp_ = xp0 + (((t) & 3) * 4096); kx0_ = *(const __attribute__((address_space(3))) bf16x8*)(xp_); kx1_ = *(const __attribute__((address_space(3))) bf16x8*)(xp_ + 512); NB_SBAR(); } \
    VRD(2); NB_SBAR(); GAPA(C0 = __builtin_amdgcn_mfma_f32_32x32x16_bf16(kf[4], qr[2], C0, 0, 0, 0),  P1[2], P1[3], P1[4], P1[5],     pw2[0] = PKW(P1, 0), pw2[1] = PKW(P1, 2), pw2); \
    VRD(6); NB_SBAR(); GAPA(C1 = __builtin_amdgcn_mfma_f32_32x32x16_bf16(kf[5], qr[2], C1, 0, 0, 0),  P1[6], P1[7], P1[8], P1[9],     pw2[2] = PKW(P1, 4), pw2[3] = PKW(P1, 6), pw2); \
    if (KX > 1) { const lds_cptr xp_ = xp0 + (((t) & 3) * 4096); kx2_ = *(const __attribute__((address_space(3))) bf16x8*)(xp_ + 2048); kx3_ = *(const __attribute__((address_space(3))) bf16x8*)(xp_ + 2560); NB_SBAR(); } \
    VRD(3); NB_SBAR(); GAPA(C0 = __builtin_amdgcn_mfma_f32_32x32x16_bf16(kf[6], qr[3], C0, 0, 0, 0),  P1[10], P1[11], P1[12], P1[13], pw3[0] = PKW(P1, 8), pw3[1] = PKW(P1, 10), pw3); \
    VRD(7); NB_SBAR(); GAPA(C1 = __builtin_amdgcn_mfma_f32_32x32x16_bf16(kf[7], qr[3], C1, 0, 0, 0),  P1[14], P1[15], 0.f, 0.f,       pw3[2] = PKW(P1, 12), pw3[3] = PKW(P1, 14), pw3); \
    if (KX) { C0 = __builtin_amdgcn_mfma_f32_32x32x16_bf16(kx0_, qx[0], C0, 0, 0, 0); NB_SBAR(); C1 = __builtin_amdgcn_mfma_f32_32x32x16_bf16(kx1_, qx[0], C1, 0, 0, 0); NB_SBAR(); } \
    if (KX > 1) { C0 = __builtin_amdgcn_mfma_f32_32x32x16_bf16(kx2_, qx[KX > 1 ? 1 : 0], C0, 0, 0, 0); NB_SBAR(); C1 = __builtin_amdgcn_mfma_f32_32x32x16_bf16(kx3_, qx[KX > 1 ? 1 : 0], C1, 0, 0, 0); NB_SBAR(); } \
    l_reg += sacc; \
    if (GK) { DMA_K((t) + 3, sl_cur); DMA_X((t) + 3); } if (GV) { DMA_V((t) + 1, sl_next); } \
    CMASK(C0, C1, t, BAND); \
    { float a = NB_MX3(C0[0], C0[1], C1[0]), b = NB_MX3(C0[2], C0[3], C1[1]); a = NB_MX3(a, C1[2], C1[3]); \
      _Pragma("unroll") for (int r = 4; r < 16; r += 4) { a = NB_MX3(a, C0[r], C0[r + 1]); b = NB_MX3(b, C0[r + 2], C0[r + 3]); a = NB_MX3(a, C1[r], C1[r + 1]); b = NB_MX3(b, C1[r + 2], C1[r + 3]); } \
      float rm = __builtin_fmaxf(a, b); { auto rr = __builtin_amdgcn_permlane32_swap(__float_as_uint(rm), __float_as_uint(rm), false, false); rm = __builtin_fmaxf(__uint_as_float(rr[0]), __uint_as_float(rr[1])); } \
      resc = false; \
      if (__builtin_expect(__any(rm > THRL), 0)) { const float dl = __builtin_fmaxf(rm, 0.f); mhat += dl; \
        _Pragma("unroll") for (int r = 0; r < 16; ++r) { C0[r] -= dl; C1[r] -= dl; } \
        if (MODE != AM_SELECT) { _Pragma("unroll") for (int r = 0; r < 16; ++r) cin[r] = -mhat; NB_PIN(cin); }        \
        const float f = __builtin_amdgcn_exp2f(-dl); l_reg *= f; { const int ln_ = fresh_lane(); if (ln_ < 32) wsf[ln_] = f; } resc = true; } } \
    SELNEXT(t); const float cv_ = SELB((t) + 1) ? -mhat : -INFINITY; \
    NB_SBAR(); \
    GAPB(o[0] = __builtin_amdgcn_mfma_f32_32x32x16_bf16(PAF(0), VFR(0), o[0], 0, 0, 0), C0, 0, 0); \
    GAPB(o[1] = __builtin_amdgcn_mfma_f32_32x32x16_bf16(PAF(0), VFR(4), o[1], 0, 0, 0), C0, 4, 2); \
    KRD(GL, 0); GAPB(o[0] = __builtin_amdgcn_mfma_f32_32x32x16_bf16(PAF(1), VFR(1), o[0], 0, 0, 0), C0, 8, 4); \
    KRD(GL, 1); GAPB(o[1] = __builtin_amdgcn_mfma_f32_32x32x16_bf16(PAF(1), VFR(5), o[1], 0, 0, 0), C0, 12, 6); \
    KRD(GL, 2); GAPB(o[0] = __builtin_amdgcn_mfma_f32_32x32x16_bf16(PAF(2), VFR(2), o[0], 0, 0, 0), C1, 0, 8); \
    KRD(GL, 3); GAPB(o[1] = __builtin_amdgcn_mfma_f32_32x32x16_bf16(PAF(2), VFR(6), o[1], 0, 0, 0), C1, 4, 10); \
    GAPB(o[0] = __builtin_amdgcn_mfma_f32_32x32x16_bf16(PAF(3), VFR(3), o[0], 0, 0, 0), C1, 8, 12); \
    GAPB(o[1] = __builtin_amdgcn_mfma_f32_32x32x16_bf16(PAF(3), VFR(7), o[1], 0, 0, 0), C1, 12, 14); \
    } while (0)
#define WAIT_FULL() do { if (KX) { NB_WAIT_BAR(3); } else { NB_WAIT_BAR(2); } } while (0)
    int t = 1;
    for (; t + 5 < NT; t += 2) {
        STEP(pB0, pB1, pA0, pA1, t, true, true, true, false);       WAIT_FULL(); RESC(); ROT();
        STEP(pA0, pA1, pB0, pB1, t + 1, true, true, true, false);   WAIT_FULL(); RESC(); ROT();
    }
#define ENDW(tt) do { if ((tt) + 3 < NT) { WAIT_FULL(); } else if ((tt) + 2 < NT) { NB_WAIT_BAR(1); } else { NB_WAIT_BAR(0); } } while (0)
    for (; t + 1 < NT; t += 2) {
        STEP(pB0, pB1, pA0, pA1, t, (t + 3 < NT), (t + 1 < NT), (t + 1 < NT), true);         ENDW(t);     RESC(); ROT();
        STEP(pA0, pA1, pB0, pB1, t + 1, (t + 4 < NT), (t + 2 < NT), (t + 2 < NT), true);     ENDW(t + 1); RESC(); ROT();
    }
    STEP(pB0, pB1, pA0, pA1, NT - 1, false, false, false, true); RESC();
    { float sacc = pB0[0] + pB0[1];
      _Pragma("unroll") for (int r = 2; r < 16; ++r) sacc += pB0[r];
      _Pragma("unroll") for (int r = 0; r < 16; ++r) sacc += pB1[r];
      l_reg += sacc;
      pw0 = (v4u){PKW(pB0, 0), PKW(pB0, 2), PKW(pB0, 4), PKW(pB0, 6)}; pw1 = (v4u){PKW(pB0, 8), PKW(pB0, 10), PKW(pB0, 12), PKW(pB0, 14)};
      pw2 = (v4u){PKW(pB1, 0), PKW(pB1, 2), PKW(pB1, 4), PKW(pB1, 6)}; pw3 = (v4u){PKW(pB1, 8), PKW(pB1, 10), PKW(pB1, 12), PKW(pB1, 14)};
      NB_SBAR();
      const lds_cptr vp_ = vp0 + sl_cur;
      _Pragma("unroll") for (int i = 0; i < 8; ++i) VRD(i);
      o[0] = __builtin_amdgcn_mfma_f32_32x32x16_bf16(PAF(0), VFR(0), o[0], 0, 0, 0); o[1] = __builtin_amdgcn_mfma_f32_32x32x16_bf16(PAF(0), VFR(4), o[1], 0, 0, 0);
      o[0] = __builtin_amdgcn_mfma_f32_32x32x16_bf16(PAF(1), VFR(1), o[0], 0, 0, 0); o[1] = __builtin_amdgcn_mfma_f32_32x32x16_bf16(PAF(1), VFR(5), o[1], 0, 0, 0);
      o[0] = __builtin_amdgcn_mfma_f32_32x32x16_bf16(PAF(2), VFR(2), o[0], 0, 0, 0); o[1] = __builtin_amdgcn_mfma_f32_32x32x16_bf16(PAF(2), VFR(6), o[1], 0, 0, 0);
      o[0] = __builtin_amdgcn_mfma_f32_32x32x16_bf16(PAF(3), VFR(3), o[0], 0, 0, 0); o[1] = __builtin_amdgcn_mfma_f32_32x32x16_bf16(PAF(3), VFR(7), o[1], 0, 0, 0); }
#undef PKW
#undef PAF
#undef VFR
#undef GAPA
#undef GAPB
#undef EX
#undef VRD
#undef KRD
#undef STEP
#undef ENDW
#undef WAIT_FULL
    { auto rr = __builtin_amdgcn_permlane32_swap(__float_as_uint(l_reg), __float_as_uint(l_reg), false, false); l_reg = __uint_as_float(rr[0]) + __uint_as_float(rr[1]); }
    const int lne = fresh_lane(), r32e = lne & 31, hie = lne >> 5;
    if (hie == 0) wsf[32 + r32e] = l_reg; asm volatile("s_waitcnt lgkmcnt(0)" ::: "memory");
    { bf16* stg = (bf16*)(shm + ost) + wid * 2048 + r32e;
#pragma unroll
      for (int r = 0; r < 16; ++r) { const int orow = crow(r, hie); const float lv = wsf[32 + orow]; const float rl = lv > 0.f ? __builtin_amdgcn_rcpf(lv) : 0.f;
#pragma unroll
          for (int d0 = 0; d0 < 2; ++d0) stg[orow * 64 + d0 * 32] = (bf16)f2bf(o[d0][r] * rl); } }
    asm volatile("s_waitcnt lgkmcnt(0)\n\ts_barrier" ::: "memory");
#undef DMA_K
#undef DMA_V
#undef DMA_X
#undef SELB
#undef SELNEXT
#undef CMASK
#undef RESC
#undef ROT
}
}

__device__ __forceinline__ void nsa_b_unit2(Frame& F, int u, const float* gb) {
    const bf16* U = (const bf16*)(F.ws + WS_U); bf16* CAT = (bf16*)(F.ws + WS_CAT); const unsigned* MASK = (const unsigned*)(F.ws + WS_MASK); const bf16* OC = (const bf16*)(F.ws + WS_OC);
    const int wid = F.wave; const int r32 = nb::fresh_lane() & 31;
    const int qb = 31 - u / 24, bh = u % 24, b = bh / 6, h = bh % 6, g = h / 3;
    const size_t rowbase = (size_t)b * SEQ; const int q0 = qb * 256, qpos0w = q0 + wid * 32;
    char* shm = (char*)F.lds;
    const bf16* Qw = U + (rowbase + qpos0w) * NU + C_QN + h * 64;
    const v4u sm = *(const GAS v4u*)(MASK + ((size_t)(b * 2 + g) * SEQ + qpos0w + r32) * 4);
    nb::branch<AM_SELECT, NU, NU, NU, 0, NU>(wid, Qw, U + rowbase * NU + C_KS + g * 64, U + rowbase * NU + C_VS + g * 64, U, 4 * qb + 4, false, sm, shm, nb::LDS_OST);
    { const int jl = qb >= 2 ? 4 * qb - 8 : 0; const int NT = 4 * qb + 4 - jl;
      nb::branch<AM_WINDOW, NU, NU, NU, 0, NU>(wid, Qw, U + (rowbase + (size_t)jl * 64) * NU + C_KW + g * 64, U + (rowbase + (size_t)jl * 64) * NU + C_VW + g * 64, U, NT, qb >= 2, (v4u){0u, 0u, 0u, 0u}, shm, nb::LDS_OST2); }
    const int lane2 = nb::fresh_lane();
    const LAS unsigned char* s1 = F.lds + nb::LDS_OST + wid * 4096; const LAS unsigned char* s2 = F.lds + nb::LDS_OST2 + wid * 4096;
#pragma unroll 1
    for (int i = 0; i < 4; ++i) { const int row = i * 8 + (lane2 >> 3), ch = lane2 & 7; const size_t grow = rowbase + qpos0w + row;
        const float gs = gate_of(U, gb, grow, h, 1), gw = gate_of(U, gb, grow, h, 2);
        const v4u a = *(const LAS v4u*)(s1 + row * 128 + ch * 16), w = *(const LAS v4u*)(s2 + row * 128 + ch * 16), c = *(const GAS v4u*)(OC + grow * 384 + h * 64 + ch * 8);
        v4u r_;
        r_.x = pg8::cvt_pk_bf16(gs * bflo(a.x) + gw * bflo(w.x) + bflo(c.x), gs * bfhi(a.x) + gw * bfhi(w.x) + bfhi(c.x));
        r_.y = pg8::cvt_pk_bf16(gs * bflo(a.y) + gw * bflo(w.y) + bflo(c.y), gs * bfhi(a.y) + gw * bfhi(w.y) + bfhi(c.y));
        r_.z = pg8::cvt_pk_bf16(gs * bflo(a.z) + gw * bflo(w.z) + bflo(c.z), gs * bfhi(a.z) + gw * bfhi(w.z) + bfhi(c.z));
        r_.w = pg8::cvt_pk_bf16(gs * bflo(a.w) + gw * bflo(w.w) + bflo(c.w), gs * bfhi(a.w) + gw * bfhi(w.w) + bfhi(c.w));
        *(GAS v4u*)(CAT + grow * DM + 640 + h * 64 + ch * 8) = r_; }
}
__device__ __forceinline__ void mla_unit2(Frame& F, int u) {
    const bf16* QM = (const bf16*)(F.ws + WS_QM); const bf16* KVM = (const bf16*)(F.ws + WS_KVM); const bf16* U = (const bf16*)(F.ws + WS_U); bf16* CAT = (bf16*)(F.ws + WS_CAT);
    const int wid = F.wave;
    const int qb = 31 - u / 24, bh = u % 24, b = bh / 6, h = bh % 6;
    const size_t rowbase = (size_t)b * SEQ; const int qpos0w = qb * 256 + wid * 32;
    nb::branch<AM_CAUSAL, 576, 768, 768, 2, NU>(wid, QM + (rowbase + qpos0w) * 576 + h * 96, KVM + rowbase * 768 + h * 128, KVM + rowbase * 768 + h * 128 + 64, U + rowbase * NU + C_KPE, 4 * qb + 4, false,
                                                (v4u){0u, 0u, 0u, 0u}, (char*)F.lds, nb::LDS_OST);
    const int lane2 = nb::fresh_lane();
    const LAS unsigned char* s1 = F.lds + nb::LDS_OST + wid * 4096;
#pragma unroll
    for (int i = 0; i < 4; ++i) { const int row = i * 8 + (lane2 >> 3), ch = lane2 & 7;
        *(GAS v4u*)(CAT + (rowbase + qpos0w + row) * DM + 256 + h * 64 + ch * 8) = *(const LAS v4u*)(s1 + row * 128 + ch * 16); }
}
__device__ __forceinline__ void mla_unit(Frame& F, int u) {
    const bf16* QM = (const bf16*)(F.ws + WS_QM); bf16* CAT = (bf16*)(F.ws + WS_CAT);
    const int r32 = F.lane & 31, hi = F.lane >> 5;
    const int qb = 31 - u / 24, bh = u % 24, b = bh / 6, h = bh % 6;
    const int qpos0w = qb * 256 + F.wave * 32; const size_t row = (size_t)b * SEQ + qpos0w + r32;
    bf16x8 qf[6];
#pragma unroll
    for (int ks = 0; ks < 6; ++ks) qf[ks] = *(const GAS bf16x8*)(QM + row * 576 + h * 96 + ks * 16 + hi * 8);
    SrcMla src{(const bf16*)(F.ws + WS_KVM), (const bf16*)(F.ws + WS_U), h, (size_t)b * SEQ};
    f32x16 o[2]; float m_, l_;
    attn_branch<96, AM_CAUSAL, 2>(F, F.lds, src, qf, qpos0w, 0, qb * 4 + 3, (v4u){0u, 0u, 0u, 0u}, o, m_, l_);
    bf16* orow = CAT + row * DM + 256 + h * 64;
#pragma unroll
    for (int db = 0; db < 2; ++db)
#pragma unroll
        for (int a = 0; a < 4; ++a) *(GAS v2u*)(orow + 32 * db + 8 * a + 4 * hi) = (v2u){pg8::cvt_pk_bf16(o[db][4 * a], o[db][4 * a + 1]), pg8::cvt_pk_bf16(o[db][4 * a + 2], o[db][4 * a + 3])};
}
__device__ __forceinline__ void p_attn1(Frame& F, int qid, const float* gb) {
    phase_begin(F);
    int dready = 0;
    unsigned tk = q_issue(F, qid);
    for (;;) {
        const int t = q_take(F, tk); if (t >= 1024) break; tk = q_issue(F, qid);
        if (t >= 576 && t < 832) {
            if (!dready) { count_await(F, CW_FLAG + 512 + (qid >> 1), (unsigned)F.G); dready = 1; phase_begin(F); }
            const int u = __builtin_amdgcn_readfirstlane(t - 576);
            nsa_a_unit(F, u, gb); unit_publish(F, CW_FLAG + (qid >> 1) * 256 + u);
        } else {
            mla_unit2(F, __builtin_amdgcn_readfirstlane(t < 576 ? t : t - 256));
        }
        phase_begin(F);
    }
    if (!dready) { phase_begin(F); count_await(F, CW_FLAG + 512 + (qid >> 1), (unsigned)F.G); }
}
template <int VAR>
__device__ __forceinline__ void p_attn2(Frame& F, int qid, const float* gb) {
    phase_begin(F);
    for (;;) { const int u = q_fetch(F, qid); if (u >= 768) break;
        { const int bh = u % 24, b = bh / 6, g = (bh % 6) / 3; unit_await(F, CW_FLAG + (qid >> 1) * 256 + (((u / 24) << 3) | (b * 2 + g))); }
        nsa_b_unit2(F, __builtin_amdgcn_readfirstlane(u), gb); phase_begin(F); }
}

struct EpiQKV {
    static constexpr bool PERM = true;
    bf16* QM; bf16* KVM; const float* ssq; const f32x2* tabm;
    __device__ __forceinline__ void operator()(const f32x4 (&acc)[2][2][4][2], const Unit& u, int wr, int wc, int fr, int fq) const {
        const int row0 = u.pm * 256 + wr * 64 + fr; const bool isq = u.pn < 3;
        float rs[8];
        { f32x4 s0[8], s1[8], s2[8];
#pragma unroll
          for (int i = 0; i < 8; ++i) { const GAS f32x4* sp = (const GAS f32x4*)((const GAS char*)ssq + (unsigned)(row0 + (i >> 2) * 128 + (i & 3) * 16) * 64u); s0[i] = sp[0]; s1[i] = sp[1]; s2[i] = sp[2]; }
#pragma unroll
          for (int i = 0; i < 8; ++i) rs[i] = isq ? QSCALE_M / sqrtf(((s0[i][0] + s0[i][1]) + (s0[i][2] + s0[i][3]) + (s1[i][0] + s1[i][1])) * (1.0f / 192.0f) + EPS)
                                                  : 1.0f / sqrtf(((s1[i][2] + s1[i][3]) + (s2[i][0] + s2[i][1])) * (1.0f / 128.0f) + EPS); }
        const bool isrope = isq && (((u.pn % 3) * 256 + wc * 32) % 96 == 64 || ((u.pn % 3) * 256 + 128 + wc * 32) % 96 == 64);
        f32x4 t0[8], t1[8];
        if (isrope) {
#pragma unroll
            for (int i = 0; i < 8; ++i) { const int pos = (row0 + (i >> 2) * 128 + (i & 3) * 16) & (SEQ - 1); const GAS f32x4* t = (const GAS f32x4*)((const GAS char*)tabm + (unsigned)(pos * 128 + 32 * fq)); t0[i] = t[0]; t1[i] = t[1]; } }
#pragma unroll
        for (int ai = 0; ai < 2; ++ai)
#pragma unroll
            for (int m = 0; m < 4; ++m) { const int row = row0 + ai * 128 + m * 16; const float r_ = rs[ai * 4 + m];
#pragma unroll
                for (int bj = 0; bj < 2; ++bj) {
                    const int c32 = (u.pn % 3) * 256 + bj * 128 + wc * 32, c8 = c32 + 8 * fq; const f32x4 v0 = acc[ai][bj][m][0], v1 = acc[ai][bj][m][1];
                    if (!isq) { const f32x4 a = v0 * r_, b = v1 * r_; *(v4u*)(KVM + (size_t)row * 768 + c8) = (v4u){pg8::cvt_pk_bf16(a[0], a[1]), pg8::cvt_pk_bf16(a[2], a[3]), pg8::cvt_pk_bf16(b[0], b[1]), pg8::cvt_pk_bf16(b[2], b[3])}; }
                    else if (c32 < 576) {
                        const int hd = c32 / 96, w32 = c32 - hd * 96;
                        if (w32 < 64) { const f32x4 a = v0 * r_, b = v1 * r_; *(v4u*)(QM + (size_t)row * 576 + c8) = (v4u){pg8::cvt_pk_bf16(a[0], a[1]), pg8::cvt_pk_bf16(a[2], a[3]), pg8::cvt_pk_bf16(b[0], b[1]), pg8::cvt_pk_bf16(b[2], b[3])}; }
                        else { const int i = fq; const f32x4 ta = t0[ai * 4 + m], tb = t1[ai * 4 + m]; const f32x4 x1 = v0 * r_, x2 = v1 * r_;
                            const auto s0 = __builtin_amdgcn_permlane16_swap(pg8::cvt_pk_bf16(x1[0] * ta[0] - x2[0] * ta[1], x1[1] * ta[2] - x2[1] * ta[3]), pg8::cvt_pk_bf16(x2[0] * ta[0] + x1[0] * ta[1], x2[1] * ta[2] + x1[1] * ta[3]), false, false);
                            const auto s1 = __builtin_amdgcn_permlane16_swap(pg8::cvt_pk_bf16(x1[2] * tb[0] - x2[2] * tb[1], x1[3] * tb[2] - x2[3] * tb[3]), pg8::cvt_pk_bf16(x2[2] * tb[0] + x1[2] * tb[1], x2[3] * tb[2] + x1[3] * tb[3]), false, false);
                            bf16* o = QM + (size_t)row * 576 + hd * 96 + 64 + 4 * i + ((fq & 1) ? 12 : 0);
                            *(v4u*)o = (v4u){s0[0], s1[0], s0[1], s1[1]}; }
                    }
                } }
    }
};
struct SchedQKV : pg8::TileOrder {
    const char* B;
    __device__ __forceinline__ bool next(int i, Unit& u) const {
        if (c < 32) return i < 2 && tile_of((long)i * G + c, u);
        if (c < 64) return i < 3 ? tile_of((long)i * G + c, u) : (i == 3 && tile_of((long)2 * G + (c - 32), u));
        return i < 3 && tile_of((long)i * G + c, u);
    }
    __device__ __forceinline__ unsigned arow(const Unit&, int r) const { return (unsigned)(r & 127) * (NU * 2); }
    __device__ __forceinline__ size_t abase(const Unit& u, int h) const { return (size_t)(u.pm * 256 + h * 128) * (NU * 2); }
    __device__ __forceinline__ const char* bbase(const Unit& u) const { return B + (size_t)u.pn * (256 * 384 * 2); }
};

__device__ __forceinline__ void p_copy_rows(Frame& F, const float* src, float* dst) {
    phase_begin(F);
    const int gw = F.vcu * NWAVES + F.wave, NGW = F.G * NWAVES;
    for (int m = gw; m < TOK; m += NGW) { const GAS f32x4* s = (const GAS f32x4*)(src + (size_t)m * DM) + F.lane; GAS f32x4* d = (GAS f32x4*)(dst + (size_t)m * DM) + F.lane;
#pragma unroll
        for (int j = 0; j < 4; ++j) d[64 * j] = s[64 * j]; }
}
template <bool ROUTE>
__device__ __forceinline__ void p_norm(Frame& F, const float* x, const float* gain, const float* rw) {
    phase_begin(F);
    bf16* XN = (bf16*)(F.ws + WS_XN);
    f32x4 gv[4];
#pragma unroll
    for (int j = 0; j < 4; ++j) gv[j] = *((const GAS f32x4*)gain + F.lane + 64 * j);
    f32x4 rwv[16][2];
    if (ROUTE) {
#pragma unroll
        for (int j = 0; j < 4; ++j)
#pragma unroll
            for (int k = 0; k < 4; ++k) { const int c = 4 * F.lane + 256 * j + k; rwv[4 * j + k][0] = *(const GAS f32x4*)(rw + (size_t)c * 8); rwv[4 * j + k][1] = *(const GAS f32x4*)(rw + (size_t)c * 8 + 4); }
    }
    LAS unsigned* es = (LAS unsigned*)F.lds;
    for (int ch = F.vcu; ch < TOK / 128; ch += F.G) {
        for (int rr = 0; rr < 16; ++rr) {
            const int m = ch * 128 + F.wave * 16 + rr;
            const GAS f32x4* xr = (const GAS f32x4*)(x + (size_t)m * DM) + F.lane;
            f32x4 v[4]; float s2 = 0.f;
#pragma unroll
            for (int j = 0; j < 4; ++j) { v[j] = xr[64 * j]; s2 += (v[j].x * v[j].x + v[j].y * v[j].y) + (v[j].z * v[j].z + v[j].w * v[j].w); }
            const float rstd = 1.0f / sqrtf(wave_sum(s2) * (1.f / DM) + EPS);
#pragma unroll
            for (int j = 0; j < 4; ++j) v[j] = v[j] * rstd * gv[j];
            GAS unsigned long long* o8 = (GAS unsigned long long*)(XN + (size_t)m * DM) + F.lane;
#pragma unroll
            for (int j = 0; j < 4; ++j) o8[64 * j] = (unsigned long long)pk2(v[j].x, v[j].y) | ((unsigned long long)pk2(v[j].z, v[j].w) << 32);
            if (ROUTE) {
                float lg[8];
#pragma unroll
                for (int e = 0; e < 8; ++e) lg[e] = 0.f;
#pragma unroll
                for (int j = 0; j < 4; ++j)
#pragma unroll
                    for (int k = 0; k < 4; ++k) { const float xv = v[j][k]; const f32x4 a = rwv[4 * j + k][0], b = rwv[4 * j + k][1];
                        lg[0] += xv * a.x; lg[1] += xv * a.y; lg[2] += xv * a.z; lg[3] += xv * a.w; lg[4] += xv * b.x; lg[5] += xv * b.y; lg[6] += xv * b.z; lg[7] += xv * b.w; }
#pragma unroll
                for (int e = 0; e < 8; ++e) lg[e] = wave_sum(lg[e]);
                int e1 = 0; float v1 = lg[0];
#pragma unroll
                for (int e = 1; e < 8; ++e) if (lg[e] > v1) { v1 = lg[e]; e1 = e; }
                int e2 = (e1 == 0) ? 1 : 0; float v2 = (e1 == 0) ? lg[1] : lg[0];
#pragma unroll
                for (int e = 0; e < 8; ++e) if (e != e1 && lg[e] > v2) { v2 = lg[e]; e2 = e; }
                const float ex = __expf(v2 - v1); const float g1 = 1.0f / (1.0f + ex), g2 = ex / (1.0f + ex);
                if (F.lane == 0) { f32x4 r; r.x = __builtin_bit_cast(float, e1); r.y = __builtin_bit_cast(float, e2); r.z = g1; r.w = g2;
                    *(GAS f32x4*)(F.ws + WS_MISC + MS_ROUTE + (size_t)m * 16) = r; es[F.wave * 16 + rr] = (unsigned)e1 | ((unsigned)e2 << 8); }
            }
        }
        if (ROUTE) {
            __syncthreads();
            { const unsigned w = (F.tid < 128) ? es[F.tid] : 0xffffu;
#pragma unroll
              for (int e = 0; e < 8; ++e) { const unsigned long long mk = __ballot((int)(w & 255u) == e || (int)(w >> 8) == e); if (F.lane == 0 && F.wave < 2) es[128 + F.wave * 8 + e] = (unsigned)__popcll(mk); } }
            __syncthreads();
            if (F.tid < 8) ((GAS int*)(F.ws + WS_MISC + MS_COUNTS))[ch * 8 + F.tid] = (int)(es[128 + F.tid] + es[136 + F.tid]);
            __syncthreads();
        }
    }
}
__device__ __forceinline__ void p_scatter(Frame& F) {
    phase_begin(F);
    LAS int* cnt = (LAS int*)F.lds;
    LAS int* tot = cnt + 2048;
    const GAS int* counts = (const GAS int*)(F.ws + WS_MISC + MS_COUNTS);
    GAS int* rowlist = (GAS int*)(F.ws + WS_MISC + MS_ROWLIST);
    GAS int* tokslot = (GAS int*)(F.ws + WS_MISC + MS_TOKSLOT);
    for (int i = F.tid; i < 2048; i += NTHR) cnt[i] = counts[i];
    __syncthreads();
    LAS int* gp = tot + 64;
    if (F.tid < 256) { const int e = F.tid & 7, g = F.tid >> 3; int t = 0;
#pragma unroll
        for (int c = 0; c < 8; ++c) t += cnt[(8 * g + c) * 8 + e];
        gp[e * 33 + g] = t; }
    __syncthreads();
    if (F.tid < 8) { int run = 0; for (int g = 0; g < 32; ++g) { const int v = gp[F.tid * 33 + g]; gp[F.tid * 33 + g] = run; run += v; } tot[F.tid] = run; }
    __syncthreads();
    if (F.tid == 0) { int b = 0; for (int e = 0; e < 8; ++e) { tot[8 + e] = b; b += (tot[e] + 255) & ~255; } tot[16] = b; }
    __syncthreads();
    LAS int* pre = tot + 32;
    for (int ch = F.vcu; ch < TOK / 128; ch += F.G) {
        if (F.tid < 8) { const int e = F.tid; int pos = tot[8 + e] + gp[e * 33 + (ch >> 3)]; for (int c = ch & ~7; c < ch; ++c) pos += cnt[c * 8 + e]; pre[e] = pos; }
        int e1 = -1, e2 = -1; const int m = ch * 128 + F.tid;
        if (F.tid < 128) { const GAS int* r = (const GAS int*)(F.ws + WS_MISC + MS_ROUTE + (size_t)m * 16); e1 = r[0]; e2 = r[1]; }
        int rk1 = 0, rk2 = 0;
        const unsigned long long lt = (1ull << F.lane) - 1ull;
#pragma unroll
        for (int e = 0; e < 8; ++e) { const unsigned long long mk = __ballot(e1 == e || e2 == e); const int rk = __popcll(mk & lt);
            if (e1 == e) rk1 = rk; if (e2 == e) rk2 = rk; if (F.tid == 0) pre[8 + e] = __popcll(mk); }
        __syncthreads();
        if (F.tid < 128) { const int add = (F.tid >= 64) ? 1 : 0;
            const int p1 = pre[e1] + (add ? pre[8 + e1] : 0) + rk1, p2 = pre[e2] + (add ? pre[8 + e2] : 0) + rk2;
            rowlist[p1] = m; tokslot[2 * m] = p1; rowlist[p2] = m; tokslot[2 * m + 1] = p2; }
        __syncthreads();
    }
    if (F.vcu == 0) {
        if (F.tid < 8) { const int e = F.tid; const int b = tot[8 + e] + tot[e], en = tot[8 + e] + ((tot[e] + 255) & ~255); for (int p = b; p < en; ++p) rowlist[p] = 0; }
        if (F.tid < 9) ((GAS int*)(F.ws + WS_MISC + MS_EBASE))[F.tid] = (F.tid < 8 ? tot[8 + F.tid] : tot[16]) / 256;
    }
}
__device__ __forceinline__ void p_combine_final(Frame& F, const float* gain) {
    phase_begin(F);
    const int gw = F.vcu * NWAVES + F.wave, NGW = F.G * NWAVES;
    const bf16* Y = (const bf16*)(F.ws + WS_Y);
    f32x4 gv[4];
#pragma unroll
    for (int j = 0; j < 4; ++j) gv[j] = *((const GAS f32x4*)gain + F.lane + 64 * j);
    f32x4 rn = (f32x4){0.f, 0.f, 0.f, 0.f}; v2u sn = (v2u){0u, 0u};
    if (gw < TOK) { rn = *(const GAS f32x4*)(F.ws + WS_MISC + MS_ROUTE + (size_t)gw * 16); sn = *(const GAS v2u*)(F.ws + WS_MISC + MS_TOKSLOT + (size_t)gw * 8); }
    for (int m = gw; m < TOK; m += NGW) {
        f32x4 r = rn; r.z *= ALPHA_MOE; r.w *= ALPHA_MOE;
        const int s1 = (int)sn.x, s2 = (int)sn.y;
        { const int mn = m + NGW; if (mn < TOK) { rn = *(const GAS f32x4*)(F.ws + WS_MISC + MS_ROUTE + (size_t)mn * 16); sn = *(const GAS v2u*)(F.ws + WS_MISC + MS_TOKSLOT + (size_t)mn * 8); } }
        GAS f32x4* xr = (GAS f32x4*)(F.out + (size_t)m * DM) + F.lane;
        const GAS v2u* y1 = (const GAS v2u*)(Y + (size_t)s1 * DM) + F.lane; const GAS v2u* y2 = (const GAS v2u*)(Y + (size_t)s2 * DM) + F.lane;
        f32x4 v[4]; float ss = 0.f;
#pragma unroll
        for (int j = 0; j < 4; ++j) { v[j] = xr[64 * j]; const v2u a = y1[64 * j], b = y2[64 * j];
            v[j].x += r.z * bflo(a.x) + r.w * bflo(b.x); v[j].y += r.z * bfhi(a.x) + r.w * bfhi(b.x); v[j].z += r.z * bflo(a.y) + r.w * bflo(b.y); v[j].w += r.z * bfhi(a.y) + r.w * bfhi(b.y);
            ss += (v[j].x * v[j].x + v[j].y * v[j].y) + (v[j].z * v[j].z + v[j].w * v[j].w); }
        const float rstd = 1.0f / sqrtf(wave_sum(ss) * (1.f / DM) + EPS);
#pragma unroll
        for (int j = 0; j < 4; ++j) xr[64 * j] = v[j] * rstd * gv[j];
    }
}
__device__ __forceinline__ void p_nan_rows(Frame& F) {
    phase_begin(F);
    const int gw = F.vcu * NWAVES + F.wave, NGW = F.G * NWAVES; const float q = __builtin_nanf("");
    for (int m = gw; m < TOK; m += NGW) { GAS f32x4* o = (GAS f32x4*)(F.out + (size_t)m * DM) + F.lane;
#pragma unroll
        for (int j = 0; j < 4; ++j) o[64 * j] = (f32x4){q, q, q, q}; }
}


#ifdef DBG
constexpr int CW_DBG = 20000;
#ifndef DBG_STAT
#define DBG_STAT 40
#endif
__device__ __forceinline__ unsigned hsh(unsigned a) { a ^= a >> 16; a *= 0x7feb352du; a ^= a >> 15; a *= 0x846ca68bu; a ^= a >> 16; return a; }
__device__ __forceinline__ void dbg_put(Frame& F, int id, float err) { if (!(err >= 0.f)) err = 1e30f; atomicMax((unsigned*)(F.ctl + CW_DBG + id), __builtin_bit_cast(unsigned, err)); }
__device__ __forceinline__ float relerr(float got, float ref) { return fabsf(got - ref) / (fabsf(ref) + 1.0f); }
__device__ __forceinline__ float silu_ref(float g) { return g / (1.0f + expf(-g)); }
__device__ __forceinline__ int dbg_sample(Frame& F, int salt) { return (int)hsh((unsigned)(blockIdx.x * NTHR + F.tid) * 7919u + (unsigned)salt); }
__device__ __forceinline__ void chk_xn(Frame& F, int id, const float* x, const float* gain) {
    phase_begin(F); if (blockIdx.x >= 16) return;
    const unsigned h = (unsigned)dbg_sample(F, 11); const int row = h % TOK, col = (h >> 16) % DM;
    float ss = 0.f; for (int k = 0; k < DM; ++k) { const float v = x[(size_t)row * DM + k]; ss += v * v; }
    const float ref = x[(size_t)row * DM + col] / sqrtf(ss / DM + EPS) * gain[col];
    dbg_put(F, id, relerr(bf2f(((const bf16*)(F.ws + WS_XN))[(size_t)row * DM + col]), ref));
}
__device__ __forceinline__ void chk_ffn_up(Frame& F, int id, const float* wg, const float* wu) {
    phase_begin(F); if (blockIdx.x >= 16) return;
    const unsigned h = (unsigned)dbg_sample(F, 23); const int row = h % TOK, hid = (h >> 15) % DFF;
    const bf16* xn = (const bf16*)(F.ws + WS_XN) + (size_t)row * DM; float g = 0.f, u = 0.f;
    for (int k = 0; k < DM; ++k) { const float a = bf2f(xn[k]); g += a * wg[(size_t)k * DFF + hid]; u += a * wu[(size_t)k * DFF + hid]; }
    dbg_put(F, id, relerr(bf2f(((const bf16*)(F.ws + WS_H))[(size_t)row * DFF + hid]), silu_ref(g) * u));
}
__device__ __forceinline__ void chk_ffn_down(Frame& F, int id, const float* base, const float* wd) {
    phase_begin(F); if (blockIdx.x >= 16) return;
    const unsigned h = (unsigned)dbg_sample(F, 37); const int row = h % TOK, col = (h >> 16) % DM;
    const bf16* hr = (const bf16*)(F.ws + WS_H) + (size_t)row * DFF; float a = base[(size_t)row * DM + col];
    for (int k = 0; k < DFF; ++k) a += bf2f(hr[k]) * wd[(size_t)k * DM + col];
    dbg_put(F, id, relerr(F.out[(size_t)row * DM + col], a));
}
__device__ __forceinline__ void chk_route(Frame& F, int id, const float* x, const float* gain, const float* rw) {
    phase_begin(F); if (blockIdx.x >= 4) return;
    const unsigned h = (unsigned)dbg_sample(F, 41); const int row = h % TOK;
    float ss = 0.f; for (int k = 0; k < DM; ++k) { const float v = x[(size_t)row * DM + k]; ss += v * v; }
    const float rstd = 1.0f / sqrtf(ss / DM + EPS); float lg[8]; for (int e = 0; e < 8; ++e) lg[e] = 0.f;
    for (int k = 0; k < DM; ++k) { const float v = x[(size_t)row * DM + k] * rstd * gain[k]; for (int e = 0; e < 8; ++e) lg[e] += v * rw[(size_t)k * 8 + e]; }
    int e1 = 0; for (int e = 1; e < 8; ++e) if (lg[e] > lg[e1]) e1 = e;
    int e2 = (e1 == 0) ? 1 : 0; for (int e = 0; e < 8; ++e) if (e != e1 && lg[e] > lg[e2]) e2 = e;
    const float g1 = 1.0f / (1.0f + expf(lg[e2] - lg[e1]));
    const GAS int* r = (const GAS int*)(F.ws + WS_MISC + MS_ROUTE + (size_t)row * 16);
    float gap = 1e9f; for (int e = 0; e < 8; ++e) if (e != e1 && e != e2) gap = fminf(gap, lg[e2] - lg[e]);
    float err = 0.f;
    if (gap > 1e-3f && lg[e1] - lg[e2] > 1e-3f) { if (r[0] != e1 || r[1] != e2) err = 10.f; err = fmaxf(err, fabsf(__builtin_bit_cast(float, r[2]) - g1)); }
    dbg_put(F, id, err);
    const GAS int* ts = (const GAS int*)(F.ws + WS_MISC + MS_TOKSLOT); const GAS int* rl = (const GAS int*)(F.ws + WS_MISC + MS_ROWLIST); const GAS int* eb = (const GAS int*)(F.ws + WS_MISC + MS_EBASE);
    float e2r = 0.f;
    for (int k = 0; k < 2; ++k) { const int sl = ts[2 * row + k]; if (sl < 0 || sl >= MAXSLOT || rl[sl] != row) { e2r = 10.f; break; }
        int ex = 0; for (int j = 1; j < 8; ++j) ex += (sl / 256 >= eb[j]) ? 1 : 0; if (ex != r[k]) e2r = 20.f; }
    dbg_put(F, id + 1, e2r);
}
__device__ __forceinline__ void chk_moe_up(Frame& F, int id, const float* wg, const float* wu) {
    phase_begin(F); if (blockIdx.x >= 16) return;
    const GAS int* eb = (const GAS int*)(F.ws + WS_MISC + MS_EBASE); const GAS int* rl = (const GAS int*)(F.ws + WS_MISC + MS_ROWLIST);
    const unsigned h = (unsigned)dbg_sample(F, 53); const int slot = h % (eb[8] * 256), hid = (h >> 15) % DFE; const int row = rl[slot];
    int ex = 0; for (int j = 1; j < 8; ++j) ex += (slot / 256 >= eb[j]) ? 1 : 0;
    const bf16* xn = (const bf16*)(F.ws + WS_XN) + (size_t)row * DM; float g = 0.f, u = 0.f;
    for (int k = 0; k < DM; ++k) { const float a = bf2f(xn[k]); g += a * wg[((size_t)ex * DM + k) * DFE + hid]; u += a * wu[((size_t)ex * DM + k) * DFE + hid]; }
    dbg_put(F, id, relerr(bf2f(((const bf16*)(F.ws + WS_H))[(size_t)slot * DFE + hid]), silu_ref(g) * u));
}
__device__ __forceinline__ void chk_moe_down(Frame& F, int id, const float* wd) {
    phase_begin(F); if (blockIdx.x >= 16) return;
    const GAS int* eb = (const GAS int*)(F.ws + WS_MISC + MS_EBASE);
    const unsigned h = (unsigned)dbg_sample(F, 67); const int slot = h % (eb[8] * 256), col = (h >> 16) % DM;
    int ex = 0; for (int j = 1; j < 8; ++j) ex += (slot / 256 >= eb[j]) ? 1 : 0;
    const bf16* hr = (const bf16*)(F.ws + WS_H) + (size_t)slot * DFE; float a = 0.f;
    for (int k = 0; k < DFE; ++k) a += bf2f(hr[k]) * wd[((size_t)ex * DFE + k) * DM + col];
    dbg_put(F, id, relerr(bf2f(((const bf16*)(F.ws + WS_Y))[(size_t)slot * DM + col]), a));
}

__device__ __forceinline__ void chk_u(Frame& F, int id, const float* w_in) {
    phase_begin(F); if (blockIdx.x >= 16) return;
    const unsigned h = (unsigned)dbg_sample(F, 71 + id); const int row = h % TOK, c = (h >> 15) % IN_COLS, pos = row & (SEQ - 1);
    const bf16* xn = (const bf16*)(F.ws + WS_XN) + (size_t)row * DM;
    int c1 = c, c2 = -1; float cs = 1.f, sn = 0.f, sc = 1.f; bool second = false;
    if (is_rope64(c)) { const int seg = c >= C_KW ? C_KW : c >= C_KS ? C_KS : c >= C_KC ? C_KC : C_QN; const int l = c - seg, hb = seg + (l & ~63), dd = l & 63, i = dd & 31;
        c1 = hb + i; c2 = hb + 32 + i; second = dd >= 32; const float ang = (float)pos * INV_N[i]; cs = cosf(ang); sn = sinf(ang); if (seg == C_QN) sc = QSCALE_N; }
    else if (c >= C_KPE && c < C_QN) { const int dd = c - C_KPE, i = dd & 15; c1 = C_KPE + i; c2 = C_KPE + 16 + i; second = dd >= 16; const float ang = (float)pos * INV_M[i]; cs = cosf(ang); sn = sinf(ang); }
    float a1 = 0.f, a2 = 0.f;
    for (int k = 0; k < DM; ++k) { const float a = bf2f(xn[k]); a1 += a * w_in[(size_t)k * IN_COLS + c1]; if (c2 >= 0) a2 += a * w_in[(size_t)k * IN_COLS + c2]; }
    const float ref = (c2 < 0) ? a1 : (second ? (a2 * cs + a1 * sn) * sc : (a1 * cs - a2 * sn) * sc);
    dbg_put(F, id, relerr(bf2f(((const bf16*)(F.ws + WS_U))[(size_t)row * NU + c]), ref));
}
__device__ __forceinline__ void chk_lru(Frame& F, int id, const float* cw, const float* cb, const float* wa, const float* ba, const float* wx, const float* bx, const float* lam) {
    phase_begin(F); if (blockIdx.x >= 2) return;
    const unsigned hs = (unsigned)dbg_sample(F, 91 + id); const int b = hs & 3, pos = (hs >> 2) % 150, d = (hs >> 16) & 255, blk = d >> 6, dd = d & 63;
    const bf16* U = (const bf16*)(F.ws + WS_U); const float sp = logf(1.0f + expf(-lam[d])); float h = 0.f;
    for (int p = 0; p <= pos; ++p) { const size_t t = (size_t)b * SEQ + p; float ra = ba[d], ia = bx[d], xcd = 0.f;
        for (int c = 0; c < 64; ++c) { const int ch = blk * 64 + c; float xc = cb[ch];
            for (int k = 0; k < 4; ++k) { const int pp = p - 3 + k; if (pp >= 0) xc += cw[k * 256 + ch] * bf2f(U[((size_t)b * SEQ + pp) * NU + C_XL + ch]); }
            ra += xc * wa[(size_t)(blk * 64 + c) * 64 + dd]; ia += xc * wx[(size_t)(blk * 64 + c) * 64 + dd]; if (c == dd) xcd = xc; }
        const float r = 1.0f / (1.0f + expf(-ra)), ig = 1.0f / (1.0f + expf(-ia)), la = -8.0f * r * sp, a = expf(la);
        h = a * h + sqrtf(1.0f - expf(2.0f * la)) * (ig * xcd); }
    const size_t t = (size_t)b * SEQ + pos; const float y = bf2f(U[t * NU + C_YL + d]); const float gl = 0.5f * y * (1.0f + tanhf(0.7978845608f * (y + 0.044715f * y * y * y)));
    dbg_put(F, id, relerr(bf2f(((const bf16*)(F.ws + WS_CAT))[t * DM + d]), h * gl));
}

__device__ __forceinline__ void chk_lru_rec(Frame& F, int id, const float* cw, const float* cb, const float* wa, const float* ba, const float* wx, const float* bx, const float* lam) {
    phase_begin(F); if (blockIdx.x >= 8) return;
    const unsigned hs = (unsigned)dbg_sample(F, 191 + id); const int b = hs & 3, pos = 4 + (hs >> 2) % (SEQ - 4), d = (hs >> 16) & 255, blk = d >> 6, dd = d & 63;
    const bf16* U = (const bf16*)(F.ws + WS_U); const bf16* CAT = (const bf16*)(F.ws + WS_CAT); const float sp = logf(1.0f + expf(-lam[d]));
    const size_t t = (size_t)b * SEQ + pos;
    float ra = ba[d], ia = bx[d], xcd = 0.f;
    for (int c = 0; c < 64; ++c) { const int ch = blk * 64 + c; float xc = cb[ch];
        for (int k = 0; k < 4; ++k) xc += cw[k * 256 + ch] * bf2f(U[(t - 3 + k) * NU + C_XL + ch]);
        ra += xc * wa[(size_t)(blk * 64 + c) * 64 + dd]; ia += xc * wx[(size_t)(blk * 64 + c) * 64 + dd]; if (c == dd) xcd = xc; }
    const float r = 1.0f / (1.0f + expf(-ra)), ig = 1.0f / (1.0f + expf(-ia)), la = -8.0f * r * sp, a = expf(la);
    const float y0 = bf2f(U[(t - 1) * NU + C_YL + d]), y1 = bf2f(U[t * NU + C_YL + d]);
    const float g0 = 0.5f * y0 * (1.0f + tanhf(0.7978845608f * (y0 + 0.044715f * y0 * y0 * y0))), g1 = 0.5f * y1 * (1.0f + tanhf(0.7978845608f * (y1 + 0.044715f * y1 * y1 * y1)));
    float err = 0.f;
    if (fabsf(g0) > 0.25f) { const float hp = bf2f(CAT[(t - 1) * DM + d]) / g0; const float ref = (a * hp + sqrtf(1.0f - expf(2.0f * la)) * (ig * xcd)) * g1; err = relerr(bf2f(CAT[t * DM + d]), ref); }
    dbg_put(F, id, err);
}
__device__ __forceinline__ void chk_outproj(Frame& F, int id, const float* base, const float* w_out) {
    phase_begin(F); if (blockIdx.x >= 16) return;
    const unsigned h = (unsigned)dbg_sample(F, 37 + id); const int row = h % TOK, col = (h >> 16) % DM;
    const bf16* cr = (const bf16*)(F.ws + WS_CAT) + (size_t)row * DM; float a = base[(size_t)row * DM + col];
    for (int k = 0; k < DM; ++k) a += bf2f(cr[k]) * w_out[(size_t)k * DM + col];
    dbg_put(F, id, relerr(F.out[(size_t)row * DM + col], a));
}


__device__ __forceinline__ void chk_qkv(Frame& F, int id, const float* qn, const float* wuq, const float* kvn, const float* wukv) {
    phase_begin(F); if (blockIdx.x >= 16) return;
    const unsigned hs = (unsigned)dbg_sample(F, 301 + id); const int row = hs % TOK, pos = row & (SEQ - 1); const bf16* ur = (const bf16*)(F.ws + WS_U) + (size_t)row * NU;
    float err;
    if (hs & 0x80000000u) {
        const int c = (hs >> 15) % 768; float ss = 0.f, a = 0.f;
        for (int k = 0; k < 128; ++k) { const float v = bf2f(ur[C_KVDN + k]); ss += v * v; a += v * kvn[k] * wukv[(size_t)k * 768 + c]; }
        err = relerr(bf2f(((const bf16*)(F.ws + WS_KVM))[(size_t)row * 768 + c]), a / sqrtf(ss / 128.f + EPS));
    } else {
        const int c = (hs >> 15) % 576, hd = c / 96, w = c % 96; int c1 = c, c2 = -1; bool second = false; float cs = 1.f, sn = 0.f;
        if (w >= 64) { const int i = (w - 64) & 15; c1 = hd * 96 + 64 + i; c2 = c1 + 16; second = (w - 64) >= 16; const float ang = (float)pos * INV_M[i]; cs = cosf(ang); sn = sinf(ang); }
        float ss = 0.f, a1 = 0.f, a2 = 0.f;
        for (int k = 0; k < 192; ++k) { const float v = bf2f(ur[C_QDN + k]); ss += v * v; a1 += v * qn[k] * wuq[(size_t)k * 576 + c1]; if (c2 >= 0) a2 += v * qn[k] * wuq[(size_t)k * 576 + c2]; }
        const float rs = QSCALE_M / sqrtf(ss / 192.f + EPS); const float ref = (c2 < 0) ? a1 * rs : (second ? (a2 * cs + a1 * sn) * rs : (a1 * cs - a2 * sn) * rs);
        err = relerr(bf2f(((const bf16*)(F.ws + WS_QM))[(size_t)row * 576 + c]), ref);
    }
    dbg_put(F, id, err);
}
__device__ __forceinline__ void chk_mla(Frame& F, int id) {
    phase_begin(F); if (blockIdx.x >= 4) return;
    const unsigned hs = (unsigned)dbg_sample(F, 401 + id); const int b = hs & 3, h = (hs >> 2) % 6, d = (hs >> 8) & 63, pos = (F.tid < 64) ? (int)((hs >> 14) % SEQ) : (int)((hs >> 14) % 1200);
    const bf16* QM = (const bf16*)(F.ws + WS_QM); const bf16* KVM = (const bf16*)(F.ws + WS_KVM); const bf16* U = (const bf16*)(F.ws + WS_U);
    const size_t t = (size_t)b * SEQ + pos; float m = -1e30f, l = 0.f, o = 0.f;
    for (int k = 0; k <= pos; ++k) { const size_t tk = (size_t)b * SEQ + k; float sc = 0.f;
        for (int j = 0; j < 64; ++j) sc += bf2f(QM[t * 576 + h * 96 + j]) * bf2f(KVM[tk * 768 + h * 128 + j]);
        for (int j = 0; j < 32; ++j) sc += bf2f(QM[t * 576 + h * 96 + 64 + j]) * bf2f(U[tk * NU + C_KPE + j]);
        const float mn = fmaxf(m, sc), al = exp2f(m - mn), p = exp2f(sc - mn); l = l * al + p; o = o * al + p * bf2f(KVM[tk * 768 + h * 128 + 64 + d]); m = mn; }
    dbg_put(F, id, fabsf(bf2f(((const bf16*)(F.ws + WS_CAT))[t * DM + 256 + h * 64 + d]) - o / l) / (fabsf(o / l) + 0.05f));
}

__device__ __forceinline__ void chk_kc(Frame& F, int id, const float* cpos, const float* w1, const float* w2) {
    phase_begin(F); if (blockIdx.x >= 8) return;
    const int grp = F.tid >> 7, j = F.tid & 127; LAS float* red = (LAS float*)F.lds;
    for (int it = 0; it < 4; ++it) {
        const unsigned hs = hsh((unsigned)((blockIdx.x * 4 + grp) * 4 + it) * 7919u + 501u + (unsigned)id); const int sr = hs & 1, b = (hs >> 1) & 3, g = (hs >> 3) & 1, n = (hs >> 4) % 511, d = (hs >> 16) & 63;
        const bf16* U = (const bf16*)(F.ws + WS_U); float y = 0.f;
        for (int l = 0; l < 32; ++l) for (int dd = 0; dd < 64; ++dd) { const float x = bf2f(U[((size_t)b * SEQ + 16 * n + l) * NU + (sr ? C_VC : C_KC) + g * 64 + dd]) + cpos[sr * 2048 + l * 64 + dd];
            y += x * w1[((size_t)sr * 2048 + l * 64 + dd) * 128 + j]; }
        __syncthreads();
        red[F.tid] = 0.5f * y * (1.0f + tanhf(0.7978845608f * (y + 0.044715f * y * y * y))) * w2[((size_t)sr * 128 + j) * 64 + d];
        __syncthreads();
        if (j == 0) { float a = 0.f; for (int k = 0; k < 128; ++k) a += red[grp * 128 + k];
            dbg_put(F, id, fabsf(bf2f(((const bf16*)(F.ws + WS_KC))[((size_t)(sr * 8 + b * 2 + g) * 512 + n) * 64 + d]) - a) / (fabsf(a) + 0.25f)); }
    }
    __syncthreads();
}
__device__ __forceinline__ void chk_nsa(Frame& F, int id, const float* gb) {
    phase_begin(F); if (blockIdx.x >= 1) return;
    const unsigned hs = (unsigned)dbg_sample(F, 601 + id); const int b = hs & 3, h = (hs >> 2) % 6, g = h / 3, d = (hs >> 8) & 63;
    const int pos = (F.tid < 32) ? (int)((hs >> 14) % SEQ) : (F.tid < 256) ? (int)(1024 + (hs >> 14) % 700) : (int)((hs >> 14) % 1100);
    const bf16* U = (const bf16*)(F.ws + WS_U); const bf16* KC = (const bf16*)(F.ws + WS_KC) + (size_t)(b * 2 + g) * KC_HEAD; const bf16* VC = KC + 8 * KC_HEAD;
    float* P3 = (float*)(F.ws + WS_XN + 32 * MiB) + (size_t)F.tid * 1024; float* imp = P3 + 512;
    const size_t t = (size_t)b * SEQ + pos; const int nv = (pos >= 31) ? (pos - 31) / 16 + 1 : 0;
    for (int n = 0; n < 512; ++n) P3[n] = 0.f;
    float oc = 0.f;
    float* SC = P3 + 1024 * 512;
    for (int p = 0; p < 3; ++p) { const int hh = g * 3 + p; float m = -1e30f;
        for (int n = 0; n < nv; ++n) { float sc = 0.f; for (int j = 0; j < 64; ++j) sc += bf2f(U[t * NU + C_QN + hh * 64 + j]) * bf2f(KC[n * 64 + j]); SC[n] = sc; m = fmaxf(m, sc); }
        float l = 0.f; for (int n = 0; n < nv; ++n) l += exp2f(SC[n] - m);
        for (int n = 0; n < nv; ++n) { const float pr = exp2f(SC[n] - m) / l; P3[n] += pr; if (hh == h) oc += pr * bf2f(VC[n * 64 + d]); } }
    const int cur = pos >> 6;
    for (int s2 = 0; s2 < 128; ++s2) { float a = 0.f; for (int n = 4 * s2 - 1; n <= 4 * s2 + 3; ++n) if (n >= 0 && n < nv) a += P3[n]; imp[s2] = (s2 <= cur) ? a : -1.f; }
    unsigned mk[4] = {0u, 0u, 0u, 0u}; float gapmin = 1e9f;
    { int cnt = 0; imp[0] += 1000.f; if (cur != 0) imp[cur] += 1000.f;
      for (int r = 0; r < 16; ++r) { int bi = -1; float bv = -0.5f; for (int s2 = 0; s2 < 128; ++s2) if (imp[s2] > bv) { bv = imp[s2]; bi = s2; } if (bi < 0) break;
          if (r == 15) { float nx = -0.5f; for (int s2 = 0; s2 < 128; ++s2) if (s2 != bi && imp[s2] > nx) nx = imp[s2]; gapmin = bv - nx; }
          imp[bi] = -3.f; const unsigned bit = 1u << (bi & 31); if ((bi >> 5) == 0) mk[0] |= bit; else if ((bi >> 5) == 1) mk[1] |= bit; else if ((bi >> 5) == 2) mk[2] |= bit; else mk[3] |= bit; ++cnt; } }
    const GAS unsigned* km = (const GAS unsigned*)(F.ws + WS_MASK) + ((size_t)(b * 2 + g) * SEQ + pos) * 4;
    const bool same = km[0] == mk[0] && km[1] == mk[1] && km[2] == mk[2] && km[3] == mk[3];
    dbg_put(F, id + 1, (same || gapmin < 2e-3f) ? 0.f : 10.f);
    float m = -1e30f, l = 0.f, os = 0.f;
    for (int k = 0; k <= pos; ++k) { const unsigned w = km[k >> 11]; if (!((w >> ((k >> 6) & 31)) & 1u)) continue; const size_t tk = (size_t)b * SEQ + k; float sc = 0.f;
        for (int j = 0; j < 64; ++j) sc += bf2f(U[t * NU + C_QN + h * 64 + j]) * bf2f(U[tk * NU + C_KS + g * 64 + j]);
        const float mn = fmaxf(m, sc), al = exp2f(m - mn), pr = exp2f(sc - mn); l = l * al + pr; os = os * al + pr * bf2f(U[tk * NU + C_VS + g * 64 + d]); m = mn; }
    os = (l > 0.f) ? os / l : 0.f;
    m = -1e30f; l = 0.f; float ow = 0.f;
    for (int k = (pos - 511 < 0 ? 0 : pos - 511); k <= pos; ++k) { const size_t tk = (size_t)b * SEQ + k; float sc = 0.f;
        for (int j = 0; j < 64; ++j) sc += bf2f(U[t * NU + C_QN + h * 64 + j]) * bf2f(U[tk * NU + C_KW + g * 64 + j]);
        const float mn = fmaxf(m, sc), al = exp2f(m - mn), pr = exp2f(sc - mn); l = l * al + pr; ow = ow * al + pr * bf2f(U[tk * NU + C_VW + g * 64 + d]); m = mn; }
    ow /= l;
    float gt[3]; for (int br = 0; br < 3; ++br) gt[br] = 1.0f / (1.0f + expf(-(bf2f(U[t * NU + C_GN + h * 3 + br]) + gb[h * 3 + br])));
    const float ref = gt[0] * oc + gt[1] * os + gt[2] * ow;
    dbg_put(F, id, fabsf(bf2f(((const bf16*)(F.ws + WS_CAT))[t * DM + 640 + h * 64 + d]) - ref) / (fabsf(ref) + 0.02f));
}
__device__ __forceinline__ void stat_mix(Frame& F, const float* x) {
    phase_begin(F); if (blockIdx.x >= 16) return;
    const unsigned h = (unsigned)dbg_sample(F, 777); const int row = h % TOK, col = (h >> 16) % DM;
    const float d = F.out[(size_t)row * DM + col] - x[(size_t)row * DM + col];
    atomicAdd((float*)(F.ctl + CW_DBG + 40), d * d);
    const float c = bf2f(((const bf16*)(F.ws + WS_CAT))[(size_t)row * DM + (col & 255)]);
    atomicAdd((float*)(F.ctl + CW_DBG + 41), c * c);
}
__device__ __forceinline__ void dbg_finish(Frame& F, int nchk) {
    if (blockIdx.x == 0 && F.tid == 0) { for (int i = 0; i < nchk; ++i) { const float e = __builtin_bit_cast(float, xb_ld((unsigned*)(F.ctl + CW_DBG + i))); if (!(e <= 0.05f)) { F.out[0] = 1000.f * (i + 1); return; } }
#ifdef DBG_STATOUT
        const float st = __builtin_bit_cast(float, xb_ld((unsigned*)(F.ctl + CW_DBG + DBG_STAT))) / 8192.f; F.out[0] = 1.0e5f * st;
#endif
    }
}
#ifdef DBG_ALL
#define DBGRUN(stmt) do { stmt; GRID_BAR(); } while (0)
#else
#define DBGRUN(stmt) do {} while (0)
#endif
#define DBGNEW(stmt) do { stmt; GRID_BAR(); } while (0)
#else
#define DBGNEW(stmt) do {} while (0)
#define DBGRUN(stmt) do {} while (0)
#endif

struct Args { const float* in[28]; float* out; unsigned char* ws; };
#ifndef PHM
#define PHM 0xffff
#endif
__device__ __forceinline__ void grid_bar(Frame& F) {
    XcdBarrier b_; b_.bar = (unsigned*)((gu32*)((unsigned char*)ARGP(29) + WS_CTL) + CW_BAR); b_.x = xb_xcc_id(); b_.st = (volatile LAS unsigned*)(F.lds + MISC_OFF) + 8; phase_begin(F); xcd_barrier(b_, F.tid);
}
#define GRID_BAR() grid_bar(F)

template <int L>
__device__ __forceinline__ void mixer_layer(Frame& F) {
    p_norm<false>(F, L == 0 ? ARGP(0) : (const float*)ARGP(28), ARGP(1) + (size_t)L * DM, nullptr);
    GRID_BAR();
    if (PHM & 1024) { phase_begin(F); SchedPlain S; S.init(TOK / 256, NU / 256, F.G, (int)blockIdx.x); S.lda2 = DM * 2; S.B = (const char*)(F.ws + WS_WIN) + (size_t)L * NU * DM * 2; S.btile = (size_t)256 * DM * 2;
      EpiInProj E{(bf16*)(F.ws + WS_U), (const f32x2*)(F.ws + WS_TABN), (const f32x2*)(F.ws + WS_TABM), (float*)(F.ws + WS_SSQ)};
      pg8::gemm_phase(F.tid, F.lds, (const char*)(F.ws + WS_XN), DM, 128u, (unsigned)DM, S, E);
#if DUP & 4
      GRID_BAR(); pg8::gemm_phase(F.tid, F.lds, (const char*)(F.ws + WS_XN), DM, 128u, (unsigned)DM, S, E);
#endif
    }
    GRID_BAR();
    DBGRUN(chk_u(F, 8 + 3 * L, ARGP(2) + (size_t)L * DM * IN_COLS));
    { phase_begin(F); SchedQKV S; S.init(TOK / 256, 6, F.G, (int)blockIdx.x); S.B = (const char*)(F.ws + WS_WQKV) + (size_t)L * 1536 * 384 * 2;
      EpiQKV E{(bf16*)(F.ws + WS_QM), (bf16*)(F.ws + WS_KVM), (const float*)(F.ws + WS_SSQ), (const f32x2*)(F.ws + WS_TABM)};
      pg8::gemm_phase(F.tid, F.lds, (const char*)(F.ws + WS_U) + C_QDN * 2, 384, 128u, 384u, S, E); }
    { phase_begin(F); SchedCmp S; S.init(32, 1, F.G, (int)blockIdx.x); S.B = (const char*)(F.ws + WS_WC1) + (size_t)L * 2 * 256 * 2048 * 2;
      EpiCmp E{(bf16*)(F.ws + WS_G1C), (const float*)(F.ws + WS_MISC + MS_CBIAS) + L * 256};
      pg8::gemm_phase(F.tid, F.lds, (const char*)(F.ws + WS_U), 2048, (unsigned)(NU * 2), 2048u, S, E); }
    if (PHM & 512) p_lru_local(F, 20 + L, ARGP(3) + (size_t)L * 1024, ARGP(4) + (size_t)L * 256, ARGP(5) + (size_t)L * 16384, ARGP(6) + (size_t)L * 256, ARGP(7) + (size_t)L * 16384, ARGP(8) + (size_t)L * 256, ARGP(9) + (size_t)L * 256);
    GRID_BAR();
#if DUP & 8
#if DUP & 256
    { phase_begin(F); SchedQKV S; S.init(TOK / 256, 6, F.G, (int)blockIdx.x); S.B = (const char*)(F.ws + WS_WQKV) + (size_t)L * 1536 * 384 * 2;
      EpiQKV E{(bf16*)(F.ws + WS_QM), (bf16*)(F.ws + WS_KVM), (const float*)(F.ws + WS_SSQ), (const f32x2*)(F.ws + WS_TABM)};
      pg8::gemm_phase(F.tid, F.lds, (const char*)(F.ws + WS_U) + C_QDN * 2, 384, 128u, 384u, S, E); }
#endif
#if DUP & 512
    { phase_begin(F); SchedCmp S; S.init(32, 1, F.G, (int)blockIdx.x); S.B = (const char*)(F.ws + WS_WC1) + (size_t)L * 2 * 256 * 2048 * 2;
      EpiCmp E{(bf16*)(F.ws + WS_G1C), (const float*)(F.ws + WS_MISC + MS_CBIAS) + L * 256};
      pg8::gemm_phase(F.tid, F.lds, (const char*)(F.ws + WS_U), 2048, (unsigned)(NU * 2), 2048u, S, E); }
#endif
#if DUP & 1024
    if (PHM & 512) p_lru_local(F, 20 + L, ARGP(3) + (size_t)L * 1024, ARGP(4) + (size_t)L * 256, ARGP(5) + (size_t)L * 16384, ARGP(6) + (size_t)L * 256, ARGP(7) + (size_t)L * 16384, ARGP(8) + (size_t)L * 256, ARGP(9) + (size_t)L * 256);
#endif
    GRID_BAR();
#endif
    if (PHM & 8192) p_lru_carry(F);
    p_cmp2(F, ARGP(16) + (size_t)L * 2 * 128 * 64);
    phase_begin(F); unit_publish(F, CW_FLAG + 512 + L);
#if DUP & 64
    if (PHM & 8192) p_lru_carry(F);
    p_cmp2(F, ARGP(16) + (size_t)L * 2 * 128 * 64);
    GRID_BAR();
#endif
    DBGRUN(chk_qkv(F, 16 + L, ARGP(10) + L * 192, ARGP(11) + (size_t)L * 192 * 576, ARGP(12) + L * 128, ARGP(13) + (size_t)L * 128 * 768));
    DBGNEW(chk_kc(F, 20 + L, ARGP(14) + (size_t)L * 4096, ARGP(15) + (size_t)L * 2 * 2048 * 128, ARGP(16) + (size_t)L * 2 * 128 * 64));
    p_attn1(F, 2 * L, ARGP(17) + L * 18);
#if DUP & 3
    GRID_BAR();
#endif
#if DUP & 1
    p_attn1(F, 4 + 2 * L, ARGP(17) + L * 18); GRID_BAR();
#endif
#ifdef ATTVAR
    p_attn2<ATTVAR>(F, 4 + 2 * L + 1, ARGP(17) + L * 18); GRID_BAR();
#endif
    p_attn2<0>(F, 2 * L + 1, ARGP(17) + L * 18);
#if DUP & 2
    GRID_BAR(); p_attn2<0>(F, 4 + 2 * L + 1, ARGP(17) + L * 18);
#endif
    if (PHM & 16384) p_lru_fix(F, 1024);
    GRID_BAR();
    DBGRUN(chk_mla(F, 18 + L));
    DBGNEW(chk_nsa(F, 22 + 2 * L, ARGP(17) + L * 18));
    DBGRUN(chk_lru(F, 9 + 3 * L, ARGP(3) + (size_t)L * 1024, ARGP(4) + (size_t)L * 256, ARGP(5) + (size_t)L * 16384, ARGP(6) + (size_t)L * 256, ARGP(7) + (size_t)L * 16384, ARGP(8) + (size_t)L * 256, ARGP(9) + (size_t)L * 256));
    DBGRUN(chk_lru_rec(F, 14 + L, ARGP(3) + (size_t)L * 1024, ARGP(4) + (size_t)L * 256, ARGP(5) + (size_t)L * 16384, ARGP(6) + (size_t)L * 256, ARGP(7) + (size_t)L * 16384, ARGP(8) + (size_t)L * 256, ARGP(9) + (size_t)L * 256));
    if (PHM & 32768) { phase_begin(F); SchedPlain S; S.init(TOK / 256, DM / 256, F.G, (int)blockIdx.x); S.lda2 = DM * 2; S.B = (const char*)(F.ws + WS_WOUT) + (size_t)L * DM * DM * 2; S.btile = (size_t)256 * DM * 2;
      EpiResF32 E{L == 0 ? ARGP(0) : (const float*)F.out, F.out, DM, ALPHA_MIX};
      pg8::gemm_phase(F.tid, F.lds, (const char*)(F.ws + WS_CAT), DM, 128u, (unsigned)DM, S, E); }
    GRID_BAR();
    if (L == 0) DBGRUN(chk_outproj(F, 10, ARGP(0), ARGP(18)));
    if (L == 0) DBGRUN(stat_mix(F, ARGP(0)));
}
__device__ __forceinline__ void ffn_dense(Frame& F) {
    p_norm<false>(F, (const float*)ARGP(28), ARGP(19), nullptr);
    GRID_BAR();
    DBGRUN(chk_xn(F, 0, F.out, ARGP(19)));
#ifdef GEMMPROBE
    { phase_begin(F); SchedPlain S; S.init(TOK / 256, 2 * DFF / 256, F.G, (int)blockIdx.x); S.lda2 = DM * 2; S.B = (const char*)(F.ws + WS_WGU); S.btile = (size_t)256 * DM * 2;
#if GEMMPROBE == 1
      EpiNull E{};
#else
      EpiSwiGLU E{(bf16*)(F.ws + WS_H), DFF};
#endif
      pg8::gemm_phase(F.tid, F.lds, (const char*)(F.ws + WS_XN), DM, 128u, (unsigned)DM, S, E); GRID_BAR(); }
#endif
    if (PHM & 8) { phase_begin(F); SchedPlain S; S.init(TOK / 256, 2 * DFF / 256, F.G, (int)blockIdx.x); S.lda2 = DM * 2; S.B = (const char*)(F.ws + WS_WGU); S.btile = (size_t)256 * DM * 2;
      EpiSwiGLU E{(bf16*)(F.ws + WS_H), DFF};
      pg8::gemm_phase(F.tid, F.lds, (const char*)(F.ws + WS_XN), DM, 128u, (unsigned)DM, S, E);
#if DUP & 16
      GRID_BAR(); pg8::gemm_phase(F.tid, F.lds, (const char*)(F.ws + WS_XN), DM, 128u, (unsigned)DM, S, E);
#endif
    }
    GRID_BAR();
    DBGRUN(chk_ffn_up(F, 1, ARGP(20), ARGP(21)));
    if (PHM & 16) { phase_begin(F); SchedPlain S; S.init(TOK / 256, DM / 256, F.G, (int)blockIdx.x); S.lda2 = DFF * 2; S.B = (const char*)(F.ws + WS_WD); S.btile = (size_t)256 * DFF * 2;
      EpiResF32 E{F.out, F.out, DM, ALPHA_FFN};
      pg8::gemm_phase(F.tid, F.lds, (const char*)(F.ws + WS_H), DFF, 128u, (unsigned)DFF, S, E); }
    GRID_BAR();
}
__device__ __forceinline__ void ffn_moe(Frame& F) {
    p_norm<true>(F, (const float*)ARGP(28), ARGP(19) + DM, ARGP(23));
    GRID_BAR();
    DBGRUN(chk_xn(F, 3, F.out, ARGP(19) + DM));
    if (PHM & 32) p_scatter(F);
    GRID_BAR();
    DBGRUN(chk_route(F, 4, F.out, ARGP(19) + DM, ARGP(23)));
    if (PHM & 64) { phase_begin(F); const int* ebase = (const int*)(F.ws + WS_MISC + MS_EBASE); const int ntiles = __builtin_amdgcn_readfirstlane(ebase[8]);
      SchedMoeUp S; S.init(ntiles, 2 * DFE / 256, F.G, (int)blockIdx.x); S.lda2 = DM * 2; S.B = (const char*)(F.ws + WS_MWGU); S.btile = (size_t)256 * DM * 2; S.bexp = (size_t)2 * DFE * DM * 2;
      S.rowlist = (const int*)(F.ws + WS_MISC + MS_ROWLIST); S.ebase = ebase;
      EpiSwiGLU E{(bf16*)(F.ws + WS_H), DFE};
      pg8::gemm_phase(F.tid, F.lds, (const char*)(F.ws + WS_XN), DM, 128u, (unsigned)DM, S, E);
#if DUP & 16
      GRID_BAR(); pg8::gemm_phase(F.tid, F.lds, (const char*)(F.ws + WS_XN), DM, 128u, (unsigned)DM, S, E);
#endif
    }
    GRID_BAR();
    DBGRUN(chk_moe_up(F, 6, ARGP(24), ARGP(25)));
    if (PHM & 128) { phase_begin(F); const int* ebase = (const int*)(F.ws + WS_MISC + MS_EBASE); const int ntiles = __builtin_amdgcn_readfirstlane(ebase[8]);
      SchedMoeDown S; S.init(ntiles, DM / 256, F.G, (int)blockIdx.x); S.lda2 = DFE * 2; S.B = (const char*)(F.ws + WS_MWD); S.btile = (size_t)256 * DFE * 2; S.bexp = (size_t)DM * DFE * 2; S.ebase = ebase;
      EpiBf16Plain E{(bf16*)(F.ws + WS_Y), DM};
      pg8::gemm_phase(F.tid, F.lds, (const char*)(F.ws + WS_H), DFE, 128u, (unsigned)DFE, S, E); }
    GRID_BAR();
    DBGRUN(chk_moe_down(F, 7, ARGP(26)));
}

__global__ void __launch_bounds__(NTHR, 2) mk_fwd(Args args) {
    extern __shared__ __attribute__((aligned(16))) unsigned char lds[];
    Frame F;
    F.lds = (LAS unsigned char*)lds;
    F.MISC = (volatile LAS unsigned*)(F.lds + MISC_OFF);
    F.wv = __builtin_amdgcn_readfirstlane((int)threadIdx.x >> 6);
    phase_begin(F);
    for (int u = F.tid; u < (LDS_BYTES - RING_BYTES) / 4; u += NTHR) ((LAS unsigned*)(F.lds + RING_BYTES))[u] = 0u;
    __syncthreads();
    (void)xcd_barrier_post((unsigned*)(F.ctl + CW_BAR), F.MISC + 8, F.wv == 0);

    F.trbase = 0;
    if (PHM & 1) p_prologue_ffn(F, ARGP(20), ARGP(21), ARGP(22), ARGP(24), ARGP(25), ARGP(26));
    if (PHM & 2048) p_prologue_mix(F, ARGP(2), ARGP(18));
    p_prologue_qkv(F, ARGP(10), ARGP(11), ARGP(12), ARGP(13));
    p_prologue_cmp(F, ARGP(15));
    p_cmp_bias(F, ARGP(14), ARGP(15));
#if DUP & 32
    GRID_BAR();
    p_prologue_ffn(F, ARGP(20), ARGP(21), ARGP(22), ARGP(24), ARGP(25), ARGP(26)); p_prologue_mix(F, ARGP(2), ARGP(18)); p_prologue_qkv(F, ARGP(10), ARGP(11), ARGP(12), ARGP(13)); p_prologue_cmp(F, ARGP(15));
#endif
    if (PHM & 4096) p_tables(F);
    GRID_BAR();

    mixer_layer<0>(F);
    ffn_dense(F);
    mixer_layer<1>(F);
    ffn_moe(F);

    phase_begin(F);
    if (xb_ld((unsigned*)(F.ctl + CW_BAR) + XB_TMO) != 0u) p_nan_rows(F);
    else if (PHM & 256) p_combine_final(F, ARGP(27));
#ifdef DBG
    GRID_BAR(); dbg_finish(F, 26);
#endif
}

extern "C" void kernel_launch(void* const* d_in, const int* in_sizes, int n_in, void* d_out, int out_size, void* d_ws, size_t ws_size, hipStream_t stream) {
    static int grid = 0;
    if (grid == 0) {
        if (n_in != 28 || in_sizes[0] != TOK * DM || out_size != TOK * DM || ws_size < WS_END) { fprintf(stderr, "kernel_launch: unexpected shapes (n_in %d, in0 %d, out %d, ws %zu)\n", n_in, n_in > 0 ? in_sizes[0] : -1, out_size, ws_size); grid = -1; return; }
        int dev = 0, cus = 0, per_cu = 0;
        if (hipGetDevice(&dev) != hipSuccess || hipDeviceGetAttribute(&cus, hipDeviceAttributeMultiprocessorCount, dev) != hipSuccess) { grid = -1; return; }
        if (hipFuncSetAttribute((const void*)mk_fwd, hipFuncAttributeMaxDynamicSharedMemorySize, LDS_BYTES) != hipSuccess) { fprintf(stderr, "kernel_launch: hipFuncSetAttribute failed\n"); grid = -1; return; }
        if (hipOccupancyMaxActiveBlocksPerMultiprocessor(&per_cu, (const void*)mk_fwd, NTHR, LDS_BYTES) != hipSuccess || per_cu < 1) fprintf(stderr, "kernel_launch: occupancy query reports %d\n", per_cu);
        (void)hipGetLastError();
        grid = cus;
    }
    if (grid < 0) return;
    if (hipMemsetAsync((char*)d_ws + WS_CTL, 0, CTL_ZERO_BYTES, stream) != hipSuccess) return;
    Args a{};
    for (int i = 0; i < 28; ++i) a.in[i] = (const float*)d_in[i];
    a.out = (float*)d_out; a.ws = (unsigned char*)d_ws;
    hipLaunchKernelGGL(mk_fwd, dim3(grid), dim3(NTHR), LDS_BYTES, stream, a);
}
```

```cpp
#include <hip/hip_runtime.h>
#include <cstdint>
#include <cstdio>
#ifndef DUP
#define DUP 0
#endif
#ifndef ALPHA_MOE
#define ALPHA_MOE 1.0f
#endif
#ifndef ALPHA_MIX
#define ALPHA_MIX 1.0f
#endif
#ifndef ALPHA_FFN
#define ALPHA_FFN 1.0f
#endif

#define GAS __attribute__((address_space(1)))
#define LAS __attribute__((address_space(3)))
typedef unsigned short bf16;
typedef unsigned v4u __attribute__((ext_vector_type(4)));
typedef unsigned v2u __attribute__((ext_vector_type(2)));
typedef float f32x4 __attribute__((ext_vector_type(4)));
typedef float f32x2 __attribute__((ext_vector_type(2)));
typedef short bf16x8 __attribute__((ext_vector_type(8)));
typedef GAS unsigned gu32;
typedef float f32x16 __attribute__((ext_vector_type(16)));
typedef short s16x4 __attribute__((ext_vector_type(4)));
__device__ __forceinline__ int crow(int r, int hi) { return (r & 3) + 8 * (r >> 2) + 4 * hi; }
#define RLX_AGENT __ATOMIC_RELAXED, __HIP_MEMORY_SCOPE_AGENT
#define LDS_WAIT() asm volatile("s_waitcnt lgkmcnt(0)" ::: "memory")
#define VM_WAIT() asm volatile("s_waitcnt vmcnt(0)" ::: "memory")

constexpr int NB = 4, SEQ = 8192, DM = 1024, TOK = NB * SEQ, DEPTH = 2;
constexpr int DFF = 2816, NEXP = 8, DFE = 1408;
constexpr float EPS = 1e-6f;
constexpr int NWAVES = 8, NTHR = 512;

constexpr size_t MiB = 1u << 20;
constexpr size_t WS_CTL = 0, CTL_ZERO_BYTES = 128 * 1024;
constexpr size_t WS_TABN = 1 * MiB, WS_TABM = 3 * MiB, WS_MISC = 4 * MiB, WS_LRU = 8 * MiB, WS_SSQ = 12 * MiB, WS_MASK = 14 * MiB, WS_KC = 15 * MiB, WS_G1C = 16 * MiB;
constexpr size_t WS_WIN = 18 * MiB, WS_WQKV = 26 * MiB, WS_WOUT = 29 * MiB, WS_WC1 = 33 * MiB, WS_WGU = 37 * MiB, WS_WD = 48 * MiB, WS_MWGU = 54 * MiB, WS_MWD = 98 * MiB;
constexpr size_t WS_XN = 120 * MiB, WS_CAT = 184 * MiB, WS_PQ = 248 * MiB, WS_U = 280 * MiB, WS_QM = 408 * MiB, WS_KVM = 444 * MiB, WS_END = 492 * MiB;
constexpr size_t WS_OC = WS_XN;
constexpr size_t WS_H = WS_U;
constexpr size_t WS_Y = WS_XN;
constexpr int MAXSLOT = 2 * TOK + NEXP * 256;
static_assert(WS_H + (size_t)MAXSLOT * DFE * 2 <= WS_END && WS_Y + (size_t)MAXSLOT * DM * 2 <= WS_U, "overlays");
constexpr size_t MS_ROUTE = 0;
constexpr size_t MS_TOKSLOT = 512 * 1024;
constexpr size_t MS_ROWLIST = 768 * 1024;
constexpr size_t MS_COUNTS = 1280 * 1024;
constexpr size_t MS_CBIAS = 1300 * 1024;
constexpr size_t MS_EBASE = 1296 * 1024;
constexpr int CW_TMO = 0, CW_BAR = 4096, CW_Q = 16384;

constexpr int NU = 2048, IN_COLS = 2034;
constexpr int C_XL = 0, C_YL = 256, C_QDN = 512, C_KVDN = 704, C_KPE = 832, C_QN = 864, C_KC = 1248, C_VC = 1376, C_KS = 1504, C_VS = 1632, C_KW = 1760, C_VW = 1888, C_GN = 2016;
constexpr float QSCALE_N = 0.125f * 1.4426950408889634f;
constexpr float QSCALE_M = 0.10206207261596575f * 1.4426950408889634f;
__device__ const float INV_N[32] = {1.0f, 0.7498942093324559f, 0.5623413251903491f, 0.4216965034285822f, 0.31622776601683794f, 0.23713737056616552f, 0.1778279410038923f, 0.1333521432163324f, 0.1f, 0.07498942093324558f, 0.05623413251903491f, 0.042169650342858224f, 0.03162277660168379f, 0.023713737056616554f, 0.01778279410038923f, 0.01333521432163324f, 0.01f, 0.007498942093324558f, 0.005623413251903491f, 0.004216965034285823f, 0.0031622776601683794f, 0.0023713737056616554f, 0.0017782794100389228f, 0.001333521432163324f, 0.001f, 0.0007498942093324559f, 0.0005623413251903491f, 0.00042169650342858224f, 0.00031622776601683794f, 0.00023713737056616554f, 0.00017782794100389227f, 0.0001333521432163324f};
__device__ const float INV_M[16] = {1.0f, 0.5623413251903491f, 0.31622776601683794f, 0.1778279410038923f, 0.1f, 0.05623413251903491f, 0.03162277660168379f, 0.01778279410038923f, 0.01f, 0.005623413251903491f, 0.0031622776601683794f, 0.0017782794100389228f, 0.001f, 0.0005623413251903491f, 0.00031622776601683794f, 0.00017782794100389227f};

constexpr int RING_BYTES = 131072, MISC_OFF = RING_BYTES + 320, LDS_BYTES = 147456;

typedef float cvf32x2_t __attribute__((ext_vector_type(2))); typedef __bf16 cvbf16x2_t __attribute__((ext_vector_type(2)));
__device__ __forceinline__ unsigned pk2(float lo, float hi) { const cvf32x2_t v = {lo, hi}; const cvbf16x2_t b = __builtin_convertvector(v, cvbf16x2_t); return __builtin_bit_cast(unsigned, b); }
__device__ __forceinline__ unsigned f2bf(float f) { return pk2(f, 0.0f) & 0xffffu; }
__device__ __forceinline__ float bf2f(unsigned short b) { return __builtin_bit_cast(float, (unsigned)b << 16); }
__device__ __forceinline__ float bflo(unsigned w) { return __builtin_bit_cast(float, w << 16); }
__device__ __forceinline__ float bfhi(unsigned w) { return __builtin_bit_cast(float, w & 0xffff0000u); }
template <int M> __device__ __forceinline__ unsigned xor_u(unsigned u) {
    if constexpr (M == 32) { auto r = __builtin_amdgcn_permlane32_swap(u, u, false, false);
        return (unsigned)r[0] ^ (unsigned)r[1] ^ u; }
    else return (unsigned)__builtin_amdgcn_ds_swizzle((int)u, (M << 10) | 0x1f);
}
template <int M> __device__ __forceinline__ float xor_f(float v) { return __builtin_bit_cast(float, xor_u<M>(__builtin_bit_cast(unsigned, v))); }
__device__ __forceinline__ float wave_sum(float v) {
    v += xor_f<1>(v); v += xor_f<2>(v); v += xor_f<4>(v); v += xor_f<8>(v); v += xor_f<16>(v); v += xor_f<32>(v);
    return v;
}

#define XB_TMO      128
#define XB_XCNT(j)  (256  + 64 * (j))
#define XB_XSUB(j)  (1280 + 64 * (j))
#define XB_XGEN(j)  (2304 + 64 * (j))
#define XB_TOP      3328
#define XB_TOPGEN   3392
#define XCD_BAR_WORDS 3456
#define XB_SPIN_CAP (1u << 18)
__device__ __forceinline__ unsigned xb_ld(unsigned* p)              { return __hip_atomic_load(p, __ATOMIC_RELAXED, __HIP_MEMORY_SCOPE_AGENT); }
__device__ __forceinline__ unsigned xb_add(unsigned* p, unsigned v) { return __hip_atomic_fetch_add(p, v, __ATOMIC_RELAXED, __HIP_MEMORY_SCOPE_AGENT); }
__device__ __forceinline__ unsigned xb_xcc_id() { return (unsigned)__builtin_amdgcn_s_getreg((3 << 11) | 20) & 0xFu; }
#define XB_SPIN(cond, bar) do { unsigned _sp = 0; while (cond) { __builtin_amdgcn_s_sleep(1); \
    if ((++_sp & 255u) == 0u) { if (xb_ld(&(bar)[XB_TMO])) break; if (_sp > XB_SPIN_CAP) { atomicAdd(&(bar)[XB_TMO], 1u); break; } } } } while (0)
struct XcdBarrier { unsigned* bar; unsigned x; volatile LAS unsigned* st; };
__device__ __forceinline__ XcdBarrier xcd_barrier_post(unsigned* bar, volatile LAS unsigned* st, const bool first_wave) {
    XcdBarrier b; b.bar = bar; b.x = xb_xcc_id(); b.st = st;
    if (st != nullptr && __builtin_amdgcn_mbcnt_hi(~0u, __builtin_amdgcn_mbcnt_lo(~0u, 0u)) == 0u && first_wave) (void)xb_add(&bar[XB_XCNT(b.x)], 1u);
    return b;
}
__device__ __forceinline__ void xcd_barrier_complete(unsigned* bar, unsigned x, unsigned& nloc, unsigned& nx) {
    const unsigned G = gridDim.x * gridDim.y * gridDim.z;
    unsigned sum, cnt, sp = 0u;
    for (;;) {
        sum = 0u; cnt = 0u;
#pragma unroll
        for (unsigned j = 0; j < 16; ++j) { const unsigned c = xb_ld(&bar[XB_XCNT(j)]); sum += c; cnt += (c > 0u) ? 1u : 0u; }
        if (sum == G) break;
        __builtin_amdgcn_s_sleep(1);
        if ((++sp & 255u) == 0u) { if (xb_ld(&bar[XB_TMO])) break; if (sp > XB_SPIN_CAP) { atomicAdd(&bar[XB_TMO], 1u); break; } }
    }
    const unsigned mine = xb_ld(&bar[XB_XCNT(x)]);
    nloc = mine > 0u ? mine : 1u; nx = cnt > 0u ? cnt : 1u;
}
__device__ __forceinline__ void xcd_barrier(const XcdBarrier& b, const int tid) {
    asm volatile("s_waitcnt vmcnt(0)" ::: "memory");
    __syncthreads();
    if (tid == 0) {
        unsigned* bar = b.bar; unsigned bx = b.x; asm volatile("" : "+s"(bx));
        __builtin_amdgcn_s_waitcnt(0);
        unsigned nloc = b.st[0], nx = b.st[1];
        if (nloc == 0u) { xcd_barrier_complete(bar, bx, nloc, nx); b.st[0] = nloc; b.st[1] = nx; }
        const unsigned old = xb_add(&bar[XB_XSUB(bx)], 1u);
        const unsigned gen = old / nloc;
        if (old + 1u == (gen + 1u) * nloc) {
            __builtin_amdgcn_fence(__ATOMIC_RELEASE, "agent");
            asm volatile("s_waitcnt vmcnt(0)" ::: "memory");
            const unsigned og = xb_add(&bar[XB_TOP], 1u);
            const unsigned tg = og / nx;
            if (og + 1u == (tg + 1u) * nx) xb_add(&bar[XB_TOPGEN], 1u);
            else XB_SPIN(xb_ld(&bar[XB_TOPGEN]) == tg, bar);
            __builtin_amdgcn_fence(__ATOMIC_ACQUIRE, "agent");
            xb_add(&bar[XB_XGEN(bx)], 1u);
            asm volatile("s_waitcnt vmcnt(0)" ::: "memory");
        } else {
            XB_SPIN(xb_ld(&bar[XB_XGEN(bx)]) == gen, bar);
            __builtin_amdgcn_fence(__ATOMIC_ACQUIRE, "agent");
            asm volatile("s_waitcnt vmcnt(0)" ::: "memory");
        }
    }
    __syncthreads();
}

namespace pg8 {
constexpr int BM = 256, BK = 64, HALF = 128, HTB = HALF * BK * 2, STAGE_BYTES = 8 * HTB, NXCD = 8, WGM = 8;
__host__ __device__ __forceinline__ int lds_byte(int r, int c) { const int st = (r >> 4) * 2 + (c >> 5), rr = r & 15, cc = c & 31, ob = rr * 64 + cc * 2; return st * 1024 + (ob ^ (((ob >> 9) & 1) << 5)); }
__host__ __device__ __forceinline__ void stage_rc(int b, int& R, int& C) { const int st = b / 1024, sb = b % 1024, swz = sb ^ (((sb >> 9) & 1) << 5); R = (st >> 1) * 16 + swz / 64; C = (st & 1) * 32 + (swz % 64) / 2; }
__host__ __device__ __forceinline__ int perm32(int rho) { const int n = rho >> 4, i = rho & 15; return 8 * (i >> 2) + 4 * n + (i & 3); }
struct Unit { int pm, pn; };
struct TileOrder {
    int nM, nN, nwg, G, c;
    __device__ __forceinline__ void init(int nM_, int nN_, int G_, int c_) { nM = nM_; nN = nN_; nwg = nM * nN; G = G_; c = c_; asm volatile("" : "+s"(c)); }
    __device__ __forceinline__ bool next(int i, Unit& u) const {
        const long L = (long)i * G + c; if (L >= nwg) return false;
        int wgid = (int)L; { const int q = nwg / NXCD, r = nwg % NXCD, xcd = wgid % NXCD, off = wgid / NXCD; wgid = (xcd < r ? xcd * (q + 1) : r * (q + 1) + (xcd - r) * q) + off; }
        const int nig = WGM * nN, gid = wgid / nig, fm = gid * WGM, gsz = (nM - fm) < WGM ? (nM - fm) : WGM;
        u.pm = fm + ((wgid % nig) % gsz); u.pn = (wgid % nig) / gsz; return true;
    }
};
__device__ __forceinline__ unsigned cvt_pk_bf16(float lo, float hi) { unsigned r; asm volatile("v_cvt_pk_bf16_f32 %0, %1, %2" : "=v"(r) : "v"(lo), "v"(hi)); return r; }

template <class Epi, class Sched>
__device__ __forceinline__ void gemm_phase(const int tid_in, LAS unsigned char* lds, const char* Abase, const int K, const unsigned kstepA, const unsigned ldb, const Sched& S, const Epi& E) {
    int tid = tid_in; asm volatile("" : "+v"(tid));
    const int wid = __builtin_amdgcn_readfirstlane(tid >> 6), lane = tid & 63, wr = wid >> 2, wc = wid & 3, fr = lane & 15, fq = lane >> 4;
    const int nt = K / BK;
    unsigned voffB[2];
#pragma unroll
    for (int i = 0; i < 2; ++i) { int R, C; stage_rc(tid * 16 + i * 8192, R, C); const int Rb = Epi::PERM ? ((R & ~31) + perm32(R & 31)) : R; voffB[i] = (unsigned)(Rb * ldb + C) * 2u; }
    const size_t hstepB = (size_t)HALF * ldb * 2;
    const unsigned kstepB = BK * 2;
    const unsigned ldsw = (unsigned)wid * 1024u;
    const int aoff = lds_byte(wr * 64 + fr, fq * 8), boff = lds_byte(wc * 32 + fr, fq * 8);
#define PG8_SA(b, h) (((b) * 2 + (h)) * HTB)
#define PG8_SB(b, h) ((4 + (b) * 2 + (h)) * HTB)
#define PG8_STAGE_B(bufoff, gbase) do { _Pragma("unroll") for (int _i = 0; _i < 2; ++_i) { unsigned _o = voffB[_i]; asm volatile("" : "+v"(_o)); \
        __builtin_amdgcn_global_load_lds((const unsigned*)((const char*)(gbase) + _o), (LAS unsigned*)(lds + (bufoff) + ldsw + _i * 8192), 16, 0, 0); } } while (0)
#define PG8_STAGE_A(bufoff, offs, ubase) do { _Pragma("unroll") for (int _i = 0; _i < 2; ++_i) { unsigned _o = (offs)[_i]; asm volatile("" : "+v"(_o)); \
        __builtin_amdgcn_global_load_lds((const unsigned*)((ubase) + _o), (LAS unsigned*)(lds + (bufoff) + ldsw + _i * 8192), 16, 0, 0); } } while (0)
#define PG8_LDA(dst, b, h) do { _Pragma("unroll") for (int m = 0; m < 4; ++m) _Pragma("unroll") for (int k = 0; k < 2; ++k) dst[m][k] = *(const LAS bf16x8*)(lds + PG8_SA(b, h) + aoff + m * 2048 + k * 1024); } while (0)
#define PG8_LDB(dst, b, h) do { _Pragma("unroll") for (int n = 0; n < 2; ++n) _Pragma("unroll") for (int k = 0; k < 2; ++k) dst[n][k] = *(const LAS bf16x8*)(lds + PG8_SB(b, h) + boff + n * 2048 + k * 1024); } while (0)
#define PG8_MMA(ai, bj, At, Bt) do { __builtin_amdgcn_s_setprio(1); _Pragma("unroll") for (int m = 0; m < 4; ++m) _Pragma("unroll") for (int n = 0; n < 2; ++n) _Pragma("unroll") for (int k = 0; k < 2; ++k) \
        acc[ai][bj][m][n] = __builtin_amdgcn_mfma_f32_16x16x32_bf16(Bt[n][k], At[m][k], acc[ai][bj][m][n], 0, 0, 0); __builtin_amdgcn_s_setprio(0); } while (0)
#define PG8_WAIT_V(n) asm volatile("s_waitcnt vmcnt(" #n ")" ::: "memory")
#define PG8_WAIT_L(n) asm volatile("s_waitcnt lgkmcnt(" #n ")" ::: "memory")
#define PG8_BAR __builtin_amdgcn_s_barrier()
#define PG8_SCHED __builtin_amdgcn_sched_barrier(0)
    Unit cur, nxt; int ui = 0;
    if (!S.next(0, cur)) return;
    f32x4 acc[2][2][4][2];
#pragma unroll
    for (int a = 0; a < 2; ++a)
#pragma unroll
        for (int b = 0; b < 2; ++b)
#pragma unroll
            for (int m = 0; m < 4; ++m)
#pragma unroll
                for (int n = 0; n < 2; ++n) acc[a][b][m][n] = (f32x4){0.f, 0.f, 0.f, 0.f};
    bf16x8 At[4][2], B0[2][2], B1[2][2];
    unsigned oA[2][2];
#define PG8_AOFF(dst, unit) do { _Pragma("unroll") for (int _h = 0; _h < 2; ++_h) _Pragma("unroll") for (int _i = 0; _i < 2; ++_i) { int _R, _C; stage_rc(tid * 16 + _i * 8192, _R, _C); \
        dst[_h][_i] = S.arow(unit, _h * HALF + _R) + (unsigned)_C * 2u; } } while (0)
    PG8_AOFF(oA, cur);
    const char* cB = S.bbase(cur);
    const char* cA0 = Abase + S.abase(cur, 0); const char* cA1 = Abase + S.abase(cur, 1);
    PG8_STAGE_B(PG8_SB(0, 0), cB); PG8_STAGE_B(PG8_SB(0, 1), cB + hstepB); PG8_STAGE_A(PG8_SA(0, 0), oA[0], cA0); PG8_STAGE_A(PG8_SA(0, 1), oA[1], cA1);
    if (wr == 1) PG8_BAR;
    PG8_WAIT_V(2); PG8_BAR;
    PG8_STAGE_B(PG8_SB(1, 0), cB + kstepB); PG8_STAGE_A(PG8_SA(1, 0), oA[0], cA0 + kstepA); PG8_STAGE_B(PG8_SB(1, 1), cB + hstepB + kstepB);
    PG8_WAIT_V(6); PG8_BAR;
    for (;;) {
        const bool has_next = S.next(ui + 1, nxt);
        const char* nB = has_next ? S.bbase(nxt) : cB;
        const char* nA0 = has_next ? Abase + S.abase(nxt, 0) : cA0; const char* nA1 = has_next ? Abase + S.abase(nxt, 1) : cA1;
        for (int t = 0; t < nt; t += 2) {
            const bool last = (t == nt - 2);
            const char* a1h1 = cA1 + (size_t)(t + 1) * kstepA;
            const char* a2h0 = last ? nA0 : cA0 + (size_t)(t + 2) * kstepA; const char* a2h1 = last ? nA1 : cA1 + (size_t)(t + 2) * kstepA;
            const char* b2 = last ? nB : cB + (size_t)(t + 2) * kstepB; const char* b3 = b2 + kstepB;
            unsigned nO[2][2];
#pragma unroll
            for (int h = 0; h < 2; ++h)
#pragma unroll
                for (int i = 0; i < 2; ++i) nO[h][i] = oA[h][i];
            if (last && has_next) PG8_AOFF(nO, nxt);
            PG8_LDB(B0, 0, 0); PG8_LDB(B1, 0, 1); PG8_SCHED; PG8_LDA(At, 0, 0); PG8_STAGE_A(PG8_SA(1, 1), oA[1], a1h1);
#pragma unroll
            for (int h = 0; h < 2; ++h)
#pragma unroll
                for (int i = 0; i < 2; ++i) oA[h][i] = nO[h][i];
            PG8_WAIT_V(8); PG8_WAIT_L(0); PG8_BAR; PG8_MMA(0, 0, At, B0); PG8_MMA(0, 1, At, B1); PG8_BAR; PG8_SCHED;
            PG8_LDA(At, 0, 1); PG8_STAGE_B(PG8_SB(0, 0), b2); PG8_STAGE_B(PG8_SB(0, 1), b2 + hstepB); PG8_STAGE_A(PG8_SA(0, 0), oA[0], a2h0);
            PG8_WAIT_V(8); PG8_WAIT_L(0); PG8_BAR; PG8_MMA(1, 0, At, B0); PG8_MMA(1, 1, At, B1); PG8_BAR; PG8_SCHED;
            PG8_LDB(B0, 1, 0); PG8_LDB(B1, 1, 1); PG8_SCHED; PG8_LDA(At, 1, 0); PG8_STAGE_A(PG8_SA(0, 1), oA[1], a2h1);
            PG8_WAIT_V(8); PG8_WAIT_L(0); PG8_BAR; PG8_MMA(0, 0, At, B0); PG8_MMA(0, 1, At, B1); PG8_BAR; PG8_SCHED;
            PG8_LDA(At, 1, 1); PG8_STAGE_B(PG8_SB(1, 0), b3); PG8_STAGE_B(PG8_SB(1, 1), b3 + hstepB); PG8_STAGE_A(PG8_SA(1, 0), oA[0], a2h0 + kstepA);
            PG8_WAIT_V(8); PG8_WAIT_L(0); PG8_BAR; PG8_MMA(1, 0, At, B0); PG8_MMA(1, 1, At, B1); PG8_BAR; PG8_SCHED;
        }
        if (wr == 0) PG8_BAR;
        E(acc, cur, wr, wc, fr, fq);
        if (!has_next) break;
#pragma unroll
        for (int a = 0; a < 2; ++a)
#pragma unroll
            for (int b = 0; b < 2; ++b)
#pragma unroll
                for (int m = 0; m < 4; ++m)
#pragma unroll
                    for (int n = 0; n < 2; ++n) acc[a][b][m][n] = (f32x4){0.f, 0.f, 0.f, 0.f};
        cur = nxt; cB = nB; cA0 = nA0; cA1 = nA1; ++ui;
        if (wr == 1) PG8_BAR;
    }
    PG8_WAIT_V(0);
    PG8_BAR;
#undef PG8_AOFF
#undef PG8_SA
#undef PG8_SB
#undef PG8_STAGE_A
#undef PG8_STAGE_B
#undef PG8_LDA
#undef PG8_LDB
#undef PG8_MMA
#undef PG8_WAIT_V
#undef PG8_WAIT_L
#undef PG8_BAR
#undef PG8_SCHED
}
}
using pg8::Unit;

typedef const float* cfptr_t;
__device__ __forceinline__ const float* ldarg(int i) {
    const unsigned long long v = (unsigned long long)(*(const volatile __attribute__((address_space(4))) cfptr_t*)((const __attribute__((address_space(4))) char*)__builtin_amdgcn_kernarg_segment_ptr() + 8 * i));
    const unsigned lo = __builtin_amdgcn_readfirstlane((unsigned)v), hi = __builtin_amdgcn_readfirstlane((unsigned)(v >> 32));
    return (const float*)(const GAS float*)(((unsigned long long)hi << 32) | lo);
}
#define ARGP(i) ldarg(i)

struct Frame {
    int trbase;
    LAS unsigned char* lds;
    volatile LAS unsigned* MISC;
    gu32* ctl;
    unsigned char* ws;
    int tid, lane, wave, G, vcu;
    int wv;
    float* out;
};

__device__ __forceinline__ void phase_begin(Frame& F) {
    unsigned z_ = 0u; asm volatile("" : "+v"(z_));
    int t = F.wv * 64 + (int)__builtin_amdgcn_mbcnt_hi(~0u, __builtin_amdgcn_mbcnt_lo(~0u, z_)); F.tid = t; F.lane = t & 63; F.wave = __builtin_amdgcn_readfirstlane(t >> 6);
    int g = gridDim.x, bx = blockIdx.x; asm volatile("" : "+s"(g), "+s"(bx)); F.G = g; F.vcu = (g % 8 == 0) ? (bx % 8) * (g / 8) + bx / 8 : bx;
    F.ws = (unsigned char*)ldarg(29); F.ctl = (gu32*)(F.ws + WS_CTL); F.out = (float*)ldarg(28);
}
struct SchedPlain : pg8::TileOrder {
    unsigned lda2; const char* B; size_t btile;
    __device__ __forceinline__ unsigned arow(const Unit&, int r) const { return (unsigned)(r & 127) * lda2; }
    __device__ __forceinline__ size_t abase(const Unit& u, int h) const { return (size_t)(u.pm * 256 + h * 128) * lda2; }
    __device__ __forceinline__ const char* bbase(const Unit& u) const { return B + (size_t)u.pn * btile; }
};
struct SchedMoeUp : pg8::TileOrder {
    unsigned lda2; const char* B; size_t btile, bexp; const int* rowlist; const int* ebase;
    __device__ __forceinline__ int expert(int pm) const { int e = 0;
#pragma unroll
        for (int j = 1; j < NEXP; ++j) e += (pm >= __builtin_amdgcn_readfirstlane(ebase[j])) ? 1 : 0; return e; }
    __device__ __forceinline__ unsigned arow(const Unit& u, int r) const { return (unsigned)rowlist[u.pm * 256 + r] * lda2; }
    __device__ __forceinline__ size_t abase(const Unit&, int) const { return 0; }
    __device__ __forceinline__ const char* bbase(const Unit& u) const { return B + (size_t)expert(u.pm) * bexp + (size_t)u.pn * btile; }
};
struct SchedMoeDown : pg8::TileOrder {
    unsigned lda2; const char* B; size_t btile, bexp; const int* ebase;
    __device__ __forceinline__ int expert(int pm) const { int e = 0;
#pragma unroll
        for (int j = 1; j < NEXP; ++j) e += (pm >= __builtin_amdgcn_readfirstlane(ebase[j])) ? 1 : 0; return e; }
    __device__ __forceinline__ unsigned arow(const Unit&, int r) const { return (unsigned)(r & 127) * lda2; }
    __device__ __forceinline__ size_t abase(const Unit& u, int h) const { return (size_t)(u.pm * 256 + h * 128) * lda2; }
    __device__ __forceinline__ const char* bbase(const Unit& u) const { return B + (size_t)expert(u.pm) * bexp + (size_t)u.pn * btile; }
};

__device__ __forceinline__ float silu_mul(float g, float u) { return g * u * __builtin_amdgcn_rcpf(1.0f + __builtin_amdgcn_exp2f(-1.4426950408889634f * g)); }
struct EpiSwiGLU {
    static constexpr bool PERM = true;
    bf16* O; int ldo;
    __device__ __forceinline__ void operator()(const f32x4 (&acc)[2][2][4][2], const Unit& u, int wr, int wc, int fr, int fq) const {
        const int row0 = u.pm * 256 + wr * 64 + fr, col0 = u.pn * 128 + wc * 32 + 8 * fq;
#pragma unroll
        for (int ai = 0; ai < 2; ++ai)
#pragma unroll
            for (int m = 0; m < 4; ++m) {
                const f32x4 g0 = acc[ai][0][m][0], g1 = acc[ai][0][m][1], u0 = acc[ai][1][m][0], u1 = acc[ai][1][m][1];
                v4u w;
                w.x = pg8::cvt_pk_bf16(silu_mul(g0[0], u0[0]), silu_mul(g0[1], u0[1])); w.y = pg8::cvt_pk_bf16(silu_mul(g0[2], u0[2]), silu_mul(g0[3], u0[3]));
                w.z = pg8::cvt_pk_bf16(silu_mul(g1[0], u1[0]), silu_mul(g1[1], u1[1])); w.w = pg8::cvt_pk_bf16(silu_mul(g1[2], u1[2]), silu_mul(g1[3], u1[3]));
                *(v4u*)(O + (size_t)(row0 + ai * 128 + m * 16) * ldo + col0) = w;
            }
    }
};
struct EpiNull {
    static constexpr bool PERM = true;
    __device__ __forceinline__ void operator()(const f32x4 (&acc)[2][2][4][2], const Unit&, int, int, int, int) const {
#pragma unroll
        for (int ai = 0; ai < 2; ++ai)
#pragma unroll
            for (int bj = 0; bj < 2; ++bj)
#pragma unroll
                for (int m = 0; m < 4; ++m) asm volatile("" :: "v"(acc[ai][bj][m][0]), "v"(acc[ai][bj][m][1]));
    }
};
struct EpiResF32 {
    static constexpr bool PERM = false;
    const float* base; float* out; int ldc; float alpha = 1.0f;
    __device__ __forceinline__ void operator()(const f32x4 (&acc)[2][2][4][2], const Unit& u, int wr, int wc, int fr, int fq) const {
        const int row0 = u.pm * 256 + wr * 64 + fr, col0 = u.pn * 256 + wc * 32 + 4 * fq;
#pragma unroll
        for (int ai = 0; ai < 2; ++ai)
#pragma unroll
            for (int m = 0; m < 4; ++m) { const size_t off = (size_t)(row0 + ai * 128 + m * 16) * ldc + col0;
#pragma unroll
                for (int bj = 0; bj < 2; ++bj)
#pragma unroll
                    for (int n = 0; n < 2; ++n) { const f32x4 b = *(const f32x4*)(base + off + bj * 128 + n * 16); *(f32x4*)(out + off + bj * 128 + n * 16) = b + acc[ai][bj][m][n] * alpha; } }
    }
};
struct EpiBf16Plain {
    static constexpr bool PERM = true;
    bf16* O; int ldo;
    __device__ __forceinline__ void operator()(const f32x4 (&acc)[2][2][4][2], const Unit& u, int wr, int wc, int fr, int fq) const {
        const int row0 = u.pm * 256 + wr * 64 + fr, col0 = u.pn * 256 + wc * 32 + 8 * fq;
#pragma unroll
        for (int ai = 0; ai < 2; ++ai)
#pragma unroll
            for (int m = 0; m < 4; ++m)
#pragma unroll
                for (int bj = 0; bj < 2; ++bj) { const f32x4 v0 = acc[ai][bj][m][0], v1 = acc[ai][bj][m][1]; v4u w;
                    w.x = pg8::cvt_pk_bf16(v0[0], v0[1]); w.y = pg8::cvt_pk_bf16(v0[2], v0[3]); w.z = pg8::cvt_pk_bf16(v1[0], v1[1]); w.w = pg8::cvt_pk_bf16(v1[2], v1[3]);
                    *(v4u*)(O + (size_t)(row0 + ai * 128 + m * 16) * ldo + col0 + bj * 128) = w; }
    }
};

template <class CM>
__device__ __forceinline__ void tr_item(const float* src, int srcN, int kofs, int kvalid, const float* kscale, bf16* dst, int dstK, int k0, int n0, const CM& cm, LAS float* scr, int lane) {
    const int col = cm(n0 + (lane & 31)); const int colc = col < 0 ? 0 : col;
    float v[32];
#pragma unroll
    for (int i = 0; i < 32; ++i) { const int ks = k0 + 2 * i + (lane >> 5) - kofs; const int ksc = ks < 0 ? 0 : (ks >= kvalid ? kvalid - 1 : ks); v[i] = src[(size_t)ksc * srcN + colc]; }
    if (kscale) {
#pragma unroll
        for (int i = 0; i < 32; ++i) { const int ks = k0 + 2 * i + (lane >> 5) - kofs; const int ksc = ks < 0 ? 0 : (ks >= kvalid ? kvalid - 1 : ks); v[i] *= kscale[ksc]; } }
#pragma unroll
    for (int i = 0; i < 32; ++i) { const int kk = 2 * i + (lane >> 5); const int ks = k0 + kk - kofs; scr[kk * 33 + (lane & 31)] = (col >= 0 && ks >= 0 && ks < kvalid) ? v[i] : 0.f; }
    LDS_WAIT(); asm volatile("" ::: "memory");
    const int c = lane & 7;
#pragma unroll
    for (int j = 0; j < 4; ++j) { const int n = (lane >> 3) + 8 * j; const LAS float* s = scr + (8 * c) * 33 + n;
        v4u o; o.x = pk2(s[0 * 33], s[1 * 33]); o.y = pk2(s[2 * 33], s[3 * 33]); o.z = pk2(s[4 * 33], s[5 * 33]); o.w = pk2(s[6 * 33], s[7 * 33]);
        *(GAS v4u*)(dst + (size_t)(n0 + n) * dstK + k0 + 8 * c) = o; }
    LDS_WAIT(); asm volatile("" ::: "memory");
}
struct CmQ { __device__ __forceinline__ int operator()(int j) const { if (j >= 576) return -1; const int hd = j / 96, w = j - hd * 96; if (w < 64) return j; const int w2 = w - 64, i = w2 >> 3, e = w2 & 7; return hd * 96 + 64 + (e < 4 ? 4 * i + e : 16 + 4 * i + (e - 4)); } };
struct CmIdent { int nvalid; __device__ __forceinline__ int operator()(int n) const { return n < nvalid ? n : -1; } };
struct CmGU { __device__ __forceinline__ int operator()(int n) const { return (n >> 8) * 128 + (n & 127); } };

template <class CM>
__device__ __forceinline__ void tr_job(Frame& F, const float* src, int srcN, int kofs, int kvalid, const float* kscale, bf16* dst, int dstK, int rows, const CM& cm) {
    LAS float* scr = (LAS float*)(F.lds + F.wave * 8704);
    const int gw = F.vcu * NWAVES + F.wave, NGW = F.G * NWAVES;
    const int nblk = rows / 32, nit = (dstK / 64) * nblk;
    int it0 = gw - F.trbase; it0 += it0 < 0 ? NGW : 0; F.trbase = (F.trbase + nit) % NGW;
    for (int it = it0; it < nit; it += NGW) { const int kb = it / nblk, nb = it % nblk; tr_item(src, srcN, kofs, kvalid, kscale, dst, dstK, 64 * kb, 32 * nb, cm, scr, F.lane); }
}
__device__ __forceinline__ void tr_job_gu(Frame& F, const float* srcG, const float* srcU, int srcN, bf16* dst, int dstK, int rows) {
    LAS float* scr = (LAS float*)(F.lds + F.wave * 8704);
    const int gw = F.vcu * NWAVES + F.wave, NGW = F.G * NWAVES;
    const int nblk = rows / 32, nit = (dstK / 64) * nblk; const CmGU cm;
    int it0 = gw - F.trbase; it0 += it0 < 0 ? NGW : 0; F.trbase = (F.trbase + nit) % NGW;
    for (int it = it0; it < nit; it += NGW) { const int kb = it / nblk, nb = it % nblk; const int n0 = 32 * nb;
        tr_item((n0 & 128) ? srcU : srcG, srcN, 0, dstK, nullptr, dst, dstK, 64 * kb, n0, cm, scr, F.lane); }
}

__device__ __forceinline__ void p_prologue_ffn(Frame& F, const float* fg, const float* fu, const float* fd, const float* mg, const float* mu, const float* md) {
    phase_begin(F);
    tr_job_gu(F, fg, fu, DFF, (bf16*)(F.ws + WS_WGU), DM, 2 * DFF);
    tr_job(F, fd, DM, 0, DFF, nullptr, (bf16*)(F.ws + WS_WD), DFF, DM, CmIdent{DM});
    for (int e = 0; e < NEXP; ++e) {
        tr_job_gu(F, mg + (size_t)e * DM * DFE, mu + (size_t)e * DM * DFE, DFE, (bf16*)(F.ws + WS_MWGU) + (size_t)e * 2 * DFE * DM, DM, 2 * DFE);
        tr_job(F, md + (size_t)e * DFE * DM, DM, 0, DFE, nullptr, (bf16*)(F.ws + WS_MWD) + (size_t)e * DM * DFE, DFE, DM, CmIdent{DM});
    }
}


__device__ __forceinline__ bool is_rope64(int c) { return (c >= C_QN && c < C_VC) || (c >= C_KS && c < C_VS) || (c >= C_KW && c < C_VW); }
struct CmInProj { __device__ __forceinline__ int operator()(int j) const {
    if (j >= IN_COLS) return -1;
    if (is_rope64(j)) { const int seg = j >= C_KW ? C_KW : j >= C_KS ? C_KS : j >= C_KC ? C_KC : C_QN; const int l = j - seg, hd = l >> 6, w = l & 63, i = w >> 3, e = w & 7; return seg + hd * 64 + (e < 4 ? 4 * i + e : 32 + 4 * i + (e - 4)); }
    if (j >= C_KPE && j < C_QN) { const int w = j - C_KPE, i = w >> 3, e = w & 7; return C_KPE + (e < 4 ? 4 * i + e : 16 + 4 * i + (e - 4)); }
    return j; } };

__device__ __forceinline__ void sincos_acc(double x, float& sn, float& cs) {
    const double kd = __builtin_rint(x * 0.63661977236758134308); const int k = (int)kd;
    const double r = ((x - kd * 1.57079632673412561417e+00) - kd * 6.07710050650619224932e-11) - kd * 2.02226624879595063154e-21, r2 = r * r;
    const double s = r * (1.0 + r2 * (-1.0 / 6 + r2 * (1.0 / 120 + r2 * (-1.0 / 5040 + r2 * (1.0 / 362880 + r2 * (-1.0 / 39916800 + r2 * (1.0 / 6227020800.0)))))));
    const double c = 1.0 + r2 * (-0.5 + r2 * (1.0 / 24 + r2 * (-1.0 / 720 + r2 * (1.0 / 40320 + r2 * (-1.0 / 3628800 + r2 * (1.0 / 479001600.0 + r2 * (-1.0 / 87178291200.0)))))));
    const int q = k & 3; sn = (float)(q == 0 ? s : q == 1 ? c : q == 2 ? -s : -c); cs = (float)(q == 0 ? c : q == 1 ? -s : q == 2 ? -c : s);
}
__device__ __forceinline__ void p_tables(Frame& F) {
    phase_begin(F);
    const int gt = F.vcu * NTHR + F.tid, NGT = F.G * NTHR;
    GAS f32x2* tn = (GAS f32x2*)(F.ws + WS_TABN); GAS f32x2* tm = (GAS f32x2*)(F.ws + WS_TABM);
    for (int e = gt; e < SEQ * 32; e += NGT) { const int pos = e >> 5, i = e & 31; float sn, cs; sincos_acc((double)((float)pos * INV_N[i]), sn, cs); tn[e] = (f32x2){cs, sn}; }
    for (int e = gt; e < SEQ * 16; e += NGT) { const int pos = e >> 4, i = e & 15; float sn, cs; sincos_acc((double)((float)pos * INV_M[i]), sn, cs); tm[e] = (f32x2){cs, sn}; }
}

struct EpiInProj {
    static constexpr bool PERM = true;
    bf16* U; const f32x2* tabn; const f32x2* tabm; float* ssq;
    __device__ __forceinline__ void operator()(const f32x4 (&acc)[2][2][4][2], const Unit& u, int wr, int wc, int fr, int fq) const {
        const int row0 = u.pm * 256 + wr * 64 + fr;
#pragma unroll
        for (int bj = 0; bj < 2; ++bj) {
            const int c32 = u.pn * 256 + bj * 128 + wc * 32;
            const int c8 = c32 + 8 * fq;
            if (is_rope64(c32)) {
                const int seg = c32 >= C_KW ? C_KW : c32 >= C_KS ? C_KS : c32 >= C_KC ? C_KC : C_QN;
                const int l = c8 - seg, hb = seg + (l & ~63), i = (l & 63) >> 3; const float sc = (seg == C_QN) ? QSCALE_N : 1.0f;
#pragma unroll
                for (int am = 0; am < 8; am += 2) {
                    f32x4 ta[2], tb[2];
#pragma unroll
                    for (int q = 0; q < 2; ++q) { const int pos = (row0 + ((am + q) >> 2) * 128 + ((am + q) & 3) * 16) & (SEQ - 1); const GAS f32x4* t = (const GAS f32x4*)(tabn + pos * 32 + 4 * i); ta[q] = t[0]; tb[q] = t[1]; }
#pragma unroll
                    for (int q = 0; q < 2; ++q) { const int ai = (am + q) >> 2, m = (am + q) & 3, row = row0 + ai * 128 + m * 16;
                        const f32x4 x1 = acc[ai][bj][m][0], x2 = acc[ai][bj][m][1]; const f32x4 t0 = ta[q], t1 = tb[q];
                        const float y10 = (x1[0] * t0[0] - x2[0] * t0[1]) * sc, y11 = (x1[1] * t0[2] - x2[1] * t0[3]) * sc, y12 = (x1[2] * t1[0] - x2[2] * t1[1]) * sc, y13 = (x1[3] * t1[2] - x2[3] * t1[3]) * sc;
                        const float y20 = (x2[0] * t0[0] + x1[0] * t0[1]) * sc, y21 = (x2[1] * t0[2] + x1[1] * t0[3]) * sc, y22 = (x2[2] * t1[0] + x1[2] * t1[1]) * sc, y23 = (x2[3] * t1[2] + x1[3] * t1[3]) * sc;
                        const auto s0 = __builtin_amdgcn_permlane16_swap(pg8::cvt_pk_bf16(y10, y11), pg8::cvt_pk_bf16(y20, y21), false, false);
                        const auto s1 = __builtin_amdgcn_permlane16_swap(pg8::cvt_pk_bf16(y12, y13), pg8::cvt_pk_bf16(y22, y23), false, false);
                        bf16* o = U + (size_t)row * NU + hb + 4 * i + ((fq & 1) ? 28 : 0);
                        *(v4u*)o = (v4u){s0[0], s1[0], s0[1], s1[1]}; }
                    asm volatile("" ::: "memory"); }
            } else if (c32 == C_KPE) {
                const int i = fq;
#pragma unroll
                for (int ai = 0; ai < 2; ++ai)
#pragma unroll
                    for (int m = 0; m < 4; ++m) { const int row = row0 + ai * 128 + m * 16, pos = row & (SEQ - 1);
                        const f32x4 x1 = acc[ai][bj][m][0], x2 = acc[ai][bj][m][1]; const GAS f32x4* t = (const GAS f32x4*)(tabm + pos * 16 + 4 * i);
                        const f32x4 t0 = t[0], t1 = t[1];
                        const float y10 = x1[0] * t0[0] - x2[0] * t0[1], y11 = x1[1] * t0[2] - x2[1] * t0[3], y12 = x1[2] * t1[0] - x2[2] * t1[1], y13 = x1[3] * t1[2] - x2[3] * t1[3];
                        const float y20 = x2[0] * t0[0] + x1[0] * t0[1], y21 = x2[1] * t0[2] + x1[1] * t0[3], y22 = x2[2] * t1[0] + x1[2] * t1[1], y23 = x2[3] * t1[2] + x1[3] * t1[3];
                        const auto s0 = __builtin_amdgcn_permlane16_swap(pg8::cvt_pk_bf16(y10, y11), pg8::cvt_pk_bf16(y20, y21), false, false);
                        const auto s1 = __builtin_amdgcn_permlane16_swap(pg8::cvt_pk_bf16(y12, y13), pg8::cvt_pk_bf16(y22, y23), false, false);
                        bf16* o = U + (size_t)row * NU + C_KPE + 4 * i + ((fq & 1) ? 12 : 0);
                        *(v4u*)o = (v4u){s0[0], s1[0], s0[1], s1[1]}; asm volatile("" ::: "memory"); }
            } else {
                const bool sq = (c32 >= C_QDN && c32 < C_KPE); const int grp = (c32 - C_QDN) >> 5;
#pragma unroll
                for (int ai = 0; ai < 2; ++ai)
#pragma unroll
                    for (int m = 0; m < 4; ++m) { const int row = row0 + ai * 128 + m * 16; const f32x4 v0 = acc[ai][bj][m][0], v1 = acc[ai][bj][m][1]; v4u w;
                        w.x = pg8::cvt_pk_bf16(v0[0], v0[1]); w.y = pg8::cvt_pk_bf16(v0[2], v0[3]); w.z = pg8::cvt_pk_bf16(v1[0], v1[1]); w.w = pg8::cvt_pk_bf16(v1[2], v1[3]);
                        *(v4u*)(U + (size_t)row * NU + c8) = w;
                        if (sq) { float q = (v0[0] * v0[0] + v0[1] * v0[1]) + (v0[2] * v0[2] + v0[3] * v0[3]) + (v1[0] * v1[0] + v1[1] * v1[1]) + (v1[2] * v1[2] + v1[3] * v1[3]);
                            q += xor_f<16>(q); q += xor_f<32>(q); if (fq == 0) ssq[(size_t)row * 16 + grp] = q; } }
            }
        }
    }
};

__device__ __forceinline__ float sigmoidf_(float x) { return __builtin_amdgcn_rcpf(1.0f + __expf(-x)); }
__device__ __forceinline__ float gelu_tanh(float y) { const float z = 0.7978845608028654f * (y + 0.044715f * y * y * y); const float t = 1.0f - 2.0f * __builtin_amdgcn_rcpf(1.0f + __expf(2.0f * z)); return 0.5f * y * (1.0f + t); }
__device__ __forceinline__ float one_minus_exp(float x) {
    const float p = -x * (1.0f + x * (0.5f + x * (0.16666667f + x * (0.041666668f + x * 0.0083333338f))));
    return (x > -0.125f) ? p : 1.0f - __expf(x); }
constexpr int LRU_XP = 264;
__device__ __forceinline__ int q_fetch(Frame& F, int qid);
__device__ __forceinline__ void p_lru_local(Frame& F, int qid, const float* cw, const float* cb, const float* wa, const float* ba, const float* wx, const float* bx, const float* lam) {
    phase_begin(F);
    const int d = F.tid & 255, half = F.tid >> 8;
    LAS bf16* xsb = (LAS bf16*)F.lds;
    LAS bf16* gts = (LAS bf16*)(F.lds + 64 * LRU_XP * 2);
    const bf16* U = (const bf16*)(F.ws + WS_U);
    bf16* P = (bf16*)(F.ws + WS_PQ); bf16* Q = P + (size_t)TOK * 256;
    float* SA = (float*)(F.ws + WS_LRU); float* SB = SA + 1024 * 256;
    const int r32 = F.lane & 31, hi = F.lane >> 5, gsel = F.wave >> 2, blk = F.wave & 3;
    bf16x8 bw[2][4];
    { const float* W = (gsel ? wx : wa) + (size_t)blk * 4096;
#pragma unroll
      for (int nt = 0; nt < 2; ++nt)
#pragma unroll
          for (int ks = 0; ks < 4; ++ks) { v4u w;
              const float* wp = W + (size_t)(16 * ks + 8 * hi) * 64 + 32 * nt + r32;
              w.x = pk2(wp[0], wp[64]); w.y = pk2(wp[128], wp[192]); w.z = pk2(wp[256], wp[320]); w.w = pk2(wp[384], wp[448]);
              bw[nt][ks] = __builtin_bit_cast(bf16x8, w); } }
    const float w0 = cw[d], w1 = cw[256 + d], w2 = cw[512 + d], w3 = cw[768 + d], cbd = cb[d], bad = ba[d], bxd = bx[d];
    const float sp = log1pf(__expf(-lam[d]));
    for (;;) {
        const int ch = q_fetch(F, qid); if (ch >= TOK / 64) break;
        const int t0 = ch * 64 + half * 32, pos0 = t0 & (SEQ - 1);
        float xm3 = 0.f, xm2 = 0.f, xm1 = 0.f;
        if (pos0 >= 3) { xm3 = bf2f(U[(size_t)(t0 - 3) * NU + C_XL + d]); xm2 = bf2f(U[(size_t)(t0 - 2) * NU + C_XL + d]); xm1 = bf2f(U[(size_t)(t0 - 1) * NU + C_XL + d]); }
        { float xv[32];
#pragma unroll
          for (int i = 0; i < 32; ++i) xv[i] = bf2f(U[(size_t)(t0 + i) * NU + C_XL + d]);
#pragma unroll
          for (int i = 0; i < 32; ++i) { const float x0 = xv[i]; const float v = cbd + w0 * xm3 + w1 * xm2 + w2 * xm1 + w3 * x0; xm3 = xm2; xm2 = xm1; xm1 = x0;
              xsb[(half * 32 + i) * LRU_XP + d] = (bf16)f2bf(v); } }
        __syncthreads();
#pragma unroll
        for (int mt = 0; mt < 2; ++mt) {
            f32x16 acc0 = f32x16{}, acc1 = f32x16{};
#pragma unroll
            for (int ks = 0; ks < 4; ++ks) { const bf16x8 a = *(const LAS bf16x8*)(xsb + (32 * mt + r32) * LRU_XP + 64 * blk + 16 * ks + 8 * hi);
                acc0 = __builtin_amdgcn_mfma_f32_32x32x16_bf16(a, bw[0][ks], acc0, 0, 0, 0); acc1 = __builtin_amdgcn_mfma_f32_32x32x16_bf16(a, bw[1][ks], acc1, 0, 0, 0); }
#pragma unroll
            for (int r = 0; r < 16; ++r) { const int tok = 32 * mt + crow(r, hi);
                gts[((size_t)gsel * 64 + tok) * 256 + 64 * blk + r32] = (bf16)f2bf(acc0[r]); gts[((size_t)gsel * 64 + tok) * 256 + 64 * blk + 32 + r32] = (bf16)f2bf(acc1[r]); }
        }
        __syncthreads();
        float h = 0.f, cum = 1.f;
        float y0 = bf2f(U[(size_t)t0 * NU + C_YL + d]), y1 = bf2f(U[(size_t)(t0 + 1) * NU + C_YL + d]);
#pragma unroll 2
        for (int i = 0; i < 32; ++i) {
            const float ycur = y0; y0 = y1; if (i + 2 < 32) y1 = bf2f(U[(size_t)(t0 + i + 2) * NU + C_YL + d]);
            const float ra = bad + bf2f(gts[(size_t)(half * 32 + i) * 256 + d]), ia = bxd + bf2f(gts[(size_t)(64 + half * 32 + i) * 256 + d]);
            const float xcv = bf2f(xsb[(half * 32 + i) * LRU_XP + d]);
            const float r = sigmoidf_(ra), ig = sigmoidf_(ia), la = -8.0f * r * sp, a = __expf(la), b = __builtin_amdgcn_sqrtf(one_minus_exp(2.0f * la)) * (ig * xcv);
            h = a * h + b; cum *= a;
            const float gl = gelu_tanh(ycur);
            P[(size_t)(t0 + i) * 256 + d] = (bf16)f2bf(h * gl); Q[(size_t)(t0 + i) * 256 + d] = (bf16)f2bf(cum * gl);
        }
        SA[(size_t)(ch * 2 + half) * 256 + d] = cum; SB[(size_t)(ch * 2 + half) * 256 + d] = h;
    }
}
__device__ __forceinline__ void p_lru_carry(Frame& F) {
    phase_begin(F);
    if (F.vcu >= NB || F.tid >= 256) return;
    const float* SA = (const float*)(F.ws + WS_LRU); const float* SB = SA + 1024 * 256; float* CY = (float*)(F.ws + WS_LRU) + 2 * 1024 * 256;
    const int d = F.tid; float c = 0.f;
    for (int k0 = 0; k0 < 256; k0 += 16) { float a[16], b[16];
#pragma unroll
        for (int i = 0; i < 16; ++i) { const size_t o = (size_t)(F.vcu * 256 + k0 + i) * 256 + d; a[i] = SA[o]; b[i] = SB[o]; }
#pragma unroll
        for (int i = 0; i < 16; ++i) { const size_t o = (size_t)(F.vcu * 256 + k0 + i) * 256 + d; CY[o] = c; c = a[i] * c + b[i]; } }
}
__device__ __forceinline__ void p_lru_fix(Frame& F, int zfrom) {
    phase_begin(F);
    const int gw = F.vcu * NWAVES + F.wave, NGW = F.G * NWAVES;
    const bf16* P = (const bf16*)(F.ws + WS_PQ); const bf16* Q = P + (size_t)TOK * 256; const float* CY = (const float*)(F.ws + WS_LRU) + 2 * 1024 * 256; bf16* CAT = (bf16*)(F.ws + WS_CAT);
    for (int m0 = gw; m0 < TOK; m0 += 4 * NGW) {
        v2u p[4], q[4]; f32x4 c[4];
#pragma unroll
        for (int i = 0; i < 4; ++i) { const int m = m0 + i * NGW; if (m < TOK) { p[i] = *((const GAS v2u*)(P + (size_t)m * 256) + F.lane); q[i] = *((const GAS v2u*)(Q + (size_t)m * 256) + F.lane);
            c[i] = *((const GAS f32x4*)(CY + (size_t)(m >> 5) * 256) + F.lane); } }
#pragma unroll
        for (int i = 0; i < 4; ++i) { const int m = m0 + i * NGW; if (m < TOK) {
            v2u o; o.x = pk2(bflo(p[i].x) + bflo(q[i].x) * c[i].x, bfhi(p[i].x) + bfhi(q[i].x) * c[i].y); o.y = pk2(bflo(p[i].y) + bflo(q[i].y) * c[i].z, bfhi(p[i].y) + bfhi(q[i].y) * c[i].w);
            *((GAS v2u*)(CAT + (size_t)m * DM) + F.lane) = o;
            { GAS v4u* z = (GAS v4u*)(CAT + (size_t)m * DM + zfrom); const int nz = (DM - zfrom) / 8;
#pragma unroll
              for (int j = 0; j < 2; ++j) { const int idx = F.lane + 64 * j; if (idx < nz) z[idx] = (v4u){0u, 0u, 0u, 0u}; } } } }
    }
}

__device__ __forceinline__ void p_prologue_mix(Frame& F, const float* w_in, const float* w_out) {
    phase_begin(F);
    for (int l = 0; l < DEPTH; ++l) {
        tr_job(F, w_in + (size_t)l * DM * IN_COLS, IN_COLS, 0, DM, nullptr, (bf16*)(F.ws + WS_WIN) + (size_t)l * NU * DM, DM, NU, CmInProj{});
        tr_job(F, w_out + (size_t)l * DM * DM, DM, 0, DM, nullptr, (bf16*)(F.ws + WS_WOUT) + (size_t)l * DM * DM, DM, DM, CmIdent{DM});
    }
}
__device__ __forceinline__ void p_prologue_cmp(Frame& F, const float* w1) {
    phase_begin(F);
    for (int ls = 0; ls < DEPTH * 2; ++ls) tr_job(F, w1 + (size_t)ls * 2048 * 128, 128, 0, 2048, nullptr, (bf16*)(F.ws + WS_WC1) + (size_t)ls * 256 * 2048, 2048, 256, CmIdent{128});
}
__device__ __forceinline__ void p_prologue_qkv(Frame& F, const float* qn, const float* wuq, const float* kvn, const float* wukv) {
    phase_begin(F);
    for (int l = 0; l < DEPTH; ++l) {
        bf16* W = (bf16*)(F.ws + WS_WQKV) + (size_t)l * 1536 * 384;
        tr_job(F, wuq + (size_t)l * 192 * 576, 576, 0, 192, qn + l * 192, W, 384, 768, CmQ{});
        tr_job(F, wukv + (size_t)l * 128 * 768, 768, 192, 128, kvn + l * 128, W + (size_t)768 * 384, 384, 768, CmIdent{768});
    }
}

enum { AM_CAUSAL = 0, AM_WINDOW = 1, AM_SELECT = 2, AM_CMP = 3 };
constexpr int NSA_WIN = 512;
template <int DK, int NSUB = 1> struct AttnLds { static constexpr int KP = DK + 8, KT = 64 * KP * 2, KBYTES = NSUB * KT, VBYTES = NSUB * 8192, BUF = KBYTES + VBYTES; };
struct SrcMla { const bf16* kvm; const bf16* u; int h; size_t base;
    __device__ __forceinline__ const bf16* kp(int key, int c) const { return c < 8 ? kvm + (base + key) * 768 + h * 128 + 8 * c : u + (base + key) * NU + C_KPE + 8 * (c - 8); }
    __device__ __forceinline__ const bf16* vp(int key, int c) const { return kvm + (base + key) * 768 + h * 128 + 64 + 8 * c; }
    __device__ __forceinline__ unsigned koff(int key, int c) const { return c < 8 ? (unsigned)WS_KVM + ((unsigned)base + key) * 1536u + h * 256 + 16 * c : (unsigned)WS_U + ((unsigned)base + key) * (NU * 2u) + (C_KPE + 8 * (c - 8)) * 2; }
    __device__ __forceinline__ unsigned kstride(int c) const { return c < 8 ? 1536u : NU * 2u; }
    __device__ __forceinline__ unsigned voff(int key, int c) const { return (unsigned)WS_KVM + ((unsigned)base + key) * 1536u + h * 256 + 128 + 16 * c; }
    __device__ __forceinline__ unsigned vstride() const { return 1536u; } };
struct SrcU { const bf16* u; int kcol, vcol; size_t base;
    __device__ __forceinline__ const bf16* kp(int key, int c) const { return u + (base + key) * NU + kcol + 8 * c; }
    __device__ __forceinline__ const bf16* vp(int key, int c) const { return u + (base + key) * NU + vcol + 8 * c; }
    __device__ __forceinline__ unsigned koff(int key, int c) const { return (unsigned)WS_U + ((unsigned)base + key) * (NU * 2u) + (kcol + 8 * c) * 2; }
    __device__ __forceinline__ unsigned kstride(int) const { return NU * 2u; }
    __device__ __forceinline__ unsigned voff(int key, int c) const { return (unsigned)WS_U + ((unsigned)base + key) * (NU * 2u) + (vcol + 8 * c) * 2; }
    __device__ __forceinline__ unsigned vstride() const { return NU * 2u; } };
struct SrcCmp { const bf16* kc; const bf16* vc; unsigned kc0, vc0;
    __device__ __forceinline__ const bf16* kp(int key, int c) const { return kc + key * 64 + 8 * c; }
    __device__ __forceinline__ const bf16* vp(int key, int c) const { return vc + key * 64 + 8 * c; }
    __device__ __forceinline__ unsigned koff(int key, int c) const { return kc0 + key * 128 + 16 * c; }
    __device__ __forceinline__ unsigned kstride(int) const { return 128u; }
    __device__ __forceinline__ unsigned voff(int key, int c) const { return vc0 + key * 128 + 16 * c; }
    __device__ __forceinline__ unsigned vstride() const { return 128u; } };

template <int DK, int MODE, int NSUB, int VAR = 0, class Src>
__device__ __forceinline__ void attn_branch(Frame& F, LAS unsigned char* lds, const Src& src, const bf16x8 (&qf)[DK / 16], int qpos0w, int jlo, int jhi, const v4u selmask, f32x16 (&o)[2], float& m_out, float& l_out) {
    typedef AttnLds<DK, NSUB> L;
    const int tid = F.tid, lane = F.lane, r32 = lane & 31, hi = lane >> 5;
    const int qpos = qpos0w + r32;
    o[0] = f32x16{}; o[1] = f32x16{};
    float m = -1.0e30f, l = 0.f;
    f32x16 lacc_unused = f32x16{};
    const bf16x8 ones = (bf16x8){(short)0x3f80, (short)0x3f80, (short)0x3f80, (short)0x3f80, (short)0x3f80, (short)0x3f80, (short)0x3f80, (short)0x3f80};
    constexpr int KC = DK / 8, NKP = NSUB * 64 * KC, NPT = (NKP + 511) / 512; constexpr bool KEXACT = (NKP % 512) == 0;
    const int vkey = tid >> 3, vc = tid & 7;
    const GAS unsigned char* wsb = (const GAS unsigned char*)F.ws;
    unsigned kl[NPT], kst[NPT], vl[NSUB];
#pragma unroll
    for (int i = 0; i < NPT; ++i) { const int p_ = tid + 512 * i; kl[i] = src.koff(p_ / KC, p_ % KC); kst[i] = src.kstride(p_ % KC); }
#pragma unroll
    for (int i = 0; i < NSUB; ++i) vl[i] = src.voff(64 * i + vkey, vc);
    v4u kr[NPT], vr[NSUB];
#define AT_LOAD(jm_) do { const unsigned kb_ = (unsigned)((jm_) * (NSUB * 64)); \
        _Pragma("unroll") for (int i_ = 0; i_ < NPT; ++i_) { const int p_ = tid + 512 * i_; if (KEXACT || i_ + 1 < NPT || p_ < NKP) kr[i_] = *(const GAS v4u*)(wsb + (size_t)(kl[i_] + kb_ * kst[i_])); } \
        _Pragma("unroll") for (int i_ = 0; i_ < NSUB; ++i_) vr[i_] = *(const GAS v4u*)(wsb + (size_t)(vl[i_] + kb_ * src.vstride())); } while (0)
#define AT_WRITE(buf) do { LAS unsigned char* b_ = lds + (buf) * L::BUF; \
        _Pragma("unroll") for (int i_ = 0; i_ < NPT; ++i_) { const int p_ = tid + 512 * i_; if (KEXACT || i_ + 1 < NPT || p_ < NKP) *(LAS v4u*)(b_ + (p_ / KC) * (L::KP * 2) + (p_ % KC) * 16) = kr[i_]; } \
        _Pragma("unroll") for (int i_ = 0; i_ < NSUB; ++i_) *(LAS v4u*)(b_ + L::KBYTES + i_ * 8192 + (vc >> 2) * 4096 + vkey * 64 + (vc & 3) * 16) = vr[i_]; } while (0)
    const int mlo = jlo / NSUB, mhi = jhi / NSUB;
    if (jlo <= jhi) { AT_LOAD(mlo); AT_WRITE(0); }
    __syncthreads();
    if (F.wave & 1) __builtin_amdgcn_s_setprio(3);
    int cur = 0;
    for (int jm = mlo; jm <= mhi; ++jm) {
        if (jm < mhi) AT_LOAD(jm + 1);
#pragma unroll
      for (int sub = 0; sub < NSUB; ++sub) {
        const int j = jm * NSUB + sub;
        const int kb = j * 64;
        bool need, part, lanesel = true;
        if (MODE == AM_CAUSAL)      { need = kb <= qpos0w + 31; part = kb + 63 > qpos0w; }
        else if (MODE == AM_WINDOW) { need = (kb <= qpos0w + 31) && (kb + 63 > qpos0w - NSA_WIN); part = (kb + 63 > qpos0w) || (kb <= qpos0w + 31 - NSA_WIN); }
        else if (MODE == AM_SELECT) { const unsigned w = (j < 32) ? selmask.x : (j < 64) ? selmask.y : (j < 96) ? selmask.z : selmask.w; lanesel = (w >> (j & 31)) & 1u;
                                      need = __any(lanesel) && kb <= qpos0w + 31; part = kb + 63 > qpos0w; }
        else                        { need = (16 * kb + 31) <= qpos0w + 31; part = (16 * (kb + 63) + 31 > qpos0w) || (kb + 63 > 510); }
        if (NSUB > 1) need = need && j >= jlo && j <= jhi;
        if (need) {
            const LAS unsigned char* kb_l = lds + cur * L::BUF + sub * L::KT; const LAS unsigned char* vb_l = lds + cur * L::BUF + L::KBYTES + sub * 8192;
            f32x16 p0 = f32x16{}, p1 = f32x16{};
#pragma unroll
            for (int ks = 0; ks < DK / 16; ++ks) {
                const bf16x8 k0 = *(const LAS bf16x8*)(kb_l + r32 * (L::KP * 2) + ks * 32 + hi * 16);
                const bf16x8 k1 = (VAR == 6) ? k0 : *(const LAS bf16x8*)(kb_l + (32 + r32) * (L::KP * 2) + ks * 32 + hi * 16);
                p0 = __builtin_amdgcn_mfma_f32_32x32x16_bf16(k0, qf[ks], p0, 0, 0, 0);
                p1 = __builtin_amdgcn_mfma_f32_32x32x16_bf16(k1, qf[ks], p1, 0, 0, 0);
            }
            s16x4 vlo[2][4], vhh[2][4];
            { const int li = lane & 15, dhalf = (lane >> 4) & 1;
              const LAS unsigned char* vbase = vb_l + (4 * hi + (li >> 2)) * 64 + (16 * dhalf + 4 * (li & 3)) * 2;
#pragma unroll
              for (int db = 0; db < 2; ++db)
#pragma unroll
                  for (int s4 = 0; s4 < 4; ++s4) {
                      vlo[db][s4] = __builtin_bit_cast(s16x4, __builtin_amdgcn_ds_read_tr16_b64_v4i16((LAS s16x4*)(vbase + db * 4096 + s4 * 1024)));
                      vhh[db][s4] = __builtin_bit_cast(s16x4, __builtin_amdgcn_ds_read_tr16_b64_v4i16((LAS s16x4*)(vbase + db * 4096 + s4 * 1024 + 512))); } }
            __builtin_amdgcn_sched_barrier(0);
            if (part) {
                const float NEG = -INFINITY;
                if (MODE == AM_WINDOW) {
                    if (kb + 63 > qpos0w) { const int lim = qpos - kb - 4 * hi;
#pragma unroll
                        for (int r = 0; r < 16; ++r) { const int c = (r & 3) + 8 * (r >> 2); if (!(lim >= c)) p0[r] = NEG; if (!(lim >= c + 32)) p1[r] = NEG; } }
                    if (kb <= qpos0w + 31 - NSA_WIN) { const int lim = qpos - NSA_WIN - kb - 4 * hi;
#pragma unroll
                        for (int r = 0; r < 16; ++r) { const int c = (r & 3) + 8 * (r >> 2); if (!(lim < c)) p0[r] = NEG; if (!(lim < c + 32)) p1[r] = NEG; } }
                } else {
                    int lim;
                    if (MODE == AM_CMP) { const int nl = (qpos - 31) >> 4; lim = (nl < 510 ? nl : 510) - kb - 4 * hi; }
                    else lim = qpos - kb - 4 * hi;
#pragma unroll
                    for (int r = 0; r < 16; ++r) { const int c = (r & 3) + 8 * (r >> 2); if (!(lim >= c)) p0[r] = NEG; if (!(lim >= c + 32)) p1[r] = NEG; }
                }
            }
            float mxa = __builtin_fmaxf(__builtin_fmaxf(p0[0], p0[1]), p1[0]), mxc = __builtin_fmaxf(__builtin_fmaxf(p0[2], p0[3]), p1[1]); mxa = __builtin_fmaxf(__builtin_fmaxf(mxa, p1[2]), p1[3]);
#pragma unroll
            for (int r = 4; r < 16; r += 4) { mxa = __builtin_fmaxf(__builtin_fmaxf(mxa, p0[r]), p0[r + 1]); mxc = __builtin_fmaxf(__builtin_fmaxf(mxc, p0[r + 2]), p0[r + 3]); mxa = __builtin_fmaxf(__builtin_fmaxf(mxa, p1[r]), p1[r + 1]); mxc = __builtin_fmaxf(__builtin_fmaxf(mxc, p1[r + 2]), p1[r + 3]); }
            float mx = __builtin_fmaxf(mxa, mxc); mx = __builtin_fmaxf(mx, xor_f<32>(mx));
            if (MODE == AM_SELECT) mx = lanesel ? mx : -INFINITY;
            if (__any(mx > m + 6.0f)) { const float mn = fmaxf(m, mx), alpha = __builtin_amdgcn_exp2f(m - mn); m = mn; l *= alpha;
#pragma unroll
                for (int r = 0; r < 16; ++r) { o[0][r] *= alpha; o[1][r] *= alpha; } }
            typedef float f32x2v __attribute__((ext_vector_type(2)));
            const float msub = (MODE == AM_SELECT) ? (lanesel ? m : INFINITY) : m;
            const f32x2v m2 = (f32x2v){msub, msub}; f32x2v ps2 = (f32x2v){0.f, 0.f};
#pragma unroll
            for (int r = 0; r < 16; r += 2) { const f32x2v a_ = (f32x2v){p0[r], p0[r + 1]} - m2, b_ = (f32x2v){p1[r], p1[r + 1]} - m2;
                p0[r] = __builtin_amdgcn_exp2f(a_[0]); p0[r + 1] = __builtin_amdgcn_exp2f(a_[1]); p1[r] = __builtin_amdgcn_exp2f(b_[0]); p1[r + 1] = __builtin_amdgcn_exp2f(b_[1]);
                ps2 += (f32x2v){p0[r], p0[r + 1]}; ps2 += (f32x2v){p1[r], p1[r + 1]}; }
            l += ps2[0] + ps2[1];
            bf16x8 pf[4];
#pragma unroll
            for (int s4 = 0; s4 < 4; ++s4) { const int rb = 8 * (s4 & 1); v4u w;
                if (s4 < 2) { w.x = pg8::cvt_pk_bf16(p0[rb], p0[rb + 1]); w.y = pg8::cvt_pk_bf16(p0[rb + 2], p0[rb + 3]); w.z = pg8::cvt_pk_bf16(p0[rb + 4], p0[rb + 5]); w.w = pg8::cvt_pk_bf16(p0[rb + 6], p0[rb + 7]); }
                else        { w.x = pg8::cvt_pk_bf16(p1[rb], p1[rb + 1]); w.y = pg8::cvt_pk_bf16(p1[rb + 2], p1[rb + 3]); w.z = pg8::cvt_pk_bf16(p1[rb + 4], p1[rb + 5]); w.w = pg8::cvt_pk_bf16(p1[rb + 6], p1[rb + 7]); }
                pf[s4] = __builtin_bit_cast(bf16x8, w); }
#pragma unroll
            for (int s4 = 0; s4 < 4; ++s4) {
#pragma unroll
                for (int db = 0; db < 2; ++db) {
                    const s16x4 lo = vlo[db][s4], hh = vhh[db][s4];
                    const bf16x8 vf = (bf16x8){lo[0], lo[1], lo[2], lo[3], hh[0], hh[1], hh[2], hh[3]};
                    o[db] = __builtin_amdgcn_mfma_f32_32x32x16_bf16(vf, pf[s4], o[db], 0, 0, 0);
                }
            }
        }
      }
        if (jm < mhi) AT_WRITE(cur ^ 1);
        if (VAR != 7) __syncthreads();
        cur ^= 1;
    }
#undef AT_LOAD
#undef AT_WRITE
    __builtin_amdgcn_s_setprio(0);
    l += xor_f<32>(l);
    m_out = m; l_out = l;
    const float inv = (l > 0.f) ? 1.0f / l : 0.f;
#pragma unroll
    for (int r = 0; r < 16; ++r) { o[0][r] *= inv; o[1][r] *= inv; }
}
__device__ __forceinline__ unsigned q_issue(Frame& F, int qid) { unsigned t = 0u; if (F.tid == 0) t = __hip_atomic_fetch_add((unsigned*)(F.ctl + CW_Q + 64 * qid), 1u, __ATOMIC_RELAXED, __HIP_MEMORY_SCOPE_AGENT); return t; }
__device__ __forceinline__ int q_take(Frame& F, unsigned t) { if (F.tid == 0) F.MISC[0] = t; __syncthreads(); const int v = (int)F.MISC[0]; __syncthreads(); return __builtin_amdgcn_readfirstlane(v); }
__device__ __forceinline__ int q_fetch(Frame& F, int qid) {
    if (F.tid == 0) F.MISC[0] = __hip_atomic_fetch_add((unsigned*)(F.ctl + CW_Q + 64 * qid), 1u, __ATOMIC_RELAXED, __HIP_MEMORY_SCOPE_AGENT);
    __syncthreads(); const int v = (int)F.MISC[0]; __syncthreads(); return __builtin_amdgcn_readfirstlane(v);
}

constexpr int CW_FLAG = 19000;
__device__ __forceinline__ void unit_publish(Frame& F, int word) {
    asm volatile("s_waitcnt vmcnt(0)" ::: "memory");
    __syncthreads();
    if (F.tid == 0) { __builtin_amdgcn_fence(__ATOMIC_RELEASE, "agent"); asm volatile("s_waitcnt vmcnt(0)" ::: "memory"); (void)xb_add((unsigned*)(F.ctl + word), 1u); }
}
__device__ __forceinline__ void count_await(Frame& F, int word, unsigned target) {
    if (F.tid == 0) { unsigned* bar = (unsigned*)(F.ctl + CW_BAR); XB_SPIN(xb_ld((unsigned*)(F.ctl + word)) < target, bar); __builtin_amdgcn_fence(__ATOMIC_ACQUIRE, "agent"); asm volatile("s_waitcnt vmcnt(0)" ::: "memory"); }
    __syncthreads();
}
__device__ __forceinline__ void unit_await(Frame& F, int word) {
    if (F.tid == 0) { unsigned* bar = (unsigned*)(F.ctl + CW_BAR); XB_SPIN(xb_ld((unsigned*)(F.ctl + word)) == 0u, bar); __builtin_amdgcn_fence(__ATOMIC_ACQUIRE, "agent"); asm volatile("s_waitcnt vmcnt(0)" ::: "memory"); }
    __syncthreads();
}

constexpr size_t KC_HEAD = (size_t)512 * 64;
struct SchedCmp : pg8::TileOrder {
    const char* B;
    __device__ __forceinline__ unsigned arow(const Unit& u, int r) const { const int R = u.pm * 256 + r, n = R & 511, g = (R >> 9) & 1, b = (R >> 10) & 3, sr = R >> 12;
        return (unsigned)(((size_t)(b * SEQ + 16 * n) * NU + (sr ? C_VC : C_KC) + g * 64) * 2); }
    __device__ __forceinline__ size_t abase(const Unit&, int) const { return 0; }
    __device__ __forceinline__ const char* bbase(const Unit& u) const { return B + (size_t)(u.pm >> 4) * (256 * 2048 * 2); }
};
struct EpiCmp {
    static constexpr bool PERM = true;
    bf16* G; const float* bias;
    __device__ __forceinline__ void operator()(const f32x4 (&acc)[2][2][4][2], const Unit& u, int wr, int wc, int fr, int fq) const {
        const int row0 = u.pm * 256 + wr * 64 + fr, c8 = wc * 32 + 8 * fq; const float* bp = bias + (u.pm >> 4) * 128 + c8;
        const f32x4 b0 = *(const GAS f32x4*)bp, b1 = *(const GAS f32x4*)(bp + 4);
#pragma unroll
        for (int ai = 0; ai < 2; ++ai)
#pragma unroll
            for (int m = 0; m < 4; ++m) { const f32x4 v0 = acc[ai][0][m][0] + b0, v1 = acc[ai][0][m][1] + b1;
                *(v4u*)(G + (size_t)(row0 + ai * 128 + m * 16) * 128 + c8) = (v4u){pg8::cvt_pk_bf16(gelu_tanh(v0[0]), gelu_tanh(v0[1])), pg8::cvt_pk_bf16(gelu_tanh(v0[2]), gelu_tanh(v0[3])),
                                                                                      pg8::cvt_pk_bf16(gelu_tanh(v1[0]), gelu_tanh(v1[1])), pg8::cvt_pk_bf16(gelu_tanh(v1[2]), gelu_tanh(v1[3]))}; }
    }
};
__device__ __forceinline__ void p_cmp2(Frame& F, const float* w2) {
    phase_begin(F);
    const bf16* G = (const bf16*)(F.ws + WS_G1C); bf16* KC = (bf16*)(F.ws + WS_KC);
    for (int e = F.vcu * NTHR + F.tid; e < 8192 * 64; e += F.G * NTHR) { const int R = e >> 6, d = e & 63, sr = R >> 12; float a = 0.f;
        const GAS v4u* gr = (const GAS v4u*)(G + (size_t)R * 128); const float* w = w2 + (size_t)sr * 128 * 64 + d;
        for (int j8 = 0; j8 < 16; ++j8) { const v4u g = gr[j8];
            a += bflo(g.x) * w[(8 * j8 + 0) * 64] + bfhi(g.x) * w[(8 * j8 + 1) * 64] + bflo(g.y) * w[(8 * j8 + 2) * 64] + bfhi(g.y) * w[(8 * j8 + 3) * 64]
               + bflo(g.z) * w[(8 * j8 + 4) * 64] + bfhi(g.z) * w[(8 * j8 + 5) * 64] + bflo(g.w) * w[(8 * j8 + 6) * 64] + bfhi(g.w) * w[(8 * j8 + 7) * 64]; }
        KC[e] = (bf16)(((R & 511) == 511) ? 0u : f2bf(a)); }
}
__device__ __forceinline__ void p_cmp_bias(Frame& F, const float* cpos, const float* w1) {
    phase_begin(F);
    float* bias = (float*)(F.ws + WS_MISC + MS_CBIAS);
    LAS float* red = (LAS float*)F.lds;
    __syncthreads();
    for (int e = F.vcu; e < DEPTH * 2 * 128; e += F.G) { const int ls = e >> 7, j = e & 127; float a = 0.f;
#pragma unroll
        for (int i = 0; i < 2048 / NTHR; ++i) { const int k = F.tid + i * NTHR; a += cpos[(size_t)ls * 2048 + k] * w1[((size_t)ls * 2048 + k) * 128 + j]; }
        a = wave_sum(a);
        if (F.lane == 0) red[F.wave] = a;
        __syncthreads();
        if (F.tid == 0) bias[e] = ((red[0] + red[1]) + (red[2] + red[3])) + ((red[4] + red[5]) + (red[6] + red[7]));
        __syncthreads(); }
}
__device__ __forceinline__ float gate_of(const bf16* U, const float* gb, size_t row, int h, int br) { return sigmoidf_(bf2f(U[row * NU + C_GN + h * 3 + br]) + gb[h * 3 + br]); }

constexpr int KALL_OFF = 36864;
__device__ __forceinline__ void nsa_a_unit(Frame& F, int u, const float* gb) {
    typedef AttnLds<64> L;
    const bf16* U = (const bf16*)(F.ws + WS_U); bf16* OC = (bf16*)(F.ws + WS_OC); unsigned* MASK = (unsigned*)(F.ws + WS_MASK);
    const int r32 = F.lane & 31, hi = F.lane >> 5;
    const int qb = 31 - (u >> 3), bg = u & 7, b = bg >> 1, g = bg & 1;
    const int qpos0w = qb * 256 + F.wave * 32, qpos = qpos0w + r32; const size_t row = (size_t)b * SEQ + qpos;
    const int nmax = (qb * 256 + 255 - 31) >> 4;
    const int jhi = nmax >> 6;
    SrcCmp src{(const bf16*)(F.ws + WS_KC) + (size_t)(b * 2 + g) * KC_HEAD, (const bf16*)(F.ws + WS_KC) + (size_t)(8 + b * 2 + g) * KC_HEAD, (unsigned)(WS_KC + (size_t)(b * 2 + g) * KC_HEAD * 2), (unsigned)(WS_KC + (size_t)(8 + b * 2 + g) * KC_HEAD * 2)};
    { const int kkey = F.tid >> 3, kc = F.tid & 7;
#pragma unroll
      for (int j = 0; j < 8; ++j) if (j <= jhi) *(LAS v4u*)(F.lds + KALL_OFF + j * L::KBYTES + kkey * (L::KP * 2) + kc * 16) = *(const GAS v4u*)src.kp(j * 64 + kkey, kc); }
    float m0 = 0.f, m1 = 0.f, m2 = 0.f, l0 = 0.f, l1 = 0.f, l2 = 0.f;
#pragma unroll 1
    for (int p = 0; p < 3; ++p) { const int h = g * 3 + p;
        bf16x8 qf[4];
#pragma unroll
        for (int ks = 0; ks < 4; ++ks) qf[ks] = *(const GAS bf16x8*)(U + row * NU + C_QN + h * 64 + ks * 16 + hi * 8);
        f32x16 o[2]; float mh, lh;
        attn_branch<64, AM_CMP, 1>(F, F.lds, src, qf, qpos0w, 0, jhi, (v4u){0u, 0u, 0u, 0u}, o, mh, lh);
        if (p == 0) { m0 = mh; l0 = lh; } else if (p == 1) { m1 = mh; l1 = lh; } else { m2 = mh; l2 = lh; }
        const float gt = gate_of(U, gb, row, h, 0);
        bf16* orow = OC + row * 384 + h * 64;
#pragma unroll
        for (int db = 0; db < 2; ++db)
#pragma unroll
            for (int a = 0; a < 4; ++a) *(GAS v2u*)(orow + 32 * db + 8 * a + 4 * hi) = (v2u){pg8::cvt_pk_bf16(o[db][4 * a] * gt, o[db][4 * a + 1] * gt), pg8::cvt_pk_bf16(o[db][4 * a + 2] * gt, o[db][4 * a + 3] * gt)};
    }
    float imp[64];
#pragma unroll
    for (int k = 0; k < 64; ++k) imp[k] = 0.f;
#pragma unroll 1
    for (int p = 0; p < 3; ++p) { const int h = g * 3 + p;
        bf16x8 qf[4];
#pragma unroll
        for (int ks = 0; ks < 4; ++ks) qf[ks] = *(const GAS bf16x8*)(U + row * NU + C_QN + h * 64 + ks * 16 + hi * 8);
        const float mh = (p == 0) ? m0 : (p == 1) ? m1 : m2, lh = (p == 0) ? l0 : (p == 1) ? l1 : l2;
        const float il = (lh > 0.f) ? 1.0f / lh : 0.f; float carryE = 0.f;
        int qp2 = qpos; asm volatile("" : "+v"(qp2));
#pragma unroll 1
        for (int j = 0; j <= jhi; ++j) {
            const int kb = j * 64; const LAS unsigned char* kb_l = F.lds + KALL_OFF + j * L::KBYTES;
            f32x16 p0 = f32x16{}, p1 = f32x16{};
#pragma unroll
            for (int ks = 0; ks < 4; ++ks) {
                const bf16x8 k0 = *(const LAS bf16x8*)(kb_l + r32 * (L::KP * 2) + ks * 32 + hi * 16);
                const bf16x8 k1 = *(const LAS bf16x8*)(kb_l + (32 + r32) * (L::KP * 2) + ks * 32 + hi * 16);
                p0 = __builtin_amdgcn_mfma_f32_32x32x16_bf16(k0, qf[ks], p0, 0, 0, 0); p1 = __builtin_amdgcn_mfma_f32_32x32x16_bf16(k1, qf[ks], p1, 0, 0, 0); }
#pragma unroll
            for (int r = 0; r < 16; ++r) { const int ka = kb + crow(r, hi), kbb = ka + 32;
                const bool v0 = (16 * ka + 31 <= qp2) && ka <= 510, v1 = (16 * kbb + 31 <= qp2) && kbb <= 510;
                p0[r] = v0 ? __builtin_amdgcn_exp2f(p0[r] - mh) * il : 0.f; p1[r] = v1 ? __builtin_amdgcn_exp2f(p1[r] - mh) * il : 0.f; }
            float E0[4], E1[4], add[8];
#pragma unroll
            for (int a = 0; a < 4; ++a) { E0[a] = xor_f<32>(p0[4 * a + 3]); E1[a] = xor_f<32>(p1[4 * a + 3]); }
#pragma unroll
            for (int a = 0; a < 4; ++a) {
                const float e0 = hi ? E0[a] : (a > 0 ? E0[a > 0 ? a - 1 : 0] : carryE), e1 = hi ? E1[a] : (a > 0 ? E1[a > 0 ? a - 1 : 0] : E0[3]);
                add[a] = ((p0[4 * a] + p0[4 * a + 1]) + (p0[4 * a + 2] + p0[4 * a + 3])) + e0;
                add[4 + a] = ((p1[4 * a] + p1[4 * a + 1]) + (p1[4 * a + 2] + p1[4 * a + 3])) + e1; }
            carryE = E1[3];
#define IMP_ADD(J) if (j == (J)) { _Pragma("unroll") for (int i = 0; i < 8; ++i) imp[8 * (J) + i] += add[i]; }
            IMP_ADD(0) else IMP_ADD(1) else IMP_ADD(2) else IMP_ADD(3) else IMP_ADD(4) else IMP_ADD(5) else IMP_ADD(6) else IMP_ADD(7)
#undef IMP_ADD
        }
    }
    __syncthreads();
    {
        const int curb = qpos >> 6; unsigned mk0 = 0u, mk1 = 0u, mk2 = 0u, mk3 = 0u;
        LAS float* iv = (LAS float*)(F.lds + F.wave * 16384) + F.lane;
#pragma unroll
        for (int k = 0; k < 64; ++k) { const int sblk = 16 * (k >> 3) + 8 * ((k >> 2) & 1) + 2 * (k & 3) + hi; iv[k * 64] = (sblk == 0 || sblk >= curb) ? -2.0f : imp[k]; }
#define MK_SET(sv) do { const int s_ = (sv); const unsigned bit_ = 1u << (s_ & 31); const int w_ = s_ >> 5; mk0 |= (w_ == 0) ? bit_ : 0u; mk1 |= (w_ == 1) ? bit_ : 0u; mk2 |= (w_ == 2) ? bit_ : 0u; mk3 |= (w_ == 3) ? bit_ : 0u; } while (0)
        if (!__all(curb < 16)) {
#pragma unroll 1
            for (int rnd = 0; rnd < 14; ++rnd) {
                float best = -1.0f; int bk = 0;
#pragma unroll 8
                for (int k = 0; k < 64; ++k) { const float v = iv[k * 64]; if (v > best) { best = v; bk = k; } }
                const int bs = 16 * (bk >> 3) + 8 * ((bk >> 2) & 1) + 2 * (bk & 3) + hi;
                const float ob = xor_f<32>(best); const int os = (int)xor_u<32>((unsigned)bs);
                const bool win = (best > ob) || (best == ob && bs < os);
                if (win && best >= 0.f) { iv[bk * 64] = -2.0f; MK_SET(bs); }
            }
            MK_SET(0); MK_SET(curb);
        }
        if (curb < 16) { mk0 = (2u << curb) - 1u; mk1 = 0u; mk2 = 0u; mk3 = 0u; }
        mk0 |= xor_u<32>(mk0); mk1 |= xor_u<32>(mk1); mk2 |= xor_u<32>(mk2); mk3 |= xor_u<32>(mk3);
#undef MK_SET
        if (hi == 0) *(GAS v4u*)(MASK + ((size_t)(b * 2 + g) * SEQ + qpos) * 4) = (v4u){mk0, mk1, mk2, mk3};
    }
    __syncthreads();
}
template <int VAR>
__device__ __forceinline__ void nsa_b_unit(Frame& F, int u, const float* gb) {
    const bf16* U = (const bf16*)(F.ws + WS_U); bf16* CAT = (bf16*)(F.ws + WS_CAT); const unsigned* MASK = (const unsigned*)(F.ws + WS_MASK);
    const int r32 = F.lane & 31, hi = F.lane >> 5;
    const int qb = 31 - u / 24, bh = u % 24, b = bh / 6, h = bh % 6, g = h / 3;
    const int qpos0w = qb * 256 + F.wave * 32, qpos = qpos0w + r32; const size_t row = (size_t)b * SEQ + qpos;
    bf16x8 qf[4];
#pragma unroll
    for (int ks = 0; ks < 4; ++ks) qf[ks] = *(const GAS bf16x8*)(U + row * NU + C_QN + h * 64 + ks * 16 + hi * 8);
    const v4u sm = *(const GAS v4u*)(MASK + ((size_t)(b * 2 + g) * SEQ + qpos) * 4);
    f32x16 o[2], acc[2]; float m_, l_;
    { SrcU src{U, C_KS + g * 64, C_VS + g * 64, (size_t)b * SEQ};
      attn_branch<64, AM_SELECT, 2, VAR>(F, F.lds, src, qf, qpos0w, 0, qb * 4 + 3, sm, o, m_, l_); }
    { const float gt = gate_of(U, gb, row, h, 1);
#pragma unroll
      for (int r = 0; r < 16; ++r) { acc[0][r] = o[0][r] * gt; acc[1][r] = o[1][r] * gt; } }
    { SrcU src{U, C_KW + g * 64, C_VW + g * 64, (size_t)b * SEQ};
      const int jl = qb * 4 - 8 < 0 ? 0 : qb * 4 - 8;
      attn_branch<64, AM_WINDOW, 2, VAR>(F, F.lds, src, qf, qpos0w, jl, qb * 4 + 3, (v4u){0u, 0u, 0u, 0u}, o, m_, l_); }
    { const float gt = gate_of(U, gb, row, h, 2);
#pragma unroll
      for (int r = 0; r < 16; ++r) { acc[0][r] += o[0][r] * gt; acc[1][r] += o[1][r] * gt; } }
    bf16* orow = CAT + row * DM + 640 + h * 64; const bf16* crow_ = (const bf16*)(F.ws + WS_OC) + row * 384 + h * 64;
#pragma unroll
    for (int db = 0; db < 2; ++db)
#pragma unroll
        for (int a = 0; a < 4; ++a) { GAS v2u* p = (GAS v2u*)(orow + 32 * db + 8 * a + 4 * hi); const v2u c = *(const GAS v2u*)(crow_ + 32 * db + 8 * a + 4 * hi);
            *p = (v2u){pg8::cvt_pk_bf16(acc[db][4 * a] + bflo(c.x), acc[db][4 * a + 1] + bfhi(c.x)), pg8::cvt_pk_bf16(acc[db][4 * a + 2] + bflo(c.y), acc[db][4 * a + 3] + bfhi(c.y))}; }
}
namespace nb {
typedef __attribute__((address_space(3))) const char* lds_cptr;
typedef short v4i16_t __attribute__((ext_vector_type(4)));
constexpr int SLOTB = 8192, NSLOT = 3, LDS_K = 0, LDS_V = NSLOT * SLOTB, LDS_WS = 2 * NSLOT * SLOTB, LDS_OST = LDS_WS + 8 * 64 * 4, LDS_OST2 = LDS_OST + 8 * 4096, LDS_END = LDS_OST2 + 8 * 4096;
static_assert(LDS_END + 8192 <= RING_BYTES, "attention scratch must fit below the frame's control words");
constexpr int LDS_X = LDS_OST2;
constexpr float THRL = 8.0f;
#define NB_SBAR() __builtin_amdgcn_sched_barrier(0)
#define NB_WAIT_BAR(N) asm volatile("s_waitcnt vmcnt(" #N ") lgkmcnt(0)\n\ts_barrier" ::: "memory")
#define NB_PIN(x) asm volatile("" : "+v"(x))
#define NB_MX3(a, b, c) __builtin_fmaxf(__builtin_fmaxf((a), (b)), (c))
__device__ __forceinline__ void glds16(const void* gbase, unsigned voff, unsigned lds_dst) { unsigned keep;
    asm volatile("s_mov_b32 %0, m0\n\ts_mov_b32 m0, %2\n\ts_nop 0\n\tglobal_load_lds_dwordx4 %1, %3\n\ts_mov_b32 m0, %0" : "=&s"(keep) : "v"(voff), "s"(lds_dst), "s"(gbase) : "memory"); }
__device__ __forceinline__ int fresh_lane() { int z_ = 0; asm volatile("" : "+v"(z_)); return (int)__builtin_amdgcn_mbcnt_hi(~0u, __builtin_amdgcn_mbcnt_lo(~0u, z_)); }
typedef float f32x2_t __attribute__((ext_vector_type(2))); typedef __bf16 bf16x2_t __attribute__((ext_vector_type(2)));
__device__ __forceinline__ unsigned cvtpk_s(float lo, float hi) { f32x2_t v = {lo, hi}; bf16x2_t b = __builtin_convertvector(v, bf16x2_t); return __builtin_bit_cast(unsigned, b); }
__device__ __forceinline__ void kload2(bf16x8* kf, lds_cptr kp, int j) { kf[2 * j] = *(const __attribute__((address_space(3))) bf16x8*)(kp + j * 2048); kf[2 * j + 1] = *(const __attribute__((address_space(3))) bf16x8*)(kp + j * 2048 + 512); }
__device__ __forceinline__ s16x4 vtr(lds_cptr p) { return __builtin_bit_cast(s16x4, __builtin_amdgcn_ds_read_tr16_b64_v4i16((__attribute__((address_space(3))) v4i16_t*)p)); }
__device__ __forceinline__ float rowmax(const f32x16& p0, const f32x16& p1) {
    float a = NB_MX3(p0[0], p0[1], p1[0]), b = NB_MX3(p0[2], p0[3], p1[1]); a = NB_MX3(a, p1[2], p1[3]);
#pragma unroll
    for (int r = 4; r < 16; r += 4) { a = NB_MX3(a, p0[r], p0[r + 1]); b = NB_MX3(b, p0[r + 2], p0[r + 3]); a = NB_MX3(a, p1[r], p1[r + 1]); b = NB_MX3(b, p1[r + 2], p1[r + 3]); }
    float m = __builtin_fmaxf(a, b); auto rr = __builtin_amdgcn_permlane32_swap(__float_as_uint(m), __float_as_uint(m), false, false);
    return __builtin_fmaxf(__uint_as_float(rr[0]), __uint_as_float(rr[1])); }
__device__ __forceinline__ void cmask(f32x16& p0, f32x16& p1, int jb, int qrel, int hi) {
    const int kb = 64 * jb + 4 * hi;
#pragma unroll
    for (int r = 0; r < 16; ++r) { const int kv = kb + (r & 3) + 8 * (r >> 2); if (kv > qrel) p0[r] = -INFINITY; if (kv + 32 > qrel) p1[r] = -INFINITY; } }
__device__ __forceinline__ void lmask(f32x16& p0, f32x16& p1, int t, int qrel, int hi) {
    const int kb = 64 * t + 4 * hi;
#pragma unroll
    for (int r = 0; r < 16; ++r) { const int kv = kb + (r & 3) + 8 * (r >> 2); if (kv <= qrel) p0[r] = -INFINITY; if (kv + 32 <= qrel) p1[r] = -INFINITY; } }

template <int MODE, int QP, int KP, int VP, int KX, int XP>
__device__ __forceinline__ void branch(int wid, const bf16* Qw, const bf16* K0, const bf16* V0, const bf16* X0, int NT, bool lowm, const v4u sm, char* shm, int ost) {
    const int lane = fresh_lane();
    const int r32 = lane & 31, hi = lane >> 5;
    const unsigned lds0 = (unsigned)(uintptr_t)shm;
    float* wsf = (float*)(shm + LDS_WS) + wid * 64;
    const unsigned koff = (unsigned)(lane * KP + wid * 8) * 2u;
    const unsigned voff = (unsigned)((16 * (wid & 3) + (lane >> 2)) * VP + (wid >> 2) * 32 + (lane & 3) * 8) * 2u;
    const unsigned xoff = (unsigned)(lane * XP + (wid & 3) * 8) * 2u;
    const unsigned kdst = lds0 + LDS_K + wid * 1024, vdst = lds0 + LDS_V + wid * 1024, xdst = lds0 + LDS_X + (wid & 3) * 1024;
#define DMA_K(t, slot) glds16(K0 + (long)(t) * 64 * KP, koff, (unsigned)__builtin_amdgcn_readfirstlane(kdst + (slot)))
#define DMA_V(t, slot) glds16(V0 + (long)(t) * 64 * VP, voff, (unsigned)__builtin_amdgcn_readfirstlane(vdst + (slot)))
#define DMA_X(t) do { if (KX) glds16(X0 + (long)(t) * 64 * XP, xoff, (unsigned)__builtin_amdgcn_readfirstlane(xdst + (((t) & 3) * 4096))); } while (0)
    LAS unsigned* smw = (LAS unsigned*)((LAS unsigned char*)(lds_cptr)shm + LDS_END) + (wid * 64 + lane) * 4;
    unsigned cw = sm.x;
    if (MODE == AM_SELECT) *(LAS v4u*)smw = sm;
#define SELB(t) ((MODE != AM_SELECT) || ((cw >> ((t) & 31)) & 1u))
#define SELNEXT(t) do { if (MODE == AM_SELECT) { if ((((t) + 1) & 31) == 0) cw = smw[(((t) + 1) >> 5) & 3]; } } while (0)
    const lds_cptr shm3 = (lds_cptr)shm; const lds_cptr kp0 = shm3 + LDS_K + hi * 1024 + r32 * 16; const lds_cptr xp0 = shm3 + LDS_X + hi * 1024 + r32 * 16;
    const lds_cptr vp0 = shm3 + LDS_V + ((lane >> 4) & 1) * 32 + (lane & 3) * 8 + (4 * hi + ((lane & 15) >> 2)) * 64;
    bf16x8 kf[8];
    DMA_K(0, 0); DMA_X(0); DMA_V(0, 0); DMA_K(1, SLOTB); DMA_X(1);
    bf16x8 qr[4], qx[KX ? KX : 1];
#pragma unroll
    for (int d0 = 0; d0 < 4; ++d0) qr[d0] = *reinterpret_cast<const bf16x8*>(&Qw[(long)r32 * QP + d0 * 16 + hi * 8]);
#pragma unroll
    for (int d0 = 0; d0 < KX; ++d0) qx[d0] = *reinterpret_cast<const bf16x8*>(&Qw[(long)r32 * QP + 64 + d0 * 16 + hi * 8]);
    float mhat = 0.f, l_reg = 0.f; f32x16 o[2]; o[0] = f32x16{}; o[1] = f32x16{};
    f32x16 cin = f32x16{}; NB_PIN(cin);
#define CMASK(P0, P1, t, BAND) do { if (BAND) { const int jb_ = (t) - (NT - 4); if (jb_ >= 0) { const int ln_ = fresh_lane(); cmask(P0, P1, jb_, wid * 32 + (ln_ & 31), ln_ >> 5); } } \
        if (MODE == AM_WINDOW) { if (lowm && (t) <= 3) { const int ln_ = fresh_lane(); lmask(P0, P1, (t), wid * 32 + (ln_ & 31), ln_ >> 5); } } } while (0)
    bool resc = false;
#define RESC() do { if (resc) { asm volatile("s_waitcnt lgkmcnt(0)" ::: "memory"); const int hi_ = fresh_lane() >> 5; \
        _Pragma("unroll") for (int d_ = 0; d_ < 2; ++d_) _Pragma("unroll") for (int r = 0; r < 16; ++r) o[d_][r] *= wsf[crow(r, hi_)]; } } while (0)
    f32x16 pA0, pA1, pB0, pB1;
    int sl_prev = 0, sl_cur = 0, sl_next = SLOTB;
#define ROT() do { sl_prev = sl_cur; sl_cur = sl_next; sl_next = (sl_next == (NSLOT - 1) * SLOTB) ? 0 : sl_next + SLOTB; } while (0)
    DMA_K(2, 2 * SLOTB); DMA_X(2);
    if (KX) { NB_WAIT_BAR(5); } else { NB_WAIT_BAR(3); }
    { _Pragma("unroll") for (int d0 = 0; d0 < 4; ++d0) kload2(kf, kp0, d0);
      pA0 = __builtin_amdgcn_mfma_f32_32x32x16_bf16(kf[0], qr[0], cin, 0, 0, 0); pA1 = __builtin_amdgcn_mfma_f32_32x32x16_bf16(kf[1], qr[0], cin, 0, 0, 0);
      _Pragma("unroll") for (int d0 = 1; d0 < 4; ++d0) { pA0 = __builtin_amdgcn_mfma_f32_32x32x16_bf16(kf[2 * d0], qr[d0], pA0, 0, 0, 0); pA1 = __builtin_amdgcn_mfma_f32_32x32x16_bf16(kf[2 * d0 + 1], qr[d0], pA1, 0, 0, 0); }
      _Pragma("unroll") for (int d0 = 0; d0 < KX; ++d0) { const bf16x8 x0 = *(const __attribute__((address_space(3))) bf16x8*)(xp0 + d0 * 2048), x1 = *(const __attribute__((address_space(3))) bf16x8*)(xp0 + d0 * 2048 + 512);
          pA0 = __builtin_amdgcn_mfma_f32_32x32x16_bf16(x0, qx[d0], pA0, 0, 0, 0); pA1 = __builtin_amdgcn_mfma_f32_32x32x16_bf16(x1, qx[d0], pA1, 0, 0, 0); } }
    CMASK(pA0, pA1, 0, true);
    if (!SELB(0)) { _Pragma("unroll") for (int r = 0; r < 16; ++r) { pA0[r] = -INFINITY; pA1[r] = -INFINITY; } }
    { const float rm = rowmax(pA0, pA1); const float dl = (rm > -1.0e30f) ? rm : 0.f; mhat = dl;
#pragma unroll
      for (int r = 0; r < 16; ++r) { pA0[r] = __builtin_amdgcn_exp2f(pA0[r] - dl); pA1[r] = __builtin_amdgcn_exp2f(pA1[r] - dl); } }
    { const float cv0 = SELB(1) ? -mhat : -INFINITY;
#pragma unroll
      for (int r = 0; r < 16; ++r) cin[r] = cv0;
      NB_PIN(cin); }
    NB_WAIT_BAR(0);
    DMA_K(3, 0); DMA_X(3); DMA_V(1, SLOTB);
    ROT();
    { _Pragma("unroll") for (int d0 = 0; d0 < 4; ++d0) kload2(kf, kp0 + sl_cur, d0); }
    if (KX) { NB_WAIT_BAR(3); } else { NB_WAIT_BAR(2); }
    s16x4 vlo[8], vhi[8]; v4u pw0, pw1, pw2, pw3;
#define PKW(P, B) cvtpk_s(P[B], P[B + 1])
#define PAF(k) __builtin_bit_cast(bf16x8, pw##k)
#define VFR(i) (bf16x8){vlo[i][0], vlo[i][1], vlo[i][2], vlo[i][3], vhi[i][0], vhi[i][1], vhi[i][2], vhi[i][3]}
#define GAPA(MF, A0, A1, A2, A3, W0, W1, PW) do { MF; sacc += A0; sacc += A1; sacc += A2; sacc += A3; NB_PIN(sacc); W0; W1; NB_PIN(PW); NB_SBAR(); } while (0)
#define EX(v) __builtin_amdgcn_exp2f(v)
#define GAPB(MF, X, B, CI) do { MF; X[B] = EX(X[B]); X[B + 1] = EX(X[B + 1]); X[B + 2] = EX(X[B + 2]); X[B + 3] = EX(X[B + 3]); if (MODE == AM_SELECT) { cin[CI] = cv_; cin[CI + 1] = cv_; NB_PIN(cin); } NB_PIN(X); NB_SBAR(); } while (0)
#define VRD(i) do { vlo[i] = vtr(vp_ + (((i) >> 2) * 4096 + ((i) & 3) * 1024)); vhi[i] = vtr(vp_ + (((i) >> 2) * 4096 + ((i) & 3) * 1024 + 512)); } while (0)
#define KRD(G, j) do { if (G) { kload2(kf, kp0 + sl_next, j); NB_SBAR(); } } while (0)
#define STEP(C0, C1, P0, P1, t, GK, GV, GL, BAND) do { NB_SBAR(); \
    const lds_cptr vp_ = vp0 + sl_prev; \
    VRD(0); NB_SBAR(); float sacc = (P0[0] + P0[1]); \
    GAPA(C0 = __builtin_amdgcn_mfma_f32_32x32x16_bf16(kf[0], qr[0], cin, 0, 0, 0), P0[2], P0[3], P0[4], P0[5],     pw0[0] = PKW(P0, 0), pw0[1] = PKW(P0, 2), pw0); \
    VRD(4); NB_SBAR(); GAPA(C1 = __builtin_amdgcn_mfma_f32_32x32x16_bf16(kf[1], qr[0], cin, 0, 0, 0), P0[6], P0[7], P0[8], P0[9],     pw0[2] = PKW(P0, 4), pw0[3] = PKW(P0, 6), pw0); \
    VRD(1); NB_SBAR(); GAPA(C0 = __builtin_amdgcn_mfma_f32_32x32x16_bf16(kf[2], qr[1], C0, 0, 0, 0),  P0[10], P0[11], P0[12], P0[13], pw1[0] = PKW(P0, 8), pw1[1] = PKW(P0, 10), pw1); \
    VRD(5); NB_SBAR(); GAPA(C1 = __builtin_amdgcn_mfma_f32_32x32x16_bf16(kf[3], qr[1], C1, 0, 0, 0),  P0[14], P0[15], P1[0], P1[1],   pw1[2] = PKW(P0, 12), pw1[3] = PKW(P0, 14), pw1); \
    bf16x8 kx0_, kx1_, kx2_, kx3_; \
    if (KX) { const lds_cptr xp_ = xp0 + (((t) & 3) * 4096); kx0_ = *(const __attribute__((address_space(3))) bf16x8*)(xp_); kx1_ = *(const __attribute__((address_space(3))) bf16x8*)(xp_ + 512); NB_SBAR(); } \
    VRD(2); NB_SBAR(); GAPA(C0 = __builtin_amdgcn_mfma_f32_32x32x16_bf16(kf[4], qr[2], C0, 0, 0, 0),  P1[2], P1[3], P1[4], P1[5],     pw2[0] = PKW(P1, 0), pw2[1] = PKW(P1, 2), pw2); \
    VRD(6); NB_SBAR(); GAPA(C1 = __builtin_amdgcn_mfma_f32_32x32x16_bf16(kf[5], qr[2], C1, 0, 0, 0),  P1[6], P1[7], P1[8], P1[9],     pw2[2] = PKW(P1, 4), pw2[3] = PKW(P1, 6), pw2); \
    if (KX > 1) { const lds_cptr xp_ = xp0 + (((t) & 3) * 4096); kx2_ = *(const __attribute__((address_space(3))) bf16x8*)(xp_ + 2048); kx3_ = *(const __attribute__((address_space(3))) bf16x8*)(xp_ + 2560); NB_SBAR(); } \
    VRD(3); NB_SBAR(); GAPA(C0 = __builtin_amdgcn_mfma_f32_32x32x16_bf16(kf[6], qr[3], C0, 0, 0, 0),  P1[10], P1[11], P1[12], P1[13], pw3[0] = PKW(P1, 8), pw3[1] = PKW(P1, 10), pw3); \
    VRD(7); NB_SBAR(); GAPA(C1 = __builtin_amdgcn_mfma_f32_32x32x16_bf16(kf[7], qr[3], C1, 0, 0, 0),  P1[14], P1[15], 0.f, 0.f,       pw3[2] = PKW(P1, 12), pw3[3] = PKW(P1, 14), pw3); \
    if (KX) { C0 = __builtin_amdgcn_mfma_f32_32x32x16_bf16(kx0_, qx[0], C0, 0, 0, 0); NB_SBAR(); C1 = __builtin_amdgcn_mfma_f32_32x32x16_bf16(kx1_, qx[0], C1, 0, 0, 0); NB_SBAR(); } \
    if (KX > 1) { C0 = __builtin_amdgcn_mfma_f32_32x32x16_bf16(kx2_, qx[KX > 1 ? 1 : 0], C0, 0, 0, 0); NB_SBAR(); C1 = __builtin_amdgcn_mfma_f32_32x32x16_bf16(kx3_, qx[KX > 1 ? 1 : 0], C1, 0, 0, 0); NB_SBAR(); } \
    l_reg += sacc; \
    if (GK) { DMA_K((t) + 3, sl_cur); DMA_X((t) + 3); } if (GV) { DMA_V((t) + 1, sl_next); } \
    CMASK(C0, C1, t, BAND); \
    { float a = NB_MX3(C0[0], C0[1], C1[0]), b = NB_MX3(C0[2], C0[3], C1[1]); a = NB_MX3(a, C1[2], C1[3]); \
      _Pragma("unroll") for (int r = 4; r < 16; r += 4) { a = NB_MX3(a, C0[r], C0[r + 1]); b = NB_MX3(b, C0[r + 2], C0[r + 3]); a = NB_MX3(a, C1[r], C1[r + 1]); b = NB_MX3(b, C1[r + 2], C1[r + 3]); } \
      float rm = __builtin_fmaxf(a, b); { auto rr = __builtin_amdgcn_permlane32_swap(__float_as_uint(rm), __float_as_uint(rm), false, false); rm = __builtin_fmaxf(__uint_as_float(rr[0]), __uint_as_float(rr[1])); } \
      resc = false; \
      if (__builtin_expect(__any(rm > THRL), 0)) { const float dl = __builtin_fmaxf(rm, 0.f); mhat += dl; \
        _Pragma("unroll") for (int r = 0; r < 16; ++r) { C0[r] -= dl; C1[r] -= dl; } \
        if (MODE != AM_SELECT) { _Pragma("unroll") for (int r = 0; r < 16; ++r) cin[r] = -mhat; NB_PIN(cin); }        \
        const float f = __builtin_amdgcn_exp2f(-dl); l_reg *= f; { const int ln_ = fresh_lane(); if (ln_ < 32) wsf[ln_] = f; } resc = true; } } \
    SELNEXT(t); const float cv_ = SELB((t) + 1) ? -mhat : -INFINITY; \
    NB_SBAR(); \
    GAPB(o[0] = __builtin_amdgcn_mfma_f32_32x32x16_bf16(PAF(0), VFR(0), o[0], 0, 0, 0), C0, 0, 0); \
    GAPB(o[1] = __builtin_amdgcn_mfma_f32_32x32x16_bf16(PAF(0), VFR(4), o[1], 0, 0, 0), C0, 4, 2); \
    KRD(GL, 0); GAPB(o[0] = __builtin_amdgcn_mfma_f32_32x32x16_bf16(PAF(1), VFR(1), o[0], 0, 0, 0), C0, 8, 4); \
    KRD(GL, 1); GAPB(o[1] = __builtin_amdgcn_mfma_f32_32x32x16_bf16(PAF(1), VFR(5), o[1], 0, 0, 0), C0, 12, 6); \
    KRD(GL, 2); GAPB(o[0] = __builtin_amdgcn_mfma_f32_32x32x16_bf16(PAF(2), VFR(2), o[0], 0, 0, 0), C1, 0, 8); \
    KRD(GL, 3); GAPB(o[1] = __builtin_amdgcn_mfma_f32_32x32x16_bf16(PAF(2), VFR(6), o[1], 0, 0, 0), C1, 4, 10); \
    GAPB(o[0] = __builtin_amdgcn_mfma_f32_32x32x16_bf16(PAF(3), VFR(3), o[0], 0, 0, 0), C1, 8, 12); \
    GAPB(o[1] = __builtin_amdgcn_mfma_f32_32x32x16_bf16(PAF(3), VFR(7), o[1], 0, 0, 0), C1, 12, 14); \
    } while (0)
#define WAIT_FULL() do { if (KX) { NB_WAIT_BAR(3); } else { NB_WAIT_BAR(2); } } while (0)
    int t = 1;
    for (; t + 5 < NT; t += 2) {
        STEP(pB0, pB1, pA0, pA1, t, true, true, true, false);       WAIT_FULL(); RESC(); ROT();
        STEP(pA0, pA1, pB0, pB1, t + 1, true, true, true, false);   WAIT_FULL(); RESC(); ROT();
    }
#define ENDW(tt) do { if ((tt) + 3 < NT) { WAIT_FULL(); } else if ((tt) + 2 < NT) { NB_WAIT_BAR(1); } else { NB_WAIT_BAR(0); } } while (0)
    for (; t + 1 < NT; t += 2) {
        STEP(pB0, pB1, pA0, pA1, t, (t + 3 < NT), (t + 1 < NT), (t + 1 < NT), true);         ENDW(t);     RESC(); ROT();
        STEP(pA0, pA1, pB0, pB1, t + 1, (t + 4 < NT), (t + 2 < NT), (t + 2 < NT), true);     ENDW(t + 1); RESC(); ROT();
    }
    STEP(pB0, pB1, pA0, pA1, NT - 1, false, false, false, true); RESC();
    { float sacc = pB0[0] + pB0[1];
      _Pragma("unroll") for (int r = 2; r < 16; ++r) sacc += pB0[r];
      _Pragma("unroll") for (int r = 0; r < 16; ++r) sacc += pB1[r];
      l_reg += sacc;
      pw0 = (v4u){PKW(pB0, 0), PKW(pB0, 2), PKW(pB0, 4), PKW(pB0, 6)}; pw1 = (v4u){PKW(pB0, 8), PKW(pB0, 10), PKW(pB0, 12), PKW(pB0, 14)};
      pw2 = (v4u){PKW(pB1, 0), PKW(pB1, 2), PKW(pB1, 4), PKW(pB1, 6)}; pw3 = (v4u){PKW(pB1, 8), PKW(pB1, 10), PKW(pB1, 12), PKW(pB1, 14)};
      NB_SBAR();
      const lds_cptr vp_ = vp0 + sl_cur;
      _Pragma("unroll") for (int i = 0; i < 8; ++i) VRD(i);
      o[0] = __builtin_amdgcn_mfma_f32_32x32x16_bf16(PAF(0), VFR(0), o[0], 0, 0, 0); o[1] = __builtin_amdgcn_mfma_f32_32x32x16_bf16(PAF(0), VFR(4), o[1], 0, 0, 0);
      o[0] = __builtin_amdgcn_mfma_f32_32x32x16_bf16(PAF(1), VFR(1), o[0], 0, 0, 0); o[1] = __builtin_amdgcn_mfma_f32_32x32x16_bf16(PAF(1), VFR(5), o[1], 0, 0, 0);
      o[0] = __builtin_amdgcn_mfma_f32_32x32x16_bf16(PAF(2), VFR(2), o[0], 0, 0, 0); o[1] = __builtin_amdgcn_mfma_f32_32x32x16_bf16(PAF(2), VFR(6), o[1], 0, 0, 0);
      o[0] = __builtin_amdgcn_mfma_f32_32x32x16_bf16(PAF(3), VFR(3), o[0], 0, 0, 0); o[1] = __builtin_amdgcn_mfma_f32_32x32x16_bf16(PAF(3), VFR(7), o[1], 0, 0, 0); }
#undef PKW
#undef PAF
#undef VFR
#undef GAPA
#undef GAPB
#undef EX
#undef VRD
#undef KRD
#undef STEP
#undef ENDW
#undef WAIT_FULL
    { auto rr = __builtin_amdgcn_permlane32_swap(__float_as_uint(l_reg), __float_as_uint(l_reg), false, false); l_reg = __uint_as_float(rr[0]) + __uint_as_float(rr[1]); }
    const int lne = fresh_lane(), r32e = lne & 31, hie = lne >> 5;
    if (hie == 0) wsf[32 + r32e] = l_reg; asm volatile("s_waitcnt lgkmcnt(0)" ::: "memory");
    { bf16* stg = (bf16*)(shm + ost) + wid * 2048 + r32e;
#pragma unroll
      for (int r = 0; r < 16; ++r) { const int orow = crow(r, hie); const float lv = wsf[32 + orow]; const float rl = lv > 0.f ? __builtin_amdgcn_rcpf(lv) : 0.f;
#pragma unroll
          for (int d0 = 0; d0 < 2; ++d0) stg[orow * 64 + d0 * 32] = (bf16)f2bf(o[d0][r] * rl); } }
    asm volatile("s_waitcnt lgkmcnt(0)\n\ts_barrier" ::: "memory");
#undef DMA_K
#undef DMA_V
#undef DMA_X
#undef SELB
#undef SELNEXT
#undef CMASK
#undef RESC
#undef ROT
}
}

__device__ __forceinline__ void nsa_b_unit2(Frame& F, int u, const float* gb) {
    const bf16* U = (const bf16*)(F.ws + WS_U); bf16* CAT = (bf16*)(F.ws + WS_CAT); const unsigned* MASK = (const unsigned*)(F.ws + WS_MASK); const bf16* OC = (const bf16*)(F.ws + WS_OC);
    const int wid = F.wave; const int r32 = nb::fresh_lane() & 31;
    const int qb = 31 - u / 24, bh = u % 24, b = bh / 6, h = bh % 6, g = h / 3;
    const size_t rowbase = (size_t)b * SEQ; const int q0 = qb * 256, qpos0w = q0 + wid * 32;
    char* shm = (char*)F.lds;
    const bf16* Qw = U + (rowbase + qpos0w) * NU + C_QN + h * 64;
    const v4u sm = *(const GAS v4u*)(MASK + ((size_t)(b * 2 + g) * SEQ + qpos0w + r32) * 4);
    nb::branch<AM_SELECT, NU, NU, NU, 0, NU>(wid, Qw, U + rowbase * NU + C_KS + g * 64, U + rowbase * NU + C_VS + g * 64, U, 4 * qb + 4, false, sm, shm, nb::LDS_OST);
    { const int jl = qb >= 2 ? 4 * qb - 8 : 0; const int NT = 4 * qb + 4 - jl;
      nb::branch<AM_WINDOW, NU, NU, NU, 0, NU>(wid, Qw, U + (rowbase + (size_t)jl * 64) * NU + C_KW + g * 64, U + (rowbase + (size_t)jl * 64) * NU + C_VW + g * 64, U, NT, qb >= 2, (v4u){0u, 0u, 0u, 0u}, shm, nb::LDS_OST2); }
    const int lane2 = nb::fresh_lane();
    const LAS unsigned char* s1 = F.lds + nb::LDS_OST + wid * 4096; const LAS unsigned char* s2 = F.lds + nb::LDS_OST2 + wid * 4096;
#pragma unroll 1
    for (int i = 0; i < 4; ++i) { const int row = i * 8 + (lane2 >> 3), ch = lane2 & 7; const size_t grow = rowbase + qpos0w + row;
        const float gs = gate_of(U, gb, grow, h, 1), gw = gate_of(U, gb, grow, h, 2);
        const v4u a = *(const LAS v4u*)(s1 + row * 128 + ch * 16), w = *(const LAS v4u*)(s2 + row * 128 + ch * 16), c = *(const GAS v4u*)(OC + grow * 384 + h * 64 + ch * 8);
        v4u r_;
        r_.x = pg8::cvt_pk_bf16(gs * bflo(a.x) + gw * bflo(w.x) + bflo(c.x), gs * bfhi(a.x) + gw * bfhi(w.x) + bfhi(c.x));
        r_.y = pg8::cvt_pk_bf16(gs * bflo(a.y) + gw * bflo(w.y) + bflo(c.y), gs * bfhi(a.y) + gw * bfhi(w.y) + bfhi(c.y));
        r_.z = pg8::cvt_pk_bf16(gs * bflo(a.z) + gw * bflo(w.z) + bflo(c.z), gs * bfhi(a.z) + gw * bfhi(w.z) + bfhi(c.z));
        r_.w = pg8::cvt_pk_bf16(gs * bflo(a.w) + gw * bflo(w.w) + bflo(c.w), gs * bfhi(a.w) + gw * bfhi(w.w) + bfhi(c.w));
        *(GAS v4u*)(CAT + grow * DM + 640 + h * 64 + ch * 8) = r_; }
}
__device__ __forceinline__ void mla_unit2(Frame& F, int u) {
    const bf16* QM = (const bf16*)(F.ws + WS_QM); const bf16* KVM = (const bf16*)(F.ws + WS_KVM); const bf16* U = (const bf16*)(F.ws + WS_U); bf16* CAT = (bf16*)(F.ws + WS_CAT);
    const int wid = F.wave;
    const int qb = 31 - u / 24, bh = u % 24, b = bh / 6, h = bh % 6;
    const size_t rowbase = (size_t)b * SEQ; const int qpos0w = qb * 256 + wid * 32;
    nb::branch<AM_CAUSAL, 576, 768, 768, 2, NU>(wid, QM + (rowbase + qpos0w) * 576 + h * 96, KVM + rowbase * 768 + h * 128, KVM + rowbase * 768 + h * 128 + 64, U + rowbase * NU + C_KPE, 4 * qb + 4, false,
                                                (v4u){0u, 0u, 0u, 0u}, (char*)F.lds, nb::LDS_OST);
    const int lane2 = nb::fresh_lane();
    const LAS unsigned char* s1 = F.lds + nb::LDS_OST + wid * 4096;
#pragma unroll
    for (int i = 0; i < 4; ++i) { const int row = i * 8 + (lane2 >> 3), ch = lane2 & 7;
        *(GAS v4u*)(CAT + (rowbase + qpos0w + row) * DM + 256 + h * 64 + ch * 8) = *(const LAS v4u*)(s1 + row * 128 + ch * 16); }
}
__device__ __forceinline__ void mla_unit(Frame& F, int u) {
    const bf16* QM = (const bf16*)(F.ws + WS_QM); bf16* CAT = (bf16*)(F.ws + WS_CAT);
    const int r32 = F.lane & 31, hi = F.lane >> 5;
    const int qb = 31 - u / 24, bh = u % 24, b = bh / 6, h = bh % 6;
    const int qpos0w = qb * 256 + F.wave * 32; const size_t row = (size_t)b * SEQ + qpos0w + r32;
    bf16x8 qf[6];
#pragma unroll
    for (int ks = 0; ks < 6; ++ks) qf[ks] = *(const GAS bf16x8*)(QM + row * 576 + h * 96 + ks * 16 + hi * 8);
    SrcMla src{(const bf16*)(F.ws + WS_KVM), (const bf16*)(F.ws + WS_U), h, (size_t)b * SEQ};
    f32x16 o[2]; float m_, l_;
    attn_branch<96, AM_CAUSAL, 2>(F, F.lds, src, qf, qpos0w, 0, qb * 4 + 3, (v4u){0u, 0u, 0u, 0u}, o, m_, l_);
    bf16* orow = CAT + row * DM + 256 + h * 64;
#pragma unroll
    for (int db = 0; db < 2; ++db)
#pragma unroll
        for (int a = 0; a < 4; ++a) *(GAS v2u*)(orow + 32 * db + 8 * a + 4 * hi) = (v2u){pg8::cvt_pk_bf16(o[db][4 * a], o[db][4 * a + 1]), pg8::cvt_pk_bf16(o[db][4 * a + 2], o[db][4 * a + 3])};
}
__device__ __forceinline__ void p_attn1(Frame& F, int qid, const float* gb) {
    phase_begin(F);
    int dready = 0;
    unsigned tk = q_issue(F, qid);
    for (;;) {
        const int t = q_take(F, tk); if (t >= 1024) break; tk = q_issue(F, qid);
        if (t >= 576 && t < 832) {
            if (!dready) { count_await(F, CW_FLAG + 512 + (qid >> 1), (unsigned)F.G); dready = 1; phase_begin(F); }
            const int u = __builtin_amdgcn_readfirstlane(t - 576);
            nsa_a_unit(F, u, gb); unit_publish(F, CW_FLAG + (qid >> 1) * 256 + u);
        } else {
            mla_unit2(F, __builtin_amdgcn_readfirstlane(t < 576 ? t : t - 256));
        }
        phase_begin(F);
    }
    if (!dready) { phase_begin(F); count_await(F, CW_FLAG + 512 + (qid >> 1), (unsigned)F.G); }
}
template <int VAR>
__device__ __forceinline__ void p_attn2(Frame& F, int qid, const float* gb) {
    phase_begin(F);
    for (;;) { const int u = q_fetch(F, qid); if (u >= 768) break;
        { const int bh = u % 24, b = bh / 6, g = (bh % 6) / 3; unit_await(F, CW_FLAG + (qid >> 1) * 256 + (((u / 24) << 3) | (b * 2 + g))); }
        nsa_b_unit2(F, __builtin_amdgcn_readfirstlane(u), gb); phase_begin(F); }
}

struct EpiQKV {
    static constexpr bool PERM = true;
    bf16* QM; bf16* KVM; const float* ssq; const f32x2* tabm;
    __device__ __forceinline__ void operator()(const f32x4 (&acc)[2][2][4][2], const Unit& u, int wr, int wc, int fr, int fq) const {
        const int row0 = u.pm * 256 + wr * 64 + fr; const bool isq = u.pn < 3;
        float rs[8];
        { f32x4 s0[8], s1[8], s2[8];
#pragma unroll
          for (int i = 0; i < 8; ++i) { const GAS f32x4* sp = (const GAS f32x4*)((const GAS char*)ssq + (unsigned)(row0 + (i >> 2) * 128 + (i & 3) * 16) * 64u); s0[i] = sp[0]; s1[i] = sp[1]; s2[i] = sp[2]; }
#pragma unroll
          for (int i = 0; i < 8; ++i) rs[i] = isq ? QSCALE_M / sqrtf(((s0[i][0] + s0[i][1]) + (s0[i][2] + s0[i][3]) + (s1[i][0] + s1[i][1])) * (1.0f / 192.0f) + EPS)
                                                  : 1.0f / sqrtf(((s1[i][2] + s1[i][3]) + (s2[i][0] + s2[i][1])) * (1.0f / 128.0f) + EPS); }
        const bool isrope = isq && (((u.pn % 3) * 256 + wc * 32) % 96 == 64 || ((u.pn % 3) * 256 + 128 + wc * 32) % 96 == 64);
        f32x4 t0[8], t1[8];
        if (isrope) {
#pragma unroll
            for (int i = 0; i < 8; ++i) { const int pos = (row0 + (i >> 2) * 128 + (i & 3) * 16) & (SEQ - 1); const GAS f32x4* t = (const GAS f32x4*)((const GAS char*)tabm + (unsigned)(pos * 128 + 32 * fq)); t0[i] = t[0]; t1[i] = t[1]; } }
#pragma unroll
        for (int ai = 0; ai < 2; ++ai)
#pragma unroll
            for (int m = 0; m < 4; ++m) { const int row = row0 + ai * 128 + m * 16; const float r_ = rs[ai * 4 + m];
#pragma unroll
                for (int bj = 0; bj < 2; ++bj) {
                    const int c32 = (u.pn % 3) * 256 + bj * 128 + wc * 32, c8 = c32 + 8 * fq; const f32x4 v0 = acc[ai][bj][m][0], v1 = acc[ai][bj][m][1];
                    if (!isq) { const f32x4 a = v0 * r_, b = v1 * r_; *(v4u*)(KVM + (size_t)row * 768 + c8) = (v4u){pg8::cvt_pk_bf16(a[0], a[1]), pg8::cvt_pk_bf16(a[2], a[3]), pg8::cvt_pk_bf16(b[0], b[1]), pg8::cvt_pk_bf16(b[2], b[3])}; }
                    else if (c32 < 576) {
                        const int hd = c32 / 96, w32 = c32 - hd * 96;
                        if (w32 < 64) { const f32x4 a = v0 * r_, b = v1 * r_; *(v4u*)(QM + (size_t)row * 576 + c8) = (v4u){pg8::cvt_pk_bf16(a[0], a[1]), pg8::cvt_pk_bf16(a[2], a[3]), pg8::cvt_pk_bf16(b[0], b[1]), pg8::cvt_pk_bf16(b[2], b[3])}; }
                        else { const int i = fq; const f32x4 ta = t0[ai * 4 + m], tb = t1[ai * 4 + m]; const f32x4 x1 = v0 * r_, x2 = v1 * r_;
                            const auto s0 = __builtin_amdgcn_permlane16_swap(pg8::cvt_pk_bf16(x1[0] * ta[0] - x2[0] * ta[1], x1[1] * ta[2] - x2[1] * ta[3]), pg8::cvt_pk_bf16(x2[0] * ta[0] + x1[0] * ta[1], x2[1] * ta[2] + x1[1] * ta[3]), false, false);
                            const auto s1 = __builtin_amdgcn_permlane16_swap(pg8::cvt_pk_bf16(x1[2] * tb[0] - x2[2] * tb[1], x1[3] * tb[2] - x2[3] * tb[3]), pg8::cvt_pk_bf16(x2[2] * tb[0] + x1[2] * tb[1], x2[3] * tb[2] + x1[3] * tb[3]), false, false);
                            bf16* o = QM + (size_t)row * 576 + hd * 96 + 64 + 4 * i + ((fq & 1) ? 12 : 0);
                            *(v4u*)o = (v4u){s0[0], s1[0], s0[1], s1[1]}; }
                    }
                } }
    }
};
struct SchedQKV : pg8::TileOrder {
    const char* B;
    __device__ __forceinline__ unsigned arow(const Unit&, int r) const { return (unsigned)(r & 127) * (NU * 2); }
    __device__ __forceinline__ size_t abase(const Unit& u, int h) const { return (size_t)(u.pm * 256 + h * 128) * (NU * 2); }
    __device__ __forceinline__ const char* bbase(const Unit& u) const { return B + (size_t)u.pn * (256 * 384 * 2); }
};

__device__ __forceinline__ void p_copy_rows(Frame& F, const float* src, float* dst) {
    phase_begin(F);
    const int gw = F.vcu * NWAVES + F.wave, NGW = F.G * NWAVES;
    for (int m = gw; m < TOK; m += NGW) { const GAS f32x4* s = (const GAS f32x4*)(src + (size_t)m * DM) + F.lane; GAS f32x4* d = (GAS f32x4*)(dst + (size_t)m * DM) + F.lane;
#pragma unroll
        for (int j = 0; j < 4; ++j) d[64 * j] = s[64 * j]; }
}
template <bool ROUTE>
__device__ __forceinline__ void p_norm(Frame& F, const float* x, const float* gain, const float* rw) {
    phase_begin(F);
    bf16* XN = (bf16*)(F.ws + WS_XN);
    f32x4 gv[4];
#pragma unroll
    for (int j = 0; j < 4; ++j) gv[j] = *((const GAS f32x4*)gain + F.lane + 64 * j);
    f32x4 rwv[16][2];
    if (ROUTE) {
#pragma unroll
        for (int j = 0; j < 4; ++j)
#pragma unroll
            for (int k = 0; k < 4; ++k) { const int c = 4 * F.lane + 256 * j + k; rwv[4 * j + k][0] = *(const GAS f32x4*)(rw + (size_t)c * 8); rwv[4 * j + k][1] = *(const GAS f32x4*)(rw + (size_t)c * 8 + 4); }
    }
    LAS unsigned* es = (LAS unsigned*)F.lds;
    for (int ch = F.vcu; ch < TOK / 128; ch += F.G) {
        for (int rr = 0; rr < 16; ++rr) {
            const int m = ch * 128 + F.wave * 16 + rr;
            const GAS f32x4* xr = (const GAS f32x4*)(x + (size_t)m * DM) + F.lane;
            f32x4 v[4]; float s2 = 0.f;
#pragma unroll
            for (int j = 0; j < 4; ++j) { v[j] = xr[64 * j]; s2 += (v[j].x * v[j].x + v[j].y * v[j].y) + (v[j].z * v[j].z + v[j].w * v[j].w); }
            const float rstd = 1.0f / sqrtf(wave_sum(s2) * (1.f / DM) + EPS);
#pragma unroll
            for (int j = 0; j < 4; ++j) v[j] = v[j] * rstd * gv[j];
            GAS unsigned long long* o8 = (GAS unsigned long long*)(XN + (size_t)m * DM) + F.lane;
#pragma unroll
            for (int j = 0; j < 4; ++j) o8[64 * j] = (unsigned long long)pk2(v[j].x, v[j].y) | ((unsigned long long)pk2(v[j].z, v[j].w) << 32);
            if (ROUTE) {
                float lg[8];
#pragma unroll
                for (int e = 0; e < 8; ++e) lg[e] = 0.f;
#pragma unroll
                for (int j = 0; j < 4; ++j)
#pragma unroll
                    for (int k = 0; k < 4; ++k) { const float xv = v[j][k]; const f32x4 a = rwv[4 * j + k][0], b = rwv[4 * j + k][1];
                        lg[0] += xv * a.x; lg[1] += xv * a.y; lg[2] += xv * a.z; lg[3] += xv * a.w; lg[4] += xv * b.x; lg[5] += xv * b.y; lg[6] += xv * b.z; lg[7] += xv * b.w; }
#pragma unroll
                for (int e = 0; e < 8; ++e) lg[e] = wave_sum(lg[e]);
                int e1 = 0; float v1 = lg[0];
#pragma unroll
                for (int e = 1; e < 8; ++e) if (lg[e] > v1) { v1 = lg[e]; e1 = e; }
                int e2 = (e1 == 0) ? 1 : 0; float v2 = (e1 == 0) ? lg[1] : lg[0];
#pragma unroll
                for (int e = 0; e < 8; ++e) if (e != e1 && lg[e] > v2) { v2 = lg[e]; e2 = e; }
                const float ex = __expf(v2 - v1); const float g1 = 1.0f / (1.0f + ex), g2 = ex / (1.0f + ex);
                if (F.lane == 0) { f32x4 r; r.x = __builtin_bit_cast(float, e1); r.y = __builtin_bit_cast(float, e2); r.z = g1; r.w = g2;
                    *(GAS f32x4*)(F.ws + WS_MISC + MS_ROUTE + (size_t)m * 16) = r; es[F.wave * 16 + rr] = (unsigned)e1 | ((unsigned)e2 << 8); }
            }
        }
        if (ROUTE) {
            __syncthreads();
            { const unsigned w = (F.tid < 128) ? es[F.tid] : 0xffffu;
#pragma unroll
              for (int e = 0; e < 8; ++e) { const unsigned long long mk = __ballot((int)(w & 255u) == e || (int)(w >> 8) == e); if (F.lane == 0 && F.wave < 2) es[128 + F.wave * 8 + e] = (unsigned)__popcll(mk); } }
            __syncthreads();
            if (F.tid < 8) ((GAS int*)(F.ws + WS_MISC + MS_COUNTS))[ch * 8 + F.tid] = (int)(es[128 + F.tid] + es[136 + F.tid]);
            __syncthreads();
        }
    }
}
__device__ __forceinline__ void p_scatter(Frame& F) {
    phase_begin(F);
    LAS int* cnt = (LAS int*)F.lds;
    LAS int* tot = cnt + 2048;
    const GAS int* counts = (const GAS int*)(F.ws + WS_MISC + MS_COUNTS);
    GAS int* rowlist = (GAS int*)(F.ws + WS_MISC + MS_ROWLIST);
    GAS int* tokslot = (GAS int*)(F.ws + WS_MISC + MS_TOKSLOT);
    for (int i = F.tid; i < 2048; i += NTHR) cnt[i] = counts[i];
    __syncthreads();
    LAS int* gp = tot + 64;
    if (F.tid < 256) { const int e = F.tid & 7, g = F.tid >> 3; int t = 0;
#pragma unroll
        for (int c = 0; c < 8; ++c) t += cnt[(8 * g + c) * 8 + e];
        gp[e * 33 + g] = t; }
    __syncthreads();
    if (F.tid < 8) { int run = 0; for (int g = 0; g < 32; ++g) { const int v = gp[F.tid * 33 + g]; gp[F.tid * 33 + g] = run; run += v; } tot[F.tid] = run; }
    __syncthreads();
    if (F.tid == 0) { int b = 0; for (int e = 0; e < 8; ++e) { tot[8 + e] = b; b += (tot[e] + 255) & ~255; } tot[16] = b; }
    __syncthreads();
    LAS int* pre = tot + 32;
    for (int ch = F.vcu; ch < TOK / 128; ch += F.G) {
        if (F.tid < 8) { const int e = F.tid; int pos = tot[8 + e] + gp[e * 33 + (ch >> 3)]; for (int c = ch & ~7; c < ch; ++c) pos += cnt[c * 8 + e]; pre[e] = pos; }
        int e1 = -1, e2 = -1; const int m = ch * 128 + F.tid;
        if (F.tid < 128) { const GAS int* r = (const GAS int*)(F.ws + WS_MISC + MS_ROUTE + (size_t)m * 16); e1 = r[0]; e2 = r[1]; }
        int rk1 = 0, rk2 = 0;
        const unsigned long long lt = (1ull << F.lane) - 1ull;
#pragma unroll
        for (int e = 0; e < 8; ++e) { const unsigned long long mk = __ballot(e1 == e || e2 == e); const int rk = __popcll(mk & lt);
            if (e1 == e) rk1 = rk; if (e2 == e) rk2 = rk; if (F.tid == 0) pre[8 + e] = __popcll(mk); }
        __syncthreads();
        if (F.tid < 128) { const int add = (F.tid >= 64) ? 1 : 0;
            const int p1 = pre[e1] + (add ? pre[8 + e1] : 0) + rk1, p2 = pre[e2] + (add ? pre[8 + e2] : 0) + rk2;
            rowlist[p1] = m; tokslot[2 * m] = p1; rowlist[p2] = m; tokslot[2 * m + 1] = p2; }
        __syncthreads();
    }
    if (F.vcu == 0) {
        if (F.tid < 8) { const int e = F.tid; const int b = tot[8 + e] + tot[e], en = tot[8 + e] + ((tot[e] + 255) & ~255); for (int p = b; p < en; ++p) rowlist[p] = 0; }
        if (F.tid < 9) ((GAS int*)(F.ws + WS_MISC + MS_EBASE))[F.tid] = (F.tid < 8 ? tot[8 + F.tid] : tot[16]) / 256;
    }
}
__device__ __forceinline__ void p_combine_final(Frame& F, const float* gain) {
    phase_begin(F);
    const int gw = F.vcu * NWAVES + F.wave, NGW = F.G * NWAVES;
    const bf16* Y = (const bf16*)(F.ws + WS_Y);
    f32x4 gv[4];
#pragma unroll
    for (int j = 0; j < 4; ++j) gv[j] = *((const GAS f32x4*)gain + F.lane + 64 * j);
    f32x4 rn = (f32x4){0.f, 0.f, 0.f, 0.f}; v2u sn = (v2u){0u, 0u};
    if (gw < TOK) { rn = *(const GAS f32x4*)(F.ws + WS_MISC + MS_ROUTE + (size_t)gw * 16); sn = *(const GAS v2u*)(F.ws + WS_MISC + MS_TOKSLOT + (size_t)gw * 8); }
    for (int m = gw; m < TOK; m += NGW) {
        f32x4 r = rn; r.z *= ALPHA_MOE; r.w *= ALPHA_MOE;
        const int s1 = (int)sn.x, s2 = (int)sn.y;
        { const int mn = m + NGW; if (mn < TOK) { rn = *(const GAS f32x4*)(F.ws + WS_MISC + MS_ROUTE + (size_t)mn * 16); sn = *(const GAS v2u*)(F.ws + WS_MISC + MS_TOKSLOT + (size_t)mn * 8); } }
        GAS f32x4* xr = (GAS f32x4*)(F.out + (size_t)m * DM) + F.lane;
        const GAS v2u* y1 = (const GAS v2u*)(Y + (size_t)s1 * DM) + F.lane; const GAS v2u* y2 = (const GAS v2u*)(Y + (size_t)s2 * DM) + F.lane;
        f32x4 v[4]; float ss = 0.f;
#pragma unroll
        for (int j = 0; j < 4; ++j) { v[j] = xr[64 * j]; const v2u a = y1[64 * j], b = y2[64 * j];
            v[j].x += r.z * bflo(a.x) + r.w * bflo(b.x); v[j].y += r.z * bfhi(a.x) + r.w * bfhi(b.x); v[j].z += r.z * bflo(a.y) + r.w * bflo(b.y); v[j].w += r.z * bfhi(a.y) + r.w * bfhi(b.y);
            ss += (v[j].x * v[j].x + v[j].y * v[j].y) + (v[j].z * v[j].z + v[j].w * v[j].w); }
        const float rstd = 1.0f / sqrtf(wave_sum(ss) * (1.f / DM) + EPS);
#pragma unroll
        for (int j = 0; j < 4; ++j) xr[64 * j] = v[j] * rstd * gv[j];
    }
}
__device__ __forceinline__ void p_nan_rows(Frame& F) {
    phase_begin(F);
    const int gw = F.vcu * NWAVES + F.wave, NGW = F.G * NWAVES; const float q = __builtin_nanf("");
    for (int m = gw; m < TOK; m += NGW) { GAS f32x4* o = (GAS f32x4*)(F.out + (size_t)m * DM) + F.lane;
#pragma unroll
        for (int j = 0; j < 4; ++j) o[64 * j] = (f32x4){q, q, q, q}; }
}


#ifdef DBG
constexpr int CW_DBG = 20000;
#ifndef DBG_STAT
#define DBG_STAT 40
#endif
__device__ __forceinline__ unsigned hsh(unsigned a) { a ^= a >> 16; a *= 0x7feb352du; a ^= a >> 15; a *= 0x846ca68bu; a ^= a >> 16; return a; }
__device__ __forceinline__ void dbg_put(Frame& F, int id, float err) { if (!(err >= 0.f)) err = 1e30f; atomicMax((unsigned*)(F.ctl + CW_DBG + id), __builtin_bit_cast(unsigned, err)); }
__device__ __forceinline__ float relerr(float got, float ref) { return fabsf(got - ref) / (fabsf(ref) + 1.0f); }
__device__ __forceinline__ float silu_ref(float g) { return g / (1.0f + expf(-g)); }
__device__ __forceinline__ int dbg_sample(Frame& F, int salt) { return (int)hsh((unsigned)(blockIdx.x * NTHR + F.tid) * 7919u + (unsigned)salt); }
__device__ __forceinline__ void chk_xn(Frame& F, int id, const float* x, const float* gain) {
    phase_begin(F); if (blockIdx.x >= 16) return;
    const unsigned h = (unsigned)dbg_sample(F, 11); const int row = h % TOK, col = (h >> 16) % DM;
    float ss = 0.f; for (int k = 0; k < DM; ++k) { const float v = x[(size_t)row * DM + k]; ss += v * v; }
    const float ref = x[(size_t)row * DM + col] / sqrtf(ss / DM + EPS) * gain[col];
    dbg_put(F, id, relerr(bf2f(((const bf16*)(F.ws + WS_XN))[(size_t)row * DM + col]), ref));
}
__device__ __forceinline__ void chk_ffn_up(Frame& F, int id, const float* wg, const float* wu) {
    phase_begin(F); if (blockIdx.x >= 16) return;
    const unsigned h = (unsigned)dbg_sample(F, 23); const int row = h % TOK, hid = (h >> 15) % DFF;
    const bf16* xn = (const bf16*)(F.ws + WS_XN) + (size_t)row * DM; float g = 0.f, u = 0.f;
    for (int k = 0; k < DM; ++k) { const float a = bf2f(xn[k]); g += a * wg[(size_t)k * DFF + hid]; u += a * wu[(size_t)k * DFF + hid]; }
    dbg_put(F, id, relerr(bf2f(((const bf16*)(F.ws + WS_H))[(size_t)row * DFF + hid]), silu_ref(g) * u));
}
__device__ __forceinline__ void chk_ffn_down(Frame& F, int id, const float* base, const float* wd) {
    phase_begin(F); if (blockIdx.x >= 16) return;
    const unsigned h = (unsigned)dbg_sample(F, 37); const int row = h % TOK, col = (h >> 16) % DM;
    const bf16* hr = (const bf16*)(F.ws + WS_H) + (size_t)row * DFF; float a = base[(size_t)row * DM + col];
    for (int k = 0; k < DFF; ++k) a += bf2f(hr[k]) * wd[(size_t)k * DM + col];
    dbg_put(F, id, relerr(F.out[(size_t)row * DM + col], a));
}
__device__ __forceinline__ void chk_route(Frame& F, int id, const float* x, const float* gain, const float* rw) {
    phase_begin(F); if (blockIdx.x >= 4) return;
    const unsigned h = (unsigned)dbg_sample(F, 41); const int row = h % TOK;
    float ss = 0.f; for (int k = 0; k < DM; ++k) { const float v = x[(size_t)row * DM + k]; ss += v * v; }
    const float rstd = 1.0f / sqrtf(ss / DM + EPS); float lg[8]; for (int e = 0; e < 8; ++e) lg[e] = 0.f;
    for (int k = 0; k < DM; ++k) { const float v = x[(size_t)row * DM + k] * rstd * gain[k]; for (int e = 0; e < 8; ++e) lg[e] += v * rw[(size_t)k * 8 + e]; }
    int e1 = 0; for (int e = 1; e < 8; ++e) if (lg[e] > lg[e1]) e1 = e;
    int e2 = (e1 == 0) ? 1 : 0; for (int e = 0; e < 8; ++e) if (e != e1 && lg[e] > lg[e2]) e2 = e;
    const float g1 = 1.0f / (1.0f + expf(lg[e2] - lg[e1]));
    const GAS int* r = (const GAS int*)(F.ws + WS_MISC + MS_ROUTE + (size_t)row * 16);
    float gap = 1e9f; for (int e = 0; e < 8; ++e) if (e != e1 && e != e2) gap = fminf(gap, lg[e2] - lg[e]);
    float err = 0.f;
    if (gap > 1e-3f && lg[e1] - lg[e2] > 1e-3f) { if (r[0] != e1 || r[1] != e2) err = 10.f; err = fmaxf(err, fabsf(__builtin_bit_cast(float, r[2]) - g1)); }
    dbg_put(F, id, err);
    const GAS int* ts = (const GAS int*)(F.ws + WS_MISC + MS_TOKSLOT); const GAS int* rl = (const GAS int*)(F.ws + WS_MISC + MS_ROWLIST); const GAS int* eb = (const GAS int*)(F.ws + WS_MISC + MS_EBASE);
    float e2r = 0.f;
    for (int k = 0; k < 2; ++k) { const int sl = ts[2 * row + k]; if (sl < 0 || sl >= MAXSLOT || rl[sl] != row) { e2r = 10.f; break; }
        int ex = 0; for (int j = 1; j < 8; ++j) ex += (sl / 256 >= eb[j]) ? 1 : 0; if (ex != r[k]) e2r = 20.f; }
    dbg_put(F, id + 1, e2r);
}
__device__ __forceinline__ void chk_moe_up(Frame& F, int id, const float* wg, const float* wu) {
    phase_begin(F); if (blockIdx.x >= 16) return;
    const GAS int* eb = (const GAS int*)(F.ws + WS_MISC + MS_EBASE); const GAS int* rl = (const GAS int*)(F.ws + WS_MISC + MS_ROWLIST);
    const unsigned h = (unsigned)dbg_sample(F, 53); const int slot = h % (eb[8] * 256), hid = (h >> 15) % DFE; const int row = rl[slot];
    int ex = 0; for (int j = 1; j < 8; ++j) ex += (slot / 256 >= eb[j]) ? 1 : 0;
    const bf16* xn = (const bf16*)(F.ws + WS_XN) + (size_t)row * DM; float g = 0.f, u = 0.f;
    for (int k = 0; k < DM; ++k) { const float a = bf2f(xn[k]); g += a * wg[((size_t)ex * DM + k) * DFE + hid]; u += a * wu[((size_t)ex * DM + k) * DFE + hid]; }
    dbg_put(F, id, relerr(bf2f(((const bf16*)(F.ws + WS_H))[(size_t)slot * DFE + hid]), silu_ref(g) * u));
}
__device__ __forceinline__ void chk_moe_down(Frame& F, int id, const float* wd) {
    phase_begin(F); if (blockIdx.x >= 16) return;
    const GAS int* eb = (const GAS int*)(F.ws + WS_MISC + MS_EBASE);
    const unsigned h = (unsigned)dbg_sample(F, 67); const int slot = h % (eb[8] * 256), col = (h >> 16) % DM;
    int ex = 0; for (int j = 1; j < 8; ++j) ex += (slot / 256 >= eb[j]) ? 1 : 0;
    const bf16* hr = (const bf16*)(F.ws + WS_H) + (size_t)slot * DFE; float a = 0.f;
    for (int k = 0; k < DFE; ++k) a += bf2f(hr[k]) * wd[((size_t)ex * DFE + k) * DM + col];
    dbg_put(F, id, relerr(bf2f(((const bf16*)(F.ws + WS_Y))[(size_t)slot * DM + col]), a));
}

__device__ __forceinline__ void chk_u(Frame& F, int id, const float* w_in) {
    phase_begin(F); if (blockIdx.x >= 16) return;
    const unsigned h = (unsigned)dbg_sample(F, 71 + id); const int row = h % TOK, c = (h >> 15) % IN_COLS, pos = row & (SEQ - 1);
    const bf16* xn = (const bf16*)(F.ws + WS_XN) + (size_t)row * DM;
    int c1 = c, c2 = -1; float cs = 1.f, sn = 0.f, sc = 1.f; bool second = false;
    if (is_rope64(c)) { const int seg = c >= C_KW ? C_KW : c >= C_KS ? C_KS : c >= C_KC ? C_KC : C_QN; const int l = c - seg, hb = seg + (l & ~63), dd = l & 63, i = dd & 31;
        c1 = hb + i; c2 = hb + 32 + i; second = dd >= 32; const float ang = (float)pos * INV_N[i]; cs = cosf(ang); sn = sinf(ang); if (seg == C_QN) sc = QSCALE_N; }
    else if (c >= C_KPE && c < C_QN) { const int dd = c - C_KPE, i = dd & 15; c1 = C_KPE + i; c2 = C_KPE + 16 + i; second = dd >= 16; const float ang = (float)pos * INV_M[i]; cs = cosf(ang); sn = sinf(ang); }
    float a1 = 0.f, a2 = 0.f;
    for (int k = 0; k < DM; ++k) { const float a = bf2f(xn[k]); a1 += a * w_in[(size_t)k * IN_COLS + c1]; if (c2 >= 0) a2 += a * w_in[(size_t)k * IN_COLS + c2]; }
    const float ref = (c2 < 0) ? a1 : (second ? (a2 * cs + a1 * sn) * sc : (a1 * cs - a2 * sn) * sc);
    dbg_put(F, id, relerr(bf2f(((const bf16*)(F.ws + WS_U))[(size_t)row * NU + c]), ref));
}
__device__ __forceinline__ void chk_lru(Frame& F, int id, const float* cw, const float* cb, const float* wa, const float* ba, const float* wx, const float* bx, const float* lam) {
    phase_begin(F); if (blockIdx.x >= 2) return;
    const unsigned hs = (unsigned)dbg_sample(F, 91 + id); const int b = hs & 3, pos = (hs >> 2) % 150, d = (hs >> 16) & 255, blk = d >> 6, dd = d & 63;
    const bf16* U = (const bf16*)(F.ws + WS_U); const float sp = logf(1.0f + expf(-lam[d])); float h = 0.f;
    for (int p = 0; p <= pos; ++p) { const size_t t = (size_t)b * SEQ + p; float ra = ba[d], ia = bx[d], xcd = 0.f;
        for (int c = 0; c < 64; ++c) { const int ch = blk * 64 + c; float xc = cb[ch];
            for (int k = 0; k < 4; ++k) { const int pp = p - 3 + k; if (pp >= 0) xc += cw[k * 256 + ch] * bf2f(U[((size_t)b * SEQ + pp) * NU + C_XL + ch]); }
            ra += xc * wa[(size_t)(blk * 64 + c) * 64 + dd]; ia += xc * wx[(size_t)(blk * 64 + c) * 64 + dd]; if (c == dd) xcd = xc; }
        const float r = 1.0f / (1.0f + expf(-ra)), ig = 1.0f / (1.0f + expf(-ia)), la = -8.0f * r * sp, a = expf(la);
        h = a * h + sqrtf(1.0f - expf(2.0f * la)) * (ig * xcd); }
    const size_t t = (size_t)b * SEQ + pos; const float y = bf2f(U[t * NU + C_YL + d]); const float gl = 0.5f * y * (1.0f + tanhf(0.7978845608f * (y + 0.044715f * y * y * y)));
    dbg_put(F, id, relerr(bf2f(((const bf16*)(F.ws + WS_CAT))[t * DM + d]), h * gl));
}

__device__ __forceinline__ void chk_lru_rec(Frame& F, int id, const float* cw, const float* cb, const float* wa, const float* ba, const float* wx, const float* bx, const float* lam) {
    phase_begin(F); if (blockIdx.x >= 8) return;
    const unsigned hs = (unsigned)dbg_sample(F, 191 + id); const int b = hs & 3, pos = 4 + (hs >> 2) % (SEQ - 4), d = (hs >> 16) & 255, blk = d >> 6, dd = d & 63;
    const bf16* U = (const bf16*)(F.ws + WS_U); const bf16* CAT = (const bf16*)(F.ws + WS_CAT); const float sp = logf(1.0f + expf(-lam[d]));
    const size_t t = (size_t)b * SEQ + pos;
    float ra = ba[d], ia = bx[d], xcd = 0.f;
    for (int c = 0; c < 64; ++c) { const int ch = blk * 64 + c; float xc = cb[ch];
        for (int k = 0; k < 4; ++k) xc += cw[k * 256 + ch] * bf2f(U[(t - 3 + k) * NU + C_XL + ch]);
        ra += xc * wa[(size_t)(blk * 64 + c) * 64 + dd]; ia += xc * wx[(size_t)(blk * 64 + c) * 64 + dd]; if (c == dd) xcd = xc; }
    const float r = 1.0f / (1.0f + expf(-ra)), ig = 1.0f / (1.0f + expf(-ia)), la = -8.0f * r * sp, a = expf(la);
    const float y0 = bf2f(U[(t - 1) * NU + C_YL + d]), y1 = bf2f(U[t * NU + C_YL + d]);
    const float g0 = 0.5f * y0 * (1.0f + tanhf(0.7978845608f * (y0 + 0.044715f * y0 * y0 * y0))), g1 = 0.5f * y1 * (1.0f + tanhf(0.7978845608f * (y1 + 0.044715f * y1 * y1 * y1)));
    float err = 0.f;
    if (fabsf(g0) > 0.25f) { const float hp = bf2f(CAT[(t - 1) * DM + d]) / g0; const float ref = (a * hp + sqrtf(1.0f - expf(2.0f * la)) * (ig * xcd)) * g1; err = relerr(bf2f(CAT[t * DM + d]), ref); }
    dbg_put(F, id, err);
}
__device__ __forceinline__ void chk_outproj(Frame& F, int id, const float* base, const float* w_out) {
    phase_begin(F); if (blockIdx.x >= 16) return;
    const unsigned h = (unsigned)dbg_sample(F, 37 + id); const int row = h % TOK, col = (h >> 16) % DM;
    const bf16* cr = (const bf16*)(F.ws + WS_CAT) + (size_t)row * DM; float a = base[(size_t)row * DM + col];
    for (int k = 0; k < DM; ++k) a += bf2f(cr[k]) * w_out[(size_t)k * DM + col];
    dbg_put(F, id, relerr(F.out[(size_t)row * DM + col], a));
}


__device__ __forceinline__ void chk_qkv(Frame& F, int id, const float* qn, const float* wuq, const float* kvn, const float* wukv) {
    phase_begin(F); if (blockIdx.x >= 16) return;
    const unsigned hs = (unsigned)dbg_sample(F, 301 + id); const int row = hs % TOK, pos = row & (SEQ - 1); const bf16* ur = (const bf16*)(F.ws + WS_U) + (size_t)row * NU;
    float err;
    if (hs & 0x80000000u) {
        const int c = (hs >> 15) % 768; float ss = 0.f, a = 0.f;
        for (int k = 0; k < 128; ++k) { const float v = bf2f(ur[C_KVDN + k]); ss += v * v; a += v * kvn[k] * wukv[(size_t)k * 768 + c]; }
        err = relerr(bf2f(((const bf16*)(F.ws + WS_KVM))[(size_t)row * 768 + c]), a / sqrtf(ss / 128.f + EPS));
    } else {
        const int c = (hs >> 15) % 576, hd = c / 96, w = c % 96; int c1 = c, c2 = -1; bool second = false; float cs = 1.f, sn = 0.f;
        if (w >= 64) { const int i = (w - 64) & 15; c1 = hd * 96 + 64 + i; c2 = c1 + 16; second = (w - 64) >= 16; const float ang = (float)pos * INV_M[i]; cs = cosf(ang); sn = sinf(ang); }
        float ss = 0.f, a1 = 0.f, a2 = 0.f;
        for (int k = 0; k < 192; ++k) { const float v = bf2f(ur[C_QDN + k]); ss += v * v; a1 += v * qn[k] * wuq[(size_t)k * 576 + c1]; if (c2 >= 0) a2 += v * qn[k] * wuq[(size_t)k * 576 + c2]; }
        const float rs = QSCALE_M / sqrtf(ss / 192.f + EPS); const float ref = (c2 < 0) ? a1 * rs : (second ? (a2 * cs + a1 * sn) * rs : (a1 * cs - a2 * sn) * rs);
        err = relerr(bf2f(((const bf16*)(F.ws + WS_QM))[(size_t)row * 576 + c]), ref);
    }
    dbg_put(F, id, err);
}
__device__ __forceinline__ void chk_mla(Frame& F, int id) {
    phase_begin(F); if (blockIdx.x >= 4) return;
    const unsigned hs = (unsigned)dbg_sample(F, 401 + id); const int b = hs & 3, h = (hs >> 2) % 6, d = (hs >> 8) & 63, pos = (F.tid < 64) ? (int)((hs >> 14) % SEQ) : (int)((hs >> 14) % 1200);
    const bf16* QM = (const bf16*)(F.ws + WS_QM); const bf16* KVM = (const bf16*)(F.ws + WS_KVM); const bf16* U = (const bf16*)(F.ws + WS_U);
    const size_t t = (size_t)b * SEQ + pos; float m = -1e30f, l = 0.f, o = 0.f;
    for (int k = 0; k <= pos; ++k) { const size_t tk = (size_t)b * SEQ + k; float sc = 0.f;
        for (int j = 0; j < 64; ++j) sc += bf2f(QM[t * 576 + h * 96 + j]) * bf2f(KVM[tk * 768 + h * 128 + j]);
        for (int j = 0; j < 32; ++j) sc += bf2f(QM[t * 576 + h * 96 + 64 + j]) * bf2f(U[tk * NU + C_KPE + j]);
        const float mn = fmaxf(m, sc), al = exp2f(m - mn), p = exp2f(sc - mn); l = l * al + p; o = o * al + p * bf2f(KVM[tk * 768 + h * 128 + 64 + d]); m = mn; }
    dbg_put(F, id, fabsf(bf2f(((const bf16*)(F.ws + WS_CAT))[t * DM + 256 + h * 64 + d]) - o / l) / (fabsf(o / l) + 0.05f));
}

__device__ __forceinline__ void chk_kc(Frame& F, int id, const float* cpos, const float* w1, const float* w2) {
    phase_begin(F); if (blockIdx.x >= 8) return;
    const int grp = F.tid >> 7, j = F.tid & 127; LAS float* red = (LAS float*)F.lds;
    for (int it = 0; it < 4; ++it) {
        const unsigned hs = hsh((unsigned)((blockIdx.x * 4 + grp) * 4 + it) * 7919u + 501u + (unsigned)id); const int sr = hs & 1, b = (hs >> 1) & 3, g = (hs >> 3) & 1, n = (hs >> 4) % 511, d = (hs >> 16) & 63;
        const bf16* U = (const bf16*)(F.ws + WS_U); float y = 0.f;
        for (int l = 0; l < 32; ++l) for (int dd = 0; dd < 64; ++dd) { const float x = bf2f(U[((size_t)b * SEQ + 16 * n + l) * NU + (sr ? C_VC : C_KC) + g * 64 + dd]) + cpos[sr * 2048 + l * 64 + dd];
            y += x * w1[((size_t)sr * 2048 + l * 64 + dd) * 128 + j]; }
        __syncthreads();
        red[F.tid] = 0.5f * y * (1.0f + tanhf(0.7978845608f * (y + 0.044715f * y * y * y))) * w2[((size_t)sr * 128 + j) * 64 + d];
        __syncthreads();
        if (j == 0) { float a = 0.f; for (int k = 0; k < 128; ++k) a += red[grp * 128 + k];
            dbg_put(F, id, fabsf(bf2f(((const bf16*)(F.ws + WS_KC))[((size_t)(sr * 8 + b * 2 + g) * 512 + n) * 64 + d]) - a) / (fabsf(a) + 0.25f)); }
    }
    __syncthreads();
}
__device__ __forceinline__ void chk_nsa(Frame& F, int id, const float* gb) {
    phase_begin(F); if (blockIdx.x >= 1) return;
    const unsigned hs = (unsigned)dbg_sample(F, 601 + id); const int b = hs & 3, h = (hs >> 2) % 6, g = h / 3, d = (hs >> 8) & 63;
    const int pos = (F.tid < 32) ? (int)((hs >> 14) % SEQ) : (F.tid < 256) ? (int)(1024 + (hs >> 14) % 700) : (int)((hs >> 14) % 1100);
    const bf16* U = (const bf16*)(F.ws + WS_U); const bf16* KC = (const bf16*)(F.ws + WS_KC) + (size_t)(b * 2 + g) * KC_HEAD; const bf16* VC = KC + 8 * KC_HEAD;
    float* P3 = (float*)(F.ws + WS_XN + 32 * MiB) + (size_t)F.tid * 1024; float* imp = P3 + 512;
    const size_t t = (size_t)b * SEQ + pos; const int nv = (pos >= 31) ? (pos - 31) / 16 + 1 : 0;
    for (int n = 0; n < 512; ++n) P3[n] = 0.f;
    float oc = 0.f;
    float* SC = P3 + 1024 * 512;
    for (int p = 0; p < 3; ++p) { const int hh = g * 3 + p; float m = -1e30f;
        for (int n = 0; n < nv; ++n) { float sc = 0.f; for (int j = 0; j < 64; ++j) sc += bf2f(U[t * NU + C_QN + hh * 64 + j]) * bf2f(KC[n * 64 + j]); SC[n] = sc; m = fmaxf(m, sc); }
        float l = 0.f; for (int n = 0; n < nv; ++n) l += exp2f(SC[n] - m);
        for (int n = 0; n < nv; ++n) { const float pr = exp2f(SC[n] - m) / l; P3[n] += pr; if (hh == h) oc += pr * bf2f(VC[n * 64 + d]); } }
    const int cur = pos >> 6;
    for (int s2 = 0; s2 < 128; ++s2) { float a = 0.f; for (int n = 4 * s2 - 1; n <= 4 * s2 + 3; ++n) if (n >= 0 && n < nv) a += P3[n]; imp[s2] = (s2 <= cur) ? a : -1.f; }
    unsigned mk[4] = {0u, 0u, 0u, 0u}; float gapmin = 1e9f;
    { int cnt = 0; imp[0] += 1000.f; if (cur != 0) imp[cur] += 1000.f;
      for (int r = 0; r < 16; ++r) { int bi = -1; float bv = -0.5f; for (int s2 = 0; s2 < 128; ++s2) if (imp[s2] > bv) { bv = imp[s2]; bi = s2; } if (bi < 0) break;
          if (r == 15) { float nx = -0.5f; for (int s2 = 0; s2 < 128; ++s2) if (s2 != bi && imp[s2] > nx) nx = imp[s2]; gapmin = bv - nx; }
          imp[bi] = -3.f; const unsigned bit = 1u << (bi & 31); if ((bi >> 5) == 0) mk[0] |= bit; else if ((bi >> 5) == 1) mk[1] |= bit; else if ((bi >> 5) == 2) mk[2] |= bit; else mk[3] |= bit; ++cnt; } }
    const GAS unsigned* km = (const GAS unsigned*)(F.ws + WS_MASK) + ((size_t)(b * 2 + g) * SEQ + pos) * 4;
    const bool same = km[0] == mk[0] && km[1] == mk[1] && km[2] == mk[2] && km[3] == mk[3];
    dbg_put(F, id + 1, (same || gapmin < 2e-3f) ? 0.f : 10.f);
    float m = -1e30f, l = 0.f, os = 0.f;
    for (int k = 0; k <= pos; ++k) { const unsigned w = km[k >> 11]; if (!((w >> ((k >> 6) & 31)) & 1u)) continue; const size_t tk = (size_t)b * SEQ + k; float sc = 0.f;
        for (int j = 0; j < 64; ++j) sc += bf2f(U[t * NU + C_QN + h * 64 + j]) * bf2f(U[tk * NU + C_KS + g * 64 + j]);
        const float mn = fmaxf(m, sc), al = exp2f(m - mn), pr = exp2f(sc - mn); l = l * al + pr; os = os * al + pr * bf2f(U[tk * NU + C_VS + g * 64 + d]); m = mn; }
    os = (l > 0.f) ? os / l : 0.f;
    m = -1e30f; l = 0.f; float ow = 0.f;
    for (int k = (pos - 511 < 0 ? 0 : pos - 511); k <= pos; ++k) { const size_t tk = (size_t)b * SEQ + k; float sc = 0.f;
        for (int j = 0; j < 64; ++j) sc += bf2f(U[t * NU + C_QN + h * 64 + j]) * bf2f(U[tk * NU + C_KW + g * 64 + j]);
        const float mn = fmaxf(m, sc), al = exp2f(m - mn), pr = exp2f(sc - mn); l = l * al + pr; ow = ow * al + pr * bf2f(U[tk * NU + C_VW + g * 64 + d]); m = mn; }
    ow /= l;
    float gt[3]; for (int br = 0; br < 3; ++br) gt[br] = 1.0f / (1.0f + expf(-(bf2f(U[t * NU + C_GN + h * 3 + br]) + gb[h * 3 + br])));
    const float ref = gt[0] * oc + gt[1] * os + gt[2] * ow;
    dbg_put(F, id, fabsf(bf2f(((const bf16*)(F.ws + WS_CAT))[t * DM + 640 + h * 64 + d]) - ref) / (fabsf(ref) + 0.02f));
}
__device__ __forceinline__ void stat_mix(Frame& F, const float* x) {
    phase_begin(F); if (blockIdx.x >= 16) return;
    const unsigned h = (unsigned)dbg_sample(F, 777); const int row = h % TOK, col = (h >> 16) % DM;
    const float d = F.out[(size_t)row * DM + col] - x[(size_t)row * DM + col];
    atomicAdd((float*)(F.ctl + CW_DBG + 40), d * d);
    const float c = bf2f(((const bf16*)(F.ws + WS_CAT))[(size_t)row * DM + (col & 255)]);
    atomicAdd((float*)(F.ctl + CW_DBG + 41), c * c);
}
__device__ __forceinline__ void dbg_finish(Frame& F, int nchk) {
    if (blockIdx.x == 0 && F.tid == 0) { for (int i = 0; i < nchk; ++i) { const float e = __builtin_bit_cast(float, xb_ld((unsigned*)(F.ctl + CW_DBG + i))); if (!(e <= 0.05f)) { F.out[0] = 1000.f * (i + 1); return; } }
#ifdef DBG_STATOUT
        const float st = __builtin_bit_cast(float, xb_ld((unsigned*)(F.ctl + CW_DBG + DBG_STAT))) / 8192.f; F.out[0] = 1.0e5f * st;
#endif
    }
}
#ifdef DBG_ALL
#define DBGRUN(stmt) do { stmt; GRID_BAR(); } while (0)
#else
#define DBGRUN(stmt) do {} while (0)
#endif
#define DBGNEW(stmt) do { stmt; GRID_BAR(); } while (0)
#else
#define DBGNEW(stmt) do {} while (0)
#define DBGRUN(stmt) do {} while (0)
#endif

struct Args { const float* in[28]; float* out; unsigned char* ws; };
#ifndef PHM
#define PHM 0xffff
#endif
__device__ __forceinline__ void grid_bar(Frame& F) {
    XcdBarrier b_; b_.bar = (unsigned*)((gu32*)((unsigned char*)ARGP(29) + WS_CTL) + CW_BAR); b_.x = xb_xcc_id(); b_.st = (volatile LAS unsigned*)(F.lds + MISC_OFF) + 8; phase_begin(F); xcd_barrier(b_, F.tid);
}
#define GRID_BAR() grid_bar(F)

template <int L>
__device__ __forceinline__ void mixer_layer(Frame& F) {
    if (L != 0) {
        p_norm<false>(F, (const float*)ARGP(28), ARGP(1) + (size_t)L * DM, nullptr);
        GRID_BAR(); }
    if (PHM & 1024) { phase_begin(F); SchedPlain S; S.init(TOK / 256, NU / 256, F.G, (int)blockIdx.x); S.lda2 = DM * 2; S.B = (const char*)(F.ws + WS_WIN) + (size_t)L * NU * DM * 2; S.btile = (size_t)256 * DM * 2;
      EpiInProj E{(bf16*)(F.ws + WS_U), (const f32x2*)(F.ws + WS_TABN), (const f32x2*)(F.ws + WS_TABM), (float*)(F.ws + WS_SSQ)};
      pg8::gemm_phase(F.tid, F.lds, (const char*)(F.ws + WS_XN), DM, 128u, (unsigned)DM, S, E);
#if DUP & 4
      GRID_BAR(); pg8::gemm_phase(F.tid, F.lds, (const char*)(F.ws + WS_XN), DM, 128u, (unsigned)DM, S, E);
#endif
    }
    GRID_BAR();
    DBGRUN(chk_u(F, 8 + 3 * L, ARGP(2) + (size_t)L * DM * IN_COLS));
    { phase_begin(F); SchedQKV S; S.init(TOK / 256, 6, F.G, (int)blockIdx.x); S.B = (const char*)(F.ws + WS_WQKV) + (size_t)L * 1536 * 384 * 2;
      EpiQKV E{(bf16*)(F.ws + WS_QM), (bf16*)(F.ws + WS_KVM), (const float*)(F.ws + WS_SSQ), (const f32x2*)(F.ws + WS_TABM)};
      pg8::gemm_phase(F.tid, F.lds, (const char*)(F.ws + WS_U) + C_QDN * 2, 384, 128u, 384u, S, E); }
    { phase_begin(F); SchedCmp S; S.init(32, 1, F.G, (int)blockIdx.x); S.B = (const char*)(F.ws + WS_WC1) + (size_t)L * 2 * 256 * 2048 * 2;
      EpiCmp E{(bf16*)(F.ws + WS_G1C), (const float*)(F.ws + WS_MISC + MS_CBIAS) + L * 256};
      pg8::gemm_phase(F.tid, F.lds, (const char*)(F.ws + WS_U), 2048, (unsigned)(NU * 2), 2048u, S, E); }
    if (PHM & 512) p_lru_local(F, 20 + L, ARGP(3) + (size_t)L * 1024, ARGP(4) + (size_t)L * 256, ARGP(5) + (size_t)L * 16384, ARGP(6) + (size_t)L * 256, ARGP(7) + (size_t)L * 16384, ARGP(8) + (size_t)L * 256, ARGP(9) + (size_t)L * 256);
    GRID_BAR();
#if DUP & 8
#if DUP & 256
    { phase_begin(F); SchedQKV S; S.init(TOK / 256, 6, F.G, (int)blockIdx.x); S.B = (const char*)(F.ws + WS_WQKV) + (size_t)L * 1536 * 384 * 2;
      EpiQKV E{(bf16*)(F.ws + WS_QM), (bf16*)(F.ws + WS_KVM), (const float*)(F.ws + WS_SSQ), (const f32x2*)(F.ws + WS_TABM)};
      pg8::gemm_phase(F.tid, F.lds, (const char*)(F.ws + WS_U) + C_QDN * 2, 384, 128u, 384u, S, E); }
#endif
#if DUP & 512
    { phase_begin(F); SchedCmp S; S.init(32, 1, F.G, (int)blockIdx.x); S.B = (const char*)(F.ws + WS_WC1) + (size_t)L * 2 * 256 * 2048 * 2;
      EpiCmp E{(bf16*)(F.ws + WS_G1C), (const float*)(F.ws + WS_MISC + MS_CBIAS) + L * 256};
      pg8::gemm_phase(F.tid, F.lds, (const char*)(F.ws + WS_U), 2048, (unsigned)(NU * 2), 2048u, S, E); }
#endif
#if DUP & 1024
    if (PHM & 512) p_lru_local(F, 20 + L, ARGP(3) + (size_t)L * 1024, ARGP(4) + (size_t)L * 256, ARGP(5) + (size_t)L * 16384, ARGP(6) + (size_t)L * 256, ARGP(7) + (size_t)L * 16384, ARGP(8) + (size_t)L * 256, ARGP(9) + (size_t)L * 256);
#endif
    GRID_BAR();
#endif
    if (PHM & 8192) p_lru_carry(F);
    p_cmp2(F, ARGP(16) + (size_t)L * 2 * 128 * 64);
    phase_begin(F); unit_publish(F, CW_FLAG + 512 + L);
#if DUP & 64
    if (PHM & 8192) p_lru_carry(F);
    p_cmp2(F, ARGP(16) + (size_t)L * 2 * 128 * 64);
    GRID_BAR();
#endif
    DBGRUN(chk_qkv(F, 16 + L, ARGP(10) + L * 192, ARGP(11) + (size_t)L * 192 * 576, ARGP(12) + L * 128, ARGP(13) + (size_t)L * 128 * 768));
    DBGNEW(chk_kc(F, 20 + L, ARGP(14) + (size_t)L * 4096, ARGP(15) + (size_t)L * 2 * 2048 * 128, ARGP(16) + (size_t)L * 2 * 128 * 64));
    p_attn1(F, 2 * L, ARGP(17) + L * 18);
#if DUP & 3
    GRID_BAR();
#endif
#if DUP & 1
    p_attn1(F, 4 + 2 * L, ARGP(17) + L * 18); GRID_BAR();
#endif
#ifdef ATTVAR
    p_attn2<ATTVAR>(F, 4 + 2 * L + 1, ARGP(17) + L * 18); GRID_BAR();
#endif
    p_attn2<0>(F, 2 * L + 1, ARGP(17) + L * 18);
#if DUP & 2
    GRID_BAR(); p_attn2<0>(F, 4 + 2 * L + 1, ARGP(17) + L * 18);
#endif
    if (PHM & 16384) p_lru_fix(F, 1024);
    GRID_BAR();
    DBGRUN(chk_mla(F, 18 + L));
    DBGNEW(chk_nsa(F, 22 + 2 * L, ARGP(17) + L * 18));
    DBGRUN(chk_lru(F, 9 + 3 * L, ARGP(3) + (size_t)L * 1024, ARGP(4) + (size_t)L * 256, ARGP(5) + (size_t)L * 16384, ARGP(6) + (size_t)L * 256, ARGP(7) + (size_t)L * 16384, ARGP(8) + (size_t)L * 256, ARGP(9) + (size_t)L * 256));
    DBGRUN(chk_lru_rec(F, 14 + L, ARGP(3) + (size_t)L * 1024, ARGP(4) + (size_t)L * 256, ARGP(5) + (size_t)L * 16384, ARGP(6) + (size_t)L * 256, ARGP(7) + (size_t)L * 16384, ARGP(8) + (size_t)L * 256, ARGP(9) + (size_t)L * 256));
    if (PHM & 32768) { phase_begin(F); SchedPlain S; S.init(TOK / 256, DM / 256, F.G, (int)blockIdx.x); S.lda2 = DM * 2; S.B = (const char*)(F.ws + WS_WOUT) + (size_t)L * DM * DM * 2; S.btile = (size_t)256 * DM * 2;
      EpiResF32 E{L == 0 ? ARGP(0) : (const float*)F.out, F.out, DM, ALPHA_MIX};
      pg8::gemm_phase(F.tid, F.lds, (const char*)(F.ws + WS_CAT), DM, 128u, (unsigned)DM, S, E); }
    GRID_BAR();
    if (L == 0) DBGRUN(chk_outproj(F, 10, ARGP(0), ARGP(18)));
    if (L == 0) DBGRUN(stat_mix(F, ARGP(0)));
}
__device__ __forceinline__ void ffn_dense(Frame& F) {
    p_norm<false>(F, (const float*)ARGP(28), ARGP(19), nullptr);
    GRID_BAR();
    DBGRUN(chk_xn(F, 0, F.out, ARGP(19)));
#ifdef GEMMPROBE
    { phase_begin(F); SchedPlain S; S.init(TOK / 256, 2 * DFF / 256, F.G, (int)blockIdx.x); S.lda2 = DM * 2; S.B = (const char*)(F.ws + WS_WGU); S.btile = (size_t)256 * DM * 2;
#if GEMMPROBE == 1
      EpiNull E{};
#else
      EpiSwiGLU E{(bf16*)(F.ws + WS_H), DFF};
#endif
      pg8::gemm_phase(F.tid, F.lds, (const char*)(F.ws + WS_XN), DM, 128u, (unsigned)DM, S, E); GRID_BAR(); }
#endif
    if (PHM & 8) { phase_begin(F); SchedPlain S; S.init(TOK / 256, 2 * DFF / 256, F.G, (int)blockIdx.x); S.lda2 = DM * 2; S.B = (const char*)(F.ws + WS_WGU); S.btile = (size_t)256 * DM * 2;
      EpiSwiGLU E{(bf16*)(F.ws + WS_H), DFF};
      pg8::gemm_phase(F.tid, F.lds, (const char*)(F.ws + WS_XN), DM, 128u, (unsigned)DM, S, E);
#if DUP & 16
      GRID_BAR(); pg8::gemm_phase(F.tid, F.lds, (const char*)(F.ws + WS_XN), DM, 128u, (unsigned)DM, S, E);
#endif
    }
    GRID_BAR();
    DBGRUN(chk_ffn_up(F, 1, ARGP(20), ARGP(21)));
    if (PHM & 16) { phase_begin(F); SchedPlain S; S.init(TOK / 256, DM / 256, F.G, (int)blockIdx.x); S.lda2 = DFF * 2; S.B = (const char*)(F.ws + WS_WD); S.btile = (size_t)256 * DFF * 2;
      EpiResF32 E{F.out, F.out, DM, ALPHA_FFN};
      pg8::gemm_phase(F.tid, F.lds, (const char*)(F.ws + WS_H), DFF, 128u, (unsigned)DFF, S, E); }
    GRID_BAR();
}
__device__ __forceinline__ void ffn_moe(Frame& F) {
    p_norm<true>(F, (const float*)ARGP(28), ARGP(19) + DM, ARGP(23));
    GRID_BAR();
    DBGRUN(chk_xn(F, 3, F.out, ARGP(19) + DM));
    if (PHM & 32) p_scatter(F);
    GRID_BAR();
    DBGRUN(chk_route(F, 4, F.out, ARGP(19) + DM, ARGP(23)));
    if (PHM & 64) { phase_begin(F); const int* ebase = (const int*)(F.ws + WS_MISC + MS_EBASE); const int ntiles = __builtin_amdgcn_readfirstlane(ebase[8]);
      SchedMoeUp S; S.init(ntiles, 2 * DFE / 256, F.G, (int)blockIdx.x); S.lda2 = DM * 2; S.B = (const char*)(F.ws + WS_MWGU); S.btile = (size_t)256 * DM * 2; S.bexp = (size_t)2 * DFE * DM * 2;
      S.rowlist = (const int*)(F.ws + WS_MISC + MS_ROWLIST); S.ebase = ebase;
      EpiSwiGLU E{(bf16*)(F.ws + WS_H), DFE};
      pg8::gemm_phase(F.tid, F.lds, (const char*)(F.ws + WS_XN), DM, 128u, (unsigned)DM, S, E);
#if DUP & 16
      GRID_BAR(); pg8::gemm_phase(F.tid, F.lds, (const char*)(F.ws + WS_XN), DM, 128u, (unsigned)DM, S, E);
#endif
    }
    GRID_BAR();
    DBGRUN(chk_moe_up(F, 6, ARGP(24), ARGP(25)));
    if (PHM & 128) { phase_begin(F); const int* ebase = (const int*)(F.ws + WS_MISC + MS_EBASE); const int ntiles = __builtin_amdgcn_readfirstlane(ebase[8]);
      SchedMoeDown S; S.init(ntiles, DM / 256, F.G, (int)blockIdx.x); S.lda2 = DFE * 2; S.B = (const char*)(F.ws + WS_MWD); S.btile = (size_t)256 * DFE * 2; S.bexp = (size_t)DM * DFE * 2; S.ebase = ebase;
      EpiBf16Plain E{(bf16*)(F.ws + WS_Y), DM};
      pg8::gemm_phase(F.tid, F.lds, (const char*)(F.ws + WS_H), DFE, 128u, (unsigned)DFE, S, E); }
    GRID_BAR();
    DBGRUN(chk_moe_down(F, 7, ARGP(26)));
}

__global__ void __launch_bounds__(NTHR, 2) mk_fwd(Args args) {
    extern __shared__ __attribute__((aligned(16))) unsigned char lds[];
    Frame F;
    F.lds = (LAS unsigned char*)lds;
    F.MISC = (volatile LAS unsigned*)(F.lds + MISC_OFF);
    F.wv = __builtin_amdgcn_readfirstlane((int)threadIdx.x >> 6);
    phase_begin(F);
    for (int u = F.tid; u < (LDS_BYTES - RING_BYTES) / 4; u += NTHR) ((LAS unsigned*)(F.lds + RING_BYTES))[u] = 0u;
    __syncthreads();
    (void)xcd_barrier_post((unsigned*)(F.ctl + CW_BAR), F.MISC + 8, F.wv == 0);

    F.trbase = 0;
    if (PHM & 1) p_prologue_ffn(F, ARGP(20), ARGP(21), ARGP(22), ARGP(24), ARGP(25), ARGP(26));
    if (PHM & 2048) p_prologue_mix(F, ARGP(2), ARGP(18));
    p_prologue_qkv(F, ARGP(10), ARGP(11), ARGP(12), ARGP(13));
    p_prologue_cmp(F, ARGP(15));
    p_cmp_bias(F, ARGP(14), ARGP(15));
#if DUP & 32
    GRID_BAR();
    p_prologue_ffn(F, ARGP(20), ARGP(21), ARGP(22), ARGP(24), ARGP(25), ARGP(26)); p_prologue_mix(F, ARGP(2), ARGP(18)); p_prologue_qkv(F, ARGP(10), ARGP(11), ARGP(12), ARGP(13)); p_prologue_cmp(F, ARGP(15));
#endif
    if (PHM & 4096) p_tables(F);
    p_norm<false>(F, ARGP(0), ARGP(1), nullptr);
    GRID_BAR();

    mixer_layer<0>(F);
    ffn_dense(F);
    mixer_layer<1>(F);
    ffn_moe(F);

    phase_begin(F);
    if (xb_ld((unsigned*)(F.ctl + CW_BAR) + XB_TMO) != 0u) p_nan_rows(F);
    else if (PHM & 256) p_combine_final(F, ARGP(27));
#ifdef DBG
    GRID_BAR(); dbg_finish(F, 26);
#endif
}

extern "C" void kernel_launch(void* const* d_in, const int* in_sizes, int n_in, void* d_out, int out_size, void* d_ws, size_t ws_size, hipStream_t stream) {
    static int grid = 0;
    if (grid == 0) {
        if (n_in != 28 || in_sizes[0] != TOK * DM || out_size != TOK * DM || ws_size < WS_END) { fprintf(stderr, "kernel_launch: unexpected shapes (n_in %d, in0 %d, out %d, ws %zu)\n", n_in, n_in > 0 ? in_sizes[0] : -1, out_size, ws_size); grid = -1; return; }
        int dev = 0, cus = 0, per_cu = 0;
        if (hipGetDevice(&dev) != hipSuccess || hipDeviceGetAttribute(&cus, hipDeviceAttributeMultiprocessorCount, dev) != hipSuccess) { grid = -1; return; }
        if (hipFuncSetAttribute((const void*)mk_fwd, hipFuncAttributeMaxDynamicSharedMemorySize, LDS_BYTES) != hipSuccess) { fprintf(stderr, "kernel_launch: hipFuncSetAttribute failed\n"); grid = -1; return; }
        if (hipOccupancyMaxActiveBlocksPerMultiprocessor(&per_cu, (const void*)mk_fwd, NTHR, LDS_BYTES) != hipSuccess || per_cu < 1) fprintf(stderr, "kernel_launch: occupancy query reports %d\n", per_cu);
        (void)hipGetLastError();
        grid = cus;
    }
    if (grid < 0) return;
    if (hipMemsetAsync((char*)d_ws + WS_CTL, 0, CTL_ZERO_BYTES, stream) != hipSuccess) return;
    Args a{};
    for (int i = 0; i < 28; ++i) a.in[i] = (const float*)d_in[i];
    a.out = (float*)d_out; a.ws = (unsigned char*)d_ws;
    hipLaunchKernelGGL(mk_fwd, dim3(grid), dim3(NTHR), LDS_BYTES, stream, a);
}
```

```cpp
#include <hip/hip_runtime.h>
#include <cstdint>
#include <cstdio>
#ifndef DUP
#define DUP 0
#endif
#ifndef ALPHA_MOE
#define ALPHA_MOE 1.0f
#endif
#ifndef ALPHA_MIX
#define ALPHA_MIX 1.0f
#endif
#ifndef ALPHA_FFN
#define ALPHA_FFN 1.0f
#endif

#define GAS __attribute__((address_space(1)))
#define LAS __attribute__((address_space(3)))
typedef unsigned short bf16;
typedef unsigned v4u __attribute__((ext_vector_type(4)));
typedef unsigned v2u __attribute__((ext_vector_type(2)));
typedef float f32x4 __attribute__((ext_vector_type(4)));
typedef float f32x2 __attribute__((ext_vector_type(2)));
typedef short bf16x8 __attribute__((ext_vector_type(8)));
typedef GAS unsigned gu32;
typedef float f32x16 __attribute__((ext_vector_type(16)));
typedef short s16x4 __attribute__((ext_vector_type(4)));
__device__ __forceinline__ int crow(int r, int hi) { return (r & 3) + 8 * (r >> 2) + 4 * hi; }
#define RLX_AGENT __ATOMIC_RELAXED, __HIP_MEMORY_SCOPE_AGENT
#define LDS_WAIT() asm volatile("s_waitcnt lgkmcnt(0)" ::: "memory")
#define VM_WAIT() asm volatile("s_waitcnt vmcnt(0)" ::: "memory")

constexpr int NB = 4, SEQ = 8192, DM = 1024, TOK = NB * SEQ, DEPTH = 2;
constexpr int DFF = 2816, NEXP = 8, DFE = 1408;
constexpr float EPS = 1e-6f;
constexpr int NWAVES = 8, NTHR = 512;

constexpr size_t MiB = 1u << 20;
constexpr size_t WS_CTL = 0, CTL_ZERO_BYTES = 1 * MiB;
constexpr size_t WS_TABN = 1 * MiB, WS_TABM = 3 * MiB, WS_MISC = 4 * MiB, WS_LRU = 8 * MiB, WS_SSQ = 12 * MiB, WS_MASK = 14 * MiB, WS_KC = 15 * MiB, WS_G1C = 16 * MiB;
constexpr size_t WS_WIN = 18 * MiB, WS_WQKV = 26 * MiB, WS_WOUT = 29 * MiB, WS_WC1 = 33 * MiB, WS_WGU = 37 * MiB, WS_WD = 48 * MiB, WS_MWGU = 54 * MiB, WS_MWD = 98 * MiB;
constexpr size_t WS_XN = 120 * MiB, WS_CAT = 184 * MiB, WS_PQ = 248 * MiB, WS_U = 280 * MiB, WS_QM = 408 * MiB, WS_KVM = 444 * MiB, WS_END = 492 * MiB;
constexpr size_t WS_OC = WS_XN;
constexpr size_t WS_H = WS_U;
constexpr size_t WS_Y = WS_XN;
constexpr int MAXSLOT = 2 * TOK + NEXP * 256;
static_assert(WS_H + (size_t)MAXSLOT * DFE * 2 <= WS_END && WS_Y + (size_t)MAXSLOT * DM * 2 <= WS_U, "overlays");
constexpr size_t MS_ROUTE = 0;
constexpr size_t MS_TOKSLOT = 512 * 1024;
constexpr size_t MS_ROWLIST = 768 * 1024;
constexpr size_t MS_COUNTS = 1280 * 1024;
constexpr size_t MS_CBIAS = 1300 * 1024;
constexpr size_t MS_EBASE = 1296 * 1024;
constexpr int CW_TMO = 0, CW_BAR = 4096, CW_Q = 16384;

constexpr int NU = 2048, IN_COLS = 2034;
constexpr int C_XL = 0, C_YL = 256, C_QDN = 512, C_KVDN = 704, C_KPE = 832, C_QN = 864, C_KC = 1248, C_VC = 1376, C_KS = 1504, C_VS = 1632, C_KW = 1760, C_VW = 1888, C_GN = 2016;
constexpr float QSCALE_N = 0.125f * 1.4426950408889634f;
constexpr float QSCALE_M = 0.10206207261596575f * 1.4426950408889634f;
__device__ const float INV_N[32] = {1.0f, 0.7498942093324559f, 0.5623413251903491f, 0.4216965034285822f, 0.31622776601683794f, 0.23713737056616552f, 0.1778279410038923f, 0.1333521432163324f, 0.1f, 0.07498942093324558f, 0.05623413251903491f, 0.042169650342858224f, 0.03162277660168379f, 0.023713737056616554f, 0.01778279410038923f, 0.01333521432163324f, 0.01f, 0.007498942093324558f, 0.005623413251903491f, 0.004216965034285823f, 0.0031622776601683794f, 0.0023713737056616554f, 0.0017782794100389228f, 0.001333521432163324f, 0.001f, 0.0007498942093324559f, 0.0005623413251903491f, 0.00042169650342858224f, 0.00031622776601683794f, 0.00023713737056616554f, 0.00017782794100389227f, 0.0001333521432163324f};
__device__ const float INV_M[16] = {1.0f, 0.5623413251903491f, 0.31622776601683794f, 0.1778279410038923f, 0.1f, 0.05623413251903491f, 0.03162277660168379f, 0.01778279410038923f, 0.01f, 0.005623413251903491f, 0.0031622776601683794f, 0.0017782794100389228f, 0.001f, 0.0005623413251903491f, 0.00031622776601683794f, 0.00017782794100389227f};

constexpr int RING_BYTES = 131072, MISC_OFF = RING_BYTES + 320, LDS_BYTES = 147456;

typedef float cvf32x2_t __attribute__((ext_vector_type(2))); typedef __bf16 cvbf16x2_t __attribute__((ext_vector_type(2)));
__device__ __forceinline__ unsigned pk2(float lo, float hi) { const cvf32x2_t v = {lo, hi}; const cvbf16x2_t b = __builtin_convertvector(v, cvbf16x2_t); return __builtin_bit_cast(unsigned, b); }
__device__ __forceinline__ unsigned f2bf(float f) { return pk2(f, 0.0f) & 0xffffu; }
__device__ __forceinline__ float bf2f(unsigned short b) { return __builtin_bit_cast(float, (unsigned)b << 16); }
__device__ __forceinline__ float bflo(unsigned w) { return __builtin_bit_cast(float, w << 16); }
__device__ __forceinline__ float bfhi(unsigned w) { return __builtin_bit_cast(float, w & 0xffff0000u); }
template <int M> __device__ __forceinline__ unsigned xor_u(unsigned u) {
    if constexpr (M == 32) { auto r = __builtin_amdgcn_permlane32_swap(u, u, false, false);
        return (unsigned)r[0] ^ (unsigned)r[1] ^ u; }
    else return (unsigned)__builtin_amdgcn_ds_swizzle((int)u, (M << 10) | 0x1f);
}
template <int M> __device__ __forceinline__ float xor_f(float v) { return __builtin_bit_cast(float, xor_u<M>(__builtin_bit_cast(unsigned, v))); }
__device__ __forceinline__ float wave_sum(float v) {
    v += xor_f<1>(v); v += xor_f<2>(v); v += xor_f<4>(v); v += xor_f<8>(v); v += xor_f<16>(v); v += xor_f<32>(v);
    return v;
}

#define XB_TMO      128
#define XB_XCNT(j)  (256  + 64 * (j))
#define XB_XSUB(j)  (1280 + 64 * (j))
#define XB_XGEN(j)  (2304 + 64 * (j))
#define XB_TOP      3328
#define XB_TOPGEN   3392
#define XCD_BAR_WORDS 3456
#define XB_SPIN_CAP (1u << 18)
__device__ __forceinline__ unsigned xb_ld(unsigned* p)              { return __hip_atomic_load(p, __ATOMIC_RELAXED, __HIP_MEMORY_SCOPE_AGENT); }
__device__ __forceinline__ unsigned xb_add(unsigned* p, unsigned v) { return __hip_atomic_fetch_add(p, v, __ATOMIC_RELAXED, __HIP_MEMORY_SCOPE_AGENT); }
__device__ __forceinline__ unsigned xb_xcc_id() { return (unsigned)__builtin_amdgcn_s_getreg((3 << 11) | 20) & 0xFu; }
#define XB_SPIN(cond, bar) do { unsigned _sp = 0; while (cond) { __builtin_amdgcn_s_sleep(1); \
    if ((++_sp & 255u) == 0u) { if (xb_ld(&(bar)[XB_TMO])) break; if (_sp > XB_SPIN_CAP) { atomicAdd(&(bar)[XB_TMO], 1u); break; } } } } while (0)
struct XcdBarrier { unsigned* bar; unsigned x; volatile LAS unsigned* st; };
__device__ __forceinline__ XcdBarrier xcd_barrier_post(unsigned* bar, volatile LAS unsigned* st, const bool first_wave) {
    XcdBarrier b; b.bar = bar; b.x = xb_xcc_id(); b.st = st;
    if (st != nullptr && __builtin_amdgcn_mbcnt_hi(~0u, __builtin_amdgcn_mbcnt_lo(~0u, 0u)) == 0u && first_wave) (void)xb_add(&bar[XB_XCNT(b.x)], 1u);
    return b;
}
__device__ __forceinline__ void xcd_barrier_complete(unsigned* bar, unsigned x, unsigned& nloc, unsigned& nx) {
    const unsigned G = gridDim.x * gridDim.y * gridDim.z;
    unsigned sum, cnt, sp = 0u;
    for (;;) {
        sum = 0u; cnt = 0u;
#pragma unroll
        for (unsigned j = 0; j < 16; ++j) { const unsigned c = xb_ld(&bar[XB_XCNT(j)]); sum += c; cnt += (c > 0u) ? 1u : 0u; }
        if (sum == G) break;
        __builtin_amdgcn_s_sleep(1);
        if ((++sp & 255u) == 0u) { if (xb_ld(&bar[XB_TMO])) break; if (sp > XB_SPIN_CAP) { atomicAdd(&bar[XB_TMO], 1u); break; } }
    }
    const unsigned mine = xb_ld(&bar[XB_XCNT(x)]);
    nloc = mine > 0u ? mine : 1u; nx = cnt > 0u ? cnt : 1u;
}
__device__ __forceinline__ void xcd_barrier(const XcdBarrier& b, const int tid) {
    asm volatile("s_waitcnt vmcnt(0)" ::: "memory");
    __syncthreads();
    if (tid == 0) {
        unsigned* bar = b.bar; unsigned bx = b.x; asm volatile("" : "+s"(bx));
        __builtin_amdgcn_s_waitcnt(0);
        unsigned nloc = b.st[0], nx = b.st[1];
        if (nloc == 0u) { xcd_barrier_complete(bar, bx, nloc, nx); b.st[0] = nloc; b.st[1] = nx; }
        const unsigned old = xb_add(&bar[XB_XSUB(bx)], 1u);
        const unsigned gen = old / nloc;
        if (old + 1u == (gen + 1u) * nloc) {
            __builtin_amdgcn_fence(__ATOMIC_RELEASE, "agent");
            asm volatile("s_waitcnt vmcnt(0)" ::: "memory");
            const unsigned og = xb_add(&bar[XB_TOP], 1u);
            const unsigned tg = og / nx;
            if (og + 1u == (tg + 1u) * nx) xb_add(&bar[XB_TOPGEN], 1u);
            else XB_SPIN(xb_ld(&bar[XB_TOPGEN]) == tg, bar);
            __builtin_amdgcn_fence(__ATOMIC_ACQUIRE, "agent");
            xb_add(&bar[XB_XGEN(bx)], 1u);
            asm volatile("s_waitcnt vmcnt(0)" ::: "memory");
        } else {
            XB_SPIN(xb_ld(&bar[XB_XGEN(bx)]) == gen, bar);
            __builtin_amdgcn_fence(__ATOMIC_ACQUIRE, "agent");
            asm volatile("s_waitcnt vmcnt(0)" ::: "memory");
        }
    }
    __syncthreads();
}

namespace pg8 {
constexpr int BM = 256, BK = 64, HALF = 128, HTB = HALF * BK * 2, STAGE_BYTES = 8 * HTB, NXCD = 8, WGM = 8;
__host__ __device__ __forceinline__ int lds_byte(int r, int c) { const int st = (r >> 4) * 2 + (c >> 5), rr = r & 15, cc = c & 31, ob = rr * 64 + cc * 2; return st * 1024 + (ob ^ (((ob >> 9) & 1) << 5)); }
__host__ __device__ __forceinline__ void stage_rc(int b, int& R, int& C) { const int st = b / 1024, sb = b % 1024, swz = sb ^ (((sb >> 9) & 1) << 5); R = (st >> 1) * 16 + swz / 64; C = (st & 1) * 32 + (swz % 64) / 2; }
__host__ __device__ __forceinline__ int perm32(int rho) { const int n = rho >> 4, i = rho & 15; return 8 * (i >> 2) + 4 * n + (i & 3); }
struct Unit { int pm, pn; };
struct TileOrder {
    int nM, nN, nwg, G, c;
    __device__ __forceinline__ void init(int nM_, int nN_, int G_, int c_) { nM = nM_; nN = nN_; nwg = nM * nN; G = G_; c = c_; asm volatile("" : "+s"(c)); }
    __device__ __forceinline__ bool next(int i, Unit& u) const {
        const long L = (long)i * G + c; if (L >= nwg) return false;
        int wgid = (int)L; { const int q = nwg / NXCD, r = nwg % NXCD, xcd = wgid % NXCD, off = wgid / NXCD; wgid = (xcd < r ? xcd * (q + 1) : r * (q + 1) + (xcd - r) * q) + off; }
        const int nig = WGM * nN, gid = wgid / nig, fm = gid * WGM, gsz = (nM - fm) < WGM ? (nM - fm) : WGM;
        u.pm = fm + ((wgid % nig) % gsz); u.pn = (wgid % nig) / gsz; return true;
    }
};
__device__ __forceinline__ unsigned cvt_pk_bf16(float lo, float hi) { unsigned r; asm volatile("v_cvt_pk_bf16_f32 %0, %1, %2" : "=v"(r) : "v"(lo), "v"(hi)); return r; }

template <class Epi, class Sched>
__device__ __forceinline__ void gemm_phase(const int tid_in, LAS unsigned char* lds, const char* Abase, const int K, const unsigned kstepA, const unsigned ldb, const Sched& S, const Epi& E) {
    int tid = tid_in; asm volatile("" : "+v"(tid));
    const int wid = __builtin_amdgcn_readfirstlane(tid >> 6), lane = tid & 63, wr = wid >> 2, wc = wid & 3, fr = lane & 15, fq = lane >> 4;
    const int nt = K / BK;
    unsigned voffB[2];
#pragma unroll
    for (int i = 0; i < 2; ++i) { int R, C; stage_rc(tid * 16 + i * 8192, R, C); const int Rb = Epi::PERM ? ((R & ~31) + perm32(R & 31)) : R; voffB[i] = (unsigned)(Rb * ldb + C) * 2u; }
    const size_t hstepB = (size_t)HALF * ldb * 2;
    const unsigned kstepB = BK * 2;
    const unsigned ldsw = (unsigned)wid * 1024u;
    const int aoff = lds_byte(wr * 64 + fr, fq * 8), boff = lds_byte(wc * 32 + fr, fq * 8);
#define PG8_SA(b, h) (((b) * 2 + (h)) * HTB)
#define PG8_SB(b, h) ((4 + (b) * 2 + (h)) * HTB)
#define PG8_STAGE_B(bufoff, gbase) do { _Pragma("unroll") for (int _i = 0; _i < 2; ++_i) { unsigned _o = voffB[_i]; asm volatile("" : "+v"(_o)); \
        __builtin_amdgcn_global_load_lds((const unsigned*)((const char*)(gbase) + _o), (LAS unsigned*)(lds + (bufoff) + ldsw + _i * 8192), 16, 0, 0); } } while (0)
#define PG8_STAGE_A(bufoff, offs, ubase) do { _Pragma("unroll") for (int _i = 0; _i < 2; ++_i) { unsigned _o = (offs)[_i]; asm volatile("" : "+v"(_o)); \
        __builtin_amdgcn_global_load_lds((const unsigned*)((ubase) + _o), (LAS unsigned*)(lds + (bufoff) + ldsw + _i * 8192), 16, 0, 0); } } while (0)
#define PG8_LDA(dst, b, h) do { _Pragma("unroll") for (int m = 0; m < 4; ++m) _Pragma("unroll") for (int k = 0; k < 2; ++k) dst[m][k] = *(const LAS bf16x8*)(lds + PG8_SA(b, h) + aoff + m * 2048 + k * 1024); } while (0)
#define PG8_LDB(dst, b, h) do { _Pragma("unroll") for (int n = 0; n < 2; ++n) _Pragma("unroll") for (int k = 0; k < 2; ++k) dst[n][k] = *(const LAS bf16x8*)(lds + PG8_SB(b, h) + boff + n * 2048 + k * 1024); } while (0)
#define PG8_MMA(ai, bj, At, Bt) do { __builtin_amdgcn_s_setprio(1); _Pragma("unroll") for (int m = 0; m < 4; ++m) _Pragma("unroll") for (int n = 0; n < 2; ++n) _Pragma("unroll") for (int k = 0; k < 2; ++k) \
        acc[ai][bj][m][n] = __builtin_amdgcn_mfma_f32_16x16x32_bf16(Bt[n][k], At[m][k], acc[ai][bj][m][n], 0, 0, 0); __builtin_amdgcn_s_setprio(0); } while (0)
#define PG8_WAIT_V(n) asm volatile("s_waitcnt vmcnt(" #n ")" ::: "memory")
#define PG8_WAIT_L(n) asm volatile("s_waitcnt lgkmcnt(" #n ")" ::: "memory")
#define PG8_BAR __builtin_amdgcn_s_barrier()
#define PG8_SCHED __builtin_amdgcn_sched_barrier(0)
    Unit cur, nxt; int ui = 0;
    if (!S.next(0, cur)) return;
    f32x4 acc[2][2][4][2];
#pragma unroll
    for (int a = 0; a < 2; ++a)
#pragma unroll
        for (int b = 0; b < 2; ++b)
#pragma unroll
            for (int m = 0; m < 4; ++m)
#pragma unroll
                for (int n = 0; n < 2; ++n) acc[a][b][m][n] = (f32x4){0.f, 0.f, 0.f, 0.f};
    bf16x8 At[4][2], B0[2][2], B1[2][2];
    unsigned oA[2][2];
#define PG8_AOFF(dst, unit) do { _Pragma("unroll") for (int _h = 0; _h < 2; ++_h) _Pragma("unroll") for (int _i = 0; _i < 2; ++_i) { int _R, _C; stage_rc(tid * 16 + _i * 8192, _R, _C); \
        dst[_h][_i] = S.arow(unit, _h * HALF + _R) + (unsigned)_C * 2u; } } while (0)
    PG8_AOFF(oA, cur);
    const char* cB = S.bbase(cur);
    const char* cA0 = Abase + S.abase(cur, 0); const char* cA1 = Abase + S.abase(cur, 1);
    PG8_STAGE_B(PG8_SB(0, 0), cB); PG8_STAGE_B(PG8_SB(0, 1), cB + hstepB); PG8_STAGE_A(PG8_SA(0, 0), oA[0], cA0); PG8_STAGE_A(PG8_SA(0, 1), oA[1], cA1);
    if (wr == 1) PG8_BAR;
    PG8_WAIT_V(2); PG8_BAR;
    PG8_STAGE_B(PG8_SB(1, 0), cB + kstepB); PG8_STAGE_A(PG8_SA(1, 0), oA[0], cA0 + kstepA); PG8_STAGE_B(PG8_SB(1, 1), cB + hstepB + kstepB);
    PG8_WAIT_V(6); PG8_BAR;
    for (;;) {
        const bool has_next = S.next(ui + 1, nxt);
        const char* nB = has_next ? S.bbase(nxt) : cB;
        const char* nA0 = has_next ? Abase + S.abase(nxt, 0) : cA0; const char* nA1 = has_next ? Abase + S.abase(nxt, 1) : cA1;
        asm volatile(".p2align 6" ::: "memory");
        for (int t = 0; t < nt; t += 2) {
            const bool last = (t == nt - 2);
            const char* a1h1 = cA1 + (size_t)(t + 1) * kstepA;
            const char* a2h0 = last ? nA0 : cA0 + (size_t)(t + 2) * kstepA; const char* a2h1 = last ? nA1 : cA1 + (size_t)(t + 2) * kstepA;
            const char* b2 = last ? nB : cB + (size_t)(t + 2) * kstepB; const char* b3 = b2 + kstepB;
            unsigned nO[2][2];
#pragma unroll
            for (int h = 0; h < 2; ++h)
#pragma unroll
                for (int i = 0; i < 2; ++i) nO[h][i] = oA[h][i];
            if (last && has_next) PG8_AOFF(nO, nxt);
            PG8_LDB(B0, 0, 0); PG8_LDB(B1, 0, 1); PG8_SCHED; PG8_LDA(At, 0, 0); PG8_STAGE_A(PG8_SA(1, 1), oA[1], a1h1);
#pragma unroll
            for (int h = 0; h < 2; ++h)
#pragma unroll
                for (int i = 0; i < 2; ++i) oA[h][i] = nO[h][i];
            PG8_WAIT_V(8); PG8_WAIT_L(0); PG8_BAR; PG8_MMA(0, 0, At, B0); PG8_MMA(0, 1, At, B1); PG8_BAR; PG8_SCHED;
            PG8_LDA(At, 0, 1); PG8_STAGE_B(PG8_SB(0, 0), b2); PG8_STAGE_B(PG8_SB(0, 1), b2 + hstepB); PG8_STAGE_A(PG8_SA(0, 0), oA[0], a2h0);
            PG8_WAIT_V(8); PG8_WAIT_L(0); PG8_BAR; PG8_MMA(1, 0, At, B0); PG8_MMA(1, 1, At, B1); PG8_BAR; PG8_SCHED;
            PG8_LDB(B0, 1, 0); PG8_LDB(B1, 1, 1); PG8_SCHED; PG8_LDA(At, 1, 0); PG8_STAGE_A(PG8_SA(0, 1), oA[1], a2h1);
            PG8_WAIT_V(8); PG8_WAIT_L(0); PG8_BAR; PG8_MMA(0, 0, At, B0); PG8_MMA(0, 1, At, B1); PG8_BAR; PG8_SCHED;
            PG8_LDA(At, 1, 1); PG8_STAGE_B(PG8_SB(1, 0), b3); PG8_STAGE_B(PG8_SB(1, 1), b3 + hstepB); PG8_STAGE_A(PG8_SA(1, 0), oA[0], a2h0 + kstepA);
            PG8_WAIT_V(8); PG8_WAIT_L(0); PG8_BAR; PG8_MMA(1, 0, At, B0); PG8_MMA(1, 1, At, B1); PG8_BAR; PG8_SCHED;
        }
        if (wr == 0) PG8_BAR;
        E(acc, cur, wr, wc, fr, fq);
        if (!has_next) break;
#pragma unroll
        for (int a = 0; a < 2; ++a)
#pragma unroll
            for (int b = 0; b < 2; ++b)
#pragma unroll
                for (int m = 0; m < 4; ++m)
#pragma unroll
                    for (int n = 0; n < 2; ++n) acc[a][b][m][n] = (f32x4){0.f, 0.f, 0.f, 0.f};
        cur = nxt; cB = nB; cA0 = nA0; cA1 = nA1; ++ui;
        if (wr == 1) PG8_BAR;
    }
    PG8_WAIT_V(0);
    PG8_BAR;
#undef PG8_AOFF
#undef PG8_SA
#undef PG8_SB
#undef PG8_STAGE_A
#undef PG8_STAGE_B
#undef PG8_LDA
#undef PG8_LDB
#undef PG8_MMA
#undef PG8_WAIT_V
#undef PG8_WAIT_L
#undef PG8_BAR
#undef PG8_SCHED
}
}
using pg8::Unit;

typedef const float* cfptr_t;
__device__ __forceinline__ const float* ldarg(int i) {
    const unsigned long long v = (unsigned long long)(*(const volatile __attribute__((address_space(4))) cfptr_t*)((const __attribute__((address_space(4))) char*)__builtin_amdgcn_kernarg_segment_ptr() + 8 * i));
    const unsigned lo = __builtin_amdgcn_readfirstlane((unsigned)v), hi = __builtin_amdgcn_readfirstlane((unsigned)(v >> 32));
    return (const float*)(const GAS float*)(((unsigned long long)hi << 32) | lo);
}
#define ARGP(i) ldarg(i)

struct Frame {
    int trbase;
    LAS unsigned char* lds;
    volatile LAS unsigned* MISC;
    gu32* ctl;
    unsigned char* ws;
    int tid, lane, wave, G, vcu;
    int wv;
    float* out;
};

__device__ __forceinline__ void phase_begin(Frame& F) {
    unsigned z_ = 0u; asm volatile("" : "+v"(z_));
    int t = F.wv * 64 + (int)__builtin_amdgcn_mbcnt_hi(~0u, __builtin_amdgcn_mbcnt_lo(~0u, z_)); F.tid = t; F.lane = t & 63; F.wave = __builtin_amdgcn_readfirstlane(t >> 6);
    int g = gridDim.x, bx = blockIdx.x; asm volatile("" : "+s"(g), "+s"(bx)); F.G = g; F.vcu = (g % 8 == 0) ? (bx % 8) * (g / 8) + bx / 8 : bx;
    F.ws = (unsigned char*)ldarg(29); F.ctl = (gu32*)(F.ws + WS_CTL); F.out = (float*)ldarg(28);
}
struct SchedPlain : pg8::TileOrder {
    unsigned lda2; const char* B; size_t btile;
    __device__ __forceinline__ unsigned arow(const Unit&, int r) const { return (unsigned)(r & 127) * lda2; }
    __device__ __forceinline__ size_t abase(const Unit& u, int h) const { return (size_t)(u.pm * 256 + h * 128) * lda2; }
    __device__ __forceinline__ const char* bbase(const Unit& u) const { return B + (size_t)u.pn * btile; }
};
struct SchedMoeUp : pg8::TileOrder {
    unsigned lda2; const char* B; size_t btile, bexp; const int* rowlist; const int* ebase;
    __device__ __forceinline__ int expert(int pm) const { int e = 0;
#pragma unroll
        for (int j = 1; j < NEXP; ++j) e += (pm >= __builtin_amdgcn_readfirstlane(ebase[j])) ? 1 : 0; return e; }
    __device__ __forceinline__ unsigned arow(const Unit& u, int r) const { return (unsigned)rowlist[u.pm * 256 + r] * lda2; }
    __device__ __forceinline__ size_t abase(const Unit&, int) const { return 0; }
    __device__ __forceinline__ const char* bbase(const Unit& u) const { return B + (size_t)expert(u.pm) * bexp + (size_t)u.pn * btile; }
};
struct SchedMoeDown : pg8::TileOrder {
    unsigned lda2; const char* B; size_t btile, bexp; const int* ebase;
    __device__ __forceinline__ int expert(int pm) const { int e = 0;
#pragma unroll
        for (int j = 1; j < NEXP; ++j) e += (pm >= __builtin_amdgcn_readfirstlane(ebase[j])) ? 1 : 0; return e; }
    __device__ __forceinline__ unsigned arow(const Unit&, int r) const { return (unsigned)(r & 127) * lda2; }
    __device__ __forceinline__ size_t abase(const Unit& u, int h) const { return (size_t)(u.pm * 256 + h * 128) * lda2; }
    __device__ __forceinline__ const char* bbase(const Unit& u) const { return B + (size_t)expert(u.pm) * bexp + (size_t)u.pn * btile; }
};

__device__ __forceinline__ float silu_mul(float g, float u) { return g * u * __builtin_amdgcn_rcpf(1.0f + __builtin_amdgcn_exp2f(-1.4426950408889634f * g)); }
struct EpiSwiGLU {
    static constexpr bool PERM = true;
    bf16* O; int ldo;
    __device__ __forceinline__ void operator()(const f32x4 (&acc)[2][2][4][2], const Unit& u, int wr, int wc, int fr, int fq) const {
        const int row0 = u.pm * 256 + wr * 64 + fr, col0 = u.pn * 128 + wc * 32 + 8 * fq;
#pragma unroll
        for (int ai = 0; ai < 2; ++ai)
#pragma unroll
            for (int m = 0; m < 4; ++m) {
                const f32x4 g0 = acc[ai][0][m][0], g1 = acc[ai][0][m][1], u0 = acc[ai][1][m][0], u1 = acc[ai][1][m][1];
                v4u w;
                w.x = pg8::cvt_pk_bf16(silu_mul(g0[0], u0[0]), silu_mul(g0[1], u0[1])); w.y = pg8::cvt_pk_bf16(silu_mul(g0[2], u0[2]), silu_mul(g0[3], u0[3]));
                w.z = pg8::cvt_pk_bf16(silu_mul(g1[0], u1[0]), silu_mul(g1[1], u1[1])); w.w = pg8::cvt_pk_bf16(silu_mul(g1[2], u1[2]), silu_mul(g1[3], u1[3]));
                *(v4u*)(O + (size_t)(row0 + ai * 128 + m * 16) * ldo + col0) = w;
            }
    }
};
struct EpiNull {
    static constexpr bool PERM = true;
    __device__ __forceinline__ void operator()(const f32x4 (&acc)[2][2][4][2], const Unit&, int, int, int, int) const {
#pragma unroll
        for (int ai = 0; ai < 2; ++ai)
#pragma unroll
            for (int bj = 0; bj < 2; ++bj)
#pragma unroll
                for (int m = 0; m < 4; ++m) asm volatile("" :: "v"(acc[ai][bj][m][0]), "v"(acc[ai][bj][m][1]));
    }
};
struct EpiResF32 {
    static constexpr bool PERM = false;
    const float* base; float* out; int ldc; float alpha = 1.0f;
    __device__ __forceinline__ void operator()(const f32x4 (&acc)[2][2][4][2], const Unit& u, int wr, int wc, int fr, int fq) const {
        const int row0 = u.pm * 256 + wr * 64 + fr, col0 = u.pn * 256 + wc * 32 + 4 * fq;
#pragma unroll
        for (int ai = 0; ai < 2; ++ai)
#pragma unroll
            for (int m = 0; m < 4; ++m) { const size_t off = (size_t)(row0 + ai * 128 + m * 16) * ldc + col0;
#pragma unroll
                for (int bj = 0; bj < 2; ++bj)
#pragma unroll
                    for (int n = 0; n < 2; ++n) { const f32x4 b = *(const f32x4*)(base + off + bj * 128 + n * 16); *(f32x4*)(out + off + bj * 128 + n * 16) = b + acc[ai][bj][m][n] * alpha; } }
    }
};
struct EpiBf16Plain {
    static constexpr bool PERM = true;
    bf16* O; int ldo;
    __device__ __forceinline__ void operator()(const f32x4 (&acc)[2][2][4][2], const Unit& u, int wr, int wc, int fr, int fq) const {
        const int row0 = u.pm * 256 + wr * 64 + fr, col0 = u.pn * 256 + wc * 32 + 8 * fq;
#pragma unroll
        for (int ai = 0; ai < 2; ++ai)
#pragma unroll
            for (int m = 0; m < 4; ++m)
#pragma unroll
                for (int bj = 0; bj < 2; ++bj) { const f32x4 v0 = acc[ai][bj][m][0], v1 = acc[ai][bj][m][1]; v4u w;
                    w.x = pg8::cvt_pk_bf16(v0[0], v0[1]); w.y = pg8::cvt_pk_bf16(v0[2], v0[3]); w.z = pg8::cvt_pk_bf16(v1[0], v1[1]); w.w = pg8::cvt_pk_bf16(v1[2], v1[3]);
                    *(v4u*)(O + (size_t)(row0 + ai * 128 + m * 16) * ldo + col0 + bj * 128) = w; }
    }
};

template <class CM>
__device__ __forceinline__ void tr_item(const float* src, int srcN, int kofs, int kvalid, const float* kscale, bf16* dst, int dstK, int k0, int n0, const CM& cm, LAS float* scr, int lane) {
    const int col = cm(n0 + (lane & 31)); const int colc = col < 0 ? 0 : col;
    float v[32];
#pragma unroll
    for (int i = 0; i < 32; ++i) { const int ks = k0 + 2 * i + (lane >> 5) - kofs; const int ksc = ks < 0 ? 0 : (ks >= kvalid ? kvalid - 1 : ks); v[i] = src[(size_t)ksc * srcN + colc]; }
    if (kscale) {
#pragma unroll
        for (int i = 0; i < 32; ++i) { const int ks = k0 + 2 * i + (lane >> 5) - kofs; const int ksc = ks < 0 ? 0 : (ks >= kvalid ? kvalid - 1 : ks); v[i] *= kscale[ksc]; } }
#pragma unroll
    for (int i = 0; i < 32; ++i) { const int kk = 2 * i + (lane >> 5); const int ks = k0 + kk - kofs; scr[kk * 33 + (lane & 31)] = (col >= 0 && ks >= 0 && ks < kvalid) ? v[i] : 0.f; }
    LDS_WAIT(); asm volatile("" ::: "memory");
    const int c = lane & 7;
#pragma unroll
    for (int j = 0; j < 4; ++j) { const int n = (lane >> 3) + 8 * j; const LAS float* s = scr + (8 * c) * 33 + n;
        v4u o; o.x = pk2(s[0 * 33], s[1 * 33]); o.y = pk2(s[2 * 33], s[3 * 33]); o.z = pk2(s[4 * 33], s[5 * 33]); o.w = pk2(s[6 * 33], s[7 * 33]);
        *(GAS v4u*)(dst + (size_t)(n0 + n) * dstK + k0 + 8 * c) = o; }
    LDS_WAIT(); asm volatile("" ::: "memory");
}
struct CmQ { __device__ __forceinline__ int operator()(int j) const { if (j >= 576) return -1; const int hd = j / 96, w = j - hd * 96; if (w < 64) return j; const int w2 = w - 64, i = w2 >> 3, e = w2 & 7; return hd * 96 + 64 + (e < 4 ? 4 * i + e : 16 + 4 * i + (e - 4)); } };
struct CmIdent { int nvalid; __device__ __forceinline__ int operator()(int n) const { return n < nvalid ? n : -1; } };
struct CmGU { __device__ __forceinline__ int operator()(int n) const { return (n >> 8) * 128 + (n & 127); } };

template <class CM>
__device__ __forceinline__ void tr_job(Frame& F, const float* src, int srcN, int kofs, int kvalid, const float* kscale, bf16* dst, int dstK, int rows, const CM& cm) {
    LAS float* scr = (LAS float*)(F.lds + F.wave * 8704);
    const int gw = F.vcu * NWAVES + F.wave, NGW = F.G * NWAVES;
    const int nblk = rows / 32, nit = (dstK / 64) * nblk;
    int it0 = gw - F.trbase; it0 += it0 < 0 ? NGW : 0; F.trbase = (F.trbase + nit) % NGW;
    for (int it = it0; it < nit; it += NGW) { const int kb = it / nblk, nb = it % nblk; tr_item(src, srcN, kofs, kvalid, kscale, dst, dstK, 64 * kb, 32 * nb, cm, scr, F.lane); }
}
__device__ __forceinline__ void tr_job_gu(Frame& F, const float* srcG, const float* srcU, int srcN, bf16* dst, int dstK, int rows) {
    LAS float* scr = (LAS float*)(F.lds + F.wave * 8704);
    const int gw = F.vcu * NWAVES + F.wave, NGW = F.G * NWAVES;
    const int nblk = rows / 32, nit = (dstK / 64) * nblk; const CmGU cm;
    int it0 = gw - F.trbase; it0 += it0 < 0 ? NGW : 0; F.trbase = (F.trbase + nit) % NGW;
    for (int it = it0; it < nit; it += NGW) { const int kb = it / nblk, nb = it % nblk; const int n0 = 32 * nb;
        tr_item((n0 & 128) ? srcU : srcG, srcN, 0, dstK, nullptr, dst, dstK, 64 * kb, n0, cm, scr, F.lane); }
}

__device__ __forceinline__ void p_prologue_ffn(Frame& F, const float* fg, const float* fu, const float* fd, const float* mg, const float* mu, const float* md) {
    phase_begin(F);
    tr_job_gu(F, fg, fu, DFF, (bf16*)(F.ws + WS_WGU), DM, 2 * DFF);
    tr_job(F, fd, DM, 0, DFF, nullptr, (bf16*)(F.ws + WS_WD), DFF, DM, CmIdent{DM});
    for (int e = 0; e < NEXP; ++e) {
        tr_job_gu(F, mg + (size_t)e * DM * DFE, mu + (size_t)e * DM * DFE, DFE, (bf16*)(F.ws + WS_MWGU) + (size_t)e * 2 * DFE * DM, DM, 2 * DFE);
        tr_job(F, md + (size_t)e * DFE * DM, DM, 0, DFE, nullptr, (bf16*)(F.ws + WS_MWD) + (size_t)e * DM * DFE, DFE, DM, CmIdent{DM});
    }
}


__device__ __forceinline__ bool is_rope64(int c) { return (c >= C_QN && c < C_VC) || (c >= C_KS && c < C_VS) || (c >= C_KW && c < C_VW); }
struct CmInProj { __device__ __forceinline__ int operator()(int j) const {
    if (j >= IN_COLS) return -1;
    if (is_rope64(j)) { const int seg = j >= C_KW ? C_KW : j >= C_KS ? C_KS : j >= C_KC ? C_KC : C_QN; const int l = j - seg, hd = l >> 6, w = l & 63, i = w >> 3, e = w & 7; return seg + hd * 64 + (e < 4 ? 4 * i + e : 32 + 4 * i + (e - 4)); }
    if (j >= C_KPE && j < C_QN) { const int w = j - C_KPE, i = w >> 3, e = w & 7; return C_KPE + (e < 4 ? 4 * i + e : 16 + 4 * i + (e - 4)); }
    return j; } };

__device__ __forceinline__ void sincos_acc(double x, float& sn, float& cs) {
    const double kd = __builtin_rint(x * 0.63661977236758134308); const int k = (int)kd;
    const double r = ((x - kd * 1.57079632673412561417e+00) - kd * 6.07710050650619224932e-11) - kd * 2.02226624879595063154e-21, r2 = r * r;
    const double s = r * (1.0 + r2 * (-1.0 / 6 + r2 * (1.0 / 120 + r2 * (-1.0 / 5040 + r2 * (1.0 / 362880 + r2 * (-1.0 / 39916800 + r2 * (1.0 / 6227020800.0)))))));
    const double c = 1.0 + r2 * (-0.5 + r2 * (1.0 / 24 + r2 * (-1.0 / 720 + r2 * (1.0 / 40320 + r2 * (-1.0 / 3628800 + r2 * (1.0 / 479001600.0 + r2 * (-1.0 / 87178291200.0)))))));
    const int q = k & 3; sn = (float)(q == 0 ? s : q == 1 ? c : q == 2 ? -s : -c); cs = (float)(q == 0 ? c : q == 1 ? -s : q == 2 ? -c : s);
}
__device__ __forceinline__ void p_tables(Frame& F) {
    phase_begin(F);
    const int gt = F.vcu * NTHR + F.tid, NGT = F.G * NTHR;
    GAS f32x2* tn = (GAS f32x2*)(F.ws + WS_TABN); GAS f32x2* tm = (GAS f32x2*)(F.ws + WS_TABM);
    for (int e = gt; e < SEQ * 32; e += NGT) { const int pos = e >> 5, i = e & 31; float sn, cs; sincos_acc((double)((float)pos * INV_N[i]), sn, cs); tn[e] = (f32x2){cs, sn}; }
    for (int e = gt; e < SEQ * 16; e += NGT) { const int pos = e >> 4, i = e & 15; float sn, cs; sincos_acc((double)((float)pos * INV_M[i]), sn, cs); tm[e] = (f32x2){cs, sn}; }
}

struct EpiInProj {
    static constexpr bool PERM = true;
    bf16* U; const f32x2* tabn; const f32x2* tabm; float* ssq;
    __device__ __forceinline__ void operator()(const f32x4 (&acc)[2][2][4][2], const Unit& u, int wr, int wc, int fr, int fq) const {
        const int row0 = u.pm * 256 + wr * 64 + fr;
#pragma unroll
        for (int bj = 0; bj < 2; ++bj) {
            const int c32 = u.pn * 256 + bj * 128 + wc * 32;
            const int c8 = c32 + 8 * fq;
            if (is_rope64(c32)) {
                const int seg = c32 >= C_KW ? C_KW : c32 >= C_KS ? C_KS : c32 >= C_KC ? C_KC : C_QN;
                const int l = c8 - seg, hb = seg + (l & ~63), i = (l & 63) >> 3; const float sc = (seg == C_QN) ? QSCALE_N : 1.0f;
#pragma unroll
                for (int am = 0; am < 8; am += 2) {
                    f32x4 ta[2], tb[2];
#pragma unroll
                    for (int q = 0; q < 2; ++q) { const int pos = (row0 + ((am + q) >> 2) * 128 + ((am + q) & 3) * 16) & (SEQ - 1); const GAS f32x4* t = (const GAS f32x4*)(tabn + pos * 32 + 4 * i); ta[q] = t[0]; tb[q] = t[1]; }
#pragma unroll
                    for (int q = 0; q < 2; ++q) { const int ai = (am + q) >> 2, m = (am + q) & 3, row = row0 + ai * 128 + m * 16;
                        const f32x4 x1 = acc[ai][bj][m][0], x2 = acc[ai][bj][m][1]; const f32x4 t0 = ta[q], t1 = tb[q];
                        const float y10 = (x1[0] * t0[0] - x2[0] * t0[1]) * sc, y11 = (x1[1] * t0[2] - x2[1] * t0[3]) * sc, y12 = (x1[2] * t1[0] - x2[2] * t1[1]) * sc, y13 = (x1[3] * t1[2] - x2[3] * t1[3]) * sc;
                        const float y20 = (x2[0] * t0[0] + x1[0] * t0[1]) * sc, y21 = (x2[1] * t0[2] + x1[1] * t0[3]) * sc, y22 = (x2[2] * t1[0] + x1[2] * t1[1]) * sc, y23 = (x2[3] * t1[2] + x1[3] * t1[3]) * sc;
                        const auto s0 = __builtin_amdgcn_permlane16_swap(pg8::cvt_pk_bf16(y10, y11), pg8::cvt_pk_bf16(y20, y21), false, false);
                        const auto s1 = __builtin_amdgcn_permlane16_swap(pg8::cvt_pk_bf16(y12, y13), pg8::cvt_pk_bf16(y22, y23), false, false);
                        bf16* o = U + (size_t)row * NU + hb + 4 * i + ((fq & 1) ? 28 : 0);
                        *(v4u*)o = (v4u){s0[0], s1[0], s0[1], s1[1]}; }
                    asm volatile("" ::: "memory"); }
            } else if (c32 == C_KPE) {
                const int i = fq;
#pragma unroll
                for (int ai = 0; ai < 2; ++ai)
#pragma unroll
                    for (int m = 0; m < 4; ++m) { const int row = row0 + ai * 128 + m * 16, pos = row & (SEQ - 1);
                        const f32x4 x1 = acc[ai][bj][m][0], x2 = acc[ai][bj][m][1]; const GAS f32x4* t = (const GAS f32x4*)(tabm + pos * 16 + 4 * i);
                        const f32x4 t0 = t[0], t1 = t[1];
                        const float y10 = x1[0] * t0[0] - x2[0] * t0[1], y11 = x1[1] * t0[2] - x2[1] * t0[3], y12 = x1[2] * t1[0] - x2[2] * t1[1], y13 = x1[3] * t1[2] - x2[3] * t1[3];
                        const float y20 = x2[0] * t0[0] + x1[0] * t0[1], y21 = x2[1] * t0[2] + x1[1] * t0[3], y22 = x2[2] * t1[0] + x1[2] * t1[1], y23 = x2[3] * t1[2] + x1[3] * t1[3];
                        const auto s0 = __builtin_amdgcn_permlane16_swap(pg8::cvt_pk_bf16(y10, y11), pg8::cvt_pk_bf16(y20, y21), false, false);
                        const auto s1 = __builtin_amdgcn_permlane16_swap(pg8::cvt_pk_bf16(y12, y13), pg8::cvt_pk_bf16(y22, y23), false, false);
                        bf16* o = U + (size_t)row * NU + C_KPE + 4 * i + ((fq & 1) ? 12 : 0);
                        *(v4u*)o = (v4u){s0[0], s1[0], s0[1], s1[1]}; asm volatile("" ::: "memory"); }
            } else {
                const bool sq = (c32 >= C_QDN && c32 < C_KPE); const int grp = (c32 - C_QDN) >> 5;
#pragma unroll
                for (int ai = 0; ai < 2; ++ai)
#pragma unroll
                    for (int m = 0; m < 4; ++m) { const int row = row0 + ai * 128 + m * 16; const f32x4 v0 = acc[ai][bj][m][0], v1 = acc[ai][bj][m][1]; v4u w;
                        w.x = pg8::cvt_pk_bf16(v0[0], v0[1]); w.y = pg8::cvt_pk_bf16(v0[2], v0[3]); w.z = pg8::cvt_pk_bf16(v1[0], v1[1]); w.w = pg8::cvt_pk_bf16(v1[2], v1[3]);
                        *(v4u*)(U + (size_t)row * NU + c8) = w;
                        if (sq) { float q = (v0[0] * v0[0] + v0[1] * v0[1]) + (v0[2] * v0[2] + v0[3] * v0[3]) + (v1[0] * v1[0] + v1[1] * v1[1]) + (v1[2] * v1[2] + v1[3] * v1[3]);
                            q += xor_f<16>(q); q += xor_f<32>(q); if (fq == 0) ssq[(size_t)row * 16 + grp] = q; } }
            }
        }
    }
};

__device__ __forceinline__ float sigmoidf_(float x) { return __builtin_amdgcn_rcpf(1.0f + __expf(-x)); }
__device__ __forceinline__ float gelu_tanh(float y) { const float z = 0.7978845608028654f * (y + 0.044715f * y * y * y); const float t = 1.0f - 2.0f * __builtin_amdgcn_rcpf(1.0f + __expf(2.0f * z)); return 0.5f * y * (1.0f + t); }
__device__ __forceinline__ float one_minus_exp(float x) {
    const float p = -x * (1.0f + x * (0.5f + x * (0.16666667f + x * (0.041666668f + x * 0.0083333338f))));
    return (x > -0.125f) ? p : 1.0f - __expf(x); }
constexpr int LRU_XP = 264;
__device__ __forceinline__ int q_fetch(Frame& F, int qid);
__device__ __forceinline__ void p_lru_local(Frame& F, int qid, const float* cw, const float* cb, const float* wa, const float* ba, const float* wx, const float* bx, const float* lam) {
    phase_begin(F);
    const int d = F.tid & 255, half = F.tid >> 8;
    LAS bf16* xsb = (LAS bf16*)F.lds;
    LAS bf16* gts = (LAS bf16*)(F.lds + 64 * LRU_XP * 2);
    const bf16* U = (const bf16*)(F.ws + WS_U);
    bf16* P = (bf16*)(F.ws + WS_PQ); bf16* Q = P + (size_t)TOK * 256;
    float* SA = (float*)(F.ws + WS_LRU); float* SB = SA + 1024 * 256;
    const int r32 = F.lane & 31, hi = F.lane >> 5, gsel = F.wave >> 2, blk = F.wave & 3;
    bf16x8 bw[2][4];
    { const float* W = (gsel ? wx : wa) + (size_t)blk * 4096;
#pragma unroll
      for (int nt = 0; nt < 2; ++nt)
#pragma unroll
          for (int ks = 0; ks < 4; ++ks) { v4u w;
              const float* wp = W + (size_t)(16 * ks + 8 * hi) * 64 + 32 * nt + r32;
              w.x = pk2(wp[0], wp[64]); w.y = pk2(wp[128], wp[192]); w.z = pk2(wp[256], wp[320]); w.w = pk2(wp[384], wp[448]);
              bw[nt][ks] = __builtin_bit_cast(bf16x8, w); } }
    const float w0 = cw[d], w1 = cw[256 + d], w2 = cw[512 + d], w3 = cw[768 + d], cbd = cb[d], bad = ba[d], bxd = bx[d];
    const float sp = log1pf(__expf(-lam[d]));
    for (;;) {
        const int ch = q_fetch(F, qid); if (ch >= TOK / 64) break;
        const int t0 = ch * 64 + half * 32, pos0 = t0 & (SEQ - 1);
        float xm3 = 0.f, xm2 = 0.f, xm1 = 0.f;
        if (pos0 >= 3) { xm3 = bf2f(U[(size_t)(t0 - 3) * NU + C_XL + d]); xm2 = bf2f(U[(size_t)(t0 - 2) * NU + C_XL + d]); xm1 = bf2f(U[(size_t)(t0 - 1) * NU + C_XL + d]); }
        { float xv[32];
#pragma unroll
          for (int i = 0; i < 32; ++i) xv[i] = bf2f(U[(size_t)(t0 + i) * NU + C_XL + d]);
#pragma unroll
          for (int i = 0; i < 32; ++i) { const float x0 = xv[i]; const float v = cbd + w0 * xm3 + w1 * xm2 + w2 * xm1 + w3 * x0; xm3 = xm2; xm2 = xm1; xm1 = x0;
              xsb[(half * 32 + i) * LRU_XP + d] = (bf16)f2bf(v); } }
        __syncthreads();
#pragma unroll
        for (int mt = 0; mt < 2; ++mt) {
            f32x16 acc0 = f32x16{}, acc1 = f32x16{};
#pragma unroll
            for (int ks = 0; ks < 4; ++ks) { const bf16x8 a = *(const LAS bf16x8*)(xsb + (32 * mt + r32) * LRU_XP + 64 * blk + 16 * ks + 8 * hi);
                acc0 = __builtin_amdgcn_mfma_f32_32x32x16_bf16(a, bw[0][ks], acc0, 0, 0, 0); acc1 = __builtin_amdgcn_mfma_f32_32x32x16_bf16(a, bw[1][ks], acc1, 0, 0, 0); }
#pragma unroll
            for (int r = 0; r < 16; ++r) { const int tok = 32 * mt + crow(r, hi);
                gts[((size_t)gsel * 64 + tok) * 256 + 64 * blk + r32] = (bf16)f2bf(acc0[r]); gts[((size_t)gsel * 64 + tok) * 256 + 64 * blk + 32 + r32] = (bf16)f2bf(acc1[r]); }
        }
        __syncthreads();
        float h = 0.f, cum = 1.f;
        float y0 = bf2f(U[(size_t)t0 * NU + C_YL + d]), y1 = bf2f(U[(size_t)(t0 + 1) * NU + C_YL + d]);
#pragma unroll 2
        for (int i = 0; i < 32; ++i) {
            const float ycur = y0; y0 = y1; if (i + 2 < 32) y1 = bf2f(U[(size_t)(t0 + i + 2) * NU + C_YL + d]);
            const float ra = bad + bf2f(gts[(size_t)(half * 32 + i) * 256 + d]), ia = bxd + bf2f(gts[(size_t)(64 + half * 32 + i) * 256 + d]);
            const float xcv = bf2f(xsb[(half * 32 + i) * LRU_XP + d]);
            const float r = sigmoidf_(ra), ig = sigmoidf_(ia), la = -8.0f * r * sp, a = __expf(la), b = __builtin_amdgcn_sqrtf(one_minus_exp(2.0f * la)) * (ig * xcv);
            h = a * h + b; cum *= a;
            const float gl = gelu_tanh(ycur);
            P[(size_t)(t0 + i) * 256 + d] = (bf16)f2bf(h * gl); Q[(size_t)(t0 + i) * 256 + d] = (bf16)f2bf(cum * gl);
        }
        SA[(size_t)(ch * 2 + half) * 256 + d] = cum; SB[(size_t)(ch * 2 + half) * 256 + d] = h;
    }
}
__device__ __forceinline__ void p_lru_carry(Frame& F) {
    phase_begin(F);
    if (F.vcu >= NB || F.tid >= 256) return;
    const float* SA = (const float*)(F.ws + WS_LRU); const float* SB = SA + 1024 * 256; float* CY = (float*)(F.ws + WS_LRU) + 2 * 1024 * 256;
    const int d = F.tid; float c = 0.f;
    for (int k0 = 0; k0 < 256; k0 += 16) { float a[16], b[16];
#pragma unroll
        for (int i = 0; i < 16; ++i) { const size_t o = (size_t)(F.vcu * 256 + k0 + i) * 256 + d; a[i] = SA[o]; b[i] = SB[o]; }
#pragma unroll
        for (int i = 0; i < 16; ++i) { const size_t o = (size_t)(F.vcu * 256 + k0 + i) * 256 + d; CY[o] = c; c = a[i] * c + b[i]; } }
}
__device__ __forceinline__ void p_lru_fix(Frame& F, int zfrom) {
    phase_begin(F);
    const int gw = F.vcu * NWAVES + F.wave, NGW = F.G * NWAVES;
    const bf16* P = (const bf16*)(F.ws + WS_PQ); const bf16* Q = P + (size_t)TOK * 256; const float* CY = (const float*)(F.ws + WS_LRU) + 2 * 1024 * 256; bf16* CAT = (bf16*)(F.ws + WS_CAT);
    for (int m0 = gw; m0 < TOK; m0 += 4 * NGW) {
        v2u p[4], q[4]; f32x4 c[4];
#pragma unroll
        for (int i = 0; i < 4; ++i) { const int m = m0 + i * NGW; if (m < TOK) { p[i] = *((const GAS v2u*)(P + (size_t)m * 256) + F.lane); q[i] = *((const GAS v2u*)(Q + (size_t)m * 256) + F.lane);
            c[i] = *((const GAS f32x4*)(CY + (size_t)(m >> 5) * 256) + F.lane); } }
#pragma unroll
        for (int i = 0; i < 4; ++i) { const int m = m0 + i * NGW; if (m < TOK) {
            v2u o; o.x = pk2(bflo(p[i].x) + bflo(q[i].x) * c[i].x, bfhi(p[i].x) + bfhi(q[i].x) * c[i].y); o.y = pk2(bflo(p[i].y) + bflo(q[i].y) * c[i].z, bfhi(p[i].y) + bfhi(q[i].y) * c[i].w);
            *((GAS v2u*)(CAT + (size_t)m * DM) + F.lane) = o;
            { GAS v4u* z = (GAS v4u*)(CAT + (size_t)m * DM + zfrom); const int nz = (DM - zfrom) / 8;
#pragma unroll
              for (int j = 0; j < 2; ++j) { const int idx = F.lane + 64 * j; if (idx < nz) z[idx] = (v4u){0u, 0u, 0u, 0u}; } } } }
    }
}

__device__ __forceinline__ void p_prologue_mix(Frame& F, const float* w_in, const float* w_out) {
    phase_begin(F);
    for (int l = 0; l < DEPTH; ++l) {
        tr_job(F, w_in + (size_t)l * DM * IN_COLS, IN_COLS, 0, DM, nullptr, (bf16*)(F.ws + WS_WIN) + (size_t)l * NU * DM, DM, NU, CmInProj{});
        tr_job(F, w_out + (size_t)l * DM * DM, DM, 0, DM, nullptr, (bf16*)(F.ws + WS_WOUT) + (size_t)l * DM * DM, DM, DM, CmIdent{DM});
    }
}
__device__ __forceinline__ void p_prologue_cmp(Frame& F, const float* w1) {
    phase_begin(F);
    for (int ls = 0; ls < DEPTH * 2; ++ls) tr_job(F, w1 + (size_t)ls * 2048 * 128, 128, 0, 2048, nullptr, (bf16*)(F.ws + WS_WC1) + (size_t)ls * 256 * 2048, 2048, 256, CmIdent{128});
}
__device__ __forceinline__ void p_prologue_qkv(Frame& F, const float* qn, const float* wuq, const float* kvn, const float* wukv) {
    phase_begin(F);
    for (int l = 0; l < DEPTH; ++l) {
        bf16* W = (bf16*)(F.ws + WS_WQKV) + (size_t)l * 1536 * 384;
        tr_job(F, wuq + (size_t)l * 192 * 576, 576, 0, 192, qn + l * 192, W, 384, 768, CmQ{});
        tr_job(F, wukv + (size_t)l * 128 * 768, 768, 192, 128, kvn + l * 128, W + (size_t)768 * 384, 384, 768, CmIdent{768});
    }
}

enum { AM_CAUSAL = 0, AM_WINDOW = 1, AM_SELECT = 2, AM_CMP = 3 };
constexpr int NSA_WIN = 512;
template <int DK, int NSUB = 1> struct AttnLds { static constexpr int KP = DK + 8, KT = 64 * KP * 2, KBYTES = NSUB * KT, VBYTES = NSUB * 8192, BUF = KBYTES + VBYTES; };
struct SrcMla { const bf16* kvm; const bf16* u; int h; size_t base;
    __device__ __forceinline__ const bf16* kp(int key, int c) const { return c < 8 ? kvm + (base + key) * 768 + h * 128 + 8 * c : u + (base + key) * NU + C_KPE + 8 * (c - 8); }
    __device__ __forceinline__ const bf16* vp(int key, int c) const { return kvm + (base + key) * 768 + h * 128 + 64 + 8 * c; }
    __device__ __forceinline__ unsigned koff(int key, int c) const { return c < 8 ? (unsigned)WS_KVM + ((unsigned)base + key) * 1536u + h * 256 + 16 * c : (unsigned)WS_U + ((unsigned)base + key) * (NU * 2u) + (C_KPE + 8 * (c - 8)) * 2; }
    __device__ __forceinline__ unsigned kstride(int c) const { return c < 8 ? 1536u : NU * 2u; }
    __device__ __forceinline__ unsigned voff(int key, int c) const { return (unsigned)WS_KVM + ((unsigned)base + key) * 1536u + h * 256 + 128 + 16 * c; }
    __device__ __forceinline__ unsigned vstride() const { return 1536u; } };
struct SrcU { const bf16* u; int kcol, vcol; size_t base;
    __device__ __forceinline__ const bf16* kp(int key, int c) const { return u + (base + key) * NU + kcol + 8 * c; }
    __device__ __forceinline__ const bf16* vp(int key, int c) const { return u + (base + key) * NU + vcol + 8 * c; }
    __device__ __forceinline__ unsigned koff(int key, int c) const { return (unsigned)WS_U + ((unsigned)base + key) * (NU * 2u) + (kcol + 8 * c) * 2; }
    __device__ __forceinline__ unsigned kstride(int) const { return NU * 2u; }
    __device__ __forceinline__ unsigned voff(int key, int c) const { return (unsigned)WS_U + ((unsigned)base + key) * (NU * 2u) + (vcol + 8 * c) * 2; }
    __device__ __forceinline__ unsigned vstride() const { return NU * 2u; } };
struct SrcCmp { const bf16* kc; const bf16* vc; unsigned kc0, vc0;
    __device__ __forceinline__ const bf16* kp(int key, int c) const { return kc + key * 64 + 8 * c; }
    __device__ __forceinline__ const bf16* vp(int key, int c) const { return vc + key * 64 + 8 * c; }
    __device__ __forceinline__ unsigned koff(int key, int c) const { return kc0 + key * 128 + 16 * c; }
    __device__ __forceinline__ unsigned kstride(int) const { return 128u; }
    __device__ __forceinline__ unsigned voff(int key, int c) const { return vc0 + key * 128 + 16 * c; }
    __device__ __forceinline__ unsigned vstride() const { return 128u; } };

template <int DK, int MODE, int NSUB, int VAR = 0, class Src>
__device__ __forceinline__ void attn_branch(Frame& F, LAS unsigned char* lds, const Src& src, const bf16x8 (&qf)[DK / 16], int qpos0w, int jlo, int jhi, const v4u selmask, f32x16 (&o)[2], float& m_out, float& l_out) {
    typedef AttnLds<DK, NSUB> L;
    const int tid = F.tid, lane = F.lane, r32 = lane & 31, hi = lane >> 5;
    const int qpos = qpos0w + r32;
    o[0] = f32x16{}; o[1] = f32x16{};
    float m = -1.0e30f, l = 0.f;
    f32x16 lacc_unused = f32x16{};
    const bf16x8 ones = (bf16x8){(short)0x3f80, (short)0x3f80, (short)0x3f80, (short)0x3f80, (short)0x3f80, (short)0x3f80, (short)0x3f80, (short)0x3f80};
    constexpr int KC = DK / 8, NKP = NSUB * 64 * KC, NPT = (NKP + 511) / 512; constexpr bool KEXACT = (NKP % 512) == 0;
    const int vkey = tid >> 3, vc = tid & 7;
    const GAS unsigned char* wsb = (const GAS unsigned char*)F.ws;
    unsigned kl[NPT], kst[NPT], vl[NSUB];
#pragma unroll
    for (int i = 0; i < NPT; ++i) { const int p_ = tid + 512 * i; kl[i] = src.koff(p_ / KC, p_ % KC); kst[i] = src.kstride(p_ % KC); }
#pragma unroll
    for (int i = 0; i < NSUB; ++i) vl[i] = src.voff(64 * i + vkey, vc);
    v4u kr[NPT], vr[NSUB];
#define AT_LOAD(jm_) do { const unsigned kb_ = (unsigned)((jm_) * (NSUB * 64)); \
        _Pragma("unroll") for (int i_ = 0; i_ < NPT; ++i_) { const int p_ = tid + 512 * i_; if (KEXACT || i_ + 1 < NPT || p_ < NKP) kr[i_] = *(const GAS v4u*)(wsb + (size_t)(kl[i_] + kb_ * kst[i_])); } \
        _Pragma("unroll") for (int i_ = 0; i_ < NSUB; ++i_) vr[i_] = *(const GAS v4u*)(wsb + (size_t)(vl[i_] + kb_ * src.vstride())); } while (0)
#define AT_WRITE(buf) do { LAS unsigned char* b_ = lds + (buf) * L::BUF; \
        _Pragma("unroll") for (int i_ = 0; i_ < NPT; ++i_) { const int p_ = tid + 512 * i_; if (KEXACT || i_ + 1 < NPT || p_ < NKP) *(LAS v4u*)(b_ + (p_ / KC) * (L::KP * 2) + (p_ % KC) * 16) = kr[i_]; } \
        _Pragma("unroll") for (int i_ = 0; i_ < NSUB; ++i_) *(LAS v4u*)(b_ + L::KBYTES + i_ * 8192 + (vc >> 2) * 4096 + vkey * 64 + (vc & 3) * 16) = vr[i_]; } while (0)
    const int mlo = jlo / NSUB, mhi = jhi / NSUB;
    if (jlo <= jhi) { AT_LOAD(mlo); AT_WRITE(0); }
    __syncthreads();
    if (F.wave & 1) __builtin_amdgcn_s_setprio(3);
    int cur = 0;
    for (int jm = mlo; jm <= mhi; ++jm) {
        if (jm < mhi) AT_LOAD(jm + 1);
#pragma unroll
      for (int sub = 0; sub < NSUB; ++sub) {
        const int j = jm * NSUB + sub;
        const int kb = j * 64;
        bool need, part, lanesel = true;
        if (MODE == AM_CAUSAL)      { need = kb <= qpos0w + 31; part = kb + 63 > qpos0w; }
        else if (MODE == AM_WINDOW) { need = (kb <= qpos0w + 31) && (kb + 63 > qpos0w - NSA_WIN); part = (kb + 63 > qpos0w) || (kb <= qpos0w + 31 - NSA_WIN); }
        else if (MODE == AM_SELECT) { const unsigned w = (j < 32) ? selmask.x : (j < 64) ? selmask.y : (j < 96) ? selmask.z : selmask.w; lanesel = (w >> (j & 31)) & 1u;
                                      need = __any(lanesel) && kb <= qpos0w + 31; part = kb + 63 > qpos0w; }
        else                        { need = (16 * kb + 31) <= qpos0w + 31; part = (16 * (kb + 63) + 31 > qpos0w) || (kb + 63 > 510); }
        if (NSUB > 1) need = need && j >= jlo && j <= jhi;
        if (need) {
            const LAS unsigned char* kb_l = lds + cur * L::BUF + sub * L::KT; const LAS unsigned char* vb_l = lds + cur * L::BUF + L::KBYTES + sub * 8192;
            f32x16 p0 = f32x16{}, p1 = f32x16{};
#pragma unroll
            for (int ks = 0; ks < DK / 16; ++ks) {
                const bf16x8 k0 = *(const LAS bf16x8*)(kb_l + r32 * (L::KP * 2) + ks * 32 + hi * 16);
                const bf16x8 k1 = (VAR == 6) ? k0 : *(const LAS bf16x8*)(kb_l + (32 + r32) * (L::KP * 2) + ks * 32 + hi * 16);
                p0 = __builtin_amdgcn_mfma_f32_32x32x16_bf16(k0, qf[ks], p0, 0, 0, 0);
                p1 = __builtin_amdgcn_mfma_f32_32x32x16_bf16(k1, qf[ks], p1, 0, 0, 0);
            }
            s16x4 vlo[2][4], vhh[2][4];
            { const int li = lane & 15, dhalf = (lane >> 4) & 1;
              const LAS unsigned char* vbase = vb_l + (4 * hi + (li >> 2)) * 64 + (16 * dhalf + 4 * (li & 3)) * 2;
#pragma unroll
              for (int db = 0; db < 2; ++db)
#pragma unroll
                  for (int s4 = 0; s4 < 4; ++s4) {
                      vlo[db][s4] = __builtin_bit_cast(s16x4, __builtin_amdgcn_ds_read_tr16_b64_v4i16((LAS s16x4*)(vbase + db * 4096 + s4 * 1024)));
                      vhh[db][s4] = __builtin_bit_cast(s16x4, __builtin_amdgcn_ds_read_tr16_b64_v4i16((LAS s16x4*)(vbase + db * 4096 + s4 * 1024 + 512))); } }
            __builtin_amdgcn_sched_barrier(0);
            if (part) {
                const float NEG = -INFINITY;
                if (MODE == AM_WINDOW) {
                    if (kb + 63 > qpos0w) { const int lim = qpos - kb - 4 * hi;
#pragma unroll
                        for (int r = 0; r < 16; ++r) { const int c = (r & 3) + 8 * (r >> 2); if (!(lim >= c)) p0[r] = NEG; if (!(lim >= c + 32)) p1[r] = NEG; } }
                    if (kb <= qpos0w + 31 - NSA_WIN) { const int lim = qpos - NSA_WIN - kb - 4 * hi;
#pragma unroll
                        for (int r = 0; r < 16; ++r) { const int c = (r & 3) + 8 * (r >> 2); if (!(lim < c)) p0[r] = NEG; if (!(lim < c + 32)) p1[r] = NEG; } }
                } else {
                    int lim;
                    if (MODE == AM_CMP) { const int nl = (qpos - 31) >> 4; lim = (nl < 510 ? nl : 510) - kb - 4 * hi; }
                    else lim = qpos - kb - 4 * hi;
#pragma unroll
                    for (int r = 0; r < 16; ++r) { const int c = (r & 3) + 8 * (r >> 2); if (!(lim >= c)) p0[r] = NEG; if (!(lim >= c + 32)) p1[r] = NEG; }
                }
            }
            float mxa = __builtin_fmaxf(__builtin_fmaxf(p0[0], p0[1]), p1[0]), mxc = __builtin_fmaxf(__builtin_fmaxf(p0[2], p0[3]), p1[1]); mxa = __builtin_fmaxf(__builtin_fmaxf(mxa, p1[2]), p1[3]);
#pragma unroll
            for (int r = 4; r < 16; r += 4) { mxa = __builtin_fmaxf(__builtin_fmaxf(mxa, p0[r]), p0[r + 1]); mxc = __builtin_fmaxf(__builtin_fmaxf(mxc, p0[r + 2]), p0[r + 3]); mxa = __builtin_fmaxf(__builtin_fmaxf(mxa, p1[r]), p1[r + 1]); mxc = __builtin_fmaxf(__builtin_fmaxf(mxc, p1[r + 2]), p1[r + 3]); }
            float mx = __builtin_fmaxf(mxa, mxc); mx = __builtin_fmaxf(mx, xor_f<32>(mx));
            if (MODE == AM_SELECT) mx = lanesel ? mx : -INFINITY;
            if (__any(mx > m + 6.0f)) { const float mn = fmaxf(m, mx), alpha = __builtin_amdgcn_exp2f(m - mn); m = mn; l *= alpha;
#pragma unroll
                for (int r = 0; r < 16; ++r) { o[0][r] *= alpha; o[1][r] *= alpha; } }
            typedef float f32x2v __attribute__((ext_vector_type(2)));
            const float msub = (MODE == AM_SELECT) ? (lanesel ? m : INFINITY) : m;
            const f32x2v m2 = (f32x2v){msub, msub}; f32x2v ps2 = (f32x2v){0.f, 0.f};
#pragma unroll
            for (int r = 0; r < 16; r += 2) { const f32x2v a_ = (f32x2v){p0[r], p0[r + 1]} - m2, b_ = (f32x2v){p1[r], p1[r + 1]} - m2;
                p0[r] = __builtin_amdgcn_exp2f(a_[0]); p0[r + 1] = __builtin_amdgcn_exp2f(a_[1]); p1[r] = __builtin_amdgcn_exp2f(b_[0]); p1[r + 1] = __builtin_amdgcn_exp2f(b_[1]);
                ps2 += (f32x2v){p0[r], p0[r + 1]}; ps2 += (f32x2v){p1[r], p1[r + 1]}; }
            l += ps2[0] + ps2[1];
            bf16x8 pf[4];
#pragma unroll
            for (int s4 = 0; s4 < 4; ++s4) { const int rb = 8 * (s4 & 1); v4u w;
                if (s4 < 2) { w.x = pg8::cvt_pk_bf16(p0[rb], p0[rb + 1]); w.y = pg8::cvt_pk_bf16(p0[rb + 2], p0[rb + 3]); w.z = pg8::cvt_pk_bf16(p0[rb + 4], p0[rb + 5]); w.w = pg8::cvt_pk_bf16(p0[rb + 6], p0[rb + 7]); }
                else        { w.x = pg8::cvt_pk_bf16(p1[rb], p1[rb + 1]); w.y = pg8::cvt_pk_bf16(p1[rb + 2], p1[rb + 3]); w.z = pg8::cvt_pk_bf16(p1[rb + 4], p1[rb + 5]); w.w = pg8::cvt_pk_bf16(p1[rb + 6], p1[rb + 7]); }
                pf[s4] = __builtin_bit_cast(bf16x8, w); }
#pragma unroll
            for (int s4 = 0; s4 < 4; ++s4) {
#pragma unroll
                for (int db = 0; db < 2; ++db) {
                    const s16x4 lo = vlo[db][s4], hh = vhh[db][s4];
                    const bf16x8 vf = (bf16x8){lo[0], lo[1], lo[2], lo[3], hh[0], hh[1], hh[2], hh[3]};
                    o[db] = __builtin_amdgcn_mfma_f32_32x32x16_bf16(vf, pf[s4], o[db], 0, 0, 0);
                }
            }
        }
      }
        if (jm < mhi) AT_WRITE(cur ^ 1);
        if (VAR != 7) __syncthreads();
        cur ^= 1;
    }
#undef AT_LOAD
#undef AT_WRITE
    __builtin_amdgcn_s_setprio(0);
    l += xor_f<32>(l);
    m_out = m; l_out = l;
    const float inv = (l > 0.f) ? 1.0f / l : 0.f;
#pragma unroll
    for (int r = 0; r < 16; ++r) { o[0][r] *= inv; o[1][r] *= inv; }
}
__device__ __forceinline__ unsigned q_issue(Frame& F, int qid) { unsigned t = 0u; if (F.tid == 0) t = __hip_atomic_fetch_add((unsigned*)(F.ctl + CW_Q + 64 * qid), 1u, __ATOMIC_RELAXED, __HIP_MEMORY_SCOPE_AGENT); return t; }
__device__ __forceinline__ int q_take(Frame& F, unsigned t) { if (F.tid == 0) F.MISC[0] = t; __syncthreads(); const int v = (int)F.MISC[0]; __syncthreads(); return __builtin_amdgcn_readfirstlane(v); }
__device__ __forceinline__ int q_fetch(Frame& F, int qid) {
    if (F.tid == 0) F.MISC[0] = __hip_atomic_fetch_add((unsigned*)(F.ctl + CW_Q + 64 * qid), 1u, __ATOMIC_RELAXED, __HIP_MEMORY_SCOPE_AGENT);
    __syncthreads(); const int v = (int)F.MISC[0]; __syncthreads(); return __builtin_amdgcn_readfirstlane(v);
}

constexpr int CW_FLAG = 19000;
__device__ __forceinline__ void unit_publish(Frame& F, int word) {
    asm volatile("s_waitcnt vmcnt(0)" ::: "memory");
    __syncthreads();
    if (F.tid == 0) { __builtin_amdgcn_fence(__ATOMIC_RELEASE, "agent"); asm volatile("s_waitcnt vmcnt(0)" ::: "memory"); (void)xb_add((unsigned*)(F.ctl + word), 1u); }
}
__device__ __forceinline__ void count_await(Frame& F, int word, unsigned target) {
    if (F.tid == 0) { unsigned* bar = (unsigned*)(F.ctl + CW_BAR); XB_SPIN(xb_ld((unsigned*)(F.ctl + word)) < target, bar); __builtin_amdgcn_fence(__ATOMIC_ACQUIRE, "agent"); asm volatile("s_waitcnt vmcnt(0)" ::: "memory"); }
    __syncthreads();
}
__device__ __forceinline__ void unit_await(Frame& F, int word) {
    if (F.tid == 0) { unsigned* bar = (unsigned*)(F.ctl + CW_BAR); XB_SPIN(xb_ld((unsigned*)(F.ctl + word)) == 0u, bar); __builtin_amdgcn_fence(__ATOMIC_ACQUIRE, "agent"); asm volatile("s_waitcnt vmcnt(0)" ::: "memory"); }
    __syncthreads();
}

constexpr size_t KC_HEAD = (size_t)512 * 64;
struct SchedCmp : pg8::TileOrder {
    const char* B;
    __device__ __forceinline__ unsigned arow(const Unit& u, int r) const { const int R = u.pm * 256 + r, n = R & 511, g = (R >> 9) & 1, b = (R >> 10) & 3, sr = R >> 12;
        return (unsigned)(((size_t)(b * SEQ + 16 * n) * NU + (sr ? C_VC : C_KC) + g * 64) * 2); }
    __device__ __forceinline__ size_t abase(const Unit&, int) const { return 0; }
    __device__ __forceinline__ const char* bbase(const Unit& u) const { return B + (size_t)(u.pm >> 4) * (256 * 2048 * 2); }
};
struct EpiCmp {
    static constexpr bool PERM = true;
    bf16* G; const float* bias;
    __device__ __forceinline__ void operator()(const f32x4 (&acc)[2][2][4][2], const Unit& u, int wr, int wc, int fr, int fq) const {
        const int row0 = u.pm * 256 + wr * 64 + fr, c8 = wc * 32 + 8 * fq; const float* bp = bias + (u.pm >> 4) * 128 + c8;
        const f32x4 b0 = *(const GAS f32x4*)bp, b1 = *(const GAS f32x4*)(bp + 4);
#pragma unroll
        for (int ai = 0; ai < 2; ++ai)
#pragma unroll
            for (int m = 0; m < 4; ++m) { const f32x4 v0 = acc[ai][0][m][0] + b0, v1 = acc[ai][0][m][1] + b1;
                *(v4u*)(G + (size_t)(row0 + ai * 128 + m * 16) * 128 + c8) = (v4u){pg8::cvt_pk_bf16(gelu_tanh(v0[0]), gelu_tanh(v0[1])), pg8::cvt_pk_bf16(gelu_tanh(v0[2]), gelu_tanh(v0[3])),
                                                                                      pg8::cvt_pk_bf16(gelu_tanh(v1[0]), gelu_tanh(v1[1])), pg8::cvt_pk_bf16(gelu_tanh(v1[2]), gelu_tanh(v1[3]))}; }
    }
};
__device__ __forceinline__ void p_cmp2(Frame& F, const float* w2) {
    phase_begin(F);
    const bf16* G = (const bf16*)(F.ws + WS_G1C); bf16* KC = (bf16*)(F.ws + WS_KC);
    for (int e = F.vcu * NTHR + F.tid; e < 8192 * 64; e += F.G * NTHR) { const int R = e >> 6, d = e & 63, sr = R >> 12; float a = 0.f;
        const GAS v4u* gr = (const GAS v4u*)(G + (size_t)R * 128); const float* w = w2 + (size_t)sr * 128 * 64 + d;
        for (int j8 = 0; j8 < 16; ++j8) { const v4u g = gr[j8];
            a += bflo(g.x) * w[(8 * j8 + 0) * 64] + bfhi(g.x) * w[(8 * j8 + 1) * 64] + bflo(g.y) * w[(8 * j8 + 2) * 64] + bfhi(g.y) * w[(8 * j8 + 3) * 64]
               + bflo(g.z) * w[(8 * j8 + 4) * 64] + bfhi(g.z) * w[(8 * j8 + 5) * 64] + bflo(g.w) * w[(8 * j8 + 6) * 64] + bfhi(g.w) * w[(8 * j8 + 7) * 64]; }
        KC[e] = (bf16)(((R & 511) == 511) ? 0u : f2bf(a)); }
}
__device__ __forceinline__ void p_cmp_bias(Frame& F, const float* cpos, const float* w1) {
    phase_begin(F);
    float* bias = (float*)(F.ws + WS_MISC + MS_CBIAS);
    LAS float* red = (LAS float*)F.lds;
    __syncthreads();
    for (int e = F.vcu; e < DEPTH * 2 * 128; e += F.G) { const int ls = e >> 7, j = e & 127; float a = 0.f;
#pragma unroll
        for (int i = 0; i < 2048 / NTHR; ++i) { const int k = F.tid + i * NTHR; a += cpos[(size_t)ls * 2048 + k] * w1[((size_t)ls * 2048 + k) * 128 + j]; }
        a = wave_sum(a);
        if (F.lane == 0) red[F.wave] = a;
        __syncthreads();
        if (F.tid == 0) bias[e] = ((red[0] + red[1]) + (red[2] + red[3])) + ((red[4] + red[5]) + (red[6] + red[7]));
        __syncthreads(); }
}
__device__ __forceinline__ float gate_of(const bf16* U, const float* gb, size_t row, int h, int br) { return sigmoidf_(bf2f(U[row * NU + C_GN + h * 3 + br]) + gb[h * 3 + br]); }

constexpr int KALL_OFF = 36864;
__device__ __forceinline__ void nsa_a_unit(Frame& F, int u, const float* gb) {
    typedef AttnLds<64> L;
    const bf16* U = (const bf16*)(F.ws + WS_U); bf16* OC = (bf16*)(F.ws + WS_OC); unsigned* MASK = (unsigned*)(F.ws + WS_MASK);
    const int r32 = F.lane & 31, hi = F.lane >> 5;
    const int qb = 31 - (u >> 3), bg = u & 7, b = bg >> 1, g = bg & 1;
    const int qpos0w = qb * 256 + F.wave * 32, qpos = qpos0w + r32; const size_t row = (size_t)b * SEQ + qpos;
    const int nmax = (qb * 256 + 255 - 31) >> 4;
    const int jhi = nmax >> 6;
    SrcCmp src{(const bf16*)(F.ws + WS_KC) + (size_t)(b * 2 + g) * KC_HEAD, (const bf16*)(F.ws + WS_KC) + (size_t)(8 + b * 2 + g) * KC_HEAD, (unsigned)(WS_KC + (size_t)(b * 2 + g) * KC_HEAD * 2), (unsigned)(WS_KC + (size_t)(8 + b * 2 + g) * KC_HEAD * 2)};
    { const int kkey = F.tid >> 3, kc = F.tid & 7;
#pragma unroll
      for (int j = 0; j < 8; ++j) if (j <= jhi) *(LAS v4u*)(F.lds + KALL_OFF + j * L::KBYTES + kkey * (L::KP * 2) + kc * 16) = *(const GAS v4u*)src.kp(j * 64 + kkey, kc); }
    float m0 = 0.f, m1 = 0.f, m2 = 0.f, l0 = 0.f, l1 = 0.f, l2 = 0.f;
#pragma unroll 1
    for (int p = 0; p < 3; ++p) { const int h = g * 3 + p;
        bf16x8 qf[4];
#pragma unroll
        for (int ks = 0; ks < 4; ++ks) qf[ks] = *(const GAS bf16x8*)(U + row * NU + C_QN + h * 64 + ks * 16 + hi * 8);
        f32x16 o[2]; float mh, lh;
        attn_branch<64, AM_CMP, 1>(F, F.lds, src, qf, qpos0w, 0, jhi, (v4u){0u, 0u, 0u, 0u}, o, mh, lh);
        if (p == 0) { m0 = mh; l0 = lh; } else if (p == 1) { m1 = mh; l1 = lh; } else { m2 = mh; l2 = lh; }
        const float gt = gate_of(U, gb, row, h, 0);
        bf16* orow = OC + row * 384 + h * 64;
#pragma unroll
        for (int db = 0; db < 2; ++db)
#pragma unroll
            for (int a = 0; a < 4; ++a) *(GAS v2u*)(orow + 32 * db + 8 * a + 4 * hi) = (v2u){pg8::cvt_pk_bf16(o[db][4 * a] * gt, o[db][4 * a + 1] * gt), pg8::cvt_pk_bf16(o[db][4 * a + 2] * gt, o[db][4 * a + 3] * gt)};
    }
    float imp[64];
#pragma unroll
    for (int k = 0; k < 64; ++k) imp[k] = 0.f;
#pragma unroll 1
    for (int p = 0; p < 3; ++p) { const int h = g * 3 + p;
        bf16x8 qf[4];
#pragma unroll
        for (int ks = 0; ks < 4; ++ks) qf[ks] = *(const GAS bf16x8*)(U + row * NU + C_QN + h * 64 + ks * 16 + hi * 8);
        const float mh = (p == 0) ? m0 : (p == 1) ? m1 : m2, lh = (p == 0) ? l0 : (p == 1) ? l1 : l2;
        const float il = (lh > 0.f) ? 1.0f / lh : 0.f; float carryE = 0.f;
        int qp2 = qpos; asm volatile("" : "+v"(qp2));
#pragma unroll 1
        for (int j = 0; j <= jhi; ++j) {
            const int kb = j * 64; const LAS unsigned char* kb_l = F.lds + KALL_OFF + j * L::KBYTES;
            f32x16 p0 = f32x16{}, p1 = f32x16{};
#pragma unroll
            for (int ks = 0; ks < 4; ++ks) {
                const bf16x8 k0 = *(const LAS bf16x8*)(kb_l + r32 * (L::KP * 2) + ks * 32 + hi * 16);
                const bf16x8 k1 = *(const LAS bf16x8*)(kb_l + (32 + r32) * (L::KP * 2) + ks * 32 + hi * 16);
                p0 = __builtin_amdgcn_mfma_f32_32x32x16_bf16(k0, qf[ks], p0, 0, 0, 0); p1 = __builtin_amdgcn_mfma_f32_32x32x16_bf16(k1, qf[ks], p1, 0, 0, 0); }
#pragma unroll
            for (int r = 0; r < 16; ++r) { const int ka = kb + crow(r, hi), kbb = ka + 32;
                const bool v0 = (16 * ka + 31 <= qp2) && ka <= 510, v1 = (16 * kbb + 31 <= qp2) && kbb <= 510;
                p0[r] = v0 ? __builtin_amdgcn_exp2f(p0[r] - mh) * il : 0.f; p1[r] = v1 ? __builtin_amdgcn_exp2f(p1[r] - mh) * il : 0.f; }
            float E0[4], E1[4], add[8];
#pragma unroll
            for (int a = 0; a < 4; ++a) { E0[a] = xor_f<32>(p0[4 * a + 3]); E1[a] = xor_f<32>(p1[4 * a + 3]); }
#pragma unroll
            for (int a = 0; a < 4; ++a) {
                const float e0 = hi ? E0[a] : (a > 0 ? E0[a > 0 ? a - 1 : 0] : carryE), e1 = hi ? E1[a] : (a > 0 ? E1[a > 0 ? a - 1 : 0] : E0[3]);
                add[a] = ((p0[4 * a] + p0[4 * a + 1]) + (p0[4 * a + 2] + p0[4 * a + 3])) + e0;
                add[4 + a] = ((p1[4 * a] + p1[4 * a + 1]) + (p1[4 * a + 2] + p1[4 * a + 3])) + e1; }
            carryE = E1[3];
#define IMP_ADD(J) if (j == (J)) { _Pragma("unroll") for (int i = 0; i < 8; ++i) imp[8 * (J) + i] += add[i]; }
            IMP_ADD(0) else IMP_ADD(1) else IMP_ADD(2) else IMP_ADD(3) else IMP_ADD(4) else IMP_ADD(5) else IMP_ADD(6) else IMP_ADD(7)
#undef IMP_ADD
        }
    }
    __syncthreads();
    {
        const int curb = qpos >> 6; unsigned mk0 = 0u, mk1 = 0u, mk2 = 0u, mk3 = 0u;
        LAS float* iv = (LAS float*)(F.lds + F.wave * 16384) + F.lane;
#pragma unroll
        for (int k = 0; k < 64; ++k) { const int sblk = 16 * (k >> 3) + 8 * ((k >> 2) & 1) + 2 * (k & 3) + hi; iv[k * 64] = (sblk == 0 || sblk >= curb) ? -2.0f : imp[k]; }
#define MK_SET(sv) do { const int s_ = (sv); const unsigned bit_ = 1u << (s_ & 31); const int w_ = s_ >> 5; mk0 |= (w_ == 0) ? bit_ : 0u; mk1 |= (w_ == 1) ? bit_ : 0u; mk2 |= (w_ == 2) ? bit_ : 0u; mk3 |= (w_ == 3) ? bit_ : 0u; } while (0)
        if (!__all(curb < 16)) {
#pragma unroll 1
            for (int rnd = 0; rnd < 14; ++rnd) {
                float best = -1.0f; int bk = 0;
#pragma unroll 8
                for (int k = 0; k < 64; ++k) { const float v = iv[k * 64]; if (v > best) { best = v; bk = k; } }
                const int bs = 16 * (bk >> 3) + 8 * ((bk >> 2) & 1) + 2 * (bk & 3) + hi;
                const float ob = xor_f<32>(best); const int os = (int)xor_u<32>((unsigned)bs);
                const bool win = (best > ob) || (best == ob && bs < os);
                if (win && best >= 0.f) { iv[bk * 64] = -2.0f; MK_SET(bs); }
            }
            MK_SET(0); MK_SET(curb);
        }
        if (curb < 16) { mk0 = (2u << curb) - 1u; mk1 = 0u; mk2 = 0u; mk3 = 0u; }
        mk0 |= xor_u<32>(mk0); mk1 |= xor_u<32>(mk1); mk2 |= xor_u<32>(mk2); mk3 |= xor_u<32>(mk3);
#undef MK_SET
        if (hi == 0) *(GAS v4u*)(MASK + ((size_t)(b * 2 + g) * SEQ + qpos) * 4) = (v4u){mk0, mk1, mk2, mk3};
    }
    __syncthreads();
}
template <int VAR>
__device__ __forceinline__ void nsa_b_unit(Frame& F, int u, const float* gb) {
    const bf16* U = (const bf16*)(F.ws + WS_U); bf16* CAT = (bf16*)(F.ws + WS_CAT); const unsigned* MASK = (const unsigned*)(F.ws + WS_MASK);
    const int r32 = F.lane & 31, hi = F.lane >> 5;
    const int qb = 31 - u / 24, bh = u % 24, b = bh / 6, h = bh % 6, g = h / 3;
    const int qpos0w = qb * 256 + F.wave * 32, qpos = qpos0w + r32; const size_t row = (size_t)b * SEQ + qpos;
    bf16x8 qf[4];
#pragma unroll
    for (int ks = 0; ks < 4; ++ks) qf[ks] = *(const GAS bf16x8*)(U + row * NU + C_QN + h * 64 + ks * 16 + hi * 8);
    const v4u sm = *(const GAS v4u*)(MASK + ((size_t)(b * 2 + g) * SEQ + qpos) * 4);
    f32x16 o[2], acc[2]; float m_, l_;
    { SrcU src{U, C_KS + g * 64, C_VS + g * 64, (size_t)b * SEQ};
      attn_branch<64, AM_SELECT, 2, VAR>(F, F.lds, src, qf, qpos0w, 0, qb * 4 + 3, sm, o, m_, l_); }
    { const float gt = gate_of(U, gb, row, h, 1);
#pragma unroll
      for (int r = 0; r < 16; ++r) { acc[0][r] = o[0][r] * gt; acc[1][r] = o[1][r] * gt; } }
    { SrcU src{U, C_KW + g * 64, C_VW + g * 64, (size_t)b * SEQ};
      const int jl = qb * 4 - 8 < 0 ? 0 : qb * 4 - 8;
      attn_branch<64, AM_WINDOW, 2, VAR>(F, F.lds, src, qf, qpos0w, jl, qb * 4 + 3, (v4u){0u, 0u, 0u, 0u}, o, m_, l_); }
    { const float gt = gate_of(U, gb, row, h, 2);
#pragma unroll
      for (int r = 0; r < 16; ++r) { acc[0][r] += o[0][r] * gt; acc[1][r] += o[1][r] * gt; } }
    bf16* orow = CAT + row * DM + 640 + h * 64; const bf16* crow_ = (const bf16*)(F.ws + WS_OC) + row * 384 + h * 64;
#pragma unroll
    for (int db = 0; db < 2; ++db)
#pragma unroll
        for (int a = 0; a < 4; ++a) { GAS v2u* p = (GAS v2u*)(orow + 32 * db + 8 * a + 4 * hi); const v2u c = *(const GAS v2u*)(crow_ + 32 * db + 8 * a + 4 * hi);
            *p = (v2u){pg8::cvt_pk_bf16(acc[db][4 * a] + bflo(c.x), acc[db][4 * a + 1] + bfhi(c.x)), pg8::cvt_pk_bf16(acc[db][4 * a + 2] + bflo(c.y), acc[db][4 * a + 3] + bfhi(c.y))}; }
}
namespace nb {
typedef __attribute__((address_space(3))) const char* lds_cptr;
typedef short v4i16_t __attribute__((ext_vector_type(4)));
constexpr int SLOTB = 8192, NSLOT = 3, LDS_K = 0, LDS_V = NSLOT * SLOTB, LDS_WS = 2 * NSLOT * SLOTB, LDS_OST = LDS_WS + 8 * 64 * 4, LDS_OST2 = LDS_OST + 8 * 4096, LDS_END = LDS_OST2 + 8 * 4096;
static_assert(LDS_END + 8192 <= RING_BYTES, "attention scratch must fit below the frame's control words");
constexpr int LDS_X = LDS_OST2;
constexpr float THRL = 8.0f;
#define NB_SBAR() __builtin_amdgcn_sched_barrier(0)
#define NB_WAIT_BAR(N) asm volatile("s_waitcnt vmcnt(" #N ") lgkmcnt(0)\n\ts_barrier" ::: "memory")
#define NB_PIN(x) asm volatile("" : "+v"(x))
#define NB_MX3(a, b, c) __builtin_fmaxf(__builtin_fmaxf((a), (b)), (c))
__device__ __forceinline__ void glds16(const void* gbase, unsigned voff, unsigned lds_dst) { unsigned keep;
    asm volatile("s_mov_b32 %0, m0\n\ts_mov_b32 m0, %2\n\ts_nop 0\n\tglobal_load_lds_dwordx4 %1, %3\n\ts_mov_b32 m0, %0" : "=&s"(keep) : "v"(voff), "s"(lds_dst), "s"(gbase) : "memory"); }
__device__ __forceinline__ int fresh_lane() { int z_ = 0; asm volatile("" : "+v"(z_)); return (int)__builtin_amdgcn_mbcnt_hi(~0u, __builtin_amdgcn_mbcnt_lo(~0u, z_)); }
typedef float f32x2_t __attribute__((ext_vector_type(2))); typedef __bf16 bf16x2_t __attribute__((ext_vector_type(2)));
__device__ __forceinline__ unsigned cvtpk_s(float lo, float hi) { f32x2_t v = {lo, hi}; bf16x2_t b = __builtin_convertvector(v, bf16x2_t); return __builtin_bit_cast(unsigned, b); }
__device__ __forceinline__ void kload2(bf16x8* kf, lds_cptr kp, int j) { kf[2 * j] = *(const __attribute__((address_space(3))) bf16x8*)(kp + j * 2048); kf[2 * j + 1] = *(const __attribute__((address_space(3))) bf16x8*)(kp + j * 2048 + 512); }
__device__ __forceinline__ s16x4 vtr(lds_cptr p) { return __builtin_bit_cast(s16x4, __builtin_amdgcn_ds_read_tr16_b64_v4i16((__attribute__((address_space(3))) v4i16_t*)p)); }
__device__ __forceinline__ float rowmax(const f32x16& p0, const f32x16& p1) {
    float a = NB_MX3(p0[0], p0[1], p1[0]), b = NB_MX3(p0[2], p0[3], p1[1]); a = NB_MX3(a, p1[2], p1[3]);
#pragma unroll
    for (int r = 4; r < 16; r += 4) { a = NB_MX3(a, p0[r], p0[r + 1]); b = NB_MX3(b, p0[r + 2], p0[r + 3]); a = NB_MX3(a, p1[r], p1[r + 1]); b = NB_MX3(b, p1[r + 2], p1[r + 3]); }
    float m = __builtin_fmaxf(a, b); auto rr = __builtin_amdgcn_permlane32_swap(__float_as_uint(m), __float_as_uint(m), false, false);
    return __builtin_fmaxf(__uint_as_float(rr[0]), __uint_as_float(rr[1])); }
__device__ __forceinline__ void cmask(f32x16& p0, f32x16& p1, int jb, int qrel, int hi) {
    const int kb = 64 * jb + 4 * hi;
#pragma unroll
    for (int r = 0; r < 16; ++r) { const int kv = kb + (r & 3) + 8 * (r >> 2); if (kv > qrel) p0[r] = -INFINITY; if (kv + 32 > qrel) p1[r] = -INFINITY; } }
__device__ __forceinline__ void lmask(f32x16& p0, f32x16& p1, int t, int qrel, int hi) {
    const int kb = 64 * t + 4 * hi;
#pragma unroll
    for (int r = 0; r < 16; ++r) { const int kv = kb + (r & 3) + 8 * (r >> 2); if (kv <= qrel) p0[r] = -INFINITY; if (kv + 32 <= qrel) p1[r] = -INFINITY; } }

template <int MODE, int QP, int KP, int VP, int KX, int XP>
__device__ __forceinline__ void branch(int wid, const bf16* Qw, const bf16* K0, const bf16* V0, const bf16* X0, int NT, bool lowm, const v4u sm, char* shm, int ost) {
    const int lane = fresh_lane();
    const int r32 = lane & 31, hi = lane >> 5;
    const unsigned lds0 = (unsigned)(uintptr_t)shm;
    float* wsf = (float*)(shm + LDS_WS) + wid * 64;
    const unsigned koff = (unsigned)(lane * KP + wid * 8) * 2u;
    const unsigned voff = (unsigned)((16 * (wid & 3) + (lane >> 2)) * VP + (wid >> 2) * 32 + (lane & 3) * 8) * 2u;
    const unsigned xoff = (unsigned)(lane * XP + (wid & 3) * 8) * 2u;
    const unsigned kdst = lds0 + LDS_K + wid * 1024, vdst = lds0 + LDS_V + wid * 1024, xdst = lds0 + LDS_X + (wid & 3) * 1024;
#define DMA_K(t, slot) glds16(K0 + (long)(t) * 64 * KP, koff, (unsigned)__builtin_amdgcn_readfirstlane(kdst + (slot)))
#define DMA_V(t, slot) glds16(V0 + (long)(t) * 64 * VP, voff, (unsigned)__builtin_amdgcn_readfirstlane(vdst + (slot)))
#define DMA_X(t) do { if (KX) glds16(X0 + (long)(t) * 64 * XP, xoff, (unsigned)__builtin_amdgcn_readfirstlane(xdst + (((t) & 3) * 4096))); } while (0)
    LAS unsigned* smw = (LAS unsigned*)((LAS unsigned char*)(lds_cptr)shm + LDS_END) + (wid * 64 + lane) * 4;
    unsigned cw = sm.x;
    if (MODE == AM_SELECT) *(LAS v4u*)smw = sm;
#define SELB(t) ((MODE != AM_SELECT) || ((cw >> ((t) & 31)) & 1u))
#define SELNEXT(t) do { if (MODE == AM_SELECT) { if ((((t) + 1) & 31) == 0) cw = smw[(((t) + 1) >> 5) & 3]; } } while (0)
    const lds_cptr shm3 = (lds_cptr)shm; const lds_cptr kp0 = shm3 + LDS_K + hi * 1024 + r32 * 16; const lds_cptr xp0 = shm3 + LDS_X + hi * 1024 + r32 * 16;
    const lds_cptr vp0 = shm3 + LDS_V + ((lane >> 4) & 1) * 32 + (lane & 3) * 8 + (4 * hi + ((lane & 15) >> 2)) * 64;
    bf16x8 kf[8];
    DMA_K(0, 0); DMA_X(0); DMA_V(0, 0); DMA_K(1, SLOTB); DMA_X(1);
    bf16x8 qr[4], qx[KX ? KX : 1];
#pragma unroll
    for (int d0 = 0; d0 < 4; ++d0) qr[d0] = *reinterpret_cast<const bf16x8*>(&Qw[(long)r32 * QP + d0 * 16 + hi * 8]);
#pragma unroll
    for (int d0 = 0; d0 < KX; ++d0) qx[d0] = *reinterpret_cast<const bf16x8*>(&Qw[(long)r32 * QP + 64 + d0 * 16 + hi * 8]);
    float mhat = 0.f, l_reg = 0.f; f32x16 o[2]; o[0] = f32x16{}; o[1] = f32x16{};
    f32x16 cin = f32x16{}; NB_PIN(cin);
#define CMASK(P0, P1, t, BAND) do { if (BAND) { const int jb_ = (t) - (NT - 4); if (jb_ >= 0) { const int ln_ = fresh_lane(); cmask(P0, P1, jb_, wid * 32 + (ln_ & 31), ln_ >> 5); } } \
        if (MODE == AM_WINDOW) { if (lowm && (t) <= 3) { const int ln_ = fresh_lane(); lmask(P0, P1, (t), wid * 32 + (ln_ & 31), ln_ >> 5); } } } while (0)
    bool resc = false;
#define RESC() do { if (resc) { asm volatile("s_waitcnt lgkmcnt(0)" ::: "memory"); const int hi_ = fresh_lane() >> 5; \
        _Pragma("unroll") for (int d_ = 0; d_ < 2; ++d_) _Pragma("unroll") for (int r = 0; r < 16; ++r) o[d_][r] *= wsf[crow(r, hi_)]; } } while (0)
    f32x16 pA0, pA1, pB0, pB1;
    int sl_prev = 0, sl_cur = 0, sl_next = SLOTB;
#define ROT() do { sl_prev = sl_cur; sl_cur = sl_next; sl_next = (sl_next == (NSLOT - 1) * SLOTB) ? 0 : sl_next + SLOTB; } while (0)
    DMA_K(2, 2 * SLOTB); DMA_X(2);
    if (KX) { NB_WAIT_BAR(5); } else { NB_WAIT_BAR(3); }
    { _Pragma("unroll") for (int d0 = 0; d0 < 4; ++d0) kload2(kf, kp0, d0);
      pA0 = __builtin_amdgcn_mfma_f32_32x32x16_bf16(kf[0], qr[0], cin, 0, 0, 0); pA1 = __builtin_amdgcn_mfma_f32_32x32x16_bf16(kf[1], qr[0], cin, 0, 0, 0);
      _Pragma("unroll") for (int d0 = 1; d0 < 4; ++d0) { pA0 = __builtin_amdgcn_mfma_f32_32x32x16_bf16(kf[2 * d0], qr[d0], pA0, 0, 0, 0); pA1 = __builtin_amdgcn_mfma_f32_32x32x16_bf16(kf[2 * d0 + 1], qr[d0], pA1, 0, 0, 0); }
      _Pragma("unroll") for (int d0 = 0; d0 < KX; ++d0) { const bf16x8 x0 = *(const __attribute__((address_space(3))) bf16x8*)(xp0 + d0 * 2048), x1 = *(const __attribute__((address_space(3))) bf16x8*)(xp0 + d0 * 2048 + 512);
          pA0 = __builtin_amdgcn_mfma_f32_32x32x16_bf16(x0, qx[d0], pA0, 0, 0, 0); pA1 = __builtin_amdgcn_mfma_f32_32x32x16_bf16(x1, qx[d0], pA1, 0, 0, 0); } }
    CMASK(pA0, pA1, 0, true);
    if (!SELB(0)) { _Pragma("unroll") for (int r = 0; r < 16; ++r) { pA0[r] = -INFINITY; pA1[r] = -INFINITY; } }
    { const float rm = rowmax(pA0, pA1); const float dl = (rm > -1.0e30f) ? rm : 0.f; mhat = dl;
#pragma unroll
      for (int r = 0; r < 16; ++r) { pA0[r] = __builtin_amdgcn_exp2f(pA0[r] - dl); pA1[r] = __builtin_amdgcn_exp2f(pA1[r] - dl); } }
    { const float cv0 = SELB(1) ? -mhat : -INFINITY;
#pragma unroll
      for (int r = 0; r < 16; ++r) cin[r] = cv0;
      NB_PIN(cin); }
    NB_WAIT_BAR(0);
    DMA_K(3, 0); DMA_X(3); DMA_V(1, SLOTB);
    ROT();
    { _Pragma("unroll") for (int d0 = 0; d0 < 4; ++d0) kload2(kf, kp0 + sl_cur, d0); }
    if (KX) { NB_WAIT_BAR(3); } else { NB_WAIT_BAR(2); }
    s16x4 vlo[8], vhi[8]; v4u pw0, pw1, pw2, pw3;
#define PKW(P, B) cvtpk_s(P[B], P[B + 1])
#define PAF(k) __builtin_bit_cast(bf16x8, pw##k)
#define VFR(i) (bf16x8){vlo[i][0], vlo[i][1], vlo[i][2], vlo[i][3], vhi[i][0], vhi[i][1], vhi[i][2], vhi[i][3]}
#define GAPA(MF, A0, A1, A2, A3, W0, W1, PW) do { MF; sacc += A0; sacc += A1; sacc += A2; sacc += A3; NB_PIN(sacc); W0; W1; NB_PIN(PW); NB_SBAR(); } while (0)
#define EX(v) __builtin_amdgcn_exp2f(v)
#define GAPB(MF, X, B, CI) do { MF; X[B] = EX(X[B]); X[B + 1] = EX(X[B + 1]); X[B + 2] = EX(X[B + 2]); X[B + 3] = EX(X[B + 3]); if (MODE == AM_SELECT) { cin[CI] = cv_; cin[CI + 1] = cv_; NB_PIN(cin); } NB_PIN(X); NB_SBAR(); } while (0)
#define VRD(i) do { vlo[i] = vtr(vp_ + (((i) >> 2) * 4096 + ((i) & 3) * 1024)); vhi[i] = vtr(vp_ + (((i) >> 2) * 4096 + ((i) & 3) * 1024 + 512)); } while (0)
#define KRD(G, j) do { if (G) { kload2(kf, kp0 + sl_next, j); NB_SBAR(); } } while (0)
#define STEP(C0, C1, P0, P1, t, GK, GV, GL, BAND) do { NB_SBAR(); \
    const lds_cptr vp_ = vp0 + sl_prev; \
    VRD(0); NB_SBAR(); float sacc = (P0[0] + P0[1]); \
    GAPA(C0 = __builtin_amdgcn_mfma_f32_32x32x16_bf16(kf[0], qr[0], cin, 0, 0, 0), P0[2], P0[3], P0[4], P0[5],     pw0[0] = PKW(P0, 0), pw0[1] = PKW(P0, 2), pw0); \
    VRD(4); NB_SBAR(); GAPA(C1 = __builtin_amdgcn_mfma_f32_32x32x16_bf16(kf[1], qr[0], cin, 0, 0, 0), P0[6], P0[7], P0[8], P0[9],     pw0[2] = PKW(P0, 4), pw0[3] = PKW(P0, 6), pw0); \
    VRD(1); NB_SBAR(); GAPA(C0 = __builtin_amdgcn_mfma_f32_32x32x16_bf16(kf[2], qr[1], C0, 0, 0, 0),  P0[10], P0[11], P0[12], P0[13], pw1[0] = PKW(P0, 8), pw1[1] = PKW(P0, 10), pw1); \
    VRD(5); NB_SBAR(); GAPA(C1 = __builtin_amdgcn_mfma_f32_32x32x16_bf16(kf[3], qr[1], C1, 0, 0, 0),  P0[14], P0[15], P1[0], P1[1],   pw1[2] = PKW(P0, 12), pw1[3] = PKW(P0, 14), pw1); \
    bf16x8 kx0_, kx1_, kx2_, kx3_; \
    if (KX) { const lds_cptr xp_ = xp0 + (((t) & 3) * 4096); kx0_ = *(const __attribute__((address_space(3))) bf16x8*)(xp_); kx1_ = *(const __attribute__((address_space(3))) bf16x8*)(xp_ + 512); NB_SBAR(); } \
    VRD(2); NB_SBAR(); GAPA(C0 = __builtin_amdgcn_mfma_f32_32x32x16_bf16(kf[4], qr[2], C0, 0, 0, 0),  P1[2], P1[3], P1[4], P1[5],     pw2[0] = PKW(P1, 0), pw2[1] = PKW(P1, 2), pw2); \
    VRD(6); NB_SBAR(); GAPA(C1 = __builtin_amdgcn_mfma_f32_32x32x16_bf16(kf[5], qr[2], C1, 0, 0, 0),  P1[6], P1[7], P1[8], P1[9],     pw2[2] = PKW(P1, 4), pw2[3] = PKW(P1, 6), pw2); \
    if (KX > 1) { const lds_cptr xp_ = xp0 + (((t) & 3) * 4096); kx2_ = *(const __attribute__((address_space(3))) bf16x8*)(xp_ + 2048); kx3_ = *(const __attribute__((address_space(3))) bf16x8*)(xp_ + 2560); NB_SBAR(); } \
    VRD(3); NB_SBAR(); GAPA(C0 = __builtin_amdgcn_mfma_f32_32x32x16_bf16(kf[6], qr[3], C0, 0, 0, 0),  P1[10], P1[11], P1[12], P1[13], pw3[0] = PKW(P1, 8), pw3[1] = PKW(P1, 10), pw3); \
    VRD(7); NB_SBAR(); GAPA(C1 = __builtin_amdgcn_mfma_f32_32x32x16_bf16(kf[7], qr[3], C1, 0, 0, 0),  P1[14], P1[15], 0.f, 0.f,       pw3[2] = PKW(P1, 12), pw3[3] = PKW(P1, 14), pw3); \
    if (KX) { C0 = __builtin_amdgcn_mfma_f32_32x32x16_bf16(kx0_, qx[0], C0, 0, 0, 0); NB_SBAR(); C1 = __builtin_amdgcn_mfma_f32_32x32x16_bf16(kx1_, qx[0], C1, 0, 0, 0); NB_SBAR(); } \
    if (KX > 1) { C0 = __builtin_amdgcn_mfma_f32_32x32x16_bf16(kx2_, qx[KX > 1 ? 1 : 0], C0, 0, 0, 0); NB_SBAR(); C1 = __builtin_amdgcn_mfma_f32_32x32x16_bf16(kx3_, qx[KX > 1 ? 1 : 0], C1, 0, 0, 0); NB_SBAR(); } \
    l_reg += sacc; \
    if (GK) { DMA_K((t) + 3, sl_cur); DMA_X((t) + 3); } if (GV) { DMA_V((t) + 1, sl_next); } \
    CMASK(C0, C1, t, BAND); \
    { float a = NB_MX3(C0[0], C0[1], C1[0]), b = NB_MX3(C0[2], C0[3], C1[1]); a = NB_MX3(a, C1[2], C1[3]); \
      _Pragma("unroll") for (int r = 4; r < 16; r += 4) { a = NB_MX3(a, C0[r], C0[r + 1]); b = NB_MX3(b, C0[r + 2], C0[r + 3]); a = NB_MX3(a, C1[r], C1[r + 1]); b = NB_MX3(b, C1[r + 2], C1[r + 3]); } \
      float rm = __builtin_fmaxf(a, b); { auto rr = __builtin_amdgcn_permlane32_swap(__float_as_uint(rm), __float_as_uint(rm), false, false); rm = __builtin_fmaxf(__uint_as_float(rr[0]), __uint_as_float(rr[1])); } \
      resc = false; \
      if (__builtin_expect(__any(rm > THRL), 0)) { const float dl = __builtin_fmaxf(rm, 0.f); mhat += dl; \
        _Pragma("unroll") for (int r = 0; r < 16; ++r) { C0[r] -= dl; C1[r] -= dl; } \
        if (MODE != AM_SELECT) { _Pragma("unroll") for (int r = 0; r < 16; ++r) cin[r] = -mhat; NB_PIN(cin); }        \
        const float f = __builtin_amdgcn_exp2f(-dl); l_reg *= f; { const int ln_ = fresh_lane(); if (ln_ < 32) wsf[ln_] = f; } resc = true; } } \
    SELNEXT(t); const float cv_ = SELB((t) + 1) ? -mhat : -INFINITY; \
    NB_SBAR(); \
    GAPB(o[0] = __builtin_amdgcn_mfma_f32_32x32x16_bf16(PAF(0), VFR(0), o[0], 0, 0, 0), C0, 0, 0); \
    GAPB(o[1] = __builtin_amdgcn_mfma_f32_32x32x16_bf16(PAF(0), VFR(4), o[1], 0, 0, 0), C0, 4, 2); \
    KRD(GL, 0); GAPB(o[0] = __builtin_amdgcn_mfma_f32_32x32x16_bf16(PAF(1), VFR(1), o[0], 0, 0, 0), C0, 8, 4); \
    KRD(GL, 1); GAPB(o[1] = __builtin_amdgcn_mfma_f32_32x32x16_bf16(PAF(1), VFR(5), o[1], 0, 0, 0), C0, 12, 6); \
    KRD(GL, 2); GAPB(o[0] = __builtin_amdgcn_mfma_f32_32x32x16_bf16(PAF(2), VFR(2), o[0], 0, 0, 0), C1, 0, 8); \
    KRD(GL, 3); GAPB(o[1] = __builtin_amdgcn_mfma_f32_32x32x16_bf16(PAF(2), VFR(6), o[1], 0, 0, 0), C1, 4, 10); \
    GAPB(o[0] = __builtin_amdgcn_mfma_f32_32x32x16_bf16(PAF(3), VFR(3), o[0], 0, 0, 0), C1, 8, 12); \
    GAPB(o[1] = __builtin_amdgcn_mfma_f32_32x32x16_bf16(PAF(3), VFR(7), o[1], 0, 0, 0), C1, 12, 14); \
    } while (0)
#define WAIT_FULL() do { if (KX) { NB_WAIT_BAR(3); } else { NB_WAIT_BAR(2); } } while (0)
    int t = 1;
    asm volatile(".p2align 6" ::: "memory");
    for (; t + 5 < NT; t += 2) {
        STEP(pB0, pB1, pA0, pA1, t, true, true, true, false);       WAIT_FULL(); RESC(); ROT();
        STEP(pA0, pA1, pB0, pB1, t + 1, true, true, true, false);   WAIT_FULL(); RESC(); ROT();
    }
#define ENDW(tt) do { if ((tt) + 3 < NT) { WAIT_FULL(); } else if ((tt) + 2 < NT) { NB_WAIT_BAR(1); } else { NB_WAIT_BAR(0); } } while (0)
    for (; t + 1 < NT; t += 2) {
        STEP(pB0, pB1, pA0, pA1, t, (t + 3 < NT), (t + 1 < NT), (t + 1 < NT), true);         ENDW(t);     RESC(); ROT();
        STEP(pA0, pA1, pB0, pB1, t + 1, (t + 4 < NT), (t + 2 < NT), (t + 2 < NT), true);     ENDW(t + 1); RESC(); ROT();
    }
    STEP(pB0, pB1, pA0, pA1, NT - 1, false, false, false, true); RESC();
    { float sacc = pB0[0] + pB0[1];
      _Pragma("unroll") for (int r = 2; r < 16; ++r) sacc += pB0[r];
      _Pragma("unroll") for (int r = 0; r < 16; ++r) sacc += pB1[r];
      l_reg += sacc;
      pw0 = (v4u){PKW(pB0, 0), PKW(pB0, 2), PKW(pB0, 4), PKW(pB0, 6)}; pw1 = (v4u){PKW(pB0, 8), PKW(pB0, 10), PKW(pB0, 12), PKW(pB0, 14)};
      pw2 = (v4u){PKW(pB1, 0), PKW(pB1, 2), PKW(pB1, 4), PKW(pB1, 6)}; pw3 = (v4u){PKW(pB1, 8), PKW(pB1, 10), PKW(pB1, 12), PKW(pB1, 14)};
      NB_SBAR();
      const lds_cptr vp_ = vp0 + sl_cur;
      _Pragma("unroll") for (int i = 0; i < 8; ++i) VRD(i);
      o[0] = __builtin_amdgcn_mfma_f32_32x32x16_bf16(PAF(0), VFR(0), o[0], 0, 0, 0); o[1] = __builtin_amdgcn_mfma_f32_32x32x16_bf16(PAF(0), VFR(4), o[1], 0, 0, 0);
      o[0] = __builtin_amdgcn_mfma_f32_32x32x16_bf16(PAF(1), VFR(1), o[0], 0, 0, 0); o[1] = __builtin_amdgcn_mfma_f32_32x32x16_bf16(PAF(1), VFR(5), o[1], 0, 0, 0);
      o[0] = __builtin_amdgcn_mfma_f32_32x32x16_bf16(PAF(2), VFR(2), o[0], 0, 0, 0); o[1] = __builtin_amdgcn_mfma_f32_32x32x16_bf16(PAF(2), VFR(6), o[1], 0, 0, 0);
      o[0] = __builtin_amdgcn_mfma_f32_32x32x16_bf16(PAF(3), VFR(3), o[0], 0, 0, 0); o[1] = __builtin_amdgcn_mfma_f32_32x32x16_bf16(PAF(3), VFR(7), o[1], 0, 0, 0); }
#undef PKW
#undef PAF
#undef VFR
#undef GAPA
#undef GAPB
#undef EX
#undef VRD
#undef KRD
#undef STEP
#undef ENDW
#undef WAIT_FULL
    { auto rr = __builtin_amdgcn_permlane32_swap(__float_as_uint(l_reg), __float_as_uint(l_reg), false, false); l_reg = __uint_as_float(rr[0]) + __uint_as_float(rr[1]); }
    const int lne = fresh_lane(), r32e = lne & 31, hie = lne >> 5;
    if (hie == 0) wsf[32 + r32e] = l_reg; asm volatile("s_waitcnt lgkmcnt(0)" ::: "memory");
    { bf16* stg = (bf16*)(shm + ost) + wid * 2048 + r32e;
#pragma unroll
      for (int r = 0; r < 16; ++r) { const int orow = crow(r, hie); const float lv = wsf[32 + orow]; const float rl = lv > 0.f ? __builtin_amdgcn_rcpf(lv) : 0.f;
#pragma unroll
          for (int d0 = 0; d0 < 2; ++d0) stg[orow * 64 + d0 * 32] = (bf16)f2bf(o[d0][r] * rl); } }
    asm volatile("s_waitcnt lgkmcnt(0)\n\ts_barrier" ::: "memory");
#undef DMA_K
#undef DMA_V
#undef DMA_X
#undef SELB
#undef SELNEXT
#undef CMASK
#undef RESC
#undef ROT
}
}

__device__ __forceinline__ void nsa_b_unit2(Frame& F, int u, const float* gb) {
    const bf16* U = (const bf16*)(F.ws + WS_U); bf16* CAT = (bf16*)(F.ws + WS_CAT); const unsigned* MASK = (const unsigned*)(F.ws + WS_MASK); const bf16* OC = (const bf16*)(F.ws + WS_OC);
    const int wid = F.wave; const int r32 = nb::fresh_lane() & 31;
    const int qb = 31 - u / 24, bh = u % 24, b = bh / 6, h = bh % 6, g = h / 3;
    const size_t rowbase = (size_t)b * SEQ; const int q0 = qb * 256, qpos0w = q0 + wid * 32;
    char* shm = (char*)F.lds;
    const bf16* Qw = U + (rowbase + qpos0w) * NU + C_QN + h * 64;
    const v4u sm = *(const GAS v4u*)(MASK + ((size_t)(b * 2 + g) * SEQ + qpos0w + r32) * 4);
    nb::branch<AM_SELECT, NU, NU, NU, 0, NU>(wid, Qw, U + rowbase * NU + C_KS + g * 64, U + rowbase * NU + C_VS + g * 64, U, 4 * qb + 4, false, sm, shm, nb::LDS_OST);
    { const int jl = qb >= 2 ? 4 * qb - 8 : 0; const int NT = 4 * qb + 4 - jl;
      nb::branch<AM_WINDOW, NU, NU, NU, 0, NU>(wid, Qw, U + (rowbase + (size_t)jl * 64) * NU + C_KW + g * 64, U + (rowbase + (size_t)jl * 64) * NU + C_VW + g * 64, U, NT, qb >= 2, (v4u){0u, 0u, 0u, 0u}, shm, nb::LDS_OST2); }
    const int lane2 = nb::fresh_lane();
    const LAS unsigned char* s1 = F.lds + nb::LDS_OST + wid * 4096; const LAS unsigned char* s2 = F.lds + nb::LDS_OST2 + wid * 4096;
#pragma unroll 1
    for (int i = 0; i < 4; ++i) { const int row = i * 8 + (lane2 >> 3), ch = lane2 & 7; const size_t grow = rowbase + qpos0w + row;
        const float gs = gate_of(U, gb, grow, h, 1), gw = gate_of(U, gb, grow, h, 2);
        const v4u a = *(const LAS v4u*)(s1 + row * 128 + ch * 16), w = *(const LAS v4u*)(s2 + row * 128 + ch * 16), c = *(const GAS v4u*)(OC + grow * 384 + h * 64 + ch * 8);
        v4u r_;
        r_.x = pg8::cvt_pk_bf16(gs * bflo(a.x) + gw * bflo(w.x) + bflo(c.x), gs * bfhi(a.x) + gw * bfhi(w.x) + bfhi(c.x));
        r_.y = pg8::cvt_pk_bf16(gs * bflo(a.y) + gw * bflo(w.y) + bflo(c.y), gs * bfhi(a.y) + gw * bfhi(w.y) + bfhi(c.y));
        r_.z = pg8::cvt_pk_bf16(gs * bflo(a.z) + gw * bflo(w.z) + bflo(c.z), gs * bfhi(a.z) + gw * bfhi(w.z) + bfhi(c.z));
        r_.w = pg8::cvt_pk_bf16(gs * bflo(a.w) + gw * bflo(w.w) + bflo(c.w), gs * bfhi(a.w) + gw * bfhi(w.w) + bfhi(c.w));
        *(GAS v4u*)(CAT + grow * DM + 640 + h * 64 + ch * 8) = r_; }
}
__device__ __forceinline__ void mla_unit2(Frame& F, int u) {
    const bf16* QM = (const bf16*)(F.ws + WS_QM); const bf16* KVM = (const bf16*)(F.ws + WS_KVM); const bf16* U = (const bf16*)(F.ws + WS_U); bf16* CAT = (bf16*)(F.ws + WS_CAT);
    const int wid = F.wave;
    const int qb = 31 - u / 24, bh = u % 24, b = bh / 6, h = bh % 6;
    const size_t rowbase = (size_t)b * SEQ; const int qpos0w = qb * 256 + wid * 32;
    nb::branch<AM_CAUSAL, 576, 768, 768, 2, NU>(wid, QM + (rowbase + qpos0w) * 576 + h * 96, KVM + rowbase * 768 + h * 128, KVM + rowbase * 768 + h * 128 + 64, U + rowbase * NU + C_KPE, 4 * qb + 4, false,
                                                (v4u){0u, 0u, 0u, 0u}, (char*)F.lds, nb::LDS_OST);
    const int lane2 = nb::fresh_lane();
    const LAS unsigned char* s1 = F.lds + nb::LDS_OST + wid * 4096;
#pragma unroll
    for (int i = 0; i < 4; ++i) { const int row = i * 8 + (lane2 >> 3), ch = lane2 & 7;
        *(GAS v4u*)(CAT + (rowbase + qpos0w + row) * DM + 256 + h * 64 + ch * 8) = *(const LAS v4u*)(s1 + row * 128 + ch * 16); }
}
__device__ __forceinline__ void mla_unit(Frame& F, int u) {
    const bf16* QM = (const bf16*)(F.ws + WS_QM); bf16* CAT = (bf16*)(F.ws + WS_CAT);
    const int r32 = F.lane & 31, hi = F.lane >> 5;
    const int qb = 31 - u / 24, bh = u % 24, b = bh / 6, h = bh % 6;
    const int qpos0w = qb * 256 + F.wave * 32; const size_t row = (size_t)b * SEQ + qpos0w + r32;
    bf16x8 qf[6];
#pragma unroll
    for (int ks = 0; ks < 6; ++ks) qf[ks] = *(const GAS bf16x8*)(QM + row * 576 + h * 96 + ks * 16 + hi * 8);
    SrcMla src{(const bf16*)(F.ws + WS_KVM), (const bf16*)(F.ws + WS_U), h, (size_t)b * SEQ};
    f32x16 o[2]; float m_, l_;
    attn_branch<96, AM_CAUSAL, 2>(F, F.lds, src, qf, qpos0w, 0, qb * 4 + 3, (v4u){0u, 0u, 0u, 0u}, o, m_, l_);
    bf16* orow = CAT + row * DM + 256 + h * 64;
#pragma unroll
    for (int db = 0; db < 2; ++db)
#pragma unroll
        for (int a = 0; a < 4; ++a) *(GAS v2u*)(orow + 32 * db + 8 * a + 4 * hi) = (v2u){pg8::cvt_pk_bf16(o[db][4 * a], o[db][4 * a + 1]), pg8::cvt_pk_bf16(o[db][4 * a + 2], o[db][4 * a + 3])};
}
__device__ __forceinline__ void p_attn1(Frame& F, int qid, const float* gb) {
    phase_begin(F);
    int dready = 0;
    unsigned tk = q_issue(F, qid);
    for (;;) {
        const int t = q_take(F, tk); if (t >= 1024) break; tk = q_issue(F, qid);
        if (t >= 576 && t < 832) {
            if (!dready) { count_await(F, CW_FLAG + 512 + (qid >> 1), (unsigned)F.G); dready = 1; phase_begin(F); }
            const int u = __builtin_amdgcn_readfirstlane(t - 576);
            nsa_a_unit(F, u, gb); unit_publish(F, CW_FLAG + (qid >> 1) * 256 + u);
        } else {
            mla_unit2(F, __builtin_amdgcn_readfirstlane(t < 576 ? t : t - 256));
        }
        phase_begin(F);
    }
    if (!dready) { phase_begin(F); count_await(F, CW_FLAG + 512 + (qid >> 1), (unsigned)F.G); }
}
template <int VAR>
__device__ __forceinline__ void p_attn2(Frame& F, int qid, const float* gb) {
    phase_begin(F);
    for (;;) { const int u = q_fetch(F, qid); if (u >= 768) break;
        { const int bh = u % 24, b = bh / 6, g = (bh % 6) / 3; unit_await(F, CW_FLAG + (qid >> 1) * 256 + (((u / 24) << 3) | (b * 2 + g))); }
        nsa_b_unit2(F, __builtin_amdgcn_readfirstlane(u), gb); phase_begin(F); }
}

struct EpiQKV {
    static constexpr bool PERM = true;
    bf16* QM; bf16* KVM; const float* ssq; const f32x2* tabm;
    __device__ __forceinline__ void operator()(const f32x4 (&acc)[2][2][4][2], const Unit& u, int wr, int wc, int fr, int fq) const {
        const int row0 = u.pm * 256 + wr * 64 + fr; const bool isq = u.pn < 3;
        float rs[8];
        { f32x4 s0[8], s1[8], s2[8];
#pragma unroll
          for (int i = 0; i < 8; ++i) { const GAS f32x4* sp = (const GAS f32x4*)((const GAS char*)ssq + (unsigned)(row0 + (i >> 2) * 128 + (i & 3) * 16) * 64u); s0[i] = sp[0]; s1[i] = sp[1]; s2[i] = sp[2]; }
#pragma unroll
          for (int i = 0; i < 8; ++i) rs[i] = isq ? QSCALE_M / sqrtf(((s0[i][0] + s0[i][1]) + (s0[i][2] + s0[i][3]) + (s1[i][0] + s1[i][1])) * (1.0f / 192.0f) + EPS)
                                                  : 1.0f / sqrtf(((s1[i][2] + s1[i][3]) + (s2[i][0] + s2[i][1])) * (1.0f / 128.0f) + EPS); }
        const bool isrope = isq && (((u.pn % 3) * 256 + wc * 32) % 96 == 64 || ((u.pn % 3) * 256 + 128 + wc * 32) % 96 == 64);
        f32x4 t0[8], t1[8];
        if (isrope) {
#pragma unroll
            for (int i = 0; i < 8; ++i) { const int pos = (row0 + (i >> 2) * 128 + (i & 3) * 16) & (SEQ - 1); const GAS f32x4* t = (const GAS f32x4*)((const GAS char*)tabm + (unsigned)(pos * 128 + 32 * fq)); t0[i] = t[0]; t1[i] = t[1]; } }
#pragma unroll
        for (int ai = 0; ai < 2; ++ai)
#pragma unroll
            for (int m = 0; m < 4; ++m) { const int row = row0 + ai * 128 + m * 16; const float r_ = rs[ai * 4 + m];
#pragma unroll
                for (int bj = 0; bj < 2; ++bj) {
                    const int c32 = (u.pn % 3) * 256 + bj * 128 + wc * 32, c8 = c32 + 8 * fq; const f32x4 v0 = acc[ai][bj][m][0], v1 = acc[ai][bj][m][1];
                    if (!isq) { const f32x4 a = v0 * r_, b = v1 * r_; *(v4u*)(KVM + (size_t)row * 768 + c8) = (v4u){pg8::cvt_pk_bf16(a[0], a[1]), pg8::cvt_pk_bf16(a[2], a[3]), pg8::cvt_pk_bf16(b[0], b[1]), pg8::cvt_pk_bf16(b[2], b[3])}; }
                    else if (c32 < 576) {
                        const int hd = c32 / 96, w32 = c32 - hd * 96;
                        if (w32 < 64) { const f32x4 a = v0 * r_, b = v1 * r_; *(v4u*)(QM + (size_t)row * 576 + c8) = (v4u){pg8::cvt_pk_bf16(a[0], a[1]), pg8::cvt_pk_bf16(a[2], a[3]), pg8::cvt_pk_bf16(b[0], b[1]), pg8::cvt_pk_bf16(b[2], b[3])}; }
                        else { const int i = fq; const f32x4 ta = t0[ai * 4 + m], tb = t1[ai * 4 + m]; const f32x4 x1 = v0 * r_, x2 = v1 * r_;
                            const auto s0 = __builtin_amdgcn_permlane16_swap(pg8::cvt_pk_bf16(x1[0] * ta[0] - x2[0] * ta[1], x1[1] * ta[2] - x2[1] * ta[3]), pg8::cvt_pk_bf16(x2[0] * ta[0] + x1[0] * ta[1], x2[1] * ta[2] + x1[1] * ta[3]), false, false);
                            const auto s1 = __builtin_amdgcn_permlane16_swap(pg8::cvt_pk_bf16(x1[2] * tb[0] - x2[2] * tb[1], x1[3] * tb[2] - x2[3] * tb[3]), pg8::cvt_pk_bf16(x2[2] * tb[0] + x1[2] * tb[1], x2[3] * tb[2] + x1[3] * tb[3]), false, false);
                            bf16* o = QM + (size_t)row * 576 + hd * 96 + 64 + 4 * i + ((fq & 1) ? 12 : 0);
                            *(v4u*)o = (v4u){s0[0], s1[0], s0[1], s1[1]}; }
                    }
                } }
    }
};
struct SchedQKV : pg8::TileOrder {
    const char* B;
    __device__ __forceinline__ unsigned arow(const Unit&, int r) const { return (unsigned)(r & 127) * (NU * 2); }
    __device__ __forceinline__ size_t abase(const Unit& u, int h) const { return (size_t)(u.pm * 256 + h * 128) * (NU * 2); }
    __device__ __forceinline__ const char* bbase(const Unit& u) const { return B + (size_t)u.pn * (256 * 384 * 2); }
};

__device__ __forceinline__ void p_copy_rows(Frame& F, const float* src, float* dst) {
    phase_begin(F);
    const int gw = F.vcu * NWAVES + F.wave, NGW = F.G * NWAVES;
    for (int m = gw; m < TOK; m += NGW) { const GAS f32x4* s = (const GAS f32x4*)(src + (size_t)m * DM) + F.lane; GAS f32x4* d = (GAS f32x4*)(dst + (size_t)m * DM) + F.lane;
#pragma unroll
        for (int j = 0; j < 4; ++j) d[64 * j] = s[64 * j]; }
}
template <bool ROUTE>
__device__ __forceinline__ void p_norm(Frame& F, const float* x, const float* gain, const float* rw) {
    phase_begin(F);
    bf16* XN = (bf16*)(F.ws + WS_XN);
    f32x4 gv[4];
#pragma unroll
    for (int j = 0; j < 4; ++j) gv[j] = *((const GAS f32x4*)gain + F.lane + 64 * j);
    f32x4 rwv[16][2];
    if (ROUTE) {
#pragma unroll
        for (int j = 0; j < 4; ++j)
#pragma unroll
            for (int k = 0; k < 4; ++k) { const int c = 4 * F.lane + 256 * j + k; rwv[4 * j + k][0] = *(const GAS f32x4*)(rw + (size_t)c * 8); rwv[4 * j + k][1] = *(const GAS f32x4*)(rw + (size_t)c * 8 + 4); }
    }
    LAS unsigned* es = (LAS unsigned*)F.lds;
    for (int ch = F.vcu; ch < TOK / 128; ch += F.G) {
        for (int rr = 0; rr < 16; ++rr) {
            const int m = ch * 128 + F.wave * 16 + rr;
            const GAS f32x4* xr = (const GAS f32x4*)(x + (size_t)m * DM) + F.lane;
            f32x4 v[4]; float s2 = 0.f;
#pragma unroll
            for (int j = 0; j < 4; ++j) { v[j] = xr[64 * j]; s2 += (v[j].x * v[j].x + v[j].y * v[j].y) + (v[j].z * v[j].z + v[j].w * v[j].w); }
            const float rstd = 1.0f / sqrtf(wave_sum(s2) * (1.f / DM) + EPS);
#pragma unroll
            for (int j = 0; j < 4; ++j) v[j] = v[j] * rstd * gv[j];
            GAS unsigned long long* o8 = (GAS unsigned long long*)(XN + (size_t)m * DM) + F.lane;
#pragma unroll
            for (int j = 0; j < 4; ++j) o8[64 * j] = (unsigned long long)pk2(v[j].x, v[j].y) | ((unsigned long long)pk2(v[j].z, v[j].w) << 32);
            if (ROUTE) {
                float lg[8];
#pragma unroll
                for (int e = 0; e < 8; ++e) lg[e] = 0.f;
#pragma unroll
                for (int j = 0; j < 4; ++j)
#pragma unroll
                    for (int k = 0; k < 4; ++k) { const float xv = v[j][k]; const f32x4 a = rwv[4 * j + k][0], b = rwv[4 * j + k][1];
                        lg[0] += xv * a.x; lg[1] += xv * a.y; lg[2] += xv * a.z; lg[3] += xv * a.w; lg[4] += xv * b.x; lg[5] += xv * b.y; lg[6] += xv * b.z; lg[7] += xv * b.w; }
#pragma unroll
                for (int e = 0; e < 8; ++e) lg[e] = wave_sum(lg[e]);
                int e1 = 0; float v1 = lg[0];
#pragma unroll
                for (int e = 1; e < 8; ++e) if (lg[e] > v1) { v1 = lg[e]; e1 = e; }
                int e2 = (e1 == 0) ? 1 : 0; float v2 = (e1 == 0) ? lg[1] : lg[0];
#pragma unroll
                for (int e = 0; e < 8; ++e) if (e != e1 && lg[e] > v2) { v2 = lg[e]; e2 = e; }
                const float ex = __expf(v2 - v1); const float g1 = 1.0f / (1.0f + ex), g2 = ex / (1.0f + ex);
                if (F.lane == 0) { f32x4 r; r.x = __builtin_bit_cast(float, e1); r.y = __builtin_bit_cast(float, e2); r.z = g1; r.w = g2;
                    *(GAS f32x4*)(F.ws + WS_MISC + MS_ROUTE + (size_t)m * 16) = r; es[F.wave * 16 + rr] = (unsigned)e1 | ((unsigned)e2 << 8); }
            }
        }
        if (ROUTE) {
            __syncthreads();
            { const unsigned w = (F.tid < 128) ? es[F.tid] : 0xffffu;
#pragma unroll
              for (int e = 0; e < 8; ++e) { const unsigned long long mk = __ballot((int)(w & 255u) == e || (int)(w >> 8) == e); if (F.lane == 0 && F.wave < 2) es[128 + F.wave * 8 + e] = (unsigned)__popcll(mk); } }
            __syncthreads();
            if (F.tid < 8) ((GAS int*)(F.ws + WS_MISC + MS_COUNTS))[ch * 8 + F.tid] = (int)(es[128 + F.tid] + es[136 + F.tid]);
            __syncthreads();
        }
    }
}
__device__ __forceinline__ void p_scatter(Frame& F) {
    phase_begin(F);
    LAS int* cnt = (LAS int*)F.lds;
    LAS int* tot = cnt + 2048;
    const GAS int* counts = (const GAS int*)(F.ws + WS_MISC + MS_COUNTS);
    GAS int* rowlist = (GAS int*)(F.ws + WS_MISC + MS_ROWLIST);
    GAS int* tokslot = (GAS int*)(F.ws + WS_MISC + MS_TOKSLOT);
    for (int i = F.tid; i < 2048; i += NTHR) cnt[i] = counts[i];
    __syncthreads();
    LAS int* gp = tot + 64;
    if (F.tid < 256) { const int e = F.tid & 7, g = F.tid >> 3; int t = 0;
#pragma unroll
        for (int c = 0; c < 8; ++c) t += cnt[(8 * g + c) * 8 + e];
        gp[e * 33 + g] = t; }
    __syncthreads();
    if (F.tid < 8) { int run = 0; for (int g = 0; g < 32; ++g) { const int v = gp[F.tid * 33 + g]; gp[F.tid * 33 + g] = run; run += v; } tot[F.tid] = run; }
    __syncthreads();
    if (F.tid == 0) { int b = 0; for (int e = 0; e < 8; ++e) { tot[8 + e] = b; b += (tot[e] + 255) & ~255; } tot[16] = b; }
    __syncthreads();
    LAS int* pre = tot + 32;
    for (int ch = F.vcu; ch < TOK / 128; ch += F.G) {
        if (F.tid < 8) { const int e = F.tid; int pos = tot[8 + e] + gp[e * 33 + (ch >> 3)]; for (int c = ch & ~7; c < ch; ++c) pos += cnt[c * 8 + e]; pre[e] = pos; }
        int e1 = -1, e2 = -1; const int m = ch * 128 + F.tid;
        if (F.tid < 128) { const GAS int* r = (const GAS int*)(F.ws + WS_MISC + MS_ROUTE + (size_t)m * 16); e1 = r[0]; e2 = r[1]; }
        int rk1 = 0, rk2 = 0;
        const unsigned long long lt = (1ull << F.lane) - 1ull;
#pragma unroll
        for (int e = 0; e < 8; ++e) { const unsigned long long mk = __ballot(e1 == e || e2 == e); const int rk = __popcll(mk & lt);
            if (e1 == e) rk1 = rk; if (e2 == e) rk2 = rk; if (F.tid == 0) pre[8 + e] = __popcll(mk); }
        __syncthreads();
        if (F.tid < 128) { const int add = (F.tid >= 64) ? 1 : 0;
            const int p1 = pre[e1] + (add ? pre[8 + e1] : 0) + rk1, p2 = pre[e2] + (add ? pre[8 + e2] : 0) + rk2;
            rowlist[p1] = m; tokslot[2 * m] = p1; rowlist[p2] = m; tokslot[2 * m + 1] = p2; }
        __syncthreads();
    }
    if (F.vcu == 0) {
        if (F.tid < 8) { const int e = F.tid; const int b = tot[8 + e] + tot[e], en = tot[8 + e] + ((tot[e] + 255) & ~255); for (int p = b; p < en; ++p) rowlist[p] = 0; }
        if (F.tid < 9) ((GAS int*)(F.ws + WS_MISC + MS_EBASE))[F.tid] = (F.tid < 8 ? tot[8 + F.tid] : tot[16]) / 256;
    }
}
__device__ __forceinline__ void p_combine_final(Frame& F, const float* gain) {
    phase_begin(F);
    const int gw = F.vcu * NWAVES + F.wave, NGW = F.G * NWAVES;
    const bf16* Y = (const bf16*)(F.ws + WS_Y);
    f32x4 gv[4];
#pragma unroll
    for (int j = 0; j < 4; ++j) gv[j] = *((const GAS f32x4*)gain + F.lane + 64 * j);
    f32x4 rn = (f32x4){0.f, 0.f, 0.f, 0.f}; v2u sn = (v2u){0u, 0u};
    if (gw < TOK) { rn = *(const GAS f32x4*)(F.ws + WS_MISC + MS_ROUTE + (size_t)gw * 16); sn = *(const GAS v2u*)(F.ws + WS_MISC + MS_TOKSLOT + (size_t)gw * 8); }
    for (int m = gw; m < TOK; m += NGW) {
        f32x4 r = rn; r.z *= ALPHA_MOE; r.w *= ALPHA_MOE;
        const int s1 = (int)sn.x, s2 = (int)sn.y;
        { const int mn = m + NGW; if (mn < TOK) { rn = *(const GAS f32x4*)(F.ws + WS_MISC + MS_ROUTE + (size_t)mn * 16); sn = *(const GAS v2u*)(F.ws + WS_MISC + MS_TOKSLOT + (size_t)mn * 8); } }
        GAS f32x4* xr = (GAS f32x4*)(F.out + (size_t)m * DM) + F.lane;
        const GAS v2u* y1 = (const GAS v2u*)(Y + (size_t)s1 * DM) + F.lane; const GAS v2u* y2 = (const GAS v2u*)(Y + (size_t)s2 * DM) + F.lane;
        f32x4 v[4]; float ss = 0.f;
#pragma unroll
        for (int j = 0; j < 4; ++j) { v[j] = xr[64 * j]; const v2u a = y1[64 * j], b = y2[64 * j];
            v[j].x += r.z * bflo(a.x) + r.w * bflo(b.x); v[j].y += r.z * bfhi(a.x) + r.w * bfhi(b.x); v[j].z += r.z * bflo(a.y) + r.w * bflo(b.y); v[j].w += r.z * bfhi(a.y) + r.w * bfhi(b.y);
            ss += (v[j].x * v[j].x + v[j].y * v[j].y) + (v[j].z * v[j].z + v[j].w * v[j].w); }
        const float rstd = 1.0f / sqrtf(wave_sum(ss) * (1.f / DM) + EPS);
#pragma unroll
        for (int j = 0; j < 4; ++j) xr[64 * j] = v[j] * rstd * gv[j];
    }
}
__device__ __forceinline__ void p_nan_rows(Frame& F) {
    phase_begin(F);
    const int gw = F.vcu * NWAVES + F.wave, NGW = F.G * NWAVES; const float q = __builtin_nanf("");
    for (int m = gw; m < TOK; m += NGW) { GAS f32x4* o = (GAS f32x4*)(F.out + (size_t)m * DM) + F.lane;
#pragma unroll
        for (int j = 0; j < 4; ++j) o[64 * j] = (f32x4){q, q, q, q}; }
}


#ifdef DBG
constexpr int CW_DBG = 20000;
#ifndef DBG_STAT
#define DBG_STAT 40
#endif
__device__ __forceinline__ unsigned hsh(unsigned a) { a ^= a >> 16; a *= 0x7feb352du; a ^= a >> 15; a *= 0x846ca68bu; a ^= a >> 16; return a; }
__device__ __forceinline__ void dbg_put(Frame& F, int id, float err) { if (!(err >= 0.f)) err = 1e30f; atomicMax((unsigned*)(F.ctl + CW_DBG + id), __builtin_bit_cast(unsigned, err)); }
__device__ __forceinline__ float relerr(float got, float ref) { return fabsf(got - ref) / (fabsf(ref) + 1.0f); }
__device__ __forceinline__ float silu_ref(float g) { return g / (1.0f + expf(-g)); }
__device__ __forceinline__ int dbg_sample(Frame& F, int salt) { return (int)hsh((unsigned)(blockIdx.x * NTHR + F.tid) * 7919u + (unsigned)salt); }
__device__ __forceinline__ void chk_xn(Frame& F, int id, const float* x, const float* gain) {
    phase_begin(F); if (blockIdx.x >= 16) return;
    const unsigned h = (unsigned)dbg_sample(F, 11); const int row = h % TOK, col = (h >> 16) % DM;
    float ss = 0.f; for (int k = 0; k < DM; ++k) { const float v = x[(size_t)row * DM + k]; ss += v * v; }
    const float ref = x[(size_t)row * DM + col] / sqrtf(ss / DM + EPS) * gain[col];
    dbg_put(F, id, relerr(bf2f(((const bf16*)(F.ws + WS_XN))[(size_t)row * DM + col]), ref));
}
__device__ __forceinline__ void chk_ffn_up(Frame& F, int id, const float* wg, const float* wu) {
    phase_begin(F); if (blockIdx.x >= 16) return;
    const unsigned h = (unsigned)dbg_sample(F, 23); const int row = h % TOK, hid = (h >> 15) % DFF;
    const bf16* xn = (const bf16*)(F.ws + WS_XN) + (size_t)row * DM; float g = 0.f, u = 0.f;
    for (int k = 0; k < DM; ++k) { const float a = bf2f(xn[k]); g += a * wg[(size_t)k * DFF + hid]; u += a * wu[(size_t)k * DFF + hid]; }
    dbg_put(F, id, relerr(bf2f(((const bf16*)(F.ws + WS_H))[(size_t)row * DFF + hid]), silu_ref(g) * u));
}
__device__ __forceinline__ void chk_ffn_down(Frame& F, int id, const float* base, const float* wd) {
    phase_begin(F); if (blockIdx.x >= 16) return;
    const unsigned h = (unsigned)dbg_sample(F, 37); const int row = h % TOK, col = (h >> 16) % DM;
    const bf16* hr = (const bf16*)(F.ws + WS_H) + (size_t)row * DFF; float a = base[(size_t)row * DM + col];
    for (int k = 0; k < DFF; ++k) a += bf2f(hr[k]) * wd[(size_t)k * DM + col];
    dbg_put(F, id, relerr(F.out[(size_t)row * DM + col], a));
}
__device__ __forceinline__ void chk_route(Frame& F, int id, const float* x, const float* gain, const float* rw) {
    phase_begin(F); if (blockIdx.x >= 4) return;
    const unsigned h = (unsigned)dbg_sample(F, 41); const int row = h % TOK;
    float ss = 0.f; for (int k = 0; k < DM; ++k) { const float v = x[(size_t)row * DM + k]; ss += v * v; }
    const float rstd = 1.0f / sqrtf(ss / DM + EPS); float lg[8]; for (int e = 0; e < 8; ++e) lg[e] = 0.f;
    for (int k = 0; k < DM; ++k) { const float v = x[(size_t)row * DM + k] * rstd * gain[k]; for (int e = 0; e < 8; ++e) lg[e] += v * rw[(size_t)k * 8 + e]; }
    int e1 = 0; for (int e = 1; e < 8; ++e) if (lg[e] > lg[e1]) e1 = e;
    int e2 = (e1 == 0) ? 1 : 0; for (int e = 0; e < 8; ++e) if (e != e1 && lg[e] > lg[e2]) e2 = e;
    const float g1 = 1.0f / (1.0f + expf(lg[e2] - lg[e1]));
    const GAS int* r = (const GAS int*)(F.ws + WS_MISC + MS_ROUTE + (size_t)row * 16);
    float gap = 1e9f; for (int e = 0; e < 8; ++e) if (e != e1 && e != e2) gap = fminf(gap, lg[e2] - lg[e]);
    float err = 0.f;
    if (gap > 1e-3f && lg[e1] - lg[e2] > 1e-3f) { if (r[0] != e1 || r[1] != e2) err = 10.f; err = fmaxf(err, fabsf(__builtin_bit_cast(float, r[2]) - g1)); }
    dbg_put(F, id, err);
    const GAS int* ts = (const GAS int*)(F.ws + WS_MISC + MS_TOKSLOT); const GAS int* rl = (const GAS int*)(F.ws + WS_MISC + MS_ROWLIST); const GAS int* eb = (const GAS int*)(F.ws + WS_MISC + MS_EBASE);
    float e2r = 0.f;
    for (int k = 0; k < 2; ++k) { const int sl = ts[2 * row + k]; if (sl < 0 || sl >= MAXSLOT || rl[sl] != row) { e2r = 10.f; break; }
        int ex = 0; for (int j = 1; j < 8; ++j) ex += (sl / 256 >= eb[j]) ? 1 : 0; if (ex != r[k]) e2r = 20.f; }
    dbg_put(F, id + 1, e2r);
}
__device__ __forceinline__ void chk_moe_up(Frame& F, int id, const float* wg, const float* wu) {
    phase_begin(F); if (blockIdx.x >= 16) return;
    const GAS int* eb = (const GAS int*)(F.ws + WS_MISC + MS_EBASE); const GAS int* rl = (const GAS int*)(F.ws + WS_MISC + MS_ROWLIST);
    const unsigned h = (unsigned)dbg_sample(F, 53); const int slot = h % (eb[8] * 256), hid = (h >> 15) % DFE; const int row = rl[slot];
    int ex = 0; for (int j = 1; j < 8; ++j) ex += (slot / 256 >= eb[j]) ? 1 : 0;
    const bf16* xn = (const bf16*)(F.ws + WS_XN) + (size_t)row * DM; float g = 0.f, u = 0.f;
    for (int k = 0; k < DM; ++k) { const float a = bf2f(xn[k]); g += a * wg[((size_t)ex * DM + k) * DFE + hid]; u += a * wu[((size_t)ex * DM + k) * DFE + hid]; }
    dbg_put(F, id, relerr(bf2f(((const bf16*)(F.ws + WS_H))[(size_t)slot * DFE + hid]), silu_ref(g) * u));
}
__device__ __forceinline__ void chk_moe_down(Frame& F, int id, const float* wd) {
    phase_begin(F); if (blockIdx.x >= 16) return;
    const GAS int* eb = (const GAS int*)(F.ws + WS_MISC + MS_EBASE);
    const unsigned h = (unsigned)dbg_sample(F, 67); const int slot = h % (eb[8] * 256), col = (h >> 16) % DM;
    int ex = 0; for (int j = 1; j < 8; ++j) ex += (slot / 256 >= eb[j]) ? 1 : 0;
    const bf16* hr = (const bf16*)(F.ws + WS_H) + (size_t)slot * DFE; float a = 0.f;
    for (int k = 0; k < DFE; ++k) a += bf2f(hr[k]) * wd[((size_t)ex * DFE + k) * DM + col];
    dbg_put(F, id, relerr(bf2f(((const bf16*)(F.ws + WS_Y))[(size_t)slot * DM + col]), a));
}

__device__ __forceinline__ void chk_u(Frame& F, int id, const float* w_in) {
    phase_begin(F); if (blockIdx.x >= 16) return;
    const unsigned h = (unsigned)dbg_sample(F, 71 + id); const int row = h % TOK, c = (h >> 15) % IN_COLS, pos = row & (SEQ - 1);
    const bf16* xn = (const bf16*)(F.ws + WS_XN) + (size_t)row * DM;
    int c1 = c, c2 = -1; float cs = 1.f, sn = 0.f, sc = 1.f; bool second = false;
    if (is_rope64(c)) { const int seg = c >= C_KW ? C_KW : c >= C_KS ? C_KS : c >= C_KC ? C_KC : C_QN; const int l = c - seg, hb = seg + (l & ~63), dd = l & 63, i = dd & 31;
        c1 = hb + i; c2 = hb + 32 + i; second = dd >= 32; const float ang = (float)pos * INV_N[i]; cs = cosf(ang); sn = sinf(ang); if (seg == C_QN) sc = QSCALE_N; }
    else if (c >= C_KPE && c < C_QN) { const int dd = c - C_KPE, i = dd & 15; c1 = C_KPE + i; c2 = C_KPE + 16 + i; second = dd >= 16; const float ang = (float)pos * INV_M[i]; cs = cosf(ang); sn = sinf(ang); }
    float a1 = 0.f, a2 = 0.f;
    for (int k = 0; k < DM; ++k) { const float a = bf2f(xn[k]); a1 += a * w_in[(size_t)k * IN_COLS + c1]; if (c2 >= 0) a2 += a * w_in[(size_t)k * IN_COLS + c2]; }
    const float ref = (c2 < 0) ? a1 : (second ? (a2 * cs + a1 * sn) * sc : (a1 * cs - a2 * sn) * sc);
    dbg_put(F, id, relerr(bf2f(((const bf16*)(F.ws + WS_U))[(size_t)row * NU + c]), ref));
}
__device__ __forceinline__ void chk_lru(Frame& F, int id, const float* cw, const float* cb, const float* wa, const float* ba, const float* wx, const float* bx, const float* lam) {
    phase_begin(F); if (blockIdx.x >= 2) return;
    const unsigned hs = (unsigned)dbg_sample(F, 91 + id); const int b = hs & 3, pos = (hs >> 2) % 150, d = (hs >> 16) & 255, blk = d >> 6, dd = d & 63;
    const bf16* U = (const bf16*)(F.ws + WS_U); const float sp = logf(1.0f + expf(-lam[d])); float h = 0.f;
    for (int p = 0; p <= pos; ++p) { const size_t t = (size_t)b * SEQ + p; float ra = ba[d], ia = bx[d], xcd = 0.f;
        for (int c = 0; c < 64; ++c) { const int ch = blk * 64 + c; float xc = cb[ch];
            for (int k = 0; k < 4; ++k) { const int pp = p - 3 + k; if (pp >= 0) xc += cw[k * 256 + ch] * bf2f(U[((size_t)b * SEQ + pp) * NU + C_XL + ch]); }
            ra += xc * wa[(size_t)(blk * 64 + c) * 64 + dd]; ia += xc * wx[(size_t)(blk * 64 + c) * 64 + dd]; if (c == dd) xcd = xc; }
        const float r = 1.0f / (1.0f + expf(-ra)), ig = 1.0f / (1.0f + expf(-ia)), la = -8.0f * r * sp, a = expf(la);
        h = a * h + sqrtf(1.0f - expf(2.0f * la)) * (ig * xcd); }
    const size_t t = (size_t)b * SEQ + pos; const float y = bf2f(U[t * NU + C_YL + d]); const float gl = 0.5f * y * (1.0f + tanhf(0.7978845608f * (y + 0.044715f * y * y * y)));
    dbg_put(F, id, relerr(bf2f(((const bf16*)(F.ws + WS_CAT))[t * DM + d]), h * gl));
}

__device__ __forceinline__ void chk_lru_rec(Frame& F, int id, const float* cw, const float* cb, const float* wa, const float* ba, const float* wx, const float* bx, const float* lam) {
    phase_begin(F); if (blockIdx.x >= 8) return;
    const unsigned hs = (unsigned)dbg_sample(F, 191 + id); const int b = hs & 3, pos = 4 + (hs >> 2) % (SEQ - 4), d = (hs >> 16) & 255, blk = d >> 6, dd = d & 63;
    const bf16* U = (const bf16*)(F.ws + WS_U); const bf16* CAT = (const bf16*)(F.ws + WS_CAT); const float sp = logf(1.0f + expf(-lam[d]));
    const size_t t = (size_t)b * SEQ + pos;
    float ra = ba[d], ia = bx[d], xcd = 0.f;
    for (int c = 0; c < 64; ++c) { const int ch = blk * 64 + c; float xc = cb[ch];
        for (int k = 0; k < 4; ++k) xc += cw[k * 256 + ch] * bf2f(U[(t - 3 + k) * NU + C_XL + ch]);
        ra += xc * wa[(size_t)(blk * 64 + c) * 64 + dd]; ia += xc * wx[(size_t)(blk * 64 + c) * 64 + dd]; if (c == dd) xcd = xc; }
    const float r = 1.0f / (1.0f + expf(-ra)), ig = 1.0f / (1.0f + expf(-ia)), la = -8.0f * r * sp, a = expf(la);
    const float y0 = bf2f(U[(t - 1) * NU + C_YL + d]), y1 = bf2f(U[t * NU + C_YL + d]);
    const float g0 = 0.5f * y0 * (1.0f + tanhf(0.7978845608f * (y0 + 0.044715f * y0 * y0 * y0))), g1 = 0.5f * y1 * (1.0f + tanhf(0.7978845608f * (y1 + 0.044715f * y1 * y1 * y1)));
    float err = 0.f;
    if (fabsf(g0) > 0.25f) { const float hp = bf2f(CAT[(t - 1) * DM + d]) / g0; const float ref = (a * hp + sqrtf(1.0f - expf(2.0f * la)) * (ig * xcd)) * g1; err = relerr(bf2f(CAT[t * DM + d]), ref); }
    dbg_put(F, id, err);
}
__device__ __forceinline__ void chk_outproj(Frame& F, int id, const float* base, const float* w_out) {
    phase_begin(F); if (blockIdx.x >= 16) return;
    const unsigned h = (unsigned)dbg_sample(F, 37 + id); const int row = h % TOK, col = (h >> 16) % DM;
    const bf16* cr = (const bf16*)(F.ws + WS_CAT) + (size_t)row * DM; float a = base[(size_t)row * DM + col];
    for (int k = 0; k < DM; ++k) a += bf2f(cr[k]) * w_out[(size_t)k * DM + col];
    dbg_put(F, id, relerr(F.out[(size_t)row * DM + col], a));
}


__device__ __forceinline__ void chk_qkv(Frame& F, int id, const float* qn, const float* wuq, const float* kvn, const float* wukv) {
    phase_begin(F); if (blockIdx.x >= 16) return;
    const unsigned hs = (unsigned)dbg_sample(F, 301 + id); const int row = hs % TOK, pos = row & (SEQ - 1); const bf16* ur = (const bf16*)(F.ws + WS_U) + (size_t)row * NU;
    float err;
    if (hs & 0x80000000u) {
        const int c = (hs >> 15) % 768; float ss = 0.f, a = 0.f;
        for (int k = 0; k < 128; ++k) { const float v = bf2f(ur[C_KVDN + k]); ss += v * v; a += v * kvn[k] * wukv[(size_t)k * 768 + c]; }
        err = relerr(bf2f(((const bf16*)(F.ws + WS_KVM))[(size_t)row * 768 + c]), a / sqrtf(ss / 128.f + EPS));
    } else {
        const int c = (hs >> 15) % 576, hd = c / 96, w = c % 96; int c1 = c, c2 = -1; bool second = false; float cs = 1.f, sn = 0.f;
        if (w >= 64) { const int i = (w - 64) & 15; c1 = hd * 96 + 64 + i; c2 = c1 + 16; second = (w - 64) >= 16; const float ang = (float)pos * INV_M[i]; cs = cosf(ang); sn = sinf(ang); }
        float ss = 0.f, a1 = 0.f, a2 = 0.f;
        for (int k = 0; k < 192; ++k) { const float v = bf2f(ur[C_QDN + k]); ss += v * v; a1 += v * qn[k] * wuq[(size_t)k * 576 + c1]; if (c2 >= 0) a2 += v * qn[k] * wuq[(size_t)k * 576 + c2]; }
        const float rs = QSCALE_M / sqrtf(ss / 192.f + EPS); const float ref = (c2 < 0) ? a1 * rs : (second ? (a2 * cs + a1 * sn) * rs : (a1 * cs - a2 * sn) * rs);
        err = relerr(bf2f(((const bf16*)(F.ws + WS_QM))[(size_t)row * 576 + c]), ref);
    }
    dbg_put(F, id, err);
}
__device__ __forceinline__ void chk_mla(Frame& F, int id) {
    phase_begin(F); if (blockIdx.x >= 4) return;
    const unsigned hs = (unsigned)dbg_sample(F, 401 + id); const int b = hs & 3, h = (hs >> 2) % 6, d = (hs >> 8) & 63, pos = (F.tid < 64) ? (int)((hs >> 14) % SEQ) : (int)((hs >> 14) % 1200);
    const bf16* QM = (const bf16*)(F.ws + WS_QM); const bf16* KVM = (const bf16*)(F.ws + WS_KVM); const bf16* U = (const bf16*)(F.ws + WS_U);
    const size_t t = (size_t)b * SEQ + pos; float m = -1e30f, l = 0.f, o = 0.f;
    for (int k = 0; k <= pos; ++k) { const size_t tk = (size_t)b * SEQ + k; float sc = 0.f;
        for (int j = 0; j < 64; ++j) sc += bf2f(QM[t * 576 + h * 96 + j]) * bf2f(KVM[tk * 768 + h * 128 + j]);
        for (int j = 0; j < 32; ++j) sc += bf2f(QM[t * 576 + h * 96 + 64 + j]) * bf2f(U[tk * NU + C_KPE + j]);
        const float mn = fmaxf(m, sc), al = exp2f(m - mn), p = exp2f(sc - mn); l = l * al + p; o = o * al + p * bf2f(KVM[tk * 768 + h * 128 + 64 + d]); m = mn; }
    dbg_put(F, id, fabsf(bf2f(((const bf16*)(F.ws + WS_CAT))[t * DM + 256 + h * 64 + d]) - o / l) / (fabsf(o / l) + 0.05f));
}

__device__ __forceinline__ void chk_kc(Frame& F, int id, const float* cpos, const float* w1, const float* w2) {
    phase_begin(F); if (blockIdx.x >= 8) return;
    const int grp = F.tid >> 7, j = F.tid & 127; LAS float* red = (LAS float*)F.lds;
    for (int it = 0; it < 4; ++it) {
        const unsigned hs = hsh((unsigned)((blockIdx.x * 4 + grp) * 4 + it) * 7919u + 501u + (unsigned)id); const int sr = hs & 1, b = (hs >> 1) & 3, g = (hs >> 3) & 1, n = (hs >> 4) % 511, d = (hs >> 16) & 63;
        const bf16* U = (const bf16*)(F.ws + WS_U); float y = 0.f;
        for (int l = 0; l < 32; ++l) for (int dd = 0; dd < 64; ++dd) { const float x = bf2f(U[((size_t)b * SEQ + 16 * n + l) * NU + (sr ? C_VC : C_KC) + g * 64 + dd]) + cpos[sr * 2048 + l * 64 + dd];
            y += x * w1[((size_t)sr * 2048 + l * 64 + dd) * 128 + j]; }
        __syncthreads();
        red[F.tid] = 0.5f * y * (1.0f + tanhf(0.7978845608f * (y + 0.044715f * y * y * y))) * w2[((size_t)sr * 128 + j) * 64 + d];
        __syncthreads();
        if (j == 0) { float a = 0.f; for (int k = 0; k < 128; ++k) a += red[grp * 128 + k];
            dbg_put(F, id, fabsf(bf2f(((const bf16*)(F.ws + WS_KC))[((size_t)(sr * 8 + b * 2 + g) * 512 + n) * 64 + d]) - a) / (fabsf(a) + 0.25f)); }
    }
    __syncthreads();
}
__device__ __forceinline__ void chk_nsa(Frame& F, int id, const float* gb) {
    phase_begin(F); if (blockIdx.x >= 1) return;
    const unsigned hs = (unsigned)dbg_sample(F, 601 + id); const int b = hs & 3, h = (hs >> 2) % 6, g = h / 3, d = (hs >> 8) & 63;
    const int pos = (F.tid < 32) ? (int)((hs >> 14) % SEQ) : (F.tid < 256) ? (int)(1024 + (hs >> 14) % 700) : (int)((hs >> 14) % 1100);
    const bf16* U = (const bf16*)(F.ws + WS_U); const bf16* KC = (const bf16*)(F.ws + WS_KC) + (size_t)(b * 2 + g) * KC_HEAD; const bf16* VC = KC + 8 * KC_HEAD;
    float* P3 = (float*)(F.ws + WS_XN + 32 * MiB) + (size_t)F.tid * 1024; float* imp = P3 + 512;
    const size_t t = (size_t)b * SEQ + pos; const int nv = (pos >= 31) ? (pos - 31) / 16 + 1 : 0;
    for (int n = 0; n < 512; ++n) P3[n] = 0.f;
    float oc = 0.f;
    float* SC = P3 + 1024 * 512;
    for (int p = 0; p < 3; ++p) { const int hh = g * 3 + p; float m = -1e30f;
        for (int n = 0; n < nv; ++n) { float sc = 0.f; for (int j = 0; j < 64; ++j) sc += bf2f(U[t * NU + C_QN + hh * 64 + j]) * bf2f(KC[n * 64 + j]); SC[n] = sc; m = fmaxf(m, sc); }
        float l = 0.f; for (int n = 0; n < nv; ++n) l += exp2f(SC[n] - m);
        for (int n = 0; n < nv; ++n) { const float pr = exp2f(SC[n] - m) / l; P3[n] += pr; if (hh == h) oc += pr * bf2f(VC[n * 64 + d]); } }
    const int cur = pos >> 6;
    for (int s2 = 0; s2 < 128; ++s2) { float a = 0.f; for (int n = 4 * s2 - 1; n <= 4 * s2 + 3; ++n) if (n >= 0 && n < nv) a += P3[n]; imp[s2] = (s2 <= cur) ? a : -1.f; }
    unsigned mk[4] = {0u, 0u, 0u, 0u}; float gapmin = 1e9f;
    { int cnt = 0; imp[0] += 1000.f; if (cur != 0) imp[cur] += 1000.f;
      for (int r = 0; r < 16; ++r) { int bi = -1; float bv = -0.5f; for (int s2 = 0; s2 < 128; ++s2) if (imp[s2] > bv) { bv = imp[s2]; bi = s2; } if (bi < 0) break;
          if (r == 15) { float nx = -0.5f; for (int s2 = 0; s2 < 128; ++s2) if (s2 != bi && imp[s2] > nx) nx = imp[s2]; gapmin = bv - nx; }
          imp[bi] = -3.f; const unsigned bit = 1u << (bi & 31); if ((bi >> 5) == 0) mk[0] |= bit; else if ((bi >> 5) == 1) mk[1] |= bit; else if ((bi >> 5) == 2) mk[2] |= bit; else mk[3] |= bit; ++cnt; } }
    const GAS unsigned* km = (const GAS unsigned*)(F.ws + WS_MASK) + ((size_t)(b * 2 + g) * SEQ + pos) * 4;
    const bool same = km[0] == mk[0] && km[1] == mk[1] && km[2] == mk[2] && km[3] == mk[3];
    dbg_put(F, id + 1, (same || gapmin < 2e-3f) ? 0.f : 10.f);
    float m = -1e30f, l = 0.f, os = 0.f;
    for (int k = 0; k <= pos; ++k) { const unsigned w = km[k >> 11]; if (!((w >> ((k >> 6) & 31)) & 1u)) continue; const size_t tk = (size_t)b * SEQ + k; float sc = 0.f;
        for (int j = 0; j < 64; ++j) sc += bf2f(U[t * NU + C_QN + h * 64 + j]) * bf2f(U[tk * NU + C_KS + g * 64 + j]);
        const float mn = fmaxf(m, sc), al = exp2f(m - mn), pr = exp2f(sc - mn); l = l * al + pr; os = os * al + pr * bf2f(U[tk * NU + C_VS + g * 64 + d]); m = mn; }
    os = (l > 0.f) ? os / l : 0.f;
    m = -1e30f; l = 0.f; float ow = 0.f;
    for (int k = (pos - 511 < 0 ? 0 : pos - 511); k <= pos; ++k) { const size_t tk = (size_t)b * SEQ + k; float sc = 0.f;
        for (int j = 0; j < 64; ++j) sc += bf2f(U[t * NU + C_QN + h * 64 + j]) * bf2f(U[tk * NU + C_KW + g * 64 + j]);
        const float mn = fmaxf(m, sc), al = exp2f(m - mn), pr = exp2f(sc - mn); l = l * al + pr; ow = ow * al + pr * bf2f(U[tk * NU + C_VW + g * 64 + d]); m = mn; }
    ow /= l;
    float gt[3]; for (int br = 0; br < 3; ++br) gt[br] = 1.0f / (1.0f + expf(-(bf2f(U[t * NU + C_GN + h * 3 + br]) + gb[h * 3 + br])));
    const float ref = gt[0] * oc + gt[1] * os + gt[2] * ow;
    dbg_put(F, id, fabsf(bf2f(((const bf16*)(F.ws + WS_CAT))[t * DM + 640 + h * 64 + d]) - ref) / (fabsf(ref) + 0.02f));
}
__device__ __forceinline__ void stat_mix(Frame& F, const float* x) {
    phase_begin(F); if (blockIdx.x >= 16) return;
    const unsigned h = (unsigned)dbg_sample(F, 777); const int row = h % TOK, col = (h >> 16) % DM;
    const float d = F.out[(size_t)row * DM + col] - x[(size_t)row * DM + col];
    atomicAdd((float*)(F.ctl + CW_DBG + 40), d * d);
    const float c = bf2f(((const bf16*)(F.ws + WS_CAT))[(size_t)row * DM + (col & 255)]);
    atomicAdd((float*)(F.ctl + CW_DBG + 41), c * c);
}
__device__ __forceinline__ void dbg_finish(Frame& F, int nchk) {
    if (blockIdx.x == 0 && F.tid == 0) { for (int i = 0; i < nchk; ++i) { const float e = __builtin_bit_cast(float, xb_ld((unsigned*)(F.ctl + CW_DBG + i))); if (!(e <= 0.05f)) { F.out[0] = 1000.f * (i + 1); return; } }
#ifdef DBG_STATOUT
        const float st = __builtin_bit_cast(float, xb_ld((unsigned*)(F.ctl + CW_DBG + DBG_STAT))) / 8192.f; F.out[0] = 1.0e5f * st;
#endif
    }
}
#ifdef DBG_ALL
#define DBGRUN(stmt) do { stmt; GRID_BAR(); } while (0)
#else
#define DBGRUN(stmt) do {} while (0)
#endif
#define DBGNEW(stmt) do { stmt; GRID_BAR(); } while (0)
#else
#define DBGNEW(stmt) do {} while (0)
#define DBGRUN(stmt) do {} while (0)
#endif

struct Args { const float* in[28]; float* out; unsigned char* ws; };
#ifndef PHM
#define PHM 0xffff
#endif
__device__ __forceinline__ void grid_bar(Frame& F) {
    XcdBarrier b_; b_.bar = (unsigned*)((gu32*)((unsigned char*)ARGP(29) + WS_CTL) + CW_BAR); b_.x = xb_xcc_id(); b_.st = (volatile LAS unsigned*)(F.lds + MISC_OFF) + 8; phase_begin(F); xcd_barrier(b_, F.tid);
}
#define GRID_BAR() grid_bar(F)

template <int L>
__device__ __forceinline__ void mixer_layer(Frame& F) {
    p_norm<false>(F, L == 0 ? ARGP(0) : (const float*)ARGP(28), ARGP(1) + (size_t)L * DM, nullptr);
    GRID_BAR();
    if (PHM & 1024) { phase_begin(F); SchedPlain S; S.init(TOK / 256, NU / 256, F.G, (int)blockIdx.x); S.lda2 = DM * 2; S.B = (const char*)(F.ws + WS_WIN) + (size_t)L * NU * DM * 2; S.btile = (size_t)256 * DM * 2;
      EpiInProj E{(bf16*)(F.ws + WS_U), (const f32x2*)(F.ws + WS_TABN), (const f32x2*)(F.ws + WS_TABM), (float*)(F.ws + WS_SSQ)};
      pg8::gemm_phase(F.tid, F.lds, (const char*)(F.ws + WS_XN), DM, 128u, (unsigned)DM, S, E);
#if DUP & 4
      GRID_BAR(); pg8::gemm_phase(F.tid, F.lds, (const char*)(F.ws + WS_XN), DM, 128u, (unsigned)DM, S, E);
#endif
    }
    GRID_BAR();
    DBGRUN(chk_u(F, 8 + 3 * L, ARGP(2) + (size_t)L * DM * IN_COLS));
    { phase_begin(F); SchedQKV S; S.init(TOK / 256, 6, F.G, (int)blockIdx.x); S.B = (const char*)(F.ws + WS_WQKV) + (size_t)L * 1536 * 384 * 2;
      EpiQKV E{(bf16*)(F.ws + WS_QM), (bf16*)(F.ws + WS_KVM), (const float*)(F.ws + WS_SSQ), (const f32x2*)(F.ws + WS_TABM)};
      pg8::gemm_phase(F.tid, F.lds, (const char*)(F.ws + WS_U) + C_QDN * 2, 384, 128u, 384u, S, E); }
    { phase_begin(F); SchedCmp S; S.init(32, 1, F.G, (int)blockIdx.x); S.B = (const char*)(F.ws + WS_WC1) + (size_t)L * 2 * 256 * 2048 * 2;
      EpiCmp E{(bf16*)(F.ws + WS_G1C), (const float*)(F.ws + WS_MISC + MS_CBIAS) + L * 256};
      pg8::gemm_phase(F.tid, F.lds, (const char*)(F.ws + WS_U), 2048, (unsigned)(NU * 2), 2048u, S, E); }
    if (PHM & 512) p_lru_local(F, 20 + L, ARGP(3) + (size_t)L * 1024, ARGP(4) + (size_t)L * 256, ARGP(5) + (size_t)L * 16384, ARGP(6) + (size_t)L * 256, ARGP(7) + (size_t)L * 16384, ARGP(8) + (size_t)L * 256, ARGP(9) + (size_t)L * 256);
    GRID_BAR();
#if DUP & 8
#if DUP & 256
    { phase_begin(F); SchedQKV S; S.init(TOK / 256, 6, F.G, (int)blockIdx.x); S.B = (const char*)(F.ws + WS_WQKV) + (size_t)L * 1536 * 384 * 2;
      EpiQKV E{(bf16*)(F.ws + WS_QM), (bf16*)(F.ws + WS_KVM), (const float*)(F.ws + WS_SSQ), (const f32x2*)(F.ws + WS_TABM)};
      pg8::gemm_phase(F.tid, F.lds, (const char*)(F.ws + WS_U) + C_QDN * 2, 384, 128u, 384u, S, E); }
#endif
#if DUP & 512
    { phase_begin(F); SchedCmp S; S.init(32, 1, F.G, (int)blockIdx.x); S.B = (const char*)(F.ws + WS_WC1) + (size_t)L * 2 * 256 * 2048 * 2;
      EpiCmp E{(bf16*)(F.ws + WS_G1C), (const float*)(F.ws + WS_MISC + MS_CBIAS) + L * 256};
      pg8::gemm_phase(F.tid, F.lds, (const char*)(F.ws + WS_U), 2048, (unsigned)(NU * 2), 2048u, S, E); }
#endif
#if DUP & 1024
    if (PHM & 512) p_lru_local(F, 20 + L, ARGP(3) + (size_t)L * 1024, ARGP(4) + (size_t)L * 256, ARGP(5) + (size_t)L * 16384, ARGP(6) + (size_t)L * 256, ARGP(7) + (size_t)L * 16384, ARGP(8) + (size_t)L * 256, ARGP(9) + (size_t)L * 256);
#endif
    GRID_BAR();
#endif
    if (PHM & 8192) p_lru_carry(F);
    p_cmp2(F, ARGP(16) + (size_t)L * 2 * 128 * 64);
    phase_begin(F); unit_publish(F, CW_FLAG + 512 + L);
#if DUP & 64
    if (PHM & 8192) p_lru_carry(F);
    p_cmp2(F, ARGP(16) + (size_t)L * 2 * 128 * 64);
    GRID_BAR();
#endif
    DBGRUN(chk_qkv(F, 16 + L, ARGP(10) + L * 192, ARGP(11) + (size_t)L * 192 * 576, ARGP(12) + L * 128, ARGP(13) + (size_t)L * 128 * 768));
    DBGNEW(chk_kc(F, 20 + L, ARGP(14) + (size_t)L * 4096, ARGP(15) + (size_t)L * 2 * 2048 * 128, ARGP(16) + (size_t)L * 2 * 128 * 64));
    p_attn1(F, 2 * L, ARGP(17) + L * 18);
#if DUP & 3
    GRID_BAR();
#endif
#if DUP & 1
    p_attn1(F, 4 + 2 * L, ARGP(17) + L * 18); GRID_BAR();
#endif
#ifdef ATTVAR
    p_attn2<ATTVAR>(F, 4 + 2 * L + 1, ARGP(17) + L * 18); GRID_BAR();
#endif
    p_attn2<0>(F, 2 * L + 1, ARGP(17) + L * 18);
#if DUP & 2
    GRID_BAR(); p_attn2<0>(F, 4 + 2 * L + 1, ARGP(17) + L * 18);
#endif
    if (PHM & 16384) p_lru_fix(F, 1024);
    GRID_BAR();
    DBGRUN(chk_mla(F, 18 + L));
    DBGNEW(chk_nsa(F, 22 + 2 * L, ARGP(17) + L * 18));
    DBGRUN(chk_lru(F, 9 + 3 * L, ARGP(3) + (size_t)L * 1024, ARGP(4) + (size_t)L * 256, ARGP(5) + (size_t)L * 16384, ARGP(6) + (size_t)L * 256, ARGP(7) + (size_t)L * 16384, ARGP(8) + (size_t)L * 256, ARGP(9) + (size_t)L * 256));
    DBGRUN(chk_lru_rec(F, 14 + L, ARGP(3) + (size_t)L * 1024, ARGP(4) + (size_t)L * 256, ARGP(5) + (size_t)L * 16384, ARGP(6) + (size_t)L * 256, ARGP(7) + (size_t)L * 16384, ARGP(8) + (size_t)L * 256, ARGP(9) + (size_t)L * 256));
    if (PHM & 32768) { phase_begin(F); SchedPlain S; S.init(TOK / 256, DM / 256, F.G, (int)blockIdx.x); S.lda2 = DM * 2; S.B = (const char*)(F.ws + WS_WOUT) + (size_t)L * DM * DM * 2; S.btile = (size_t)256 * DM * 2;
      EpiResF32 E{L == 0 ? ARGP(0) : (const float*)F.out, F.out, DM, ALPHA_MIX};
      pg8::gemm_phase(F.tid, F.lds, (const char*)(F.ws + WS_CAT), DM, 128u, (unsigned)DM, S, E); }
    GRID_BAR();
    if (L == 0) DBGRUN(chk_outproj(F, 10, ARGP(0), ARGP(18)));
    if (L == 0) DBGRUN(stat_mix(F, ARGP(0)));
}
__device__ __forceinline__ void ffn_dense(Frame& F) {
    p_norm<false>(F, (const float*)ARGP(28), ARGP(19), nullptr);
    GRID_BAR();
    DBGRUN(chk_xn(F, 0, F.out, ARGP(19)));
#ifdef GEMMPROBE
    { phase_begin(F); SchedPlain S; S.init(TOK / 256, 2 * DFF / 256, F.G, (int)blockIdx.x); S.lda2 = DM * 2; S.B = (const char*)(F.ws + WS_WGU); S.btile = (size_t)256 * DM * 2;
#if GEMMPROBE == 1
      EpiNull E{};
#else
      EpiSwiGLU E{(bf16*)(F.ws + WS_H), DFF};
#endif
      pg8::gemm_phase(F.tid, F.lds, (const char*)(F.ws + WS_XN), DM, 128u, (unsigned)DM, S, E); GRID_BAR(); }
#endif
    if (PHM & 8) { phase_begin(F); SchedPlain S; S.init(TOK / 256, 2 * DFF / 256, F.G, (int)blockIdx.x); S.lda2 = DM * 2; S.B = (const char*)(F.ws + WS_WGU); S.btile = (size_t)256 * DM * 2;
      EpiSwiGLU E{(bf16*)(F.ws + WS_H), DFF};
      pg8::gemm_phase(F.tid, F.lds, (const char*)(F.ws + WS_XN), DM, 128u, (unsigned)DM, S, E);
#if DUP & 16
      GRID_BAR(); pg8::gemm_phase(F.tid, F.lds, (const char*)(F.ws + WS_XN), DM, 128u, (unsigned)DM, S, E);
#endif
    }
    GRID_BAR();
    DBGRUN(chk_ffn_up(F, 1, ARGP(20), ARGP(21)));
    if (PHM & 16) { phase_begin(F); SchedPlain S; S.init(TOK / 256, DM / 256, F.G, (int)blockIdx.x); S.lda2 = DFF * 2; S.B = (const char*)(F.ws + WS_WD); S.btile = (size_t)256 * DFF * 2;
      EpiResF32 E{F.out, F.out, DM, ALPHA_FFN};
      pg8::gemm_phase(F.tid, F.lds, (const char*)(F.ws + WS_H), DFF, 128u, (unsigned)DFF, S, E); }
    GRID_BAR();
}
__device__ __forceinline__ void ffn_moe(Frame& F) {
    p_norm<true>(F, (const float*)ARGP(28), ARGP(19) + DM, ARGP(23));
    GRID_BAR();
    DBGRUN(chk_xn(F, 3, F.out, ARGP(19) + DM));
    if (PHM & 32) p_scatter(F);
    GRID_BAR();
    DBGRUN(chk_route(F, 4, F.out, ARGP(19) + DM, ARGP(23)));
    if (PHM & 64) { phase_begin(F); const int* ebase = (const int*)(F.ws + WS_MISC + MS_EBASE); const int ntiles = __builtin_amdgcn_readfirstlane(ebase[8]);
      SchedMoeUp S; S.init(ntiles, 2 * DFE / 256, F.G, (int)blockIdx.x); S.lda2 = DM * 2; S.B = (const char*)(F.ws + WS_MWGU); S.btile = (size_t)256 * DM * 2; S.bexp = (size_t)2 * DFE * DM * 2;
      S.rowlist = (const int*)(F.ws + WS_MISC + MS_ROWLIST); S.ebase = ebase;
      EpiSwiGLU E{(bf16*)(F.ws + WS_H), DFE};
      pg8::gemm_phase(F.tid, F.lds, (const char*)(F.ws + WS_XN), DM, 128u, (unsigned)DM, S, E);
#if DUP & 16
      GRID_BAR(); pg8::gemm_phase(F.tid, F.lds, (const char*)(F.ws + WS_XN), DM, 128u, (unsigned)DM, S, E);
#endif
    }
    GRID_BAR();
    DBGRUN(chk_moe_up(F, 6, ARGP(24), ARGP(25)));
    if (PHM & 128) { phase_begin(F); const int* ebase = (const int*)(F.ws + WS_MISC + MS_EBASE); const int ntiles = __builtin_amdgcn_readfirstlane(ebase[8]);
      SchedMoeDown S; S.init(ntiles, DM / 256, F.G, (int)blockIdx.x); S.lda2 = DFE * 2; S.B = (const char*)(F.ws + WS_MWD); S.btile = (size_t)256 * DFE * 2; S.bexp = (size_t)DM * DFE * 2; S.ebase = ebase;
      EpiBf16Plain E{(bf16*)(F.ws + WS_Y), DM};
      pg8::gemm_phase(F.tid, F.lds, (const char*)(F.ws + WS_H), DFE, 128u, (unsigned)DFE, S, E); }
    GRID_BAR();
    DBGRUN(chk_moe_down(F, 7, ARGP(26)));
}

__global__ void __launch_bounds__(NTHR, 2) mk_fwd(Args args) {
    extern __shared__ __attribute__((aligned(16))) unsigned char lds[];
    Frame F;
    F.lds = (LAS unsigned char*)lds;
    F.MISC = (volatile LAS unsigned*)(F.lds + MISC_OFF);
    F.wv = __builtin_amdgcn_readfirstlane((int)threadIdx.x >> 6);
    phase_begin(F);
    for (int u = F.tid; u < (LDS_BYTES - RING_BYTES) / 4; u += NTHR) ((LAS unsigned*)(F.lds + RING_BYTES))[u] = 0u;
    __syncthreads();
    (void)xcd_barrier_post((unsigned*)(F.ctl + CW_BAR), F.MISC + 8, F.wv == 0);

    F.trbase = 0;
    if (PHM & 1) p_prologue_ffn(F, ARGP(20), ARGP(21), ARGP(22), ARGP(24), ARGP(25), ARGP(26));
    if (PHM & 2048) p_prologue_mix(F, ARGP(2), ARGP(18));
    p_prologue_qkv(F, ARGP(10), ARGP(11), ARGP(12), ARGP(13));
    p_prologue_cmp(F, ARGP(15));
    p_cmp_bias(F, ARGP(14), ARGP(15));
#if DUP & 32
    GRID_BAR();
    p_prologue_ffn(F, ARGP(20), ARGP(21), ARGP(22), ARGP(24), ARGP(25), ARGP(26)); p_prologue_mix(F, ARGP(2), ARGP(18)); p_prologue_qkv(F, ARGP(10), ARGP(11), ARGP(12), ARGP(13)); p_prologue_cmp(F, ARGP(15));
#endif
    if (PHM & 4096) p_tables(F);
    GRID_BAR();

    mixer_layer<0>(F);
    ffn_dense(F);
    mixer_layer<1>(F);
    ffn_moe(F);

    phase_begin(F);
    if (xb_ld((unsigned*)(F.ctl + CW_BAR) + XB_TMO) != 0u) p_nan_rows(F);
    else if (PHM & 256) p_combine_final(F, ARGP(27));
#ifdef DBG
    GRID_BAR(); dbg_finish(F, 26);
#endif
}

extern "C" void kernel_launch(void* const* d_in, const int* in_sizes, int n_in, void* d_out, int out_size, void* d_ws, size_t ws_size, hipStream_t stream) {
    static int grid = 0;
    if (grid == 0) {
        if (n_in != 28 || in_sizes[0] != TOK * DM || out_size != TOK * DM || ws_size < WS_END) { fprintf(stderr, "kernel_launch: unexpected shapes (n_in %d, in0 %d, out %d, ws %zu)\n", n_in, n_in > 0 ? in_sizes[0] : -1, out_size, ws_size); grid = -1; return; }
        int dev = 0, cus = 0, per_cu = 0;
        if (hipGetDevice(&dev) != hipSuccess || hipDeviceGetAttribute(&cus, hipDeviceAttributeMultiprocessorCount, dev) != hipSuccess) { grid = -1; return; }
        if (hipFuncSetAttribute((const void*)mk_fwd, hipFuncAttributeMaxDynamicSharedMemorySize, LDS_BYTES) != hipSuccess) { fprintf(stderr, "kernel_launch: hipFuncSetAttribute failed\n"); grid = -1; return; }
        if (hipOccupancyMaxActiveBlocksPerMultiprocessor(&per_cu, (const void*)mk_fwd, NTHR, LDS_BYTES) != hipSuccess || per_cu < 1) fprintf(stderr, "kernel_launch: occupancy query reports %d\n", per_cu);
        (void)hipGetLastError();
        grid = cus;
    }
    if (grid < 0) return;
    if (hipMemsetAsync((char*)d_ws + WS_CTL, 0, CTL_ZERO_BYTES, stream) != hipSuccess) return;
    Args a{};
    for (int i = 0; i < 28; ++i) a.in[i] = (const float*)d_in[i];
    a.out = (float*)d_out; a.ws = (unsigned char*)d_ws;
    hipLaunchKernelGGL(mk_fwd, dim3(grid), dim3(NTHR), LDS_BYTES, stream, a);
}
```
